# Optimizing an MI355X kernel written in HIP

```python
import math
import jax, jax.numpy as jnp
from jax import lax
import numpy as np

D_MODEL = 4096
BATCH = 1
SEQ = 8192
DEPTH = 1
DEC_BATCH = 8
DEC_SEQ = 64
PAST_LEN = 2048

CHUNK = 64
Q_BLOCK = 128
ROPE_THETA = 500000.0
EPS = 1e-6
NEG = -1e30
H_A = 16
DH_A = 64
DV_A = 2 * DH_A
ROT_A = DH_A // 4
SCALE_A = DH_A ** -0.5
H_B = 16
Q_LORA = 896
KV_LORA = 512
D_NOPE = 128
D_ROPE = 64
DV_B = 128
SCALE_B = (D_NOPE + D_ROPE) ** -0.5
D_FF = 11008
CONV_W = 3
N_QK_A = 2 * H_A * DH_A
N_V_A = H_A * DV_A
N_KV_B = KV_LORA + D_ROPE
N_GATE = 2 * D_MODEL
SPLITS = [N_QK_A, 2 * N_QK_A, 2 * N_QK_A + N_V_A, 2 * N_QK_A + N_V_A + Q_LORA,
          2 * N_QK_A + N_V_A + Q_LORA + N_KV_B]
N_IN = SPLITS[-1] + N_GATE

kernel_name = 'gated_diffattn_mla_convffn_stream_step'


def _rmsnorm(x, g):
    xf = x.astype(jnp.float32)
    y = xf * lax.rsqrt(jnp.mean(xf * xf, axis=-1, keepdims=True) + EPS)
    return (y * g.astype(jnp.float32)).astype(x.dtype)


def _rope(x, pos, rot):
    half = rot // 2
    inv = jnp.power(jnp.float32(ROPE_THETA), -jnp.arange(half, dtype=jnp.float32) / half)
    ang = pos.astype(jnp.float32)[:, None] * inv[None, :]
    cos = jnp.cos(ang)[None, :, None, :]
    sin = jnp.sin(ang)[None, :, None, :]
    xr = x[..., :rot].astype(jnp.float32)
    x1, x2 = xr[..., :half], xr[..., half:]
    xr = jnp.concatenate([x1 * cos - x2 * sin, x2 * cos + x1 * sin], axis=-1).astype(x.dtype)
    return jnp.concatenate([xr, x[..., rot:]], axis=-1)


def _diff_attend(q1, q2, k1, k2, v, lam, mask):
    s1 = jnp.einsum('bqhd,bkhd->bhqk', q1, k1).astype(jnp.float32) * SCALE_A
    s2 = jnp.einsum('bqhd,bkhd->bhqk', q2, k2).astype(jnp.float32) * SCALE_A
    if mask is not None:
        s1 = jnp.where(mask, s1, NEG)
        s2 = jnp.where(mask, s2, NEG)
    p = jax.nn.softmax(s1, axis=-1) - lam * jax.nn.softmax(s2, axis=-1)
    return jnp.einsum('bhqk,bkhd->bqhd', p.astype(v.dtype), v)


def _mla_attend(q_nope, q_pe, k_nope, k_pe, v, mask):
    s = (jnp.einsum('bqhd,bkhd->bhqk', q_nope, k_nope)
         + jnp.einsum('bqhd,bkd->bhqk', q_pe, k_pe)).astype(jnp.float32) * SCALE_B
    if mask is not None:
        s = jnp.where(mask, s, NEG)
    p = jax.nn.softmax(s, axis=-1)
    return jnp.einsum('bhqk,bkhd->bqhd', p.astype(v.dtype), v)


def _sweep(fn, qs, T):
    nblk = T // Q_BLOCK
    qb = tuple(jnp.swapaxes(q.reshape(q.shape[0], nblk, Q_BLOCK, *q.shape[2:]), 0, 1) for q in qs)
    kchunk = jnp.arange(T) // CHUNK

    def body(args):
        i, blk = args
        qchunk = (i * Q_BLOCK + jnp.arange(Q_BLOCK)) // CHUNK
        mask = kchunk[None, :] <= qchunk[:, None]
        return fn(*blk, mask)

    out = lax.map(body, (jnp.arange(nblk), qb))
    out = jnp.swapaxes(out, 0, 1)
    return out.reshape(out.shape[0], T, *out.shape[3:])


def _layer(x, pos, past, lam_init, p):
    B, T, _ = x.shape
    xn = _rmsnorm(x, p['g_attn'])
    proj = xn @ p['w_in']
    q_a, k_a, v_a, c_q, c_kv, gate = jnp.split(proj, SPLITS, axis=-1)
    qa = _rope(q_a.reshape(B, T, 2 * H_A, DH_A), pos, ROT_A)
    ka = _rope(k_a.reshape(B, T, 2 * H_A, DH_A), pos, ROT_A)
    va = v_a.reshape(B, T, H_A, DV_A)
    qb = (_rmsnorm(c_q, p['g_qa']) @ p['w_qb']).reshape(B, T, H_B, D_NOPE + D_ROPE)
    qb_nope = qb[..., :D_NOPE]
    qb_pe = _rope(qb[..., D_NOPE:], pos, D_ROPE)
    ckv = _rmsnorm(c_kv[..., :KV_LORA], p['g_kva'])
    kpe = _rope(c_kv[..., None, KV_LORA:], pos, D_ROPE)[:, :, 0]
    if past is None:
        ka_all, va_all, ckv_all, kpe_all = ka, va, ckv, kpe
        conv_past = jnp.zeros((B, CONV_W - 1, D_FF), x.dtype)
    else:
        ka_all = jnp.concatenate([past['dk'], ka], axis=1)
        va_all = jnp.concatenate([past['dv'], va], axis=1)
        ckv_all = jnp.concatenate([past['ckv'], ckv], axis=1)
        kpe_all = jnp.concatenate([past['kpe'], kpe], axis=1)
        conv_past = past['conv']
    kvb = (ckv_all @ p['w_kvb']).reshape(B, -1, H_B, D_NOPE + DV_B)
    kb_nope, vb = kvb[..., :D_NOPE], kvb[..., D_NOPE:]
    f32 = jnp.float32
    lam = (jnp.exp(jnp.sum(p['lam_q1'].astype(f32) * p['lam_k1'].astype(f32)))
           - jnp.exp(jnp.sum(p['lam_q2'].astype(f32) * p['lam_k2'].astype(f32))) + lam_init)
    k1, k2 = ka_all[:, :, :H_A], ka_all[:, :, H_A:]
    q1, q2 = qa[:, :, :H_A], qa[:, :, H_A:]
    fa = lambda a1, a2, mask: _diff_attend(a1, a2, k1, k2, va_all, lam, mask)
    fb = lambda bn, bp, mask: _mla_attend(bn, bp, kb_nope, kpe_all, vb, mask)
    if past is None:
        oa = _sweep(fa, (q1, q2), T)
        ob = _sweep(fb, (qb_nope, qb_pe), T)
    else:
        oa = fa(q1, q2, None)
        ob = fb(qb_nope, qb_pe, None)
    oa = _rmsnorm(oa, p['g_subln']) * (1.0 - lam_init)
    ya = oa.reshape(B, T, H_A * DV_A) @ p['w_branch_a']
    yb = ob.reshape(B, T, H_B * DV_B) @ p['w_branch_b']
    g = jax.nn.sigmoid((gate + p['b_gate']).astype(f32)).astype(x.dtype).reshape(B, T, 2, D_MODEL)
    h = x + (g[:, :, 0] * ya + g[:, :, 1] * yb) @ p['w_out']
    hn = _rmsnorm(h, p['g_ffn'])
    u_g = hn @ p['w_ff_gate']
    u = hn @ p['w_ff_up']
    gp = jnp.concatenate([conv_past, u_g], axis=1)
    c = p['b_conv'] + sum(p['w_conv'][j] * gp[:, j:j + T] for j in range(CONV_W))
    y = h + (jax.nn.silu(c) * u) @ p['w_ff_down']
    return y, (ka, va, ckv, kpe, gp[:, T:])


def setup_inputs(seed: int = 0) -> dict:
    key = jax.random.key(seed)
    ks = jax.random.split(key, 40)
    f32 = jnp.float32
    nrm = lambda k, shape, s: jax.random.normal(k, shape, f32) * s
    gain = lambda k, n: 1.0 + 0.02 * jax.random.normal(k, (DEPTH, n), f32)
    return {
        'x_prompt': nrm(ks[0], (BATCH, SEQ, D_MODEL), 1.0),
        'x_sample': nrm(ks[1], (DEC_BATCH, DEC_SEQ, D_MODEL), 1.0),
        'cache_dk': nrm(ks[2], (DEPTH, DEC_BATCH, PAST_LEN, 2 * H_A, DH_A), 1.0),
        'cache_dv': nrm(ks[3], (DEPTH, DEC_BATCH, PAST_LEN, H_A, DV_A), 1.0),
        'cache_ckv': nrm(ks[4], (DEPTH, DEC_BATCH, PAST_LEN, KV_LORA), 1.0),
        'cache_kpe': nrm(ks[5], (DEPTH, DEC_BATCH, PAST_LEN, D_ROPE), 1.0),
        'state_conv': nrm(ks[6], (DEPTH, DEC_BATCH, CONV_W - 1, D_FF), 1.0),
        'g_attn': gain(ks[7], D_MODEL),
        'w_in': nrm(ks[8], (DEPTH, D_MODEL, N_IN), D_MODEL ** -0.5),
        'lam_q1': nrm(ks[9], (DEPTH, DH_A), 0.1),
        'lam_k1': nrm(ks[10], (DEPTH, DH_A), 0.1),
        'lam_q2': nrm(ks[11], (DEPTH, DH_A), 0.1),
        'lam_k2': nrm(ks[12], (DEPTH, DH_A), 0.1),
        'g_subln': gain(ks[13], DV_A),
        'w_branch_a': nrm(ks[14], (DEPTH, H_A * DV_A, D_MODEL), (H_A * DV_A) ** -0.5),
        'g_qa': gain(ks[15], Q_LORA),
        'w_qb': nrm(ks[16], (DEPTH, Q_LORA, H_B * (D_NOPE + D_ROPE)), Q_LORA ** -0.5),
        'g_kva': gain(ks[17], KV_LORA),
        'w_kvb': nrm(ks[18], (DEPTH, KV_LORA, H_B * (D_NOPE + DV_B)), KV_LORA ** -0.5),
        'w_branch_b': nrm(ks[19], (DEPTH, H_B * DV_B, D_MODEL), (H_B * DV_B) ** -0.5),
        'b_gate': nrm(ks[20], (DEPTH, N_GATE), 0.02),
        'w_out': nrm(ks[21], (DEPTH, D_MODEL, D_MODEL), D_MODEL ** -0.5),
        'g_ffn': gain(ks[22], D_MODEL),
        'w_ff_gate': nrm(ks[23], (DEPTH, D_MODEL, D_FF), D_MODEL ** -0.5),
        'w_ff_up': nrm(ks[24], (DEPTH, D_MODEL, D_FF), D_MODEL ** -0.5),
        'w_conv': nrm(ks[25], (DEPTH, CONV_W, D_FF), CONV_W ** -0.5),
        'b_conv': nrm(ks[26], (DEPTH, D_FF), 0.02),
        'w_ff_down': nrm(ks[27], (DEPTH, D_FF, D_MODEL), D_FF ** -0.5),
        'g_final': 1.0 + 0.02 * jax.random.normal(ks[28], (D_MODEL,), f32),
    }


def reference(x_prompt, x_sample, cache_dk, cache_dv, cache_ckv, cache_kpe, state_conv,
              g_attn, w_in, lam_q1, lam_k1, lam_q2, lam_k2, g_subln, w_branch_a,
              g_qa, w_qb, g_kva, w_kvb, w_branch_b, b_gate, w_out,
              g_ffn, w_ff_gate, w_ff_up, w_conv, b_conv, w_ff_down, g_final):
    T_p = x_prompt.shape[1]
    T_s = x_sample.shape[1]
    P = cache_dk.shape[2]
    pos_p = jnp.arange(T_p)
    pos_s = P + jnp.arange(T_s)
    hp, hs = x_prompt, x_sample
    outs_p, outs_s = [], []
    for l in range(DEPTH):
        lam_init = 0.8 - 0.6 * math.exp(-0.3 * l)
        p = dict(g_attn=g_attn[l], w_in=w_in[l], lam_q1=lam_q1[l], lam_k1=lam_k1[l],
                 lam_q2=lam_q2[l], lam_k2=lam_k2[l], g_subln=g_subln[l], w_branch_a=w_branch_a[l],
                 g_qa=g_qa[l], w_qb=w_qb[l], g_kva=g_kva[l], w_kvb=w_kvb[l], w_branch_b=w_branch_b[l],
                 b_gate=b_gate[l], w_out=w_out[l], g_ffn=g_ffn[l], w_ff_gate=w_ff_gate[l],
                 w_ff_up=w_ff_up[l], w_conv=w_conv[l], b_conv=b_conv[l], w_ff_down=w_ff_down[l])
        hp, st_p = _layer(hp, pos_p, None, lam_init, p)
        past = dict(dk=cache_dk[l], dv=cache_dv[l], ckv=cache_ckv[l], kpe=cache_kpe[l], conv=state_conv[l])
        hs, st_s = _layer(hs, pos_s, past, lam_init, p)
        outs_p.append(st_p)
        outs_s.append(st_s)
    stk = lambda outs, i: jnp.stack([o[i] for o in outs], axis=0)
    y_prompt = _rmsnorm(hp, g_final)
    y_sample = _rmsnorm(hs, g_final)
    return (y_prompt, y_sample,
            stk(outs_p, 0), stk(outs_p, 1), stk(outs_p, 2), stk(outs_p, 3), stk(outs_p, 4),
            stk(outs_s, 0), stk(outs_s, 1), stk(outs_s, 2), stk(outs_s, 3), stk(outs_s, 4))
```

```cpp
#include <hip/hip_runtime.h>
#include <hip/hip_bf16.h>
#include <cstdio>
#include <cstdint>

#ifndef MK_N_LAUNCHES
#define MK_N_LAUNCHES 1
#endif

namespace cfg {
constexpr int DM = 4096, TP = 8192, NB = 8, TS = 64, PAST = 2048;
constexpr int MS = NB * TS;
constexpr int M = TP + MS;
constexpr int NQK = 2048, NVA = 2048, QL = 896, KVL = 512, DR = 64, NG = 8192;
constexpr int NINP = 15872;
constexpr int NRAW = 1536;
constexpr int NQB = 3072, NKVBO = 4096;
constexpr int MKV = TP + NB * (PAST + TS);
constexpr int DFF = 11008;
constexpr float EPS = 1e-6f;
constexpr size_t O_Y = 0, O_DKP = 35651584, O_DVP = 52428800, O_CKVP = 69206016, O_KPEP = 73400320, O_CONVP = 73924608,
                 O_DKS = 73946624, O_DVS = 74995200, O_CKVS = 76043776, O_KPES = 76305920, O_CONVS = 76338688, O_END = 76514816;
}
namespace pg8 {
#define PG8_LAS __attribute__((address_space(3)))
typedef unsigned short bf16_t;
typedef short bf16x8 __attribute__((ext_vector_type(8)));
typedef float f32x4 __attribute__((ext_vector_type(4)));
typedef unsigned u32x4 __attribute__((ext_vector_type(4)));
constexpr int BM = 256, BK = 64, HALF = 128, HTB = HALF * BK * 2  , STAGE_BYTES = 8 * HTB, NXCD = 8, WGM = 8;

__host__ __device__ __forceinline__ int lds_byte(int r, int c) { const int st = (r >> 4) * 2 + (c >> 5), rr = r & 15, cc = c & 31, ob = rr * 64 + cc * 2; return st * 1024 + (ob ^ (((ob >> 9) & 1) << 5)); }
__host__ __device__ __forceinline__ void stage_rc(int b, int& R, int& C) { const int st = b / 1024, sb = b % 1024, swz = sb ^ (((sb >> 9) & 1) << 5); R = (st >> 1) * 16 + swz / 64; C = (st & 1) * 32 + (swz % 64) / 2; }
__host__ __device__ __forceinline__ int perm32(int rho) { const int n = rho >> 4, i = rho & 15; return 8 * (i >> 2) + 4 * n + (i & 3); }

struct Unit { int pm, pn; };
struct Gemm { const bf16_t* A; const bf16_t* Bt; int M, N, K; };

struct StaticOrder {
    int nM, nN, nwg, G, c;
    __host__ __device__ void init(int M, int N, int G_, int c_) { nM = M / BM; nN = N / BM; nwg = nM * nN; G = G_; c = c_; }
    __host__ __device__ bool next(int i, Unit& u) const {
        const long L = (long)i * G + c; if (L >= nwg) return false;
        int wgid = (int)L; { const int q = nwg / NXCD, r = nwg % NXCD, xcd = wgid % NXCD, off = wgid / NXCD; wgid = (xcd < r ? xcd * (q + 1) : r * (q + 1) + (xcd - r) * q) + off; }
        const int nig = WGM * nN, gid = wgid / nig, fm = gid * WGM, gsz = (nM - fm) < WGM ? (nM - fm) : WGM;
        u.pm = fm + ((wgid % nig) % gsz); u.pn = (wgid % nig) / gsz; return true;
    }
    __device__ __forceinline__ void a_ready(const Unit&) const {}
    __device__ __forceinline__ void done(const Unit&) const {}
};

typedef float f32x2c_t __attribute__((ext_vector_type(2))); typedef __bf16 bf16x2c_t __attribute__((ext_vector_type(2)));
__device__ __forceinline__ unsigned cvt_pk_bf16(float lo, float hi) { f32x2c_t v = {lo, hi}; bf16x2c_t b = __builtin_convertvector(v, bf16x2c_t); return __builtin_bit_cast(unsigned, b); }
typedef float f32x2 __attribute__((ext_vector_type(2)));
__device__ __forceinline__ u32x4 pack8(const f32x4 v0, const f32x4 v1) { u32x4 w; w.x = cvt_pk_bf16(v0[0], v0[1]); w.y = cvt_pk_bf16(v0[2], v0[3]); w.z = cvt_pk_bf16(v1[0], v1[1]); w.w = cvt_pk_bf16(v1[2], v1[3]); return w; }
__device__ __forceinline__ void unpack8(const u32x4 w, f32x4& a, f32x4& b) {
    a[0] = __uint_as_float(w.x << 16); a[1] = __uint_as_float(w.x & 0xffff0000u); a[2] = __uint_as_float(w.y << 16); a[3] = __uint_as_float(w.y & 0xffff0000u);
    b[0] = __uint_as_float(w.z << 16); b[1] = __uint_as_float(w.z & 0xffff0000u); b[2] = __uint_as_float(w.w << 16); b[3] = __uint_as_float(w.w & 0xffff0000u); }
__device__ __forceinline__ float sigmoidf_(float x) { return __builtin_amdgcn_rcpf(1.0f + __expf(-x)); }

struct EpiPlain {
    static constexpr bool PERM = true, AFTER_DRAIN = false;
    bf16_t* O; int ldc;
    __device__ __forceinline__ void operator()(const f32x4 (&acc)[2][2][4][2], const Unit& u, int wr, int wc, int fr, int fq) const {
        const int row0 = u.pm * BM + wr * 64 + fr, col0 = u.pn * BM + wc * 32 + 8 * fq;
#pragma unroll
        for (int ai = 0; ai < 2; ++ai)
#pragma unroll
            for (int m = 0; m < 4; ++m) { bf16_t* rowp = O + (size_t)(row0 + ai * HALF + m * 16) * ldc + col0;
#pragma unroll
                for (int bj = 0; bj < 2; ++bj) *(u32x4*)(rowp + bj * HALF) = pack8(acc[ai][bj][m][0], acc[ai][bj][m][1]); }
    }
};

struct EpiIn {
    static constexpr bool PERM = true, AFTER_DRAIN = false;
    bf16_t* QA; bf16_t* KA; bf16_t* VA; bf16_t* G; float* RAW; float* out; const float* b_gate; const float* tabA;
    __device__ __forceinline__ void operator()(const f32x4 (&acc)[2][2][4][2], const Unit& u, int wr, int wc, int fr, int fq) const {
        const int pn = u.pn; const bool smp = u.pm >= 32;
        const int row0 = u.pm * BM + wr * 64 + fr, cw = wc * 32 + 8 * fq;
        if (pn < 16) {
            const bool isk = pn >= 8; bf16_t* dst = isk ? KA : QA; const int cb = (pn & 7) * BM + cw;
            float* fo = out + (smp ? (cfg::O_DKS - (size_t)cfg::TP * 2048) : cfg::O_DKP);
            const bool ropew = (wc & 1) == 0;
#pragma unroll
            for (int ai = 0; ai < 2; ++ai)
#pragma unroll
                for (int m = 0; m < 4; ++m) {
                    const int row = row0 + ai * HALF + m * 16; const int pos = smp ? 2048 + (row & 63) : row;
                    f32x4 t0 = {1.f, 0.f, 1.f, 0.f}, t1 = t0, t2 = t0, t3 = t0;
                    if (ropew) { const f32x4* tp = (const f32x4*)(tabA + (size_t)pos * 16); t0 = tp[0]; t1 = tp[1]; t2 = tp[2]; t3 = tp[3]; }
#pragma unroll
                    for (int bj = 0; bj < 2; ++bj) {
                        f32x4 v0 = acc[ai][bj][m][0], v1 = acc[ai][bj][m][1];
                        if (ropew) {
                            f32x4 p0, p1;
#pragma unroll
                            for (int e = 0; e < 4; ++e) { p0[e] = __shfl_xor(v0[e], 16); p1[e] = __shfl_xor(v1[e], 16); }
                            const float sg = (fq == 0) ? -1.f : 1.f;
                            if (fq < 2) {
                                v0[0] = v0[0] * t0[0] + sg * p0[0] * t0[1]; v0[1] = v0[1] * t0[2] + sg * p0[1] * t0[3];
                                v0[2] = v0[2] * t1[0] + sg * p0[2] * t1[1]; v0[3] = v0[3] * t1[2] + sg * p0[3] * t1[3];
                                v1[0] = v1[0] * t2[0] + sg * p1[0] * t2[1]; v1[1] = v1[1] * t2[2] + sg * p1[1] * t2[3];
                                v1[2] = v1[2] * t3[0] + sg * p1[2] * t3[1]; v1[3] = v1[3] * t3[2] + sg * p1[3] * t3[3];
                            }
                        }
                        const size_t off = (size_t)row * 2048 + cb + bj * HALF;
                        *(u32x4*)(dst + off) = pack8(v0, v1);
                        if (isk) { *(f32x4*)(fo + off) = v0; *(f32x4*)(fo + off + 4) = v1; }
                    }
                }
        } else if (pn < 24) {
            const int cb = (pn - 16) * BM + cw; float* fo = out + (smp ? (cfg::O_DVS - (size_t)cfg::TP * 2048) : cfg::O_DVP);
#pragma unroll
            for (int ai = 0; ai < 2; ++ai)
#pragma unroll
                for (int m = 0; m < 4; ++m) { const int row = row0 + ai * HALF + m * 16;
#pragma unroll
                    for (int bj = 0; bj < 2; ++bj) { const size_t off = (size_t)row * 2048 + cb + bj * HALF; const f32x4 v0 = acc[ai][bj][m][0], v1 = acc[ai][bj][m][1];
                        *(u32x4*)(VA + off) = pack8(v0, v1); *(f32x4*)(fo + off) = v0; *(f32x4*)(fo + off + 4) = v1; } }
        } else if (pn < 56) {
            const int cb = (pn - 24) * BM + cw;
            f32x4 bv[2][2];
#pragma unroll
            for (int bj = 0; bj < 2; ++bj) { bv[bj][0] = *(const f32x4*)(b_gate + cb + bj * HALF); bv[bj][1] = *(const f32x4*)(b_gate + cb + bj * HALF + 4); }
#pragma unroll
            for (int ai = 0; ai < 2; ++ai)
#pragma unroll
                for (int m = 0; m < 4; ++m) { const int row = row0 + ai * HALF + m * 16;
#pragma unroll
                    for (int bj = 0; bj < 2; ++bj) { f32x4 v0 = acc[ai][bj][m][0] + bv[bj][0], v1 = acc[ai][bj][m][1] + bv[bj][1];
#pragma unroll
                        for (int e = 0; e < 4; ++e) { v0[e] = sigmoidf_(v0[e]); v1[e] = sigmoidf_(v1[e]); }
                        *(u32x4*)(G + (size_t)row * 8192 + cb + bj * HALF) = pack8(v0, v1); } }
        } else {
            const int cb = (pn - 56) * BM + cw;
#pragma unroll
            for (int ai = 0; ai < 2; ++ai)
#pragma unroll
                for (int m = 0; m < 4; ++m) { const int row = row0 + ai * HALF + m * 16;
#pragma unroll
                    for (int bj = 0; bj < 2; ++bj) { float* p = RAW + (size_t)row * cfg::NRAW + cb + bj * HALF; *(f32x4*)p = acc[ai][bj][m][0]; *(f32x4*)(p + 4) = acc[ai][bj][m][1]; } }
        }
    }
};

struct EpiQB {
    static constexpr bool PERM = true, AFTER_DRAIN = false;
    bf16_t* QB; const float* tabB;
    __device__ __forceinline__ void operator()(const f32x4 (&acc)[2][2][4][2], const Unit& u, int wr, int wc, int fr, int fq) const {
        const bool smp = u.pm >= 32; const int row0 = u.pm * BM + wr * 64 + fr, col0 = u.pn * BM + wc * 32 + 8 * fq;
#pragma unroll
        for (int bj = 0; bj < 2; ++bj) {
            const int g6 = (u.pn * 8 + bj * 4 + wc) % 6; const bool pe = g6 >= 4; const int i0 = 16 * (g6 - 4) + 4 * fq;
#pragma unroll
            for (int ai = 0; ai < 2; ++ai)
#pragma unroll
                for (int m = 0; m < 4; ++m) { const int row = row0 + ai * HALF + m * 16; const int pos = smp ? 2048 + (row & 63) : row;
                    f32x4 v0 = acc[ai][bj][m][0], v1 = acc[ai][bj][m][1];
                    if (pe) { const f32x4* tp = (const f32x4*)(tabB + ((size_t)pos * 32 + i0) * 2); const f32x4 ta = tp[0], tb = tp[1];
                        f32x4 w0, w1;
                        w0[0] = v0[0] * ta[0] - v0[1] * ta[1]; w0[1] = v0[1] * ta[0] + v0[0] * ta[1];
                        w0[2] = v0[2] * ta[2] - v0[3] * ta[3]; w0[3] = v0[3] * ta[2] + v0[2] * ta[3];
                        w1[0] = v1[0] * tb[0] - v1[1] * tb[1]; w1[1] = v1[1] * tb[0] + v1[0] * tb[1];
                        w1[2] = v1[2] * tb[2] - v1[3] * tb[3]; w1[3] = v1[3] * tb[2] + v1[2] * tb[3];
                        v0 = w0; v1 = w1; }
                    *(u32x4*)(QB + (size_t)row * cfg::NQB + col0 + bj * HALF) = pack8(v0, v1); }
        }
    }
};

struct EpiYA {
    static constexpr bool PERM = true, AFTER_DRAIN = false;
    const bf16_t* G; float* P;
    __device__ __forceinline__ void operator()(const f32x4 (&acc)[2][2][4][2], const Unit& u, int wr, int wc, int fr, int fq) const {
        const int row0 = u.pm * BM + wr * 64 + fr, col0 = u.pn * BM + wc * 32 + 8 * fq;
#pragma unroll
        for (int ai = 0; ai < 2; ++ai)
#pragma unroll
            for (int m = 0; m < 4; ++m) { const int row = row0 + ai * HALF + m * 16;
#pragma unroll
                for (int bj = 0; bj < 2; ++bj) { const int col = col0 + bj * HALF; f32x4 g0, g1; unpack8(*(const u32x4*)(G + (size_t)row * 8192 + col), g0, g1);
                    float* p = P + (size_t)row * 4096 + col;
#ifdef DBG_NOG
                    g0 = (f32x4){1.f, 1.f, 1.f, 1.f}; g1 = g0;
#endif
                    *(f32x4*)p = acc[ai][bj][m][0] * g0; *(f32x4*)(p + 4) = acc[ai][bj][m][1] * g1; } }
    }
};
struct EpiYB {
    static constexpr bool PERM = true, AFTER_DRAIN = false;
    const bf16_t* G; const float* P; bf16_t* MB;
    __device__ __forceinline__ void operator()(const f32x4 (&acc)[2][2][4][2], const Unit& u, int wr, int wc, int fr, int fq) const {
        const int row0 = u.pm * BM + wr * 64 + fr, col0 = u.pn * BM + wc * 32 + 8 * fq;
#pragma unroll
        for (int ai = 0; ai < 2; ++ai)
#pragma unroll
            for (int m = 0; m < 4; ++m) { const int row = row0 + ai * HALF + m * 16;
#pragma unroll
                for (int bj = 0; bj < 2; ++bj) { const int col = col0 + bj * HALF; f32x4 g0, g1; unpack8(*(const u32x4*)(G + (size_t)row * 8192 + 4096 + col), g0, g1);
                    const float* p = P + (size_t)row * 4096 + col; const f32x4 a = *(const f32x4*)p + acc[ai][bj][m][0] * g0, b = *(const f32x4*)(p + 4) + acc[ai][bj][m][1] * g1;
                    *(u32x4*)(MB + (size_t)row * 4096 + col) = pack8(a, b); } }
    }
};
struct EpiRes {
    static constexpr bool PERM = true, AFTER_DRAIN = false;
    const float* base_p; const float* base_s; float* out;
    __device__ __forceinline__ void operator()(const f32x4 (&acc)[2][2][4][2], const Unit& u, int wr, int wc, int fr, int fq) const {
        const int row0 = u.pm * BM + wr * 64 + fr, col0 = u.pn * BM + wc * 32 + 8 * fq; const bool smp = u.pm >= 32;
        const float* bs = smp ? base_s - (size_t)cfg::TP * 4096 : base_p;
#pragma unroll
        for (int ai = 0; ai < 2; ++ai)
#pragma unroll
            for (int m = 0; m < 4; ++m) { const int row = row0 + ai * HALF + m * 16;
#pragma unroll
                for (int bj = 0; bj < 2; ++bj) { const size_t off = (size_t)row * 4096 + col0 + bj * HALF;
                    const f32x4 a = *(const f32x4*)(bs + off) + acc[ai][bj][m][0], b = *(const f32x4*)(bs + off + 4) + acc[ai][bj][m][1];
                    *(f32x4*)(out + off) = a; *(f32x4*)(out + off + 4) = b; } }
    }
};
struct EpiGU {
    static constexpr bool PERM = true, AFTER_DRAIN = false;
    bf16_t* UG; bf16_t* U; float* out;
    __device__ __forceinline__ void operator()(const f32x4 (&acc)[2][2][4][2], const Unit& u, int wr, int wc, int fr, int fq) const {
        const bool up = u.pn >= 43; bf16_t* dst = up ? U : UG; const int colt = (up ? u.pn - 43 : u.pn) * BM;
        const int row0 = u.pm * BM + wr * 64 + fr, col0 = colt + wc * 32 + 8 * fq;
#pragma unroll
        for (int ai = 0; ai < 2; ++ai)
#pragma unroll
            for (int m = 0; m < 4; ++m) { const int row = row0 + ai * HALF + m * 16;
#pragma unroll
                for (int bj = 0; bj < 2; ++bj) { const int col = col0 + bj * HALF;
                    *(u32x4*)(dst + (size_t)row * cfg::DFF + col) = pack8(acc[ai][bj][m][0], acc[ai][bj][m][1]);
                    if (!up && (row & 63) >= 62 && (row >= cfg::TP || row >= cfg::TP - 2)) {
                        float* p = (row < cfg::TP) ? out + cfg::O_CONVP + (size_t)(row - (cfg::TP - 2)) * cfg::DFF + col
                                                   : out + cfg::O_CONVS + (size_t)(((row - cfg::TP) >> 6) * 2 + ((row & 63) - 62)) * cfg::DFF + col;
                        *(f32x4*)p = acc[ai][bj][m][0]; *(f32x4*)(p + 4) = acc[ai][bj][m][1]; } } }
    }
};
template <class Epi, class Sched, bool ALIGN_EPI = false, bool SP2 = false>
__device__ __forceinline__ void gemm_phase(PG8_LAS unsigned char* lds, const Gemm g, const Sched& S, const Epi& E) {
    const int tid = threadIdx.x, wid = __builtin_amdgcn_readfirstlane(tid >> 6), lane = tid & 63, wr = wid >> 2, wc = wid & 3, fr = lane & 15, fq = lane >> 4;
    const int K = g.K, nt = K / BK;
    unsigned voffA[2], voffB[2];
#pragma unroll
    for (int i = 0; i < 2; ++i) { int R, C; stage_rc(tid * 16 + i * 8192, R, C); const int Rb = Epi::PERM ? ((R & ~31) + perm32(R & 31)) : R;
        voffA[i] = (unsigned)(R * K + C) * 2u; voffB[i] = (unsigned)(Rb * K + C) * 2u; }
    const size_t kstep = (size_t)(BK * 2);
    const size_t hstep = (size_t)HALF * K * 2;
    const size_t tstep = 2 * hstep;
    const unsigned ldsw = (unsigned)wid * 1024u;
    const int aoff = lds_byte(wr * 64 + fr, fq * 8), boff = lds_byte(wc * 32 + fr, fq * 8);
#define PG8_SA(b, h) (((b) * 2 + (h)) * HTB)
#define PG8_SB(b, h) ((4 + (b) * 2 + (h)) * HTB)
#define PG8_STAGE(bufoff, gbase, voff) do { _Pragma("unroll") for (int _i = 0; _i < 2; ++_i) \
        __builtin_amdgcn_global_load_lds((const unsigned*)((const char*)(gbase) + (voff)[_i]), (PG8_LAS unsigned*)(lds + (bufoff) + ldsw + _i * 8192), 16, 0, 0); } while (0)
#define PG8_LDA(dst, b, h) do { _Pragma("unroll") for (int m = 0; m < 4; ++m) _Pragma("unroll") for (int k = 0; k < 2; ++k) dst[m][k] = *(const PG8_LAS bf16x8*)(lds + PG8_SA(b, h) + aoff + m * 2048 + k * 1024); } while (0)
#define PG8_LDB(dst, b, h) do { _Pragma("unroll") for (int n = 0; n < 2; ++n) _Pragma("unroll") for (int k = 0; k < 2; ++k) dst[n][k] = *(const PG8_LAS bf16x8*)(lds + PG8_SB(b, h) + boff + n * 2048 + k * 1024); } while (0)
#define PG8_MMA(ai, bj, At, Bt) do { __builtin_amdgcn_s_setprio(1); _Pragma("unroll") for (int m = 0; m < 4; ++m) _Pragma("unroll") for (int n = 0; n < 2; ++n) _Pragma("unroll") for (int k = 0; k < 2; ++k) \
        acc[ai][bj][m][n] = __builtin_amdgcn_mfma_f32_16x16x32_bf16(Bt[n][k], At[m][k], acc[ai][bj][m][n], 0, 0, 0); __builtin_amdgcn_s_setprio(0); } while (0)
#define PG8_WAIT_V(n) asm volatile("s_waitcnt vmcnt(" #n ")" ::: "memory")
#define PG8_WAIT_L(n) asm volatile("s_waitcnt lgkmcnt(" #n ")" ::: "memory")
#define PG8_BAR __builtin_amdgcn_s_barrier()
#define PG8_SCHED __builtin_amdgcn_sched_barrier(0)
    Unit cur, nxt; int ui = 0;
    if (!S.next(0, cur)) return;
    f32x4 acc[2][2][4][2];
#pragma unroll
    for (int a = 0; a < 2; ++a)
#pragma unroll
        for (int b = 0; b < 2; ++b)
#pragma unroll
            for (int m = 0; m < 4; ++m)
#pragma unroll
                for (int n = 0; n < 2; ++n) acc[a][b][m][n] = (f32x4){0.f, 0.f, 0.f, 0.f};
    bf16x8 At[4][2], B0[2][2], B1[2][2];
    const char* cA = (const char*)g.A + (size_t)cur.pm * tstep; const char* cB = (const char*)g.Bt + (size_t)cur.pn * tstep;
    S.a_ready(cur);
    if constexpr (SP2) {
        PG8_STAGE(PG8_SB(0, 0), cB, voffB); PG8_STAGE(PG8_SB(0, 1), cB + hstep, voffB); PG8_STAGE(PG8_SA(0, 0), cA, voffA); PG8_STAGE(PG8_SA(0, 1), cA + hstep, voffA);
        if (wr == 1) PG8_BAR;
        PG8_WAIT_V(2); PG8_BAR;
        PG8_STAGE(PG8_SB(1, 0), cB + kstep, voffB); PG8_STAGE(PG8_SA(1, 0), cA + kstep, voffA); PG8_STAGE(PG8_SB(1, 1), cB + hstep + kstep, voffB);
        PG8_WAIT_V(6); PG8_BAR;
    } else {
        PG8_STAGE(PG8_SB(0, 0), cB, voffB); PG8_STAGE(PG8_SA(0, 0), cA, voffA); PG8_STAGE(PG8_SB(0, 1), cB + hstep, voffB); PG8_STAGE(PG8_SA(0, 1), cA + hstep, voffA);
        if (wr == 1) PG8_BAR;
        PG8_WAIT_V(4); PG8_BAR;
        PG8_STAGE(PG8_SB(1, 0), cB + kstep, voffB); PG8_STAGE(PG8_SA(1, 0), cA + kstep, voffA); PG8_STAGE(PG8_SB(1, 1), cB + hstep + kstep, voffB);
        PG8_WAIT_V(6); PG8_BAR;
    }
    for (;;) {
        const bool has_next = S.next(ui + 1, nxt);
        const char* nA = has_next ? (const char*)g.A + (size_t)nxt.pm * tstep : cA; const char* nB = has_next ? (const char*)g.Bt + (size_t)nxt.pn * tstep : cB;
        for (int t = 0; t < nt; t += 2) {
            const bool last = (t == nt - 2);
            const char* a1 = cA + (size_t)(t + 1) * kstep;
            const char* a2 = last ? nA : cA + (size_t)(t + 2) * kstep; const char* b2 = last ? nB : cB + (size_t)(t + 2) * kstep;
            const char* a3 = a2 + kstep; const char* b3 = b2 + kstep;
            if (last && has_next) S.a_ready(nxt);
            if constexpr (SP2) {
            PG8_LDB(B0, 0, 0); PG8_LDB(B1, 0, 1); PG8_SCHED; PG8_LDA(At, 0, 0); PG8_STAGE(PG8_SA(1, 1), a1 + hstep, voffA);
            PG8_WAIT_V(8); PG8_WAIT_L(0); PG8_BAR; PG8_MMA(0, 0, At, B0); PG8_MMA(0, 1, At, B1); PG8_BAR; PG8_SCHED;
            PG8_LDA(At, 0, 1); PG8_STAGE(PG8_SB(0, 0), b2, voffB); PG8_STAGE(PG8_SB(0, 1), b2 + hstep, voffB); PG8_STAGE(PG8_SA(0, 0), a2, voffA);
            PG8_WAIT_V(8); PG8_WAIT_L(0); PG8_BAR; PG8_MMA(1, 0, At, B0); PG8_MMA(1, 1, At, B1); PG8_BAR; PG8_SCHED;
            PG8_LDB(B0, 1, 0); PG8_LDB(B1, 1, 1); PG8_SCHED; PG8_LDA(At, 1, 0); PG8_STAGE(PG8_SA(0, 1), a2 + hstep, voffA);
            PG8_WAIT_V(8); PG8_WAIT_L(0); PG8_BAR; PG8_MMA(0, 0, At, B0); PG8_MMA(0, 1, At, B1); PG8_BAR; PG8_SCHED;
            PG8_LDA(At, 1, 1); PG8_STAGE(PG8_SB(1, 0), b3, voffB); PG8_STAGE(PG8_SB(1, 1), b3 + hstep, voffB); PG8_STAGE(PG8_SA(1, 0), a3, voffA);
            PG8_WAIT_V(8); PG8_WAIT_L(0); PG8_BAR; PG8_MMA(1, 0, At, B0); PG8_MMA(1, 1, At, B1); PG8_BAR; PG8_SCHED;
            } else {
            PG8_LDB(B0, 0, 0); PG8_SCHED; PG8_LDA(At, 0, 0); PG8_STAGE(PG8_SA(1, 1), a1 + hstep, voffA);
            PG8_WAIT_L(8); PG8_BAR; PG8_WAIT_L(0); PG8_MMA(0, 0, At, B0); PG8_BAR; PG8_SCHED;
            PG8_LDB(B1, 0, 1); PG8_STAGE(PG8_SB(0, 0), b2, voffB);
            PG8_BAR; PG8_WAIT_L(0); PG8_MMA(0, 1, At, B1); PG8_BAR;
            PG8_LDA(At, 0, 1); PG8_STAGE(PG8_SA(0, 0), a2, voffA);
            PG8_BAR; PG8_WAIT_L(0); PG8_MMA(1, 0, At, B0); PG8_BAR; PG8_SCHED;
            PG8_STAGE(PG8_SB(0, 1), b2 + hstep, voffB);
            PG8_WAIT_V(6); PG8_BAR; PG8_MMA(1, 1, At, B1); PG8_BAR;
            PG8_LDB(B0, 1, 0); PG8_SCHED; PG8_LDA(At, 1, 0); PG8_STAGE(PG8_SA(0, 1), a2 + hstep, voffA);
            PG8_WAIT_L(8); PG8_BAR; PG8_WAIT_L(0); PG8_MMA(0, 0, At, B0); PG8_BAR; PG8_SCHED;
            PG8_LDB(B1, 1, 1); PG8_STAGE(PG8_SB(1, 0), b3, voffB);
            PG8_BAR; PG8_WAIT_L(0); PG8_MMA(0, 1, At, B1); PG8_BAR;
            PG8_LDA(At, 1, 1); PG8_STAGE(PG8_SA(1, 0), a3, voffA);
            PG8_BAR; PG8_WAIT_L(0); PG8_MMA(1, 0, At, B0); PG8_BAR; PG8_SCHED;
            PG8_STAGE(PG8_SB(1, 1), b3 + hstep, voffB);
            PG8_WAIT_V(6); PG8_BAR; PG8_MMA(1, 1, At, B1); PG8_BAR;
            }
        }
        if constexpr (ALIGN_EPI) { if (wr == 0) PG8_BAR; }
        if constexpr (!Epi::AFTER_DRAIN) { E(acc, cur, wr, wc, fr, fq); S.done(cur); }
        if (!has_next) break;
#pragma unroll
        for (int a = 0; a < 2; ++a)
#pragma unroll
            for (int b = 0; b < 2; ++b)
#pragma unroll
                for (int m = 0; m < 4; ++m)
#pragma unroll
                    for (int n = 0; n < 2; ++n) acc[a][b][m][n] = (f32x4){0.f, 0.f, 0.f, 0.f};
        cur = nxt; cA = nA; cB = nB; ++ui;
        if constexpr (ALIGN_EPI) { if (wr == 1) PG8_BAR; }
    }
    PG8_WAIT_V(0);
    if constexpr (!ALIGN_EPI) { if (wr == 0) PG8_BAR; }
    PG8_BAR;
    if constexpr (Epi::AFTER_DRAIN) { E.fused(acc, cur, wr, wc, fr, fq, lds, wid, lane); S.done(cur); }
#undef PG8_SA
#undef PG8_SB
#undef PG8_STAGE
#undef PG8_LDA
#undef PG8_LDB
#undef PG8_MMA
#undef PG8_WAIT_V
#undef PG8_WAIT_L
#undef PG8_BAR
#undef PG8_SCHED
}
}
#define GAS __attribute__((address_space(1)))
#define LAS __attribute__((address_space(3)))
typedef unsigned short bf16;
typedef unsigned v4u __attribute__((ext_vector_type(4)));
typedef float f32x4 __attribute__((ext_vector_type(4)));
typedef short bf16x8 __attribute__((ext_vector_type(8)));
typedef GAS unsigned gu32;
typedef GAS unsigned long long gu64;
#define RLX_AGENT __ATOMIC_RELAXED, __HIP_MEMORY_SCOPE_AGENT
#define LDS_WAIT() asm volatile("s_waitcnt lgkmcnt(0)" ::: "memory")
#define VM_WAIT() asm volatile("s_waitcnt vmcnt(0)" ::: "memory")
__device__ __forceinline__ unsigned long long rt() { return __builtin_amdgcn_s_memrealtime(); }
__device__ __forceinline__ unsigned f2bf(float f) { unsigned u = __builtin_bit_cast(unsigned, f); return (u + 0x7fffu + ((u >> 16) & 1u)) >> 16; }
__device__ __forceinline__ unsigned pk2(float lo, float hi) { return f2bf(lo) | (f2bf(hi) << 16); }

#define XB_TMO      128
#define XB_XCNT(j)  (256  + 64 * (j))
#define XB_XSUB(j)  (1280 + 64 * (j))
#define XB_XGEN(j)  (2304 + 64 * (j))
#define XB_TOP      3328
#define XB_TOPGEN   3392
#define XCD_BAR_WORDS 3456
#define XB_SPIN_CAP (1u << 18)

__device__ __forceinline__ unsigned xb_ld(unsigned* p)              { return __hip_atomic_load(p, __ATOMIC_RELAXED, __HIP_MEMORY_SCOPE_AGENT); }
__device__ __forceinline__ unsigned xb_add(unsigned* p, unsigned v) { return __hip_atomic_fetch_add(p, v, __ATOMIC_RELAXED, __HIP_MEMORY_SCOPE_AGENT); }
__device__ __forceinline__ unsigned xb_xcc_id() { return (unsigned)__builtin_amdgcn_s_getreg((3 << 11) | 20) & 0xFu; }
#define XB_SPIN(cond, bar) do { unsigned _sp = 0; while (cond) { __builtin_amdgcn_s_sleep(1); \
    if ((++_sp & 255u) == 0u) { if (xb_ld(&(bar)[XB_TMO])) break; if (_sp > XB_SPIN_CAP) { atomicAdd(&(bar)[XB_TMO], 1u); break; } } } } while (0)

struct XcdBarrier {
    unsigned* bar; unsigned x;
    volatile LAS unsigned* st;
};

__device__ __forceinline__ XcdBarrier xcd_barrier_post(unsigned* bar, volatile LAS unsigned* st) {
    XcdBarrier b; b.bar = bar; b.x = xb_xcc_id(); b.st = st;
    if (threadIdx.x == 0) (void)xb_add(&bar[XB_XCNT(b.x)], 1u);
    return b;
}
__device__ __forceinline__ void xcd_barrier_complete(unsigned* bar, unsigned x, unsigned& nloc, unsigned& nx) {
    const unsigned G = gridDim.x * gridDim.y * gridDim.z;
    unsigned sum, cnt, mine, sp = 0u;
    for (;;) {
        sum = 0u; cnt = 0u; mine = 0u;
#pragma unroll
        for (unsigned j = 0; j < 16; ++j) { const unsigned c = xb_ld(&bar[XB_XCNT(j)]); sum += c; cnt += (c > 0u) ? 1u : 0u; mine = (j == x) ? c : mine; }
        if (sum == G) break;
        __builtin_amdgcn_s_sleep(1);
        if ((++sp & 255u) == 0u) { if (xb_ld(&bar[XB_TMO])) break; if (sp > XB_SPIN_CAP) { atomicAdd(&bar[XB_TMO], 1u); break; } }
    }
    nloc = mine > 0u ? mine : 1u; nx = cnt > 0u ? cnt : 1u;
}

__device__ __forceinline__ void xcd_barrier(const XcdBarrier& b) {
    asm volatile("s_waitcnt vmcnt(0)" ::: "memory");
    __syncthreads();
    if (threadIdx.x == 0) {
        unsigned* bar = b.bar;
        __builtin_amdgcn_s_waitcnt(0);
        unsigned nloc = b.st[0], nx = b.st[1];
        if (nloc == 0u) { xcd_barrier_complete(bar, b.x, nloc, nx); b.st[0] = nloc; b.st[1] = nx; }
        const unsigned old = xb_add(&bar[XB_XSUB(b.x)], 1u);
        const unsigned gen = old / nloc;
        if (old + 1u == (gen + 1u) * nloc) {
            __builtin_amdgcn_fence(__ATOMIC_RELEASE, "agent");
            asm volatile("s_waitcnt vmcnt(0)" ::: "memory");
            const unsigned og = xb_add(&bar[XB_TOP], 1u);
            const unsigned tg = og / nx;
            if (og + 1u == (tg + 1u) * nx) xb_add(&bar[XB_TOPGEN], 1u);
            else XB_SPIN(xb_ld(&bar[XB_TOPGEN]) == tg, bar);
            __builtin_amdgcn_fence(__ATOMIC_ACQUIRE, "agent");
            xb_add(&bar[XB_XGEN(b.x)], 1u);
            asm volatile("s_waitcnt vmcnt(0)" ::: "memory");
        } else {
            XB_SPIN(xb_ld(&bar[XB_XGEN(b.x)]) == gen, bar);
            __builtin_amdgcn_fence(__ATOMIC_ACQUIRE, "agent");
            asm volatile("s_waitcnt vmcnt(0)" ::: "memory");
        }
    }
    __syncthreads();
}
namespace att {
typedef unsigned short bf16_t;
using bf16x8 = __attribute__((ext_vector_type(8))) short;
using s16x4  = __attribute__((ext_vector_type(4))) short;
using f32x16 = __attribute__((ext_vector_type(16))) float;
using f32x8  = __attribute__((ext_vector_type(8))) float;
using u32x4  = __attribute__((ext_vector_type(4))) unsigned;
constexpr int NW = 8, QBLK = 32, KVBLK = 64;
constexpr int SHM_V = KVBLK * 128 * 2;
constexpr int SHM_KMAX = KVBLK * 192 * 2;
constexpr int LDS_V = 0, LDS_K = 2 * SHM_V, LDS_WS = LDS_K + 2 * SHM_KMAX, LDS_BYTES = LDS_WS + NW * 64 * 4;
#define ASBAR() __builtin_amdgcn_sched_barrier(0)
__device__ __forceinline__ int crow(int r, int hi) { return (r & 3) + 8 * (r >> 2) + 4 * hi; }
typedef float f32x2c_t __attribute__((ext_vector_type(2))); typedef __bf16 bf16x2c_t __attribute__((ext_vector_type(2)));
__device__ __forceinline__ unsigned cvtpk(float lo, float hi) { f32x2c_t v = {lo, hi}; bf16x2c_t b = __builtin_convertvector(v, bf16x2c_t); return __builtin_bit_cast(unsigned, b); }
template <typename TIn> struct Stage;
template <> struct Stage<bf16_t> { using T = bf16x8; static constexpr int NLD = 1;
  __device__ static __forceinline__ T ld8(const bf16_t* p) { return *reinterpret_cast<const bf16x8*>(p); }
  __device__ static __forceinline__ bf16x8 tobf(T x) { return x; } };
template <> struct Stage<float> { using T = f32x8; static constexpr int NLD = 2;
  __device__ static __forceinline__ T ld8(const float* p) { return *reinterpret_cast<const f32x8*>(p); }
  __device__ static __forceinline__ bf16x8 tobf(T x) { u32x4 w = {cvtpk(x[0], x[1]), cvtpk(x[2], x[3]), cvtpk(x[4], x[5]), cvtpk(x[6], x[7])}; return *reinterpret_cast<bf16x8*>(&w); } };

template <int NDQ> __device__ __forceinline__ int kswz(int row, int ch) { return row * (32 * NDQ) + ((ch ^ ((row >> 1) & 7)) << 4); }

__device__ __forceinline__ void partialSM(f32x16& p0, f32x16& p1, float& m_reg, float& mn, float& alpha, const float C, const float THRS) {
  float pmax = p0[0];
#pragma unroll
  for (int r = 1; r < 16; ++r) pmax = fmaxf(pmax, p0[r]);
#pragma unroll
  for (int r = 0; r < 16; ++r) pmax = fmaxf(pmax, p1[r]);
  { auto rr = __builtin_amdgcn_permlane32_swap(__float_as_uint(pmax), __float_as_uint(pmax), false, false);
    pmax = fmaxf(__uint_as_float(rr[0]), __uint_as_float(rr[1])); }
  if (__builtin_expect(__all(pmax - m_reg <= THRS), 1)) { mn = m_reg; alpha = 1.f; }
  else { mn = fmaxf(m_reg, pmax); alpha = __builtin_amdgcn_exp2f((m_reg - mn) * C); m_reg = mn; }
  const float mnC = -mn * C;
#pragma unroll
  for (int r = 0; r < 16; ++r) p0[r] = fmaf(p0[r], C, mnC);
#pragma unroll
  for (int r = 0; r < 16; ++r) p1[r] = fmaf(p1[r], C, mnC);
#pragma unroll
  for (int r = 0; r < 16; ++r) p0[r] = __builtin_amdgcn_exp2f(p0[r]);
}
__device__ __forceinline__ void finishSM(f32x16& p0, f32x16& p1, float alpha, float& l_reg, bf16x8& pa0, bf16x8& pa1, bf16x8& pa2, bf16x8& pa3) {
#pragma unroll
  for (int r = 0; r < 16; ++r) p1[r] = __builtin_amdgcn_exp2f(p1[r]);
  float ps = 0;
#pragma unroll
  for (int r = 0; r < 16; ++r) ps += p0[r];
#pragma unroll
  for (int r = 0; r < 16; ++r) ps += p1[r];
  { auto rr = __builtin_amdgcn_permlane32_swap(__float_as_uint(ps), __float_as_uint(ps), false, false);
    ps = __uint_as_float(rr[0]) + __uint_as_float(rr[1]); }
  l_reg = l_reg * alpha + ps;
#define ATT_PK4(P, BASE, OUT) do { unsigned a0 = cvtpk(P[BASE + 0], P[BASE + 1]), a1 = cvtpk(P[BASE + 2], P[BASE + 3]);   \
    unsigned b0 = cvtpk(P[BASE + 4], P[BASE + 5]), b1 = cvtpk(P[BASE + 6], P[BASE + 7]);                              \
    auto r0 = __builtin_amdgcn_permlane32_swap(a0, b0, false, false); auto r1 = __builtin_amdgcn_permlane32_swap(a1, b1, false, false); \
    u32x4 w = {r0[0], r1[0], r0[1], r1[1]}; OUT = *reinterpret_cast<bf16x8*>(&w); } while (0)
  ATT_PK4(p0, 0, pa0); ATT_PK4(p0, 8, pa1); ATT_PK4(p1, 0, pa2); ATT_PK4(p1, 8, pa3);
#undef ATT_PK4
}
template <int NDQ> __device__ __forceinline__ void qkt(f32x16& p0, f32x16& p1, const char* Ks, const bf16x8 (&qr)[NDQ], int r32, int hi) {
  p0 = f32x16{}; p1 = f32x16{};
  const int f = (r32 >> 1) & 7; int kb[4];
#pragma unroll
  for (int q = 0; q < 4; ++q) kb[q] = r32 * (32 * NDQ) + (((2 * q + hi) ^ f) << 4);
#pragma unroll
  for (int d0 = 0; d0 < NDQ; ++d0) { const char* kp = Ks + kb[d0 & 3] + 128 * (d0 >> 2);
    const bf16x8 b0 = *reinterpret_cast<const bf16x8*>(kp);
    const bf16x8 b1 = *reinterpret_cast<const bf16x8*>(kp + 32 * 32 * NDQ);
    p0 = __builtin_amdgcn_mfma_f32_32x32x16_bf16(b0, qr[d0], p0, 0, 0, 0);
    p1 = __builtin_amdgcn_mfma_f32_32x32x16_bf16(b1, qr[d0], p1, 0, 0, 0); }
}
__device__ __forceinline__ int v_st(int k, int c) { const int kk = (k & ~0xC) | ((k & 4) << 1) | ((k & 8) >> 1); return ((kk >> 3) * 4 + (c >> 5)) * 512 + ((kk & 7) * 32 + (c & 31)) * 2; }
__device__ __forceinline__ int v_rd_base(int lane) { return ((lane & 3) << 3) | (((lane >> 2) & 3) << 6) | (((lane >> 4) & 1) << 5) | (((lane >> 5) & 1) << 8); }
constexpr int v_rd_off(int d0, int ks, int half) { return d0 * 512 + ks * 4096 + half * 2048; }
template <int OFF> __device__ __forceinline__ s16x4 tr_read(int vb) { s16x4 r; asm volatile("ds_read_b64_tr_b16 %0, %1 offset:%2" : "=&v"(r) : "v"(vb), "i"(OFF) : "memory"); return r; }
template <int D0> __device__ __forceinline__ void pv_one(f32x16& od, int vb, bf16x8 pa0, bf16x8 pa1, bf16x8 pa2, bf16x8 pa3) {
  const s16x4 l0 = tr_read<v_rd_off(D0, 0, 0)>(vb), h0 = tr_read<v_rd_off(D0, 0, 1)>(vb), l1 = tr_read<v_rd_off(D0, 1, 0)>(vb), h1 = tr_read<v_rd_off(D0, 1, 1)>(vb);
  const s16x4 l2 = tr_read<v_rd_off(D0, 2, 0)>(vb), h2 = tr_read<v_rd_off(D0, 2, 1)>(vb), l3 = tr_read<v_rd_off(D0, 3, 0)>(vb), h3 = tr_read<v_rd_off(D0, 3, 1)>(vb);
  asm volatile("s_waitcnt lgkmcnt(0)" ::: "memory"); ASBAR();
#define ATT_PK(L, H) (bf16x8){L[0], L[1], L[2], L[3], H[0], H[1], H[2], H[3]}
  od = __builtin_amdgcn_mfma_f32_32x32x16_bf16(pa0, ATT_PK(l0, h0), od, 0, 0, 0);
  od = __builtin_amdgcn_mfma_f32_32x32x16_bf16(pa1, ATT_PK(l1, h1), od, 0, 0, 0);
  od = __builtin_amdgcn_mfma_f32_32x32x16_bf16(pa2, ATT_PK(l2, h2), od, 0, 0, 0);
  od = __builtin_amdgcn_mfma_f32_32x32x16_bf16(pa3, ATT_PK(l3, h3), od, 0, 0, 0);
#undef ATT_PK
}
__device__ __forceinline__ void pv_d0(f32x16 (&o)[4], int vb, bf16x8 pa0, bf16x8 pa1, bf16x8 pa2, bf16x8 pa3) {
  pv_one<0>(o[0], vb, pa0, pa1, pa2, pa3); pv_one<1>(o[1], vb, pa0, pa1, pa2, pa3); pv_one<2>(o[2], vb, pa0, pa1, pa2, pa3); pv_one<3>(o[3], vb, pa0, pa1, pa2, pa3);
}

template <typename TKV> struct Src { const TKV* kp; const TKV* kn; const TKV* k2p; const TKV* k2n; const TKV* vp; const TKV* vn; int npast, nvalid; };

template <int NDQ, typename TKV, int LDK, int LDK2, int LDV>
__device__ __forceinline__ void attn_core(const bf16x8 (&qr)[NDQ], const Src<TKV>& S, const int NT, const int limit, const bool active, const float C, const float THRS,
                                          char* lds, f32x16 (&o)[4], float& l_reg) {
  using St = Stage<TKV>;
  constexpr int SHM_K = KVBLK * 32 * NDQ;
  int tid_ = threadIdx.x; asm volatile("" : "+v"(tid_));
  const int tid = tid_, wid = tid >> 6, lane = tid & 63, r32 = lane & 31, hi = lane >> 5;
  char* V_lds = lds + LDS_V; char* K_lds = lds + LDS_K;
  float* al_l = (float*)(lds + LDS_WS) + wid * 64 + 32;
  float m_reg = -1e30f; l_reg = 0.f;
#pragma unroll
  for (int d = 0; d < 4; ++d) o[d] = f32x16{};
  const int sr = tid >> 4, sc = (tid & 15) * 8, vst0 = v_st(sr, sc), vst1 = v_st(32 + sr, sc);
  const int kr8 = tid >> 3, kc8 = tid & 7;
  const int vb0 = (int)(uintptr_t)V_lds + v_rd_base(lane);
  struct Slot { typename St::T vs0, vs1, ks0, ks1, ks2; } sl[1];
#define ATT_SLOAD(i, j) do { const int jj_ = (j) < S.nvalid ? (j) : S.nvalid - 1; const bool ps_ = jj_ < S.npast; const long r0_ = ps_ ? (long)jj_ * 64 : (long)(jj_ - S.npast) * 64; \
    const TKV* vb_ = ps_ ? S.vp : S.vn; const TKV* kb_ = ps_ ? S.kp : S.kn; \
    sl[i].vs0 = St::ld8(vb_ + (r0_ + sr) * LDV + sc); sl[i].vs1 = St::ld8(vb_ + (r0_ + 32 + sr) * LDV + sc); \
    if constexpr (NDQ == 4) { sl[i].ks0 = St::ld8(kb_ + (r0_ + kr8) * LDK + kc8 * 8); } \
    else { const TKV* k2_ = ps_ ? S.k2p : S.k2n; sl[i].ks0 = St::ld8(kb_ + (r0_ + sr) * LDK + sc); sl[i].ks1 = St::ld8(kb_ + (r0_ + 32 + sr) * LDK + sc); sl[i].ks2 = St::ld8(k2_ + (r0_ + kr8) * LDK2 + kc8 * 8); } } while (0)
#define ATT_SWRITE(b, i) do { *(bf16x8*)(V_lds + (b) * SHM_V + vst0) = St::tobf(sl[i].vs0); *(bf16x8*)(V_lds + (b) * SHM_V + vst1) = St::tobf(sl[i].vs1); \
    if constexpr (NDQ == 4) { *(bf16x8*)(K_lds + (b) * SHM_K + kswz<NDQ>(kr8, kc8)) = St::tobf(sl[i].ks0); } \
    else { *(bf16x8*)(K_lds + (b) * SHM_K + kswz<NDQ>(sr, tid & 15)) = St::tobf(sl[i].ks0); *(bf16x8*)(K_lds + (b) * SHM_K + kswz<NDQ>(32 + sr, tid & 15)) = St::tobf(sl[i].ks1); \
           *(bf16x8*)(K_lds + (b) * SHM_K + kswz<NDQ>(kr8, 16 + kc8)) = St::tobf(sl[i].ks2); } } while (0)
#define ATT_RESC(a) do { if (__any((a) < 1.f)) { if (hi == 0) al_l[r32] = (a); asm volatile("s_waitcnt lgkmcnt(0)" ::: "memory"); \
    _Pragma("unroll") for (int d = 0; d < 4; ++d) _Pragma("unroll") for (int r = 0; r < 16; ++r) o[d][r] *= al_l[crow(r, hi)]; } } while (0)
#define ATT_MASK(P0, P1, j) do { if ((j) > limit) { _Pragma("unroll") for (int r = 0; r < 16; ++r) { P0[r] = -1e30f; P1[r] = -1e30f; } } } while (0)
  f32x16 pA0, pA1; float mnA, alA = 1.f; bf16x8 pa0, pa1, pa2, pa3;
  ATT_SLOAD(0, 0); asm volatile("s_waitcnt vmcnt(0)" ::: "memory"); ATT_SWRITE(0, 0); __syncthreads();
#pragma unroll 1
  for (int j = 0; j < NT; ++j) {
    const int cur = j & 1;
    if (j + 1 < NT) ATT_SLOAD(0, j + 1);
    ASBAR();
    if (active) {
      qkt<NDQ>(pA0, pA1, K_lds + cur * SHM_K, qr, r32, hi); ATT_MASK(pA0, pA1, j);
      partialSM(pA0, pA1, m_reg, mnA, alA, C, THRS);
      ATT_RESC(alA);
      finishSM(pA0, pA1, alA, l_reg, pa0, pa1, pa2, pa3);
      ASBAR();
      pv_d0(o, vb0 + cur * SHM_V, pa0, pa1, pa2, pa3);
    }
    ASBAR();
    if (j + 1 < NT) ATT_SWRITE(cur ^ 1, 0);
    __syncthreads();
  }
#undef ATT_SLOAD
#undef ATT_SWRITE
#undef ATT_RESC
#undef ATT_MASK
}
__device__ __forceinline__ void normalize(f32x16 (&o)[4], float l_reg, char* lds, int wid, int r32, int hi) {
  float* li_l = (float*)(lds + LDS_WS) + wid * 64;
  if (hi == 0) li_l[r32] = l_reg;
  asm volatile("s_waitcnt lgkmcnt(0)" ::: "memory");
#pragma unroll
  for (int r = 0; r < 16; ++r) { const float rl = __builtin_amdgcn_rcpf(li_l[crow(r, hi)]);
#pragma unroll
    for (int d = 0; d < 4; ++d) o[d][r] *= rl; }
}
__device__ __forceinline__ unsigned short f2bf1(float f) { unsigned u = __builtin_bit_cast(unsigned, f); return (unsigned short)((u + 0x7fffu + ((u >> 16) & 1u)) >> 16); }

constexpr float LOG2E = 1.4426950408889634f;
constexpr float SCALE_A = 0.125f, SCALE_B = 0.07216878364870322f;
constexpr float THR = 8.f;

template <typename TKV>
__device__ __forceinline__ void diff_unit(const bf16_t* QA, long qrow0, int h, const Src<TKV>& S1, const Src<TKV>& S2, int NT, int limit, bool active, float lam,
                                          const float* g_subln, float* stash, bf16_t* OA, char* lds) {
  asm volatile("" : "+s"(h), "+s"(qrow0));
  const int tid = threadIdx.x, wid = tid >> 6, lane = tid & 63, r32 = lane & 31, hi = lane >> 5;
  const long qrow = qrow0 + (active ? wid * QBLK : 0) + r32;
  f32x16 o[4]; float l_reg; float* st = stash + wid * 4096;
  {
    bf16x8 qr[4];
#pragma unroll
    for (int d0 = 0; d0 < 4; ++d0) qr[d0] = *reinterpret_cast<const bf16x8*>(QA + qrow * 2048 + h * 64 + d0 * 16 + hi * 8);
    attn_core<4, TKV, 2048, 64, 2048>(qr, S1, NT, limit, active, SCALE_A * LOG2E, THR / SCALE_A, lds, o, l_reg);
  }
  if (active) { normalize(o, l_reg, lds, wid, r32, hi);
    __attribute__((address_space(1))) float* st1 = (__attribute__((address_space(1))) float*)(st + lane); asm volatile("" : "+v"(st1));
#pragma unroll
    for (int d = 0; d < 4; ++d)
#pragma unroll
      for (int r = 0; r < 16; ++r) st1[(d * 16 + r) * 64] = o[d][r]; }
  {
    bf16x8 qr[4];
#pragma unroll
    for (int d0 = 0; d0 < 4; ++d0) qr[d0] = *reinterpret_cast<const bf16x8*>(QA + qrow * 2048 + (16 + h) * 64 + d0 * 16 + hi * 8);
    attn_core<4, TKV, 2048, 64, 2048>(qr, S2, NT, limit, active, SCALE_A * LOG2E, THR / SCALE_A, lds, o, l_reg);
  }
  if (active) { normalize(o, l_reg, lds, wid, r32, hi);
    float ss[16];
    const __attribute__((address_space(1))) float* st2 = (const __attribute__((address_space(1))) float*)(st + lane); asm volatile("" : "+v"(st2));
#pragma unroll
    for (int r = 0; r < 16; ++r) ss[r] = 0.f;
#pragma unroll
    for (int d = 0; d < 4; ++d)
#pragma unroll
      for (int r = 0; r < 16; ++r) { const float a = st2[(d * 16 + r) * 64] - lam * o[d][r]; o[d][r] = a; ss[r] += a * a; }
#pragma unroll
    for (int r = 0; r < 16; ++r) { float s = ss[r]; s += __shfl_xor(s, 1); s += __shfl_xor(s, 2); s += __shfl_xor(s, 4); s += __shfl_xor(s, 8); s += __shfl_xor(s, 16);
      ss[r] = 0.8f * rsqrtf(s * (1.f / 128.f) + cfg::EPS); }
    __attribute__((address_space(1))) bf16_t* op = (__attribute__((address_space(1))) bf16_t*)(OA + (qrow0 + wid * QBLK + 4 * hi) * 2048 + h * 128 + r32); asm volatile("" : "+v"(op));
#pragma unroll
    for (int d = 0; d < 4; ++d) { const float g = g_subln[d * 32 + r32];
#pragma unroll
      for (int r = 0; r < 16; ++r) op[((r & 3) + 8 * (r >> 2)) * 2048 + d * 32] = f2bf1(o[d][r] * ss[r] * g); }
  }
}
__device__ __forceinline__ void mla_unit(const bf16_t* QB, long qrow0, int h, const Src<bf16_t>& S, int NT, int limit, bool active, bf16_t* OB, char* lds) {
  asm volatile("" : "+s"(h), "+s"(qrow0));
  const int tid = threadIdx.x, wid = tid >> 6, lane = tid & 63, r32 = lane & 31, hi = lane >> 5;
  const long qrow = qrow0 + (active ? wid * QBLK : 0) + r32;
  f32x16 o[4]; float l_reg;
  bf16x8 qr[12];
#pragma unroll
  for (int d0 = 0; d0 < 12; ++d0) qr[d0] = *reinterpret_cast<const bf16x8*>(QB + qrow * 3072 + h * 192 + d0 * 16 + hi * 8);
  attn_core<12, bf16_t, 4096, 64, 4096>(qr, S, NT, limit, active, SCALE_B * LOG2E, THR / SCALE_B, lds, o, l_reg);
  if (active) { normalize(o, l_reg, lds, wid, r32, hi);
    __attribute__((address_space(1))) bf16_t* op = (__attribute__((address_space(1))) bf16_t*)(OB + (qrow0 + wid * QBLK + 4 * hi) * 2048 + h * 128 + r32); asm volatile("" : "+v"(op));
#pragma unroll
    for (int d = 0; d < 4; ++d)
#pragma unroll
      for (int r = 0; r < 16; ++r) op[((r & 3) + 8 * (r >> 2)) * 2048 + d * 32] = f2bf1(o[d][r]); }
}
#undef ASBAR
}
#ifndef PG8_SP2
#define PG8_SP2 true
#endif
constexpr int NWAVES = 8;
constexpr int NPH = 12;
constexpr int N_LAUNCHES = MK_N_LAUNCHES;
static_assert(N_LAUNCHES == 1 || N_LAUNCHES == NPH, "MK_N_LAUNCHES is 1 or 12");

constexpr size_t MiB = 1u << 20;
constexpr size_t WS_CTL = 0, CTL_ZERO_BYTES = 1 * MiB;
constexpr size_t WS_WIN = 1 * MiB;
constexpr size_t WS_WQB = WS_WIN + (size_t)cfg::NINP * 4096 * 2;
constexpr size_t WS_WKVB = WS_WQB + (size_t)3072 * 896 * 2;
constexpr size_t WS_WBA = WS_WKVB + (size_t)4096 * 512 * 2;
constexpr size_t WS_WBB = WS_WBA + (size_t)4096 * 2048 * 2;
constexpr size_t WS_WOUT = WS_WBB + (size_t)4096 * 2048 * 2;
constexpr size_t WS_WGU = WS_WOUT + (size_t)4096 * 4096 * 2;
constexpr size_t WS_WFD = WS_WGU + (size_t)22016 * 4096 * 2;
constexpr size_t WS_TABA = WS_WFD + (size_t)4096 * 11008 * 2;
constexpr size_t WS_TABB = WS_TABA + (size_t)8192 * 8 * 8;
constexpr size_t WS_XN = WS_TABB + (size_t)8192 * 32 * 8;
constexpr size_t WS_R0 = WS_XN + (size_t)cfg::M * 4096 * 2;
constexpr size_t WS_QA = WS_R0;
constexpr size_t WS_KA = WS_QA + (size_t)cfg::M * 2048 * 2;
constexpr size_t WS_VA = WS_KA + (size_t)cfg::M * 2048 * 2;
constexpr size_t WS_RAW = WS_VA + (size_t)cfg::M * 2048 * 2;
constexpr size_t WS_CQN = WS_RAW + (size_t)cfg::M * cfg::NRAW * 4;
constexpr size_t WS_CKV = WS_CQN + (size_t)cfg::M * 896 * 2;
constexpr size_t WS_KPE = WS_CKV + (size_t)cfg::MKV * 512 * 2;
constexpr size_t WS_QB = WS_KPE + (size_t)cfg::MKV * 64 * 2;
constexpr size_t WS_KVB = WS_QB + (size_t)cfg::M * 3072 * 2;
constexpr size_t WS_G = WS_KVB + (size_t)cfg::MKV * 4096 * 2;
constexpr size_t WS_OA = WS_G + (size_t)cfg::M * 8192 * 2;
constexpr size_t WS_OB = WS_OA + (size_t)cfg::M * 2048 * 2;
constexpr size_t WS_STASH = WS_OB + (size_t)cfg::M * 2048 * 2;
constexpr size_t WS_END = WS_STASH + (size_t)256 * 8 * 4096 * 4;
constexpr size_t WS_MB = WS_QA;
constexpr size_t WS_UG = WS_R0;
constexpr size_t WS_U = WS_UG + (size_t)cfg::M * cfg::DFF * 2;
static_assert(WS_U + (size_t)cfg::M * cfg::DFF * 2 <= WS_END, "FFN overlay fits");
static_assert(WS_END < (size_t)1390 * 1000 * 1000, "workspace budget");
constexpr int CW_TMO = 0, CW_CODE = 1, CW_BAR = 4096;

constexpr int RING_OFF = 0, RING_BYTES = 131072;
constexpr int LDSCTL_OFF = RING_BYTES, MISC_OFF = LDSCTL_OFF + 320;
constexpr int LDS_BYTES = 147456;
static_assert(att::LDS_BYTES <= RING_BYTES && pg8::STAGE_BYTES <= RING_BYTES, "phase scratch fits the ring region");

struct Args { const float* in[29]; float* out; unsigned char* ws; int ph_lo, ph_hi; };
struct Frame {
    LAS unsigned char* lds; volatile LAS unsigned* MISC; gu32* ctl;
    int tid, lane, wave, vcu, G;
    float* out; unsigned char* ws;
};
__device__ __forceinline__ float wave_sum(float v) {
#pragma unroll
    for (int o = 1; o < 64; o <<= 1) v += __shfl_xor(v, o);
    return v;
}
template <int MAP> __device__ __forceinline__ int src_col(int n) {
    if (MAP == 1) { if (n < 6144) return n; if (n < 14336) return 7616 + (n - 6144); if (n < 15808) return 6144 + (n - 14336); return -1; }
    if (MAP == 2) { const int h = n / 192, d = n - h * 192; if (d < 128) return n; const int e = d - 128; return h * 192 + 128 + (e >> 1) + 32 * (e & 1); }
    return n;
}
template <int MAP> __device__ __forceinline__ void p0_transpose_item(const float* W, int K, int Nsrc, int Ndst, bf16* WT, int row_off, LAS float* scr, int item, int lane) {
    const int nblk = Ndst / 32, kb = item / nblk, nb = item - kb * nblk, k0 = 64 * kb, n0 = 32 * nb;
    const int sn = src_col<MAP>(n0 + (lane & 31));
#pragma unroll 8
    for (int i = 0; i < 32; ++i) { const int kk = 2 * i + (lane >> 5); scr[kk * 33 + (lane & 31)] = sn >= 0 ? W[(size_t)(k0 + kk) * Nsrc + sn] : 0.f; }
    LDS_WAIT(); asm volatile("" ::: "memory");
    const int c = lane & 7;
#pragma unroll
    for (int j = 0; j < 4; ++j) { const int n = (lane >> 3) + 8 * j; const LAS float* s = scr + (8 * c) * 33 + n;
        v4u o; o.x = pk2(s[0 * 33], s[1 * 33]); o.y = pk2(s[2 * 33], s[3 * 33]); o.z = pk2(s[4 * 33], s[5 * 33]); o.w = pk2(s[6 * 33], s[7 * 33]);
        *(GAS v4u*)(WT + (size_t)(row_off + n0 + n) * K + k0 + 8 * c) = o; }
    LDS_WAIT(); asm volatile("" ::: "memory");
}
template <typename TO> __device__ __forceinline__ void rms_row4096(const float* xrow, const float* gain, TO* orow, int lane) {
    const GAS f32x4* xr = (const GAS f32x4*)xrow + lane; const GAS f32x4* gr = (const GAS f32x4*)gain + lane;
    f32x4 v[16]; float s = 0.f;
#pragma unroll
    for (int j = 0; j < 16; ++j) { v[j] = xr[64 * j]; s += (v[j].x * v[j].x + v[j].y * v[j].y) + (v[j].z * v[j].z + v[j].w * v[j].w); }
    const float rstd = rsqrtf(wave_sum(s) * (1.f / 4096.f) + cfg::EPS);
#pragma unroll
    for (int j = 0; j < 16; ++j) { const f32x4 g = gr[64 * j]; const f32x4 y = v[j] * rstd * g;
        if constexpr (sizeof(TO) == 2) { ((GAS unsigned long long*)orow)[64 * j + lane] = (unsigned long long)pk2(y.x, y.y) | ((unsigned long long)pk2(y.z, y.w) << 32); }
        else { ((GAS f32x4*)orow)[64 * j + lane] = y; } }
}
__device__ __forceinline__ void p0_prologue(Frame& F, const Args& A) {
    LAS float* scr = (LAS float*)(F.lds + RING_OFF + F.wave * 16384);
    const int gw = F.vcu * NWAVES + F.wave, NGW = F.G * NWAVES;
    unsigned char* ws = F.ws;
    constexpr int I_IN = 64 * (cfg::NINP / 32), I_QB = 14 * 96, I_KVB = 8 * 128, I_BR = 32 * 128, I_OUT = 64 * 128, I_FF = 64 * 344, I_FD = 172 * 128;
    constexpr int NITEMS = I_IN + I_QB + I_KVB + 2 * I_BR + I_OUT + 2 * I_FF + I_FD;
    for (int it = gw; it < NITEMS; it += NGW) {
        int r = it;
        if (r < I_IN) { p0_transpose_item<1>(A.in[8], 4096, 15808, cfg::NINP, (bf16*)(ws + WS_WIN), 0, scr, r, F.lane); continue; } r -= I_IN;
        if (r < I_QB) { p0_transpose_item<2>(A.in[16], 896, 3072, 3072, (bf16*)(ws + WS_WQB), 0, scr, r, F.lane); continue; } r -= I_QB;
        if (r < I_KVB) { p0_transpose_item<0>(A.in[18], 512, 4096, 4096, (bf16*)(ws + WS_WKVB), 0, scr, r, F.lane); continue; } r -= I_KVB;
        if (r < I_BR) { p0_transpose_item<0>(A.in[14], 2048, 4096, 4096, (bf16*)(ws + WS_WBA), 0, scr, r, F.lane); continue; } r -= I_BR;
        if (r < I_BR) { p0_transpose_item<0>(A.in[19], 2048, 4096, 4096, (bf16*)(ws + WS_WBB), 0, scr, r, F.lane); continue; } r -= I_BR;
        if (r < I_OUT) { p0_transpose_item<0>(A.in[21], 4096, 4096, 4096, (bf16*)(ws + WS_WOUT), 0, scr, r, F.lane); continue; } r -= I_OUT;
        if (r < I_FF) { p0_transpose_item<0>(A.in[23], 4096, cfg::DFF, cfg::DFF, (bf16*)(ws + WS_WGU), 0, scr, r, F.lane); continue; } r -= I_FF;
        if (r < I_FF) { p0_transpose_item<0>(A.in[24], 4096, cfg::DFF, cfg::DFF, (bf16*)(ws + WS_WGU), cfg::DFF, scr, r, F.lane); continue; } r -= I_FF;
        p0_transpose_item<0>(A.in[27], cfg::DFF, 4096, 4096, (bf16*)(ws + WS_WFD), 0, scr, r, F.lane);
    }
    for (int m = gw; m < cfg::M; m += NGW) { const float* xr = m < cfg::TP ? A.in[0] + (size_t)m * 4096 : A.in[1] + (size_t)(m - cfg::TP) * 4096;
        rms_row4096<bf16>(xr, A.in[7], (bf16*)(ws + WS_XN) + (size_t)m * 4096, F.lane); }
    const int gt = gw * 64 + F.lane, NGT = NGW * 64;
    float* tabA = (float*)(ws + WS_TABA); float* tabB = (float*)(ws + WS_TABB);
    for (int i = gt; i < 8192 * 40; i += NGT) {
        int pos, fi; float ex; float* dst;
        if (i < 8192 * 8) { pos = i >> 3; fi = i & 7; ex = (float)fi * (1.f / 8.f); dst = tabA + (size_t)i * 2; }
        else { const int k = i - 8192 * 8; pos = k >> 5; fi = k & 31; ex = (float)fi * (1.f / 32.f); dst = tabB + (size_t)k * 2; }
        const float inv = exp2f(-ex * 18.931568569324174f);
        const float ang = (float)pos * inv;
        double rev = (double)ang * 0.15915494309189535; rev -= __builtin_floor(rev);
        const float fr = (float)rev;
        dst[0] = __builtin_amdgcn_cosf(fr); dst[1] = __builtin_amdgcn_sinf(fr);
    }
    { const float* src = A.in[4]; bf16* dst = (bf16*)(ws + WS_CKV) + (size_t)cfg::TP * 512;
      for (int i = gt; i < 16384 * 512 / 8; i += NGT) { const f32x4 a = *(const GAS f32x4*)(src + (size_t)i * 8), b = *(const GAS f32x4*)(src + (size_t)i * 8 + 4);
          v4u o; o.x = pk2(a.x, a.y); o.y = pk2(a.z, a.w); o.z = pk2(b.x, b.y); o.w = pk2(b.z, b.w); *(GAS v4u*)(dst + (size_t)i * 8) = o; } }
    { const float* src = A.in[5]; bf16* dst = (bf16*)(ws + WS_KPE) + (size_t)cfg::TP * 64;
      for (int i = gt; i < 16384 * 8; i += NGT) { const int row = i >> 3, c = i & 7; const f32x4 a = *(const GAS f32x4*)(src + (size_t)row * 64 + 4 * c), b = *(const GAS f32x4*)(src + (size_t)row * 64 + 32 + 4 * c);
          v4u o; o.x = pk2(a.x, b.x); o.y = pk2(a.y, b.y); o.z = pk2(a.z, b.z); o.w = pk2(a.w, b.w); *(GAS v4u*)(dst + (size_t)row * 64 + 8 * c) = o; } }
}
__device__ __forceinline__ void p2_latents(Frame& F, const Args& A) {
    const int gw = F.vcu * NWAVES + F.wave, NGW = F.G * NWAVES, lane = F.lane;
    unsigned char* ws = F.ws; const float* g_qa = A.in[15]; const float* g_kva = A.in[17]; const float* tabB = (const float*)(ws + WS_TABB);
    for (int m = gw; m < cfg::M; m += NGW) {
        const float* raw = (const float*)(ws + WS_RAW) + (size_t)m * cfg::NRAW;
        const bool smp = m >= cfg::TP; const int pos = smp ? 2048 + (m & 63) : m; const size_t mk = smp ? (size_t)m + 16384 : (size_t)m;
        float v[14]; float s = 0.f;
#pragma unroll
        for (int j = 0; j < 14; ++j) { v[j] = raw[64 * j + lane]; s += v[j] * v[j]; }
        float rstd = rsqrtf(wave_sum(s) * (1.f / 896.f) + cfg::EPS);
        bf16* cq = (bf16*)(ws + WS_CQN) + (size_t)m * 896;
#pragma unroll
        for (int j = 0; j < 14; ++j) cq[64 * j + lane] = (bf16)f2bf(v[j] * rstd * g_qa[64 * j + lane]);
        float w[8]; s = 0.f;
#pragma unroll
        for (int j = 0; j < 8; ++j) { w[j] = raw[896 + 64 * j + lane]; s += w[j] * w[j]; }
        rstd = rsqrtf(wave_sum(s) * (1.f / 512.f) + cfg::EPS);
        float* co = smp ? F.out + cfg::O_CKVS + (size_t)(m - cfg::TP) * 512 : F.out + cfg::O_CKVP + (size_t)m * 512;
        bf16* ck = (bf16*)(ws + WS_CKV) + mk * 512;
#pragma unroll
        for (int j = 0; j < 8; ++j) { const float y = w[j] * rstd * g_kva[64 * j + lane]; co[64 * j + lane] = y; ck[64 * j + lane] = (bf16)f2bf(y); }
        if (lane < 32) { const float x1 = raw[1408 + lane], x2 = raw[1440 + lane]; const float c = tabB[((size_t)pos * 32 + lane) * 2], sn = tabB[((size_t)pos * 32 + lane) * 2 + 1];
            const float o1 = x1 * c - x2 * sn, o2 = x2 * c + x1 * sn;
            float* ko = smp ? F.out + cfg::O_KPES + (size_t)(m - cfg::TP) * 64 : F.out + cfg::O_KPEP + (size_t)m * 64;
            ko[lane] = o1; ko[32 + lane] = o2;
            ((GAS unsigned*)((bf16*)(ws + WS_KPE) + mk * 64))[lane] = pk2(o1, o2); }
    }
}
__device__ __forceinline__ void unpack8f(const v4u w, float (&f)[8]) {
    f[0] = __uint_as_float(w.x << 16); f[1] = __uint_as_float(w.x & 0xffff0000u); f[2] = __uint_as_float(w.y << 16); f[3] = __uint_as_float(w.y & 0xffff0000u);
    f[4] = __uint_as_float(w.z << 16); f[5] = __uint_as_float(w.z & 0xffff0000u); f[6] = __uint_as_float(w.w << 16); f[7] = __uint_as_float(w.w & 0xffff0000u); }
__device__ __forceinline__ void p9_convact(Frame& F, const Args& A) {
    const int gt = (F.vcu * NWAVES + F.wave) * 64 + F.lane, NGT = F.G * NWAVES * 64;
    const bf16* UG = (const bf16*)(F.ws + WS_UG); bf16* U = (bf16*)(F.ws + WS_U);
    const float* wc = A.in[25]; const float* bc = A.in[26]; const float* stc = A.in[6];
    constexpr int NCC = cfg::DFF / 8, NRB = cfg::M / 16;
    for (int it = gt; it < NRB * NCC; it += NGT) {
        const int rb = it / NCC, cc = it - rb * NCC, m0 = rb * 16, col = cc * 8;
        float w0[8], w1[8], w2[8], b[8], p2[8], p1[8];
#pragma unroll
        for (int e = 0; e < 8; ++e) { w0[e] = wc[col + e]; w1[e] = wc[cfg::DFF + col + e]; w2[e] = wc[2 * cfg::DFF + col + e]; b[e] = bc[col + e]; }
        const bool start = (m0 == 0) || (m0 >= cfg::TP && (m0 & 63) == 0);
        if (start) {
            if (m0 == 0) {
#pragma unroll
                for (int e = 0; e < 8; ++e) { p2[e] = 0.f; p1[e] = 0.f; }
            } else { const int bb = (m0 - cfg::TP) >> 6;
#pragma unroll
                for (int e = 0; e < 8; ++e) { p2[e] = stc[(size_t)(bb * 2 + 0) * cfg::DFF + col + e]; p1[e] = stc[(size_t)(bb * 2 + 1) * cfg::DFF + col + e]; } }
        } else { unpack8f(*(const GAS v4u*)(UG + (size_t)(m0 - 2) * cfg::DFF + col), p2); unpack8f(*(const GAS v4u*)(UG + (size_t)(m0 - 1) * cfg::DFF + col), p1); }
#pragma unroll 4
        for (int i = 0; i < 16; ++i) { const size_t off = (size_t)(m0 + i) * cfg::DFF + col; float cur[8], uu[8], a[8];
            unpack8f(*(const GAS v4u*)(UG + off), cur); unpack8f(*(const GAS v4u*)(U + off), uu);
#pragma unroll
            for (int e = 0; e < 8; ++e) { const float c = b[e] + w0[e] * p2[e] + w1[e] * p1[e] + w2[e] * cur[e]; a[e] = c * __builtin_amdgcn_rcpf(1.f + __expf(-c)) * uu[e]; p2[e] = p1[e]; p1[e] = cur[e]; }
            v4u o; o.x = pk2(a[0], a[1]); o.y = pk2(a[2], a[3]); o.z = pk2(a[4], a[5]); o.w = pk2(a[6], a[7]); *(GAS v4u*)(U + off) = o; }
    }
}
__device__ __forceinline__ void p4_attention(Frame& F, const Args& A, char* lds) {
    using att::bf16_t; using att::Src;
    unsigned char* ws = F.ws; const int wid = F.wave;
    const bf16_t* QA = (const bf16_t*)(ws + WS_QA); const bf16_t* KA = (const bf16_t*)(ws + WS_KA); const bf16_t* VA = (const bf16_t*)(ws + WS_VA);
    const bf16_t* QB = (const bf16_t*)(ws + WS_QB); const bf16_t* KVB = (const bf16_t*)(ws + WS_KVB); const bf16_t* KPE = (const bf16_t*)(ws + WS_KPE);
    bf16_t* OA = (bf16_t*)(ws + WS_OA); bf16_t* OB = (bf16_t*)(ws + WS_OB);
    float lam;
    { const float a = A.in[9][F.lane] * A.in[10][F.lane], b = A.in[11][F.lane] * A.in[12][F.lane]; lam = __expf(wave_sum(a)) - __expf(wave_sum(b)) + 0.2f; }
    const float* g_subln = A.in[13];
    { const int v = F.vcu & 255;
        float* stash = (float*)(ws + WS_STASH) + (size_t)v * 8 * 4096;
        const int h = v >> 4, s = v & 15;
#ifndef ATT_SEL
#define ATT_SEL 7
#endif
#pragma unroll 1
        for (int k = 0; k < ((ATT_SEL & 1) ? 2 : 0); ++k) {
            const int qb = k ? 31 - s : s, NT = 4 * qb + 4, limit = 4 * qb + (wid >> 1);
            Src<bf16_t> S1{KA + h * 64, KA + h * 64, nullptr, nullptr, VA + h * 128, VA + h * 128, NT, NT};
            Src<bf16_t> S2{KA + (16 + h) * 64, KA + (16 + h) * 64, nullptr, nullptr, VA + h * 128, VA + h * 128, NT, NT};
            att::diff_unit<bf16_t>(QA, (long)qb * 256, h, S1, S2, NT, limit, true, lam, g_subln, stash, OA, lds);
        }
#pragma unroll 1
        for (int k = 0; k < ((ATT_SEL & 2) ? 3 : 0); ++k) {
            if (k < 2) { const int qb = k ? 31 - s : s, NT = 4 * qb + 4, limit = 4 * qb + (wid >> 1);
                Src<bf16_t> S{KVB + h * 256, KVB + h * 256, KPE, KPE, KVB + h * 256 + 128, KVB + h * 256 + 128, NT, NT};
                att::mla_unit(QB, (long)qb * 256, h, S, NT, limit, true, OB, lds);
            } else if (v >= 128) { const int b = (v - 128) >> 4, hh = v & 15;
                const bf16_t* kp = KVB + (size_t)(cfg::TP + b * 2048) * 4096 + hh * 256; const bf16_t* kn = KVB + (size_t)(cfg::TP + 16384 + b * 64) * 4096 + hh * 256;
                Src<bf16_t> S{kp, kn, KPE + (size_t)(cfg::TP + b * 2048) * 64, KPE + (size_t)(cfg::TP + 16384 + b * 64) * 64, kp + 128, kn + 128, 32, 33};
                att::mla_unit(QB, (long)cfg::TP + b * 64, hh, S, 34, 32, wid < 2, OB, lds);
            }
        }
        if ((ATT_SEL & 4) && v < 128) { const int b = v >> 4, hh = v & 15;
            const float* kp = A.in[2] + (size_t)b * 2048 * 2048 + hh * 64; const float* kn = F.out + cfg::O_DKS + (size_t)b * 64 * 2048 + hh * 64;
            const float* vp = A.in[3] + (size_t)b * 2048 * 2048 + hh * 128; const float* vn = F.out + cfg::O_DVS + (size_t)b * 64 * 2048 + hh * 128;
            Src<float> S1{kp, kn, nullptr, nullptr, vp, vn, 32, 33};
            Src<float> S2{kp + 16 * 64, kn + 16 * 64, nullptr, nullptr, vp, vn, 32, 33};
            att::diff_unit<float>(QA, (long)cfg::TP + b * 64, hh, S1, S2, 34, 32, wid < 2, lam, g_subln, stash, OA, lds);
        }
    }
}

__global__ void __launch_bounds__(NWAVES * 64, 2) fwd(Args args) {
    extern __shared__ __attribute__((aligned(16))) unsigned char lds[];
    Frame F;
    F.lds = (LAS unsigned char*)lds; F.MISC = (volatile LAS unsigned*)(F.lds + MISC_OFF);
    F.tid = threadIdx.x; F.lane = F.tid & 63; F.wave = __builtin_amdgcn_readfirstlane(F.tid >> 6);
    F.G = gridDim.x; { const int bx = blockIdx.x; F.vcu = (F.G % 8 == 0) ? (bx % 8) * (F.G / 8) + bx / 8 : bx; }
    F.out = args.out; F.ws = args.ws; unsigned char* ws = args.ws;
    F.ctl = (gu32*)(ws + WS_CTL);
    for (int u = F.tid; u < (LDS_BYTES - LDSCTL_OFF) / 4; u += NWAVES * 64) ((LAS unsigned*)(F.lds + LDSCTL_OFF))[u] = 0u;
    __syncthreads();
    XcdBarrier bar; bar.bar = (unsigned*)(F.ctl + CW_BAR); bar.x = 0; bar.st = nullptr;
    if (N_LAUNCHES == 1) bar = xcd_barrier_post((unsigned*)(F.ctl + CW_BAR), F.MISC + 8);
#define GRID_BAR() do { if (N_LAUNCHES == 1) xcd_barrier(bar); } while (0)
    const int lo = args.ph_lo, hi = args.ph_hi;
#ifndef PH_MASK
#define PH_MASK 0xFFF
#endif
#define IN(k) (((PH_MASK >> (k)) & 1) && lo <= (k) && (k) < hi)
    typedef pg8::bf16_t pb;
    float* Y = args.out + cfg::O_Y;

    if (IN(0)) { p0_prologue(F, args); GRID_BAR(); }
    if (IN(1)) {
        pg8::Gemm g{(const pb*)(ws + WS_XN), (const pb*)(ws + WS_WIN), cfg::M, cfg::NINP, 4096}; pg8::StaticOrder S; S.init(cfg::M, cfg::NINP, F.G, (int)blockIdx.x);
        pg8::EpiIn E{(pb*)(ws + WS_QA), (pb*)(ws + WS_KA), (pb*)(ws + WS_VA), (pb*)(ws + WS_G), (float*)(ws + WS_RAW), args.out, args.in[20], (const float*)(ws + WS_TABA)};
        pg8::gemm_phase<pg8::EpiIn, pg8::StaticOrder, true, PG8_SP2>(F.lds + RING_OFF, g, S, E);
        GRID_BAR();
    }
    if (IN(2)) { p2_latents(F, args); GRID_BAR(); }
    if (IN(3)) {
        { pg8::Gemm g{(const pb*)(ws + WS_CQN), (const pb*)(ws + WS_WQB), cfg::M, cfg::NQB, 896}; pg8::StaticOrder S; S.init(cfg::M, cfg::NQB, F.G, (int)blockIdx.x);
          pg8::EpiQB E{(pb*)(ws + WS_QB), (const float*)(ws + WS_TABB)};
          pg8::gemm_phase<pg8::EpiQB, pg8::StaticOrder, true, PG8_SP2>(F.lds + RING_OFF, g, S, E); }
        __syncthreads();
        { pg8::Gemm g{(const pb*)(ws + WS_CKV), (const pb*)(ws + WS_WKVB), cfg::MKV, cfg::NKVBO, 512}; pg8::StaticOrder S; S.init(cfg::MKV, cfg::NKVBO, F.G, (int)((blockIdx.x + F.G / 2) % F.G));
          pg8::EpiPlain E{(pb*)(ws + WS_KVB), cfg::NKVBO};
          pg8::gemm_phase<pg8::EpiPlain, pg8::StaticOrder, true, PG8_SP2>(F.lds + RING_OFF, g, S, E); }
        GRID_BAR();
    }
    if (IN(4)) { p4_attention(F, args, (char*)lds + RING_OFF); GRID_BAR(); }
    if (IN(5)) {
        { pg8::Gemm g{(const pb*)(ws + WS_OA), (const pb*)(ws + WS_WBA), cfg::M, 4096, 2048}; pg8::StaticOrder S; S.init(cfg::M, 4096, F.G, (int)blockIdx.x);
          pg8::EpiYA E{(const pb*)(ws + WS_G), Y};
          pg8::gemm_phase<pg8::EpiYA, pg8::StaticOrder, true, PG8_SP2>(F.lds + RING_OFF, g, S, E); }
        __syncthreads();
#ifndef SKIP_YB
        { pg8::Gemm g{(const pb*)(ws + WS_OB), (const pb*)(ws + WS_WBB), cfg::M, 4096, 2048}; pg8::StaticOrder S; S.init(cfg::M, 4096, F.G, (int)blockIdx.x);
          pg8::EpiYB E{(const pb*)(ws + WS_G), Y, (pb*)(ws + WS_MB)};
          pg8::gemm_phase<pg8::EpiYB, pg8::StaticOrder, true, PG8_SP2>(F.lds + RING_OFF, g, S, E); }
#endif
        GRID_BAR();
    }
    if (IN(6)) {
        pg8::Gemm g{(const pb*)(ws + WS_MB), (const pb*)(ws + WS_WOUT), cfg::M, 4096, 4096}; pg8::StaticOrder S; S.init(cfg::M, 4096, F.G, (int)blockIdx.x);
        pg8::EpiRes E{args.in[0], args.in[1], Y};
        pg8::gemm_phase<pg8::EpiRes, pg8::StaticOrder, true, PG8_SP2>(F.lds + RING_OFF, g, S, E);
        GRID_BAR();
    }
    if (IN(7)) {
        const int gw = F.vcu * NWAVES + F.wave, NGW = F.G * NWAVES;
        for (int m = gw; m < cfg::M; m += NGW) rms_row4096<bf16>(Y + (size_t)m * 4096, args.in[22], (bf16*)(ws + WS_XN) + (size_t)m * 4096, F.lane);
        GRID_BAR();
    }
    if (IN(8)) {
        pg8::Gemm g{(const pb*)(ws + WS_XN), (const pb*)(ws + WS_WGU), cfg::M, 2 * cfg::DFF, 4096}; pg8::StaticOrder S; S.init(cfg::M, 2 * cfg::DFF, F.G, (int)blockIdx.x);
        pg8::EpiGU E{(pb*)(ws + WS_UG), (pb*)(ws + WS_U), args.out};
        pg8::gemm_phase<pg8::EpiGU, pg8::StaticOrder, true, PG8_SP2>(F.lds + RING_OFF, g, S, E);
        GRID_BAR();
    }
    if (IN(9)) { p9_convact(F, args); GRID_BAR(); }
    if (IN(10)) {
        pg8::Gemm g{(const pb*)(ws + WS_U), (const pb*)(ws + WS_WFD), cfg::M, 4096, cfg::DFF}; pg8::StaticOrder S; S.init(cfg::M, 4096, F.G, (int)blockIdx.x);
        pg8::EpiRes E{Y, Y + (size_t)cfg::TP * 4096, Y};
        pg8::gemm_phase<pg8::EpiRes, pg8::StaticOrder, true, PG8_SP2>(F.lds + RING_OFF, g, S, E);
        GRID_BAR();
    }
    if (IN(11)) {
        const int gw = F.vcu * NWAVES + F.wave, NGW = F.G * NWAVES;
        for (int m = gw; m < cfg::M; m += NGW) rms_row4096<float>(Y + (size_t)m * 4096, args.in[28], Y + (size_t)m * 4096, F.lane);
    }
#ifdef DBG_COPY
    if (lo <= DBG_COPY && DBG_COPY < hi) {
        const size_t gt = (size_t)(F.vcu * NWAVES + F.wave) * 64 + F.lane, NGT = (size_t)F.G * NWAVES * 64;
        const v4u* s0 = (const v4u*)(ws + WS_WQB); v4u* d0 = (v4u*)Y; const size_t n0 = (size_t)(WS_WGU - WS_WQB) / 16;
        for (size_t i = gt; i < n0; i += NGT) d0[i] = s0[i];
        const v4u* s1 = (const v4u*)(ws + WS_WFD); v4u* d1 = d0 + n0; const size_t n1 = (size_t)60000000 / 16;
        for (size_t i = gt; i < n1; i += NGT) d1[i] = s1[i];
    }
#endif
#undef IN
#undef GRID_BAR
}

extern "C" void kernel_launch(void* const* d_in, const int* in_sizes, int n_in, void* d_out, int out_size, void* d_ws, size_t ws_size, hipStream_t stream) {
    static int grid = 0;
    if (grid == 0) {
        if (n_in != 29 || in_sizes[0] != cfg::TP * 4096 || (size_t)out_size != cfg::O_END || ws_size < WS_END) {
            fprintf(stderr, "kernel_launch: shape mismatch: n_in %d in0 %d out %d ws %zu (need %zu); nothing launched\n", n_in, n_in > 0 ? in_sizes[0] : -1, out_size, ws_size, (size_t)WS_END); grid = -1; return; }
        int dev = 0, cus = 0, per_cu = 0;
        if (hipGetDevice(&dev) != hipSuccess || hipDeviceGetAttribute(&cus, hipDeviceAttributeMultiprocessorCount, dev) != hipSuccess) { grid = -1; return; }
        if (hipFuncSetAttribute((const void*)fwd, hipFuncAttributeMaxDynamicSharedMemorySize, LDS_BYTES) != hipSuccess) { fprintf(stderr, "kernel_launch: hipFuncSetAttribute failed\n"); grid = -1; return; }
        if (hipOccupancyMaxActiveBlocksPerMultiprocessor(&per_cu, (const void*)fwd, NWAVES * 64, LDS_BYTES) != hipSuccess || per_cu < 1)
            fprintf(stderr, "kernel_launch: note: occupancy query reports %d workgroups per CU\n", per_cu);
        (void)hipGetLastError();
        grid = cus;
    }
    if (grid < 0) return;
    if (hipMemsetAsync((char*)d_ws + WS_CTL, 0, CTL_ZERO_BYTES, stream) != hipSuccess) { fprintf(stderr, "kernel_launch: memset failed\n"); return; }
    Args a{};
    for (int i = 0; i < 29; ++i) a.in[i] = (const float*)d_in[i];
    a.out = (float*)d_out; a.ws = (unsigned char*)d_ws;
    for (int li = 0; li < N_LAUNCHES; ++li) {
        a.ph_lo = (N_LAUNCHES == 1) ? 0 : li; a.ph_hi = (N_LAUNCHES == 1) ? NPH : li + 1;
        hipLaunchKernelGGL(fwd, dim3(grid), dim3(NWAVES * 64), LDS_BYTES, stream, a);
        const hipError_t le = hipPeekAtLastError();
        if (le != hipSuccess) { fprintf(stderr, "kernel_launch: launch %d failed: %s\n", li, hipGetErrorName(le)); break; }
    }
}
```

```cpp
#include <hip/hip_runtime.h>
#include <hip/hip_bf16.h>
#include <cstdio>
#include <cstdint>

#define DUP_PH -1
#ifndef MK_N_LAUNCHES
#define MK_N_LAUNCHES 1
#endif

namespace cfg {
constexpr int DM = 4096, TP = 8192, NB = 8, TS = 64, PAST = 2048;
constexpr int MS = NB * TS;
constexpr int M = TP + MS;
constexpr int NQK = 2048, NVA = 2048, QL = 896, KVL = 512, DR = 64, NG = 8192;
constexpr int NINP = 15872;
constexpr int NRAW = 1536;
constexpr int NQB = 3072, NKVBO = 4096;
constexpr int MKV = TP + NB * (PAST + TS);
constexpr int DFF = 11008;
constexpr float EPS = 1e-6f;
constexpr size_t O_Y = 0, O_DKP = 35651584, O_DVP = 52428800, O_CKVP = 69206016, O_KPEP = 73400320, O_CONVP = 73924608,
                 O_DKS = 73946624, O_DVS = 74995200, O_CKVS = 76043776, O_KPES = 76305920, O_CONVS = 76338688, O_END = 76514816;
}
namespace pg8 {
#define PG8_LAS __attribute__((address_space(3)))
typedef unsigned short bf16_t;
typedef short bf16x8 __attribute__((ext_vector_type(8)));
typedef float f32x4 __attribute__((ext_vector_type(4)));
typedef unsigned u32x4 __attribute__((ext_vector_type(4)));
constexpr int BM = 256, BK = 64, HALF = 128, HTB = HALF * BK * 2  , STAGE_BYTES = 8 * HTB, NXCD = 8, WGM = 8;

__host__ __device__ __forceinline__ int lds_byte(int r, int c) { const int st = (r >> 4) * 2 + (c >> 5), rr = r & 15, cc = c & 31, ob = rr * 64 + cc * 2; return st * 1024 + (ob ^ (((ob >> 9) & 1) << 5)); }
__host__ __device__ __forceinline__ void stage_rc(int b, int& R, int& C) { const int st = b / 1024, sb = b % 1024, swz = sb ^ (((sb >> 9) & 1) << 5); R = (st >> 1) * 16 + swz / 64; C = (st & 1) * 32 + (swz % 64) / 2; }
__host__ __device__ __forceinline__ int perm32(int rho) { const int n = rho >> 4, i = rho & 15; return 8 * (i >> 2) + 4 * n + (i & 3); }

struct Unit { int pm, pn; };
struct Gemm { const bf16_t* A; const bf16_t* Bt; int M, N, K; };

struct StaticOrder {
    int nM, nN, nwg, G, c;
    __host__ __device__ void init(int M, int N, int G_, int c_) { nM = M / BM; nN = N / BM; nwg = nM * nN; G = G_; c = c_; }
    __host__ __device__ bool next(int i, Unit& u) const {
        const long L = (long)i * G + c; if (L >= nwg) return false;
        int wgid = (int)L; { const int q = nwg / NXCD, r = nwg % NXCD, xcd = wgid % NXCD, off = wgid / NXCD; wgid = (xcd < r ? xcd * (q + 1) : r * (q + 1) + (xcd - r) * q) + off; }
        const int nig = WGM * nN, gid = wgid / nig, fm = gid * WGM, gsz = (nM - fm) < WGM ? (nM - fm) : WGM;
        u.pm = fm + ((wgid % nig) % gsz); u.pn = (wgid % nig) / gsz; return true;
    }
    __device__ __forceinline__ void a_ready(const Unit&) const {}
    __device__ __forceinline__ void done(const Unit&) const {}
};

typedef float f32x2c_t __attribute__((ext_vector_type(2))); typedef __bf16 bf16x2c_t __attribute__((ext_vector_type(2)));
__device__ __forceinline__ unsigned cvt_pk_bf16(float lo, float hi) { f32x2c_t v = {lo, hi}; bf16x2c_t b = __builtin_convertvector(v, bf16x2c_t); return __builtin_bit_cast(unsigned, b); }
typedef float f32x2 __attribute__((ext_vector_type(2)));
__device__ __forceinline__ u32x4 pack8(const f32x4 v0, const f32x4 v1) { u32x4 w; w.x = cvt_pk_bf16(v0[0], v0[1]); w.y = cvt_pk_bf16(v0[2], v0[3]); w.z = cvt_pk_bf16(v1[0], v1[1]); w.w = cvt_pk_bf16(v1[2], v1[3]); return w; }
__device__ __forceinline__ void unpack8(const u32x4 w, f32x4& a, f32x4& b) {
    a[0] = __uint_as_float(w.x << 16); a[1] = __uint_as_float(w.x & 0xffff0000u); a[2] = __uint_as_float(w.y << 16); a[3] = __uint_as_float(w.y & 0xffff0000u);
    b[0] = __uint_as_float(w.z << 16); b[1] = __uint_as_float(w.z & 0xffff0000u); b[2] = __uint_as_float(w.w << 16); b[3] = __uint_as_float(w.w & 0xffff0000u); }
__device__ __forceinline__ float sigmoidf_(float x) { return __builtin_amdgcn_rcpf(1.0f + __expf(-x)); }

struct EpiPlain {
    static constexpr bool PERM = true, AFTER_DRAIN = false;
    bf16_t* O; int ldc;
    __device__ __forceinline__ void operator()(const f32x4 (&acc)[2][2][4][2], const Unit& u, int wr, int wc, int fr, int fq) const {
        const int row0 = u.pm * BM + wr * 64 + fr, col0 = u.pn * BM + wc * 32 + 8 * fq;
#pragma unroll
        for (int ai = 0; ai < 2; ++ai)
#pragma unroll
            for (int m = 0; m < 4; ++m) { bf16_t* rowp = O + (size_t)(row0 + ai * HALF + m * 16) * ldc + col0;
#pragma unroll
                for (int bj = 0; bj < 2; ++bj) *(u32x4*)(rowp + bj * HALF) = pack8(acc[ai][bj][m][0], acc[ai][bj][m][1]); }
    }
};

struct EpiIn {
    static constexpr bool PERM = true, AFTER_DRAIN = false;
    bf16_t* QA; bf16_t* KA; bf16_t* VA; bf16_t* G; float* RAW; float* out; const float* b_gate; const float* tabA;
    __device__ __forceinline__ void operator()(const f32x4 (&acc)[2][2][4][2], const Unit& u, int wr, int wc, int fr, int fq) const {
        const int pn = u.pn; const bool smp = u.pm >= 32;
        const int row0 = u.pm * BM + wr * 64 + fr, cw = wc * 32 + 8 * fq;
        if (pn < 16) {
            const bool isk = pn >= 8; bf16_t* dst = isk ? KA : QA; const int cb = (pn & 7) * BM + cw;
            float* fo = out + (smp ? (cfg::O_DKS - (size_t)cfg::TP * 2048) : cfg::O_DKP);
            const bool ropew = (wc & 1) == 0;
#pragma unroll
            for (int ah = 0; ah < 4; ++ah) {
                const int ai = ah >> 1, mh = ah & 1;
                f32x4 tq[2][4];
                if (ropew) {
#pragma unroll
                    for (int mm = 0; mm < 2; ++mm) { const int row = row0 + ai * HALF + (mh * 2 + mm) * 16; const int pos = smp ? 2048 + (row & 63) : row; const f32x4* tp = (const f32x4*)(tabA + (size_t)pos * 16);
                        tq[mm][0] = tp[0]; tq[mm][1] = tp[1]; tq[mm][2] = tp[2]; tq[mm][3] = tp[3]; } }
#pragma unroll
                for (int mm = 0; mm < 2; ++mm) {
                    const int m = mh * 2 + mm; const int row = row0 + ai * HALF + m * 16;
                    f32x4 t0 = {1.f, 0.f, 1.f, 0.f}, t1 = t0, t2 = t0, t3 = t0;
                    if (ropew) { t0 = tq[mm][0]; t1 = tq[mm][1]; t2 = tq[mm][2]; t3 = tq[mm][3]; }
#pragma unroll
                    for (int bj = 0; bj < 2; ++bj) {
                        f32x4 v0 = acc[ai][bj][m][0], v1 = acc[ai][bj][m][1];
                        if (ropew) {
                            f32x4 p0, p1;
#pragma unroll
                            for (int e = 0; e < 4; ++e) { p0[e] = __shfl_xor(v0[e], 16); p1[e] = __shfl_xor(v1[e], 16); }
                            const float sg = (fq == 0) ? -1.f : 1.f;
                            if (fq < 2) {
                                v0[0] = v0[0] * t0[0] + sg * p0[0] * t0[1]; v0[1] = v0[1] * t0[2] + sg * p0[1] * t0[3];
                                v0[2] = v0[2] * t1[0] + sg * p0[2] * t1[1]; v0[3] = v0[3] * t1[2] + sg * p0[3] * t1[3];
                                v1[0] = v1[0] * t2[0] + sg * p1[0] * t2[1]; v1[1] = v1[1] * t2[2] + sg * p1[1] * t2[3];
                                v1[2] = v1[2] * t3[0] + sg * p1[2] * t3[1]; v1[3] = v1[3] * t3[2] + sg * p1[3] * t3[3];
                            }
                        }
                        const size_t off = (size_t)row * 2048 + cb + bj * HALF;
                        *(u32x4*)(dst + off) = pack8(v0, v1);
                        if (isk) { *(f32x4*)(fo + off) = v0; *(f32x4*)(fo + off + 4) = v1; }
                    }
                }
            }
        } else if (pn < 24) {
            const int cb = (pn - 16) * BM + cw; float* fo = out + (smp ? (cfg::O_DVS - (size_t)cfg::TP * 2048) : cfg::O_DVP);
#pragma unroll
            for (int ai = 0; ai < 2; ++ai)
#pragma unroll
                for (int m = 0; m < 4; ++m) { const int row = row0 + ai * HALF + m * 16;
#pragma unroll
                    for (int bj = 0; bj < 2; ++bj) { const size_t off = (size_t)row * 2048 + cb + bj * HALF; const f32x4 v0 = acc[ai][bj][m][0], v1 = acc[ai][bj][m][1];
                        *(u32x4*)(VA + off) = pack8(v0, v1); *(f32x4*)(fo + off) = v0; *(f32x4*)(fo + off + 4) = v1; } }
        } else if (pn < 56) {
            const int cb = (pn - 24) * BM + cw;
            f32x4 bv[2][2];
#pragma unroll
            for (int bj = 0; bj < 2; ++bj) { bv[bj][0] = *(const f32x4*)(b_gate + cb + bj * HALF); bv[bj][1] = *(const f32x4*)(b_gate + cb + bj * HALF + 4); }
#pragma unroll
            for (int ai = 0; ai < 2; ++ai)
#pragma unroll
                for (int m = 0; m < 4; ++m) { const int row = row0 + ai * HALF + m * 16;
#pragma unroll
                    for (int bj = 0; bj < 2; ++bj) { f32x4 v0 = acc[ai][bj][m][0] + bv[bj][0], v1 = acc[ai][bj][m][1] + bv[bj][1];
#pragma unroll
                        for (int e = 0; e < 4; ++e) { v0[e] = sigmoidf_(v0[e]); v1[e] = sigmoidf_(v1[e]); }
                        *(u32x4*)(G + (size_t)row * 8192 + cb + bj * HALF) = pack8(v0, v1); } }
        } else {
            const int cb = (pn - 56) * BM + cw;
#pragma unroll
            for (int ai = 0; ai < 2; ++ai)
#pragma unroll
                for (int m = 0; m < 4; ++m) { const int row = row0 + ai * HALF + m * 16;
#pragma unroll
                    for (int bj = 0; bj < 2; ++bj) { float* p = RAW + (size_t)row * cfg::NRAW + cb + bj * HALF; *(f32x4*)p = acc[ai][bj][m][0]; *(f32x4*)(p + 4) = acc[ai][bj][m][1]; } }
        }
    }
};

struct EpiQB {
    static constexpr bool PERM = true, AFTER_DRAIN = false;
    bf16_t* QB; const float* tabB;
    __device__ __forceinline__ void operator()(const f32x4 (&acc)[2][2][4][2], const Unit& u, int wr, int wc, int fr, int fq) const {
        const bool smp = u.pm >= 32; const int row0 = u.pm * BM + wr * 64 + fr, col0 = u.pn * BM + wc * 32 + 8 * fq;
#pragma unroll
        for (int bj = 0; bj < 2; ++bj) {
            const int g6 = (u.pn * 8 + bj * 4 + wc) % 6; const bool pe = g6 >= 4; const int i0 = 16 * (g6 - 4) + 4 * fq;
#pragma unroll
            for (int ai = 0; ai < 2; ++ai)
#pragma unroll
                for (int m = 0; m < 4; ++m) { const int row = row0 + ai * HALF + m * 16; const int pos = smp ? 2048 + (row & 63) : row;
                    f32x4 v0 = acc[ai][bj][m][0], v1 = acc[ai][bj][m][1];
                    if (pe) { const f32x4* tp = (const f32x4*)(tabB + ((size_t)pos * 32 + i0) * 2); const f32x4 ta = tp[0], tb = tp[1];
                        f32x4 w0, w1;
                        w0[0] = v0[0] * ta[0] - v0[1] * ta[1]; w0[1] = v0[1] * ta[0] + v0[0] * ta[1];
                        w0[2] = v0[2] * ta[2] - v0[3] * ta[3]; w0[3] = v0[3] * ta[2] + v0[2] * ta[3];
                        w1[0] = v1[0] * tb[0] - v1[1] * tb[1]; w1[1] = v1[1] * tb[0] + v1[0] * tb[1];
                        w1[2] = v1[2] * tb[2] - v1[3] * tb[3]; w1[3] = v1[3] * tb[2] + v1[2] * tb[3];
                        v0 = w0; v1 = w1; }
                    *(u32x4*)(QB + (size_t)row * cfg::NQB + col0 + bj * HALF) = pack8(v0, v1); }
        }
    }
};

struct EpiYA {
    static constexpr bool PERM = true, AFTER_DRAIN = false;
    const bf16_t* G; float* P;
    __device__ __forceinline__ void operator()(const f32x4 (&acc)[2][2][4][2], const Unit& u, int wr, int wc, int fr, int fq) const {
        const int row0 = u.pm * BM + wr * 64 + fr, col0 = u.pn * BM + wc * 32 + 8 * fq;
#pragma unroll
        for (int ai = 0; ai < 2; ++ai) {
            u32x4 gq[4][2];
#pragma unroll
            for (int m = 0; m < 4; ++m)
#pragma unroll
                for (int bj = 0; bj < 2; ++bj) gq[m][bj] = *(const u32x4*)(G + (size_t)(row0 + ai * HALF + m * 16) * 8192 + col0 + bj * HALF);
#pragma unroll
            for (int m = 0; m < 4; ++m) { const int row = row0 + ai * HALF + m * 16;
#pragma unroll
                for (int bj = 0; bj < 2; ++bj) { const int col = col0 + bj * HALF; f32x4 g0, g1; unpack8(gq[m][bj], g0, g1);
                    float* p = P + (size_t)row * 4096 + col; *(f32x4*)p = acc[ai][bj][m][0] * g0; *(f32x4*)(p + 4) = acc[ai][bj][m][1] * g1; } }
        }
    }
};
struct EpiYB {
    static constexpr bool PERM = true, AFTER_DRAIN = false;
    const bf16_t* G; const float* P; bf16_t* MB;
    __device__ __forceinline__ void operator()(const f32x4 (&acc)[2][2][4][2], const Unit& u, int wr, int wc, int fr, int fq) const {
        const int row0 = u.pm * BM + wr * 64 + fr, col0 = u.pn * BM + wc * 32 + 8 * fq;
#pragma unroll
        for (int ai = 0; ai < 2; ++ai)
#pragma unroll
            for (int mh = 0; mh < 2; ++mh) {
                u32x4 gq[2][2]; f32x4 pq[2][2][2];
#pragma unroll
                for (int mm = 0; mm < 2; ++mm)
#pragma unroll
                    for (int bj = 0; bj < 2; ++bj) { const int row = row0 + ai * HALF + (mh * 2 + mm) * 16, col = col0 + bj * HALF;
                        gq[mm][bj] = *(const u32x4*)(G + (size_t)row * 8192 + 4096 + col);
                        const float* p = P + (size_t)row * 4096 + col; pq[mm][bj][0] = *(const f32x4*)p; pq[mm][bj][1] = *(const f32x4*)(p + 4); }
#pragma unroll
                for (int mm = 0; mm < 2; ++mm)
#pragma unroll
                    for (int bj = 0; bj < 2; ++bj) { const int m = mh * 2 + mm; const int row = row0 + ai * HALF + m * 16, col = col0 + bj * HALF; f32x4 g0, g1; unpack8(gq[mm][bj], g0, g1);
                        const f32x4 a = pq[mm][bj][0] + acc[ai][bj][m][0] * g0, b = pq[mm][bj][1] + acc[ai][bj][m][1] * g1;
                        *(u32x4*)(MB + (size_t)row * 4096 + col) = pack8(a, b); }
            }
    }
};
struct EpiRes {
    static constexpr bool PERM = true, AFTER_DRAIN = false;
    const float* base_p; const float* base_s; float* out;
    __device__ __forceinline__ void operator()(const f32x4 (&acc)[2][2][4][2], const Unit& u, int wr, int wc, int fr, int fq) const {
        const int row0 = u.pm * BM + wr * 64 + fr, col0 = u.pn * BM + wc * 32 + 8 * fq; const bool smp = u.pm >= 32;
        const float* bs = smp ? base_s - (size_t)cfg::TP * 4096 : base_p;
#pragma unroll
        for (int ai = 0; ai < 2; ++ai)
#pragma unroll
            for (int mh = 0; mh < 2; ++mh) {
                f32x4 bq[2][2][2];
#pragma unroll
                for (int mm = 0; mm < 2; ++mm)
#pragma unroll
                    for (int bj = 0; bj < 2; ++bj) { const size_t off = (size_t)(row0 + ai * HALF + (mh * 2 + mm) * 16) * 4096 + col0 + bj * HALF;
                        bq[mm][bj][0] = *(const f32x4*)(bs + off); bq[mm][bj][1] = *(const f32x4*)(bs + off + 4); }
#pragma unroll
                for (int mm = 0; mm < 2; ++mm)
#pragma unroll
                    for (int bj = 0; bj < 2; ++bj) { const int m = mh * 2 + mm; const size_t off = (size_t)(row0 + ai * HALF + m * 16) * 4096 + col0 + bj * HALF;
                        *(f32x4*)(out + off) = bq[mm][bj][0] + acc[ai][bj][m][0]; *(f32x4*)(out + off + 4) = bq[mm][bj][1] + acc[ai][bj][m][1]; }
            }
    }
};
struct EpiGU {
    static constexpr bool PERM = true, AFTER_DRAIN = false;
    bf16_t* UG; bf16_t* U; float* out;
    __device__ __forceinline__ void operator()(const f32x4 (&acc)[2][2][4][2], const Unit& u, int wr, int wc, int fr, int fq) const {
        const bool up = u.pn >= 43; bf16_t* dst = up ? U : UG; const int colt = (up ? u.pn - 43 : u.pn) * BM;
        const int row0 = u.pm * BM + wr * 64 + fr, col0 = colt + wc * 32 + 8 * fq;
#pragma unroll
        for (int ai = 0; ai < 2; ++ai)
#pragma unroll
            for (int m = 0; m < 4; ++m) { const int row = row0 + ai * HALF + m * 16;
#pragma unroll
                for (int bj = 0; bj < 2; ++bj) { const int col = col0 + bj * HALF;
                    *(u32x4*)(dst + (size_t)row * cfg::DFF + col) = pack8(acc[ai][bj][m][0], acc[ai][bj][m][1]);
                    if (!up && (row & 63) >= 62 && (row >= cfg::TP || row >= cfg::TP - 2)) {
                        float* p = (row < cfg::TP) ? out + cfg::O_CONVP + (size_t)(row - (cfg::TP - 2)) * cfg::DFF + col
                                                   : out + cfg::O_CONVS + (size_t)(((row - cfg::TP) >> 6) * 2 + ((row & 63) - 62)) * cfg::DFF + col;
                        *(f32x4*)p = acc[ai][bj][m][0]; *(f32x4*)(p + 4) = acc[ai][bj][m][1]; } } }
    }
};
template <class Epi, class Sched, bool ALIGN_EPI = false, bool SP2 = false>
__device__ __forceinline__ void gemm_phase(PG8_LAS unsigned char* lds, const Gemm g, const Sched& S, const Epi& E) {
    const int tid = threadIdx.x, wid = __builtin_amdgcn_readfirstlane(tid >> 6), lane = tid & 63, wr = wid >> 2, wc = wid & 3, fr = lane & 15, fq = lane >> 4;
    const int K = g.K, nt = K / BK;
    unsigned voffA[2], voffB[2];
#pragma unroll
    for (int i = 0; i < 2; ++i) { int R, C; stage_rc(tid * 16 + i * 8192, R, C); const int Rb = Epi::PERM ? ((R & ~31) + perm32(R & 31)) : R;
        voffA[i] = (unsigned)(R * K + C) * 2u; voffB[i] = (unsigned)(Rb * K + C) * 2u; }
    const size_t kstep = (size_t)(BK * 2);
    const size_t hstep = (size_t)HALF * K * 2;
    const size_t tstep = 2 * hstep;
    const unsigned ldsw = (unsigned)wid * 1024u;
    const int aoff = lds_byte(wr * 64 + fr, fq * 8), boff = lds_byte(wc * 32 + fr, fq * 8);
#define PG8_SA(b, h) (((b) * 2 + (h)) * HTB)
#define PG8_SB(b, h) ((4 + (b) * 2 + (h)) * HTB)
#define PG8_STAGE(bufoff, gbase, voff) do { _Pragma("unroll") for (int _i = 0; _i < 2; ++_i) \
        __builtin_amdgcn_global_load_lds((const unsigned*)((const char*)(gbase) + (voff)[_i]), (PG8_LAS unsigned*)(lds + (bufoff) + ldsw + _i * 8192), 16, 0, 0); } while (0)
#define PG8_LDA(dst, b, h) do { _Pragma("unroll") for (int m = 0; m < 4; ++m) _Pragma("unroll") for (int k = 0; k < 2; ++k) dst[m][k] = *(const PG8_LAS bf16x8*)(lds + PG8_SA(b, h) + aoff + m * 2048 + k * 1024); } while (0)
#define PG8_LDB(dst, b, h) do { _Pragma("unroll") for (int n = 0; n < 2; ++n) _Pragma("unroll") for (int k = 0; k < 2; ++k) dst[n][k] = *(const PG8_LAS bf16x8*)(lds + PG8_SB(b, h) + boff + n * 2048 + k * 1024); } while (0)
#define PG8_MMA(ai, bj, At, Bt) do { __builtin_amdgcn_s_setprio(1); _Pragma("unroll") for (int m = 0; m < 4; ++m) _Pragma("unroll") for (int n = 0; n < 2; ++n) _Pragma("unroll") for (int k = 0; k < 2; ++k) \
        acc[ai][bj][m][n] = __builtin_amdgcn_mfma_f32_16x16x32_bf16(Bt[n][k], At[m][k], acc[ai][bj][m][n], 0, 0, 0); __builtin_amdgcn_s_setprio(0); } while (0)
#define PG8_WAIT_V(n) asm volatile("s_waitcnt vmcnt(" #n ")" ::: "memory")
#define PG8_WAIT_L(n) asm volatile("s_waitcnt lgkmcnt(" #n ")" ::: "memory")
#define PG8_BAR __builtin_amdgcn_s_barrier()
#define PG8_SCHED __builtin_amdgcn_sched_barrier(0)
    Unit cur, nxt; int ui = 0;
    if (!S.next(0, cur)) return;
    f32x4 acc[2][2][4][2];
#pragma unroll
    for (int a = 0; a < 2; ++a)
#pragma unroll
        for (int b = 0; b < 2; ++b)
#pragma unroll
            for (int m = 0; m < 4; ++m)
#pragma unroll
                for (int n = 0; n < 2; ++n) acc[a][b][m][n] = (f32x4){0.f, 0.f, 0.f, 0.f};
    bf16x8 At[4][2], B0[2][2], B1[2][2];
    const char* cA = (const char*)g.A + (size_t)cur.pm * tstep; const char* cB = (const char*)g.Bt + (size_t)cur.pn * tstep;
    S.a_ready(cur);
    if constexpr (SP2) {
        PG8_STAGE(PG8_SB(0, 0), cB, voffB); PG8_STAGE(PG8_SB(0, 1), cB + hstep, voffB); PG8_STAGE(PG8_SA(0, 0), cA, voffA); PG8_STAGE(PG8_SA(0, 1), cA + hstep, voffA);
        if (wr == 1) PG8_BAR;
        PG8_WAIT_V(2); PG8_BAR;
        PG8_STAGE(PG8_SB(1, 0), cB + kstep, voffB); PG8_STAGE(PG8_SA(1, 0), cA + kstep, voffA); PG8_STAGE(PG8_SB(1, 1), cB + hstep + kstep, voffB);
        PG8_WAIT_V(6); PG8_BAR;
    } else {
        PG8_STAGE(PG8_SB(0, 0), cB, voffB); PG8_STAGE(PG8_SA(0, 0), cA, voffA); PG8_STAGE(PG8_SB(0, 1), cB + hstep, voffB); PG8_STAGE(PG8_SA(0, 1), cA + hstep, voffA);
        if (wr == 1) PG8_BAR;
        PG8_WAIT_V(4); PG8_BAR;
        PG8_STAGE(PG8_SB(1, 0), cB + kstep, voffB); PG8_STAGE(PG8_SA(1, 0), cA + kstep, voffA); PG8_STAGE(PG8_SB(1, 1), cB + hstep + kstep, voffB);
        PG8_WAIT_V(6); PG8_BAR;
    }
    for (;;) {
        const bool has_next = S.next(ui + 1, nxt);
        const char* nA = has_next ? (const char*)g.A + (size_t)nxt.pm * tstep : cA; const char* nB = has_next ? (const char*)g.Bt + (size_t)nxt.pn * tstep : cB;
        for (int t = 0; t < nt; t += 2) {
            const bool last = (t == nt - 2);
            const char* a1 = cA + (size_t)(t + 1) * kstep;
            const char* a2 = last ? nA : cA + (size_t)(t + 2) * kstep; const char* b2 = last ? nB : cB + (size_t)(t + 2) * kstep;
            const char* a3 = a2 + kstep; const char* b3 = b2 + kstep;
            if (last && has_next) S.a_ready(nxt);
            if constexpr (SP2) {
            PG8_LDB(B0, 0, 0); PG8_LDB(B1, 0, 1); PG8_SCHED; PG8_LDA(At, 0, 0); PG8_STAGE(PG8_SA(1, 1), a1 + hstep, voffA);
            PG8_WAIT_V(8); PG8_WAIT_L(0); PG8_BAR; PG8_MMA(0, 0, At, B0); PG8_MMA(0, 1, At, B1); PG8_BAR; PG8_SCHED;
            PG8_LDA(At, 0, 1); PG8_STAGE(PG8_SB(0, 0), b2, voffB); PG8_STAGE(PG8_SB(0, 1), b2 + hstep, voffB); PG8_STAGE(PG8_SA(0, 0), a2, voffA);
            PG8_WAIT_V(8); PG8_WAIT_L(0); PG8_BAR; PG8_MMA(1, 0, At, B0); PG8_MMA(1, 1, At, B1); PG8_BAR; PG8_SCHED;
            PG8_LDB(B0, 1, 0); PG8_LDB(B1, 1, 1); PG8_SCHED; PG8_LDA(At, 1, 0); PG8_STAGE(PG8_SA(0, 1), a2 + hstep, voffA);
            PG8_WAIT_V(8); PG8_WAIT_L(0); PG8_BAR; PG8_MMA(0, 0, At, B0); PG8_MMA(0, 1, At, B1); PG8_BAR; PG8_SCHED;
            PG8_LDA(At, 1, 1); PG8_STAGE(PG8_SB(1, 0), b3, voffB); PG8_STAGE(PG8_SB(1, 1), b3 + hstep, voffB); PG8_STAGE(PG8_SA(1, 0), a3, voffA);
            PG8_WAIT_V(8); PG8_WAIT_L(0); PG8_BAR; PG8_MMA(1, 0, At, B0); PG8_MMA(1, 1, At, B1); PG8_BAR; PG8_SCHED;
            } else {
            PG8_LDB(B0, 0, 0); PG8_SCHED; PG8_LDA(At, 0, 0); PG8_STAGE(PG8_SA(1, 1), a1 + hstep, voffA);
            PG8_WAIT_L(8); PG8_BAR; PG8_WAIT_L(0); PG8_MMA(0, 0, At, B0); PG8_BAR; PG8_SCHED;
            PG8_LDB(B1, 0, 1); PG8_STAGE(PG8_SB(0, 0), b2, voffB);
            PG8_BAR; PG8_WAIT_L(0); PG8_MMA(0, 1, At, B1); PG8_BAR;
            PG8_LDA(At, 0, 1); PG8_STAGE(PG8_SA(0, 0), a2, voffA);
            PG8_BAR; PG8_WAIT_L(0); PG8_MMA(1, 0, At, B0); PG8_BAR; PG8_SCHED;
            PG8_STAGE(PG8_SB(0, 1), b2 + hstep, voffB);
            PG8_WAIT_V(6); PG8_BAR; PG8_MMA(1, 1, At, B1); PG8_BAR;
            PG8_LDB(B0, 1, 0); PG8_SCHED; PG8_LDA(At, 1, 0); PG8_STAGE(PG8_SA(0, 1), a2 + hstep, voffA);
            PG8_WAIT_L(8); PG8_BAR; PG8_WAIT_L(0); PG8_MMA(0, 0, At, B0); PG8_BAR; PG8_SCHED;
            PG8_LDB(B1, 1, 1); PG8_STAGE(PG8_SB(1, 0), b3, voffB);
            PG8_BAR; PG8_WAIT_L(0); PG8_MMA(0, 1, At, B1); PG8_BAR;
            PG8_LDA(At, 1, 1); PG8_STAGE(PG8_SA(1, 0), a3, voffA);
            PG8_BAR; PG8_WAIT_L(0); PG8_MMA(1, 0, At, B0); PG8_BAR; PG8_SCHED;
            PG8_STAGE(PG8_SB(1, 1), b3 + hstep, voffB);
            PG8_WAIT_V(6); PG8_BAR; PG8_MMA(1, 1, At, B1); PG8_BAR;
            }
        }
        if constexpr (ALIGN_EPI) { if (wr == 0) PG8_BAR; }
        if constexpr (!Epi::AFTER_DRAIN) { E(acc, cur, wr, wc, fr, fq); S.done(cur); }
        if (!has_next) break;
#pragma unroll
        for (int a = 0; a < 2; ++a)
#pragma unroll
            for (int b = 0; b < 2; ++b)
#pragma unroll
                for (int m = 0; m < 4; ++m)
#pragma unroll
                    for (int n = 0; n < 2; ++n) acc[a][b][m][n] = (f32x4){0.f, 0.f, 0.f, 0.f};
        cur = nxt; cA = nA; cB = nB; ++ui;
        if constexpr (ALIGN_EPI) { if (wr == 1) PG8_BAR; }
    }
    PG8_WAIT_V(0);
    if constexpr (!ALIGN_EPI) { if (wr == 0) PG8_BAR; }
    PG8_BAR;
    if constexpr (Epi::AFTER_DRAIN) { E.fused(acc, cur, wr, wc, fr, fq, lds, wid, lane); S.done(cur); }
#undef PG8_SA
#undef PG8_SB
#undef PG8_STAGE
#undef PG8_LDA
#undef PG8_LDB
#undef PG8_MMA
#undef PG8_WAIT_V
#undef PG8_WAIT_L
#undef PG8_BAR
#undef PG8_SCHED
}
}
#define GAS __attribute__((address_space(1)))
#define LAS __attribute__((address_space(3)))
typedef unsigned short bf16;
typedef unsigned v4u __attribute__((ext_vector_type(4)));
typedef float f32x4 __attribute__((ext_vector_type(4)));
typedef short bf16x8 __attribute__((ext_vector_type(8)));
typedef GAS unsigned gu32;
typedef GAS unsigned long long gu64;
#define RLX_AGENT __ATOMIC_RELAXED, __HIP_MEMORY_SCOPE_AGENT
#define LDS_WAIT() asm volatile("s_waitcnt lgkmcnt(0)" ::: "memory")
#define VM_WAIT() asm volatile("s_waitcnt vmcnt(0)" ::: "memory")
__device__ __forceinline__ unsigned long long rt() { return __builtin_amdgcn_s_memrealtime(); }
__device__ __forceinline__ unsigned f2bf(float f) { unsigned u = __builtin_bit_cast(unsigned, f); return (u + 0x7fffu + ((u >> 16) & 1u)) >> 16; }
__device__ __forceinline__ unsigned pk2(float lo, float hi) { return f2bf(lo) | (f2bf(hi) << 16); }

#define XB_TMO      128
#define XB_XCNT(j)  (256  + 64 * (j))
#define XB_XSUB(j)  (1280 + 64 * (j))
#define XB_XGEN(j)  (2304 + 64 * (j))
#define XB_TOP      3328
#define XB_TOPGEN   3392
#define XCD_BAR_WORDS 3456
#define XB_SPIN_CAP (1u << 18)

__device__ __forceinline__ unsigned xb_ld(unsigned* p)              { return __hip_atomic_load(p, __ATOMIC_RELAXED, __HIP_MEMORY_SCOPE_AGENT); }
__device__ __forceinline__ unsigned xb_add(unsigned* p, unsigned v) { return __hip_atomic_fetch_add(p, v, __ATOMIC_RELAXED, __HIP_MEMORY_SCOPE_AGENT); }
__device__ __forceinline__ unsigned xb_xcc_id() { return (unsigned)__builtin_amdgcn_s_getreg((3 << 11) | 20) & 0xFu; }
#define XB_SPIN(cond, bar) do { unsigned _sp = 0; while (cond) { __builtin_amdgcn_s_sleep(1); \
    if ((++_sp & 255u) == 0u) { if (xb_ld(&(bar)[XB_TMO])) break; if (_sp > XB_SPIN_CAP) { atomicAdd(&(bar)[XB_TMO], 1u); break; } } } } while (0)

struct XcdBarrier {
    unsigned* bar; unsigned x;
    volatile LAS unsigned* st;
};

__device__ __forceinline__ XcdBarrier xcd_barrier_post(unsigned* bar, volatile LAS unsigned* st) {
    XcdBarrier b; b.bar = bar; b.x = xb_xcc_id(); b.st = st;
    if (threadIdx.x == 0) (void)xb_add(&bar[XB_XCNT(b.x)], 1u);
    return b;
}
__device__ __forceinline__ void xcd_barrier_complete(unsigned* bar, unsigned x, unsigned& nloc, unsigned& nx) {
    const unsigned G = gridDim.x * gridDim.y * gridDim.z;
    unsigned sum, cnt, mine, sp = 0u;
    for (;;) {
        sum = 0u; cnt = 0u; mine = 0u;
#pragma unroll
        for (unsigned j = 0; j < 16; ++j) { const unsigned c = xb_ld(&bar[XB_XCNT(j)]); sum += c; cnt += (c > 0u) ? 1u : 0u; mine = (j == x) ? c : mine; }
        if (sum == G) break;
        __builtin_amdgcn_s_sleep(1);
        if ((++sp & 255u) == 0u) { if (xb_ld(&bar[XB_TMO])) break; if (sp > XB_SPIN_CAP) { atomicAdd(&bar[XB_TMO], 1u); break; } }
    }
    nloc = mine > 0u ? mine : 1u; nx = cnt > 0u ? cnt : 1u;
}

__device__ __forceinline__ void xcd_barrier(const XcdBarrier& b) {
    asm volatile("s_waitcnt vmcnt(0)" ::: "memory");
    __syncthreads();
    if (threadIdx.x == 0) {
        unsigned* bar = b.bar;
        __builtin_amdgcn_s_waitcnt(0);
        unsigned nloc = b.st[0], nx = b.st[1];
        if (nloc == 0u) { xcd_barrier_complete(bar, b.x, nloc, nx); b.st[0] = nloc; b.st[1] = nx; }
        const unsigned old = xb_add(&bar[XB_XSUB(b.x)], 1u);
        const unsigned gen = old / nloc;
        if (old + 1u == (gen + 1u) * nloc) {
            __builtin_amdgcn_fence(__ATOMIC_RELEASE, "agent");
            asm volatile("s_waitcnt vmcnt(0)" ::: "memory");
            const unsigned og = xb_add(&bar[XB_TOP], 1u);
            const unsigned tg = og / nx;
            if (og + 1u == (tg + 1u) * nx) xb_add(&bar[XB_TOPGEN], 1u);
            else XB_SPIN(xb_ld(&bar[XB_TOPGEN]) == tg, bar);
            __builtin_amdgcn_fence(__ATOMIC_ACQUIRE, "agent");
            xb_add(&bar[XB_XGEN(b.x)], 1u);
            asm volatile("s_waitcnt vmcnt(0)" ::: "memory");
        } else {
            XB_SPIN(xb_ld(&bar[XB_XGEN(b.x)]) == gen, bar);
            __builtin_amdgcn_fence(__ATOMIC_ACQUIRE, "agent");
            asm volatile("s_waitcnt vmcnt(0)" ::: "memory");
        }
    }
    __syncthreads();
}
namespace att {
typedef unsigned short bf16_t;
using bf16x8 = __attribute__((ext_vector_type(8))) short;
using s16x4  = __attribute__((ext_vector_type(4))) short;
using f32x16 = __attribute__((ext_vector_type(16))) float;
using f32x8  = __attribute__((ext_vector_type(8))) float;
using u32x4  = __attribute__((ext_vector_type(4))) unsigned;
constexpr int NW = 8, QBLK = 32, KVBLK = 64;
constexpr int SHM_V = KVBLK * 128 * 2;
constexpr int SHM_KMAX = KVBLK * 192 * 2;
constexpr int LDS_V = 0, LDS_K = 2 * SHM_V, LDS_WS = LDS_K + 2 * SHM_KMAX, LDS_BYTES = LDS_WS + NW * 64 * 4;
#define ASBAR() __builtin_amdgcn_sched_barrier(0)
__device__ __forceinline__ int crow(int r, int hi) { return (r & 3) + 8 * (r >> 2) + 4 * hi; }
typedef float f32x2c_t __attribute__((ext_vector_type(2))); typedef __bf16 bf16x2c_t __attribute__((ext_vector_type(2)));
__device__ __forceinline__ unsigned cvtpk(float lo, float hi) { f32x2c_t v = {lo, hi}; bf16x2c_t b = __builtin_convertvector(v, bf16x2c_t); return __builtin_bit_cast(unsigned, b); }
template <typename TIn> struct Stage;
template <> struct Stage<bf16_t> { using T = bf16x8; static constexpr int NLD = 1;
  __device__ static __forceinline__ T ld8(const bf16_t* p) { return *reinterpret_cast<const bf16x8*>(p); }
  __device__ static __forceinline__ bf16x8 tobf(T x) { return x; } };
template <> struct Stage<float> { using T = f32x8; static constexpr int NLD = 2;
  __device__ static __forceinline__ T ld8(const float* p) { return *reinterpret_cast<const f32x8*>(p); }
  __device__ static __forceinline__ bf16x8 tobf(T x) { u32x4 w = {cvtpk(x[0], x[1]), cvtpk(x[2], x[3]), cvtpk(x[4], x[5]), cvtpk(x[6], x[7])}; return *reinterpret_cast<bf16x8*>(&w); } };

template <int NDQ> __device__ __forceinline__ int kswz(int row, int ch) { return row * (32 * NDQ) + ((ch ^ ((row >> 1) & 7)) << 4); }

__device__ __forceinline__ void partialSM(f32x16& p0, f32x16& p1, float& m_reg, float& mn, float& alpha, const float C, const float THRS) {
  float pmax = p0[0];
#pragma unroll
  for (int r = 1; r < 16; ++r) pmax = fmaxf(pmax, p0[r]);
#pragma unroll
  for (int r = 0; r < 16; ++r) pmax = fmaxf(pmax, p1[r]);
  { auto rr = __builtin_amdgcn_permlane32_swap(__float_as_uint(pmax), __float_as_uint(pmax), false, false);
    pmax = fmaxf(__uint_as_float(rr[0]), __uint_as_float(rr[1])); }
  if (__builtin_expect(__all(pmax - m_reg <= THRS), 1)) { mn = m_reg; alpha = 1.f; }
  else { mn = fmaxf(m_reg, pmax); alpha = __builtin_amdgcn_exp2f((m_reg - mn) * C); m_reg = mn; }
  const float mnC = -mn * C;
#pragma unroll
  for (int r = 0; r < 16; ++r) p0[r] = fmaf(p0[r], C, mnC);
#pragma unroll
  for (int r = 0; r < 16; ++r) p1[r] = fmaf(p1[r], C, mnC);
#pragma unroll
  for (int r = 0; r < 16; ++r) p0[r] = __builtin_amdgcn_exp2f(p0[r]);
}
__device__ __forceinline__ void finishSM(f32x16& p0, f32x16& p1, float alpha, float& l_reg, bf16x8& pa0, bf16x8& pa1, bf16x8& pa2, bf16x8& pa3) {
#pragma unroll
  for (int r = 0; r < 16; ++r) p1[r] = __builtin_amdgcn_exp2f(p1[r]);
  float ps = 0;
#pragma unroll
  for (int r = 0; r < 16; ++r) ps += p0[r];
#pragma unroll
  for (int r = 0; r < 16; ++r) ps += p1[r];
  { auto rr = __builtin_amdgcn_permlane32_swap(__float_as_uint(ps), __float_as_uint(ps), false, false);
    ps = __uint_as_float(rr[0]) + __uint_as_float(rr[1]); }
  l_reg = l_reg * alpha + ps;
#define ATT_PK4(P, BASE, OUT) do { unsigned a0 = cvtpk(P[BASE + 0], P[BASE + 1]), a1 = cvtpk(P[BASE + 2], P[BASE + 3]);   \
    unsigned b0 = cvtpk(P[BASE + 4], P[BASE + 5]), b1 = cvtpk(P[BASE + 6], P[BASE + 7]);                              \
    auto r0 = __builtin_amdgcn_permlane32_swap(a0, b0, false, false); auto r1 = __builtin_amdgcn_permlane32_swap(a1, b1, false, false); \
    u32x4 w = {r0[0], r1[0], r0[1], r1[1]}; OUT = *reinterpret_cast<bf16x8*>(&w); } while (0)
  ATT_PK4(p0, 0, pa0); ATT_PK4(p0, 8, pa1); ATT_PK4(p1, 0, pa2); ATT_PK4(p1, 8, pa3);
#undef ATT_PK4
}
template <int NDQ> __device__ __forceinline__ void qkt(f32x16& p0, f32x16& p1, const char* Ks, const bf16x8 (&qr)[NDQ], int r32, int hi) {
  p0 = f32x16{}; p1 = f32x16{};
  const int f = (r32 >> 1) & 7; int kb[4];
#pragma unroll
  for (int q = 0; q < 4; ++q) kb[q] = r32 * (32 * NDQ) + (((2 * q + hi) ^ f) << 4);
#pragma unroll
  for (int d0 = 0; d0 < NDQ; ++d0) { const char* kp = Ks + kb[d0 & 3] + 128 * (d0 >> 2);
    const bf16x8 b0 = *reinterpret_cast<const bf16x8*>(kp);
    const bf16x8 b1 = *reinterpret_cast<const bf16x8*>(kp + 32 * 32 * NDQ);
    p0 = __builtin_amdgcn_mfma_f32_32x32x16_bf16(b0, qr[d0], p0, 0, 0, 0);
    p1 = __builtin_amdgcn_mfma_f32_32x32x16_bf16(b1, qr[d0], p1, 0, 0, 0); }
}
__device__ __forceinline__ int v_st(int k, int c) { const int kk = (k & ~0xC) | ((k & 4) << 1) | ((k & 8) >> 1); return ((kk >> 3) * 4 + (c >> 5)) * 512 + ((kk & 7) * 32 + (c & 31)) * 2; }
__device__ __forceinline__ int v_rd_base(int lane) { return ((lane & 3) << 3) | (((lane >> 2) & 3) << 6) | (((lane >> 4) & 1) << 5) | (((lane >> 5) & 1) << 8); }
constexpr int v_rd_off(int d0, int ks, int half) { return d0 * 512 + ks * 4096 + half * 2048; }
template <int OFF> __device__ __forceinline__ s16x4 tr_read(int vb) { s16x4 r; asm volatile("ds_read_b64_tr_b16 %0, %1 offset:%2" : "=&v"(r) : "v"(vb), "i"(OFF) : "memory"); return r; }
template <int D0> __device__ __forceinline__ void pv_one(f32x16& od, int vb, bf16x8 pa0, bf16x8 pa1, bf16x8 pa2, bf16x8 pa3) {
  const s16x4 l0 = tr_read<v_rd_off(D0, 0, 0)>(vb), h0 = tr_read<v_rd_off(D0, 0, 1)>(vb), l1 = tr_read<v_rd_off(D0, 1, 0)>(vb), h1 = tr_read<v_rd_off(D0, 1, 1)>(vb);
  const s16x4 l2 = tr_read<v_rd_off(D0, 2, 0)>(vb), h2 = tr_read<v_rd_off(D0, 2, 1)>(vb), l3 = tr_read<v_rd_off(D0, 3, 0)>(vb), h3 = tr_read<v_rd_off(D0, 3, 1)>(vb);
  asm volatile("s_waitcnt lgkmcnt(0)" ::: "memory"); ASBAR();
#define ATT_PK(L, H) (bf16x8){L[0], L[1], L[2], L[3], H[0], H[1], H[2], H[3]}
  od = __builtin_amdgcn_mfma_f32_32x32x16_bf16(pa0, ATT_PK(l0, h0), od, 0, 0, 0);
  od = __builtin_amdgcn_mfma_f32_32x32x16_bf16(pa1, ATT_PK(l1, h1), od, 0, 0, 0);
  od = __builtin_amdgcn_mfma_f32_32x32x16_bf16(pa2, ATT_PK(l2, h2), od, 0, 0, 0);
  od = __builtin_amdgcn_mfma_f32_32x32x16_bf16(pa3, ATT_PK(l3, h3), od, 0, 0, 0);
#undef ATT_PK
}
__device__ __forceinline__ void pv_d0(f32x16 (&o)[4], int vb, bf16x8 pa0, bf16x8 pa1, bf16x8 pa2, bf16x8 pa3) {
  pv_one<0>(o[0], vb, pa0, pa1, pa2, pa3); pv_one<1>(o[1], vb, pa0, pa1, pa2, pa3); pv_one<2>(o[2], vb, pa0, pa1, pa2, pa3); pv_one<3>(o[3], vb, pa0, pa1, pa2, pa3);
}

template <typename TKV> struct Src { const TKV* kp; const TKV* kn; const TKV* k2p; const TKV* k2n; const TKV* vp; const TKV* vn; int npast, nvalid; };

template <int NDQ, typename TKV, int LDK, int LDK2, int LDV>
__device__ __forceinline__ void attn_core(const bf16x8 (&qr)[NDQ], const Src<TKV>& S, const int NT, const int limit, const bool active, const float C, const float THRS,
                                          char* lds, f32x16 (&o)[4], float& l_reg) {
  using St = Stage<TKV>;
  constexpr int SHM_K = KVBLK * 32 * NDQ;
  int tid_ = threadIdx.x; asm volatile("" : "+v"(tid_));
  const int tid = tid_, wid = tid >> 6, lane = tid & 63, r32 = lane & 31, hi = lane >> 5;
  char* V_lds = lds + LDS_V; char* K_lds = lds + LDS_K;
  float* al_l = (float*)(lds + LDS_WS) + wid * 64 + 32;
  float m_reg = -1e30f; l_reg = 0.f;
#pragma unroll
  for (int d = 0; d < 4; ++d) o[d] = f32x16{};
  const int sr = tid >> 4, sc = (tid & 15) * 8, vst0 = v_st(sr, sc), vst1 = v_st(32 + sr, sc);
  const int kr8 = tid >> 3, kc8 = tid & 7;
  const int vb0 = (int)(uintptr_t)V_lds + v_rd_base(lane);
  struct Slot { typename St::T vs0, vs1, ks0, ks1, ks2; } sl[1];
#define ATT_SLOAD(i, j) do { const int jj_ = (j) < S.nvalid ? (j) : S.nvalid - 1; const bool ps_ = jj_ < S.npast; const long r0_ = ps_ ? (long)jj_ * 64 : (long)(jj_ - S.npast) * 64; \
    const TKV* vb_ = ps_ ? S.vp : S.vn; const TKV* kb_ = ps_ ? S.kp : S.kn; \
    sl[i].vs0 = St::ld8(vb_ + (r0_ + sr) * LDV + sc); sl[i].vs1 = St::ld8(vb_ + (r0_ + 32 + sr) * LDV + sc); \
    if constexpr (NDQ == 4) { sl[i].ks0 = St::ld8(kb_ + (r0_ + kr8) * LDK + kc8 * 8); } \
    else { const TKV* k2_ = ps_ ? S.k2p : S.k2n; sl[i].ks0 = St::ld8(kb_ + (r0_ + sr) * LDK + sc); sl[i].ks1 = St::ld8(kb_ + (r0_ + 32 + sr) * LDK + sc); sl[i].ks2 = St::ld8(k2_ + (r0_ + kr8) * LDK2 + kc8 * 8); } } while (0)
#define ATT_SWRITE(b, i) do { *(bf16x8*)(V_lds + (b) * SHM_V + vst0) = St::tobf(sl[i].vs0); *(bf16x8*)(V_lds + (b) * SHM_V + vst1) = St::tobf(sl[i].vs1); \
    if constexpr (NDQ == 4) { *(bf16x8*)(K_lds + (b) * SHM_K + kswz<NDQ>(kr8, kc8)) = St::tobf(sl[i].ks0); } \
    else { *(bf16x8*)(K_lds + (b) * SHM_K + kswz<NDQ>(sr, tid & 15)) = St::tobf(sl[i].ks0); *(bf16x8*)(K_lds + (b) * SHM_K + kswz<NDQ>(32 + sr, tid & 15)) = St::tobf(sl[i].ks1); \
           *(bf16x8*)(K_lds + (b) * SHM_K + kswz<NDQ>(kr8, 16 + kc8)) = St::tobf(sl[i].ks2); } } while (0)
#define ATT_RESC(a) do { if (__any((a) < 1.f)) { if (hi == 0) al_l[r32] = (a); asm volatile("s_waitcnt lgkmcnt(0)" ::: "memory"); \
    _Pragma("unroll") for (int d = 0; d < 4; ++d) _Pragma("unroll") for (int r = 0; r < 16; ++r) o[d][r] *= al_l[crow(r, hi)]; } } while (0)
#define ATT_MASK(P0, P1, j) do { if ((j) > limit) { _Pragma("unroll") for (int r = 0; r < 16; ++r) { P0[r] = -1e30f; P1[r] = -1e30f; } } } while (0)
  f32x16 pA0, pA1; float mnA, alA = 1.f; bf16x8 pa0, pa1, pa2, pa3;
  ATT_SLOAD(0, 0); asm volatile("s_waitcnt vmcnt(0)" ::: "memory"); ATT_SWRITE(0, 0); __syncthreads();
#pragma unroll 1
  for (int j = 0; j < NT; ++j) {
    const int cur = j & 1;
    if (j + 1 < NT) ATT_SLOAD(0, j + 1);
    ASBAR();
    if (active) {
      qkt<NDQ>(pA0, pA1, K_lds + cur * SHM_K, qr, r32, hi); ATT_MASK(pA0, pA1, j);
      partialSM(pA0, pA1, m_reg, mnA, alA, C, THRS);
      ATT_RESC(alA);
      finishSM(pA0, pA1, alA, l_reg, pa0, pa1, pa2, pa3);
      ASBAR();
      pv_d0(o, vb0 + cur * SHM_V, pa0, pa1, pa2, pa3);
    }
    ASBAR();
    if (j + 1 < NT) ATT_SWRITE(cur ^ 1, 0);
    __syncthreads();
  }
#undef ATT_SLOAD
#undef ATT_SWRITE
#undef ATT_RESC
#undef ATT_MASK
}
__device__ __forceinline__ void normalize(f32x16 (&o)[4], float l_reg, char* lds, int wid, int r32, int hi) {
  float* li_l = (float*)(lds + LDS_WS) + wid * 64;
  if (hi == 0) li_l[r32] = l_reg;
  asm volatile("s_waitcnt lgkmcnt(0)" ::: "memory");
#pragma unroll
  for (int r = 0; r < 16; ++r) { const float rl = __builtin_amdgcn_rcpf(li_l[crow(r, hi)]);
#pragma unroll
    for (int d = 0; d < 4; ++d) o[d][r] *= rl; }
}
__device__ __forceinline__ unsigned short f2bf1(float f) { unsigned u = __builtin_bit_cast(unsigned, f); return (unsigned short)((u + 0x7fffu + ((u >> 16) & 1u)) >> 16); }

constexpr float LOG2E = 1.4426950408889634f;
constexpr float SCALE_A = 0.125f, SCALE_B = 0.07216878364870322f;
constexpr float THR = 8.f;

template <typename TKV>
__device__ __forceinline__ void diff_unit(const bf16_t* QA, long qrow0, int h, const Src<TKV>& S1, const Src<TKV>& S2, int NT, int limit, bool active, float lam,
                                          const float* g_subln, float* stash, bf16_t* OA, char* lds) {
  asm volatile("" : "+s"(h), "+s"(qrow0));
  const int tid = threadIdx.x, wid = tid >> 6, lane = tid & 63, r32 = lane & 31, hi = lane >> 5;
  const long qrow = qrow0 + (active ? wid * QBLK : 0) + r32;
  f32x16 o[4]; float l_reg; float* st = stash + wid * 4096;
  {
    bf16x8 qr[4];
#pragma unroll
    for (int d0 = 0; d0 < 4; ++d0) qr[d0] = *reinterpret_cast<const bf16x8*>(QA + qrow * 2048 + h * 64 + d0 * 16 + hi * 8);
    attn_core<4, TKV, 2048, 64, 2048>(qr, S1, NT, limit, active, SCALE_A * LOG2E, THR / SCALE_A, lds, o, l_reg);
  }
  if (active) { normalize(o, l_reg, lds, wid, r32, hi);
    __attribute__((address_space(1))) float* st1 = (__attribute__((address_space(1))) float*)(st + lane); asm volatile("" : "+v"(st1));
#pragma unroll
    for (int d = 0; d < 4; ++d)
#pragma unroll
      for (int r = 0; r < 16; ++r) st1[(d * 16 + r) * 64] = o[d][r]; }
  {
    bf16x8 qr[4];
#pragma unroll
    for (int d0 = 0; d0 < 4; ++d0) qr[d0] = *reinterpret_cast<const bf16x8*>(QA + qrow * 2048 + (16 + h) * 64 + d0 * 16 + hi * 8);
    attn_core<4, TKV, 2048, 64, 2048>(qr, S2, NT, limit, active, SCALE_A * LOG2E, THR / SCALE_A, lds, o, l_reg);
  }
  if (active) { normalize(o, l_reg, lds, wid, r32, hi);
    float ss[16];
    const __attribute__((address_space(1))) float* st2 = (const __attribute__((address_space(1))) float*)(st + lane); asm volatile("" : "+v"(st2));
#pragma unroll
    for (int r = 0; r < 16; ++r) ss[r] = 0.f;
#pragma unroll
    for (int d = 0; d < 4; ++d)
#pragma unroll
      for (int r = 0; r < 16; ++r) { const float a = st2[(d * 16 + r) * 64] - lam * o[d][r]; o[d][r] = a; ss[r] += a * a; }
#pragma unroll
    for (int r = 0; r < 16; ++r) { float s = ss[r]; s += __shfl_xor(s, 1); s += __shfl_xor(s, 2); s += __shfl_xor(s, 4); s += __shfl_xor(s, 8); s += __shfl_xor(s, 16);
      ss[r] = 0.8f * rsqrtf(s * (1.f / 128.f) + cfg::EPS); }
    __attribute__((address_space(1))) bf16_t* op = (__attribute__((address_space(1))) bf16_t*)(OA + (qrow0 + wid * QBLK + 4 * hi) * 2048 + h * 128 + r32); asm volatile("" : "+v"(op));
#pragma unroll
    for (int d = 0; d < 4; ++d) { const float g = g_subln[d * 32 + r32];
#pragma unroll
      for (int r = 0; r < 16; ++r) op[((r & 3) + 8 * (r >> 2)) * 2048 + d * 32] = f2bf1(o[d][r] * ss[r] * g); }
  }
}
__device__ __forceinline__ void mla_unit(const bf16_t* QB, long qrow0, int h, const Src<bf16_t>& S, int NT, int limit, bool active, bf16_t* OB, char* lds) {
  asm volatile("" : "+s"(h), "+s"(qrow0));
  const int tid = threadIdx.x, wid = tid >> 6, lane = tid & 63, r32 = lane & 31, hi = lane >> 5;
  const long qrow = qrow0 + (active ? wid * QBLK : 0) + r32;
  f32x16 o[4]; float l_reg;
  bf16x8 qr[12];
#pragma unroll
  for (int d0 = 0; d0 < 12; ++d0) qr[d0] = *reinterpret_cast<const bf16x8*>(QB + qrow * 3072 + h * 192 + d0 * 16 + hi * 8);
  attn_core<12, bf16_t, 4096, 64, 4096>(qr, S, NT, limit, active, SCALE_B * LOG2E, THR / SCALE_B, lds, o, l_reg);
  if (active) { normalize(o, l_reg, lds, wid, r32, hi);
    __attribute__((address_space(1))) bf16_t* op = (__attribute__((address_space(1))) bf16_t*)(OB + (qrow0 + wid * QBLK + 4 * hi) * 2048 + h * 128 + r32); asm volatile("" : "+v"(op));
#pragma unroll
    for (int d = 0; d < 4; ++d)
#pragma unroll
      for (int r = 0; r < 16; ++r) op[((r & 3) + 8 * (r >> 2)) * 2048 + d * 32] = f2bf1(o[d][r]); }
}
#undef ASBAR
}
#ifndef PG8_SP2
#define PG8_SP2 true
#endif
constexpr int NWAVES = 8;
constexpr int NPH = 12;
constexpr int N_LAUNCHES = MK_N_LAUNCHES;
static_assert(N_LAUNCHES == 1 || N_LAUNCHES == NPH, "MK_N_LAUNCHES is 1 or 12");

constexpr size_t MiB = 1u << 20;
constexpr size_t WS_CTL = 0, CTL_ZERO_BYTES = 1 * MiB;
constexpr size_t WS_WIN = 1 * MiB;
constexpr size_t WS_WQB = WS_WIN + (size_t)cfg::NINP * 4096 * 2;
constexpr size_t WS_WKVB = WS_WQB + (size_t)3072 * 896 * 2;
constexpr size_t WS_WBA = WS_WKVB + (size_t)4096 * 512 * 2;
constexpr size_t WS_WBB = WS_WBA + (size_t)4096 * 2048 * 2;
constexpr size_t WS_WOUT = WS_WBB + (size_t)4096 * 2048 * 2;
constexpr size_t WS_WGU = WS_WOUT + (size_t)4096 * 4096 * 2;
constexpr size_t WS_WFD = WS_WGU + (size_t)22016 * 4096 * 2;
constexpr size_t WS_TABA = WS_WFD + (size_t)4096 * 11008 * 2;
constexpr size_t WS_TABB = WS_TABA + (size_t)8192 * 8 * 8;
constexpr size_t WS_XN = WS_TABB + (size_t)8192 * 32 * 8;
constexpr size_t WS_R0 = WS_XN + (size_t)cfg::M * 4096 * 2;
constexpr size_t WS_QA = WS_R0;
constexpr size_t WS_KA = WS_QA + (size_t)cfg::M * 2048 * 2;
constexpr size_t WS_VA = WS_KA + (size_t)cfg::M * 2048 * 2;
constexpr size_t WS_RAW = WS_VA + (size_t)cfg::M * 2048 * 2;
constexpr size_t WS_CQN = WS_RAW + (size_t)cfg::M * cfg::NRAW * 4;
constexpr size_t WS_CKV = WS_CQN + (size_t)cfg::M * 896 * 2;
constexpr size_t WS_KPE = WS_CKV + (size_t)cfg::MKV * 512 * 2;
constexpr size_t WS_QB = WS_KPE + (size_t)cfg::MKV * 64 * 2;
constexpr size_t WS_KVB = WS_QB + (size_t)cfg::M * 3072 * 2;
constexpr size_t WS_G = WS_KVB + (size_t)cfg::MKV * 4096 * 2;
constexpr size_t WS_OA = WS_G + (size_t)cfg::M * 8192 * 2;
constexpr size_t WS_OB = WS_OA + (size_t)cfg::M * 2048 * 2;
constexpr size_t WS_STASH = WS_OB + (size_t)cfg::M * 2048 * 2;
constexpr size_t WS_END = WS_STASH + (size_t)256 * 8 * 4096 * 4;
constexpr size_t WS_MB = WS_QA;
constexpr size_t WS_UG = WS_R0;
constexpr size_t WS_U = WS_UG + (size_t)cfg::M * cfg::DFF * 2;
static_assert(WS_U + (size_t)cfg::M * cfg::DFF * 2 <= WS_END, "FFN overlay fits");
static_assert(WS_END < (size_t)1390 * 1000 * 1000, "workspace budget");
constexpr int CW_TMO = 0, CW_CODE = 1, CW_BAR = 4096;

constexpr int RING_OFF = 0, RING_BYTES = 131072;
constexpr int LDSCTL_OFF = RING_BYTES, MISC_OFF = LDSCTL_OFF + 320;
constexpr int LDS_BYTES = 147456;
static_assert(att::LDS_BYTES <= RING_BYTES && pg8::STAGE_BYTES <= RING_BYTES, "phase scratch fits the ring region");

struct Args { const float* in[29]; float* out; unsigned char* ws; int ph_lo, ph_hi; };
struct Frame {
    LAS unsigned char* lds; volatile LAS unsigned* MISC; gu32* ctl;
    int tid, lane, wave, vcu, G;
    float* out; unsigned char* ws;
};
__device__ __forceinline__ float wave_sum(float v) {
#pragma unroll
    for (int o = 1; o < 64; o <<= 1) v += __shfl_xor(v, o);
    return v;
}
template <int MAP> __device__ __forceinline__ int src_col(int n) {
    if (MAP == 1) { if (n < 6144) return n; if (n < 14336) return 7616 + (n - 6144); if (n < 15808) return 6144 + (n - 14336); return -1; }
    if (MAP == 2) { const int h = n / 192, d = n - h * 192; if (d < 128) return n; const int e = d - 128; return h * 192 + 128 + (e >> 1) + 32 * (e & 1); }
    return n;
}
template <int MAP> __device__ __forceinline__ void p0_transpose_item(const float* W, int K, int Nsrc, int Ndst, bf16* WT, int row_off, LAS float* scr, int item, int lane) {
    const int nblk = Ndst / 32, kb = item / nblk, nb = item - kb * nblk, k0 = 64 * kb, n0 = 32 * nb;
    if constexpr (MAP == 2) {
        const int sn = src_col<MAP>(n0 + (lane & 31));
#pragma unroll 8
        for (int i = 0; i < 32; ++i) { const int kk = 2 * i + (lane >> 5); scr[kk * 33 + (lane & 31)] = W[(size_t)(k0 + kk) * Nsrc + sn]; }
    } else {
        const int n4 = 4 * (lane & 7), kq = lane >> 3;
        const int sn = src_col<MAP>(n0 + n4);
        f32x4 v[8];
#pragma unroll
        for (int i = 0; i < 8; ++i) v[i] = sn >= 0 ? *(const GAS f32x4*)(W + (size_t)(k0 + 8 * i + kq) * Nsrc + sn) : (f32x4){0.f, 0.f, 0.f, 0.f};
#pragma unroll
        for (int i = 0; i < 8; ++i) { LAS float* d = scr + (8 * i + kq) * 33 + n4; d[0] = v[i].x; d[1] = v[i].y; d[2] = v[i].z; d[3] = v[i].w; }
    }
    LDS_WAIT(); asm volatile("" ::: "memory");
    const int c = lane & 7;
#pragma unroll
    for (int j = 0; j < 4; ++j) { const int n = (lane >> 3) + 8 * j; const LAS float* s = scr + (8 * c) * 33 + n;
        v4u o; o.x = pk2(s[0 * 33], s[1 * 33]); o.y = pk2(s[2 * 33], s[3 * 33]); o.z = pk2(s[4 * 33], s[5 * 33]); o.w = pk2(s[6 * 33], s[7 * 33]);
        *(GAS v4u*)(WT + (size_t)(row_off + n0 + n) * K + k0 + 8 * c) = o; }
    LDS_WAIT(); asm volatile("" ::: "memory");
}
template <typename TO> __device__ __forceinline__ void rms_row4096(const float* xrow, const float* gain, TO* orow, int lane) {
    const GAS f32x4* xr = (const GAS f32x4*)xrow + lane; const GAS f32x4* gr = (const GAS f32x4*)gain + lane;
    f32x4 v[16]; float s = 0.f;
#pragma unroll
    for (int j = 0; j < 16; ++j) { v[j] = xr[64 * j]; s += (v[j].x * v[j].x + v[j].y * v[j].y) + (v[j].z * v[j].z + v[j].w * v[j].w); }
    const float rstd = rsqrtf(wave_sum(s) * (1.f / 4096.f) + cfg::EPS);
#pragma unroll
    for (int j = 0; j < 16; ++j) { const f32x4 g = gr[64 * j]; const f32x4 y = v[j] * rstd * g;
        if constexpr (sizeof(TO) == 2) { ((GAS unsigned long long*)orow)[64 * j + lane] = (unsigned long long)pk2(y.x, y.y) | ((unsigned long long)pk2(y.z, y.w) << 32); }
        else { ((GAS f32x4*)orow)[64 * j + lane] = y; } }
}
__device__ __forceinline__ void p0_prologue(Frame& F, const Args& A) {
    LAS float* scr = (LAS float*)(F.lds + RING_OFF + F.wave * 16384);
    const int gw = F.vcu * NWAVES + F.wave, NGW = F.G * NWAVES;
    unsigned char* ws = F.ws;
    constexpr int I_IN = 64 * (cfg::NINP / 32), I_QB = 14 * 96, I_KVB = 8 * 128, I_BR = 32 * 128, I_OUT = 64 * 128, I_FF = 64 * 344, I_FD = 172 * 128;
    constexpr int NITEMS = I_IN + I_QB + I_KVB + 2 * I_BR + I_OUT + 2 * I_FF + I_FD;
    for (int it = gw; it < NITEMS; it += NGW) {
        int r = it;
        if (r < I_IN) { p0_transpose_item<1>(A.in[8], 4096, 15808, cfg::NINP, (bf16*)(ws + WS_WIN), 0, scr, r, F.lane); continue; } r -= I_IN;
        if (r < I_QB) { p0_transpose_item<2>(A.in[16], 896, 3072, 3072, (bf16*)(ws + WS_WQB), 0, scr, r, F.lane); continue; } r -= I_QB;
        if (r < I_KVB) { p0_transpose_item<0>(A.in[18], 512, 4096, 4096, (bf16*)(ws + WS_WKVB), 0, scr, r, F.lane); continue; } r -= I_KVB;
        if (r < I_BR) { p0_transpose_item<0>(A.in[14], 2048, 4096, 4096, (bf16*)(ws + WS_WBA), 0, scr, r, F.lane); continue; } r -= I_BR;
        if (r < I_BR) { p0_transpose_item<0>(A.in[19], 2048, 4096, 4096, (bf16*)(ws + WS_WBB), 0, scr, r, F.lane); continue; } r -= I_BR;
        if (r < I_OUT) { p0_transpose_item<0>(A.in[21], 4096, 4096, 4096, (bf16*)(ws + WS_WOUT), 0, scr, r, F.lane); continue; } r -= I_OUT;
        if (r < I_FF) { p0_transpose_item<0>(A.in[23], 4096, cfg::DFF, cfg::DFF, (bf16*)(ws + WS_WGU), 0, scr, r, F.lane); continue; } r -= I_FF;
        if (r < I_FF) { p0_transpose_item<0>(A.in[24], 4096, cfg::DFF, cfg::DFF, (bf16*)(ws + WS_WGU), cfg::DFF, scr, r, F.lane); continue; } r -= I_FF;
        p0_transpose_item<0>(A.in[27], cfg::DFF, 4096, 4096, (bf16*)(ws + WS_WFD), 0, scr, r, F.lane);
    }
    for (int m = gw; m < cfg::M; m += NGW) { const float* xr = m < cfg::TP ? A.in[0] + (size_t)m * 4096 : A.in[1] + (size_t)(m - cfg::TP) * 4096;
        rms_row4096<bf16>(xr, A.in[7], (bf16*)(ws + WS_XN) + (size_t)m * 4096, F.lane); }
    const int gt = gw * 64 + F.lane, NGT = NGW * 64;
    float* tabA = (float*)(ws + WS_TABA); float* tabB = (float*)(ws + WS_TABB);
    for (int i = gt; i < 8192 * 40; i += NGT) {
        int pos, fi; float ex; float* dst;
        if (i < 8192 * 8) { pos = i >> 3; fi = i & 7; ex = (float)fi * (1.f / 8.f); dst = tabA + (size_t)i * 2; }
        else { const int k = i - 8192 * 8; pos = k >> 5; fi = k & 31; ex = (float)fi * (1.f / 32.f); dst = tabB + (size_t)k * 2; }
        const float inv = exp2f(-ex * 18.931568569324174f);
        const float ang = (float)pos * inv;
        double rev = (double)ang * 0.15915494309189535; rev -= __builtin_floor(rev);
        const float fr = (float)rev;
        dst[0] = __builtin_amdgcn_cosf(fr); dst[1] = __builtin_amdgcn_sinf(fr);
    }
    { const float* src = A.in[4]; bf16* dst = (bf16*)(ws + WS_CKV) + (size_t)cfg::TP * 512;
      for (int i = gt; i < 16384 * 512 / 8; i += NGT) { const f32x4 a = *(const GAS f32x4*)(src + (size_t)i * 8), b = *(const GAS f32x4*)(src + (size_t)i * 8 + 4);
          v4u o; o.x = pk2(a.x, a.y); o.y = pk2(a.z, a.w); o.z = pk2(b.x, b.y); o.w = pk2(b.z, b.w); *(GAS v4u*)(dst + (size_t)i * 8) = o; } }
    { const float* src = A.in[5]; bf16* dst = (bf16*)(ws + WS_KPE) + (size_t)cfg::TP * 64;
      for (int i = gt; i < 16384 * 8; i += NGT) { const int row = i >> 3, c = i & 7; const f32x4 a = *(const GAS f32x4*)(src + (size_t)row * 64 + 4 * c), b = *(const GAS f32x4*)(src + (size_t)row * 64 + 32 + 4 * c);
          v4u o; o.x = pk2(a.x, b.x); o.y = pk2(a.y, b.y); o.z = pk2(a.z, b.z); o.w = pk2(a.w, b.w); *(GAS v4u*)(dst + (size_t)row * 64 + 8 * c) = o; } }
}
__device__ __forceinline__ void p2_latents(Frame& F, const Args& A) {
    const int gw = F.vcu * NWAVES + F.wave, NGW = F.G * NWAVES, lane = F.lane;
    unsigned char* ws = F.ws; const float* g_qa = A.in[15]; const float* g_kva = A.in[17]; const float* tabB = (const float*)(ws + WS_TABB);
    for (int m = gw; m < cfg::M; m += NGW) {
        const float* raw = (const float*)(ws + WS_RAW) + (size_t)m * cfg::NRAW;
        const bool smp = m >= cfg::TP; const int pos = smp ? 2048 + (m & 63) : m; const size_t mk = smp ? (size_t)m + 16384 : (size_t)m;
        float v[14]; float s = 0.f;
#pragma unroll
        for (int j = 0; j < 14; ++j) { v[j] = raw[64 * j + lane]; s += v[j] * v[j]; }
        float rstd = rsqrtf(wave_sum(s) * (1.f / 896.f) + cfg::EPS);
        bf16* cq = (bf16*)(ws + WS_CQN) + (size_t)m * 896;
#pragma unroll
        for (int j = 0; j < 14; ++j) cq[64 * j + lane] = (bf16)f2bf(v[j] * rstd * g_qa[64 * j + lane]);
        float w[8]; s = 0.f;
#pragma unroll
        for (int j = 0; j < 8; ++j) { w[j] = raw[896 + 64 * j + lane]; s += w[j] * w[j]; }
        rstd = rsqrtf(wave_sum(s) * (1.f / 512.f) + cfg::EPS);
        float* co = smp ? F.out + cfg::O_CKVS + (size_t)(m - cfg::TP) * 512 : F.out + cfg::O_CKVP + (size_t)m * 512;
        bf16* ck = (bf16*)(ws + WS_CKV) + mk * 512;
#pragma unroll
        for (int j = 0; j < 8; ++j) { const float y = w[j] * rstd * g_kva[64 * j + lane]; co[64 * j + lane] = y; ck[64 * j + lane] = (bf16)f2bf(y); }
        if (lane < 32) { const float x1 = raw[1408 + lane], x2 = raw[1440 + lane]; const float c = tabB[((size_t)pos * 32 + lane) * 2], sn = tabB[((size_t)pos * 32 + lane) * 2 + 1];
            const float o1 = x1 * c - x2 * sn, o2 = x2 * c + x1 * sn;
            float* ko = smp ? F.out + cfg::O_KPES + (size_t)(m - cfg::TP) * 64 : F.out + cfg::O_KPEP + (size_t)m * 64;
            ko[lane] = o1; ko[32 + lane] = o2;
            ((GAS unsigned*)((bf16*)(ws + WS_KPE) + mk * 64))[lane] = pk2(o1, o2); }
    }
}
__device__ __forceinline__ void unpack8f(const v4u w, float (&f)[8]) {
    f[0] = __uint_as_float(w.x << 16); f[1] = __uint_as_float(w.x & 0xffff0000u); f[2] = __uint_as_float(w.y << 16); f[3] = __uint_as_float(w.y & 0xffff0000u);
    f[4] = __uint_as_float(w.z << 16); f[5] = __uint_as_float(w.z & 0xffff0000u); f[6] = __uint_as_float(w.w << 16); f[7] = __uint_as_float(w.w & 0xffff0000u); }
__device__ __forceinline__ void p9_convact(Frame& F, const Args& A) {
    const int gt = (F.vcu * NWAVES + F.wave) * 64 + F.lane, NGT = F.G * NWAVES * 64;
    const bf16* UG = (const bf16*)(F.ws + WS_UG); bf16* U = (bf16*)(F.ws + WS_U);
    const float* wc = A.in[25]; const float* bc = A.in[26]; const float* stc = A.in[6];
    constexpr int NCC = cfg::DFF / 8, NRB = cfg::M / 16;
    for (int it = gt; it < NRB * NCC; it += NGT) {
        const int rb = it / NCC, cc = it - rb * NCC, m0 = rb * 16, col = cc * 8;
        float w0[8], w1[8], w2[8], b[8], p2[8], p1[8];
#pragma unroll
        for (int e = 0; e < 8; ++e) { w0[e] = wc[col + e]; w1[e] = wc[cfg::DFF + col + e]; w2[e] = wc[2 * cfg::DFF + col + e]; b[e] = bc[col + e]; }
        const bool start = (m0 == 0) || (m0 >= cfg::TP && (m0 & 63) == 0);
        if (start) {
            if (m0 == 0) {
#pragma unroll
                for (int e = 0; e < 8; ++e) { p2[e] = 0.f; p1[e] = 0.f; }
            } else { const int bb = (m0 - cfg::TP) >> 6;
#pragma unroll
                for (int e = 0; e < 8; ++e) { p2[e] = stc[(size_t)(bb * 2 + 0) * cfg::DFF + col + e]; p1[e] = stc[(size_t)(bb * 2 + 1) * cfg::DFF + col + e]; } }
        } else { unpack8f(*(const GAS v4u*)(UG + (size_t)(m0 - 2) * cfg::DFF + col), p2); unpack8f(*(const GAS v4u*)(UG + (size_t)(m0 - 1) * cfg::DFF + col), p1); }
#pragma unroll 4
        for (int i = 0; i < 16; ++i) { const size_t off = (size_t)(m0 + i) * cfg::DFF + col; float cur[8], uu[8], a[8];
            unpack8f(*(const GAS v4u*)(UG + off), cur); unpack8f(*(const GAS v4u*)(U + off), uu);
#pragma unroll
            for (int e = 0; e < 8; ++e) { const float c = b[e] + w0[e] * p2[e] + w1[e] * p1[e] + w2[e] * cur[e]; a[e] = c * __builtin_amdgcn_rcpf(1.f + __expf(-c)) * uu[e]; p2[e] = p1[e]; p1[e] = cur[e]; }
            v4u o; o.x = pk2(a[0], a[1]); o.y = pk2(a[2], a[3]); o.z = pk2(a[4], a[5]); o.w = pk2(a[6], a[7]); *(GAS v4u*)(U + off) = o; }
    }
}
__device__ __forceinline__ void p4_attention(Frame& F, const Args& A, char* lds) {
    using att::bf16_t; using att::Src;
    unsigned char* ws = F.ws; const int wid = F.wave;
    const bf16_t* QA = (const bf16_t*)(ws + WS_QA); const bf16_t* KA = (const bf16_t*)(ws + WS_KA); const bf16_t* VA = (const bf16_t*)(ws + WS_VA);
    const bf16_t* QB = (const bf16_t*)(ws + WS_QB); const bf16_t* KVB = (const bf16_t*)(ws + WS_KVB); const bf16_t* KPE = (const bf16_t*)(ws + WS_KPE);
    bf16_t* OA = (bf16_t*)(ws + WS_OA); bf16_t* OB = (bf16_t*)(ws + WS_OB);
    float lam;
    { const float a = A.in[9][F.lane] * A.in[10][F.lane], b = A.in[11][F.lane] * A.in[12][F.lane]; lam = __expf(wave_sum(a)) - __expf(wave_sum(b)) + 0.2f; }
    const float* g_subln = A.in[13];
    { const int v = F.vcu & 255;
        float* stash = (float*)(ws + WS_STASH) + (size_t)v * 8 * 4096;
        const int h = v >> 4, s = v & 15;
#ifndef ATT_SEL
#define ATT_SEL 7
#endif
#pragma unroll 1
        for (int k = 0; k < ((ATT_SEL & 1) ? 2 : 0); ++k) {
            const int qb = k ? 31 - s : s, NT = 4 * qb + 4, limit = 4 * qb + (wid >> 1);
            Src<bf16_t> S1{KA + h * 64, KA + h * 64, nullptr, nullptr, VA + h * 128, VA + h * 128, NT, NT};
            Src<bf16_t> S2{KA + (16 + h) * 64, KA + (16 + h) * 64, nullptr, nullptr, VA + h * 128, VA + h * 128, NT, NT};
            att::diff_unit<bf16_t>(QA, (long)qb * 256, h, S1, S2, NT, limit, true, lam, g_subln, stash, OA, lds);
        }
#pragma unroll 1
        for (int k = 0; k < ((ATT_SEL & 2) ? 3 : 0); ++k) {
            if (k < 2) { const int qb = k ? 31 - s : s, NT = 4 * qb + 4, limit = 4 * qb + (wid >> 1);
                Src<bf16_t> S{KVB + h * 256, KVB + h * 256, KPE, KPE, KVB + h * 256 + 128, KVB + h * 256 + 128, NT, NT};
                att::mla_unit(QB, (long)qb * 256, h, S, NT, limit, true, OB, lds);
            } else if (v >= 128) { const int b = (v - 128) >> 4, hh = v & 15;
                const bf16_t* kp = KVB + (size_t)(cfg::TP + b * 2048) * 4096 + hh * 256; const bf16_t* kn = KVB + (size_t)(cfg::TP + 16384 + b * 64) * 4096 + hh * 256;
                Src<bf16_t> S{kp, kn, KPE + (size_t)(cfg::TP + b * 2048) * 64, KPE + (size_t)(cfg::TP + 16384 + b * 64) * 64, kp + 128, kn + 128, 32, 33};
                att::mla_unit(QB, (long)cfg::TP + b * 64, hh, S, 34, 32, wid < 2, OB, lds);
            }
        }
        if ((ATT_SEL & 4) && v < 128) { const int b = v >> 4, hh = v & 15;
            const float* kp = A.in[2] + (size_t)b * 2048 * 2048 + hh * 64; const float* kn = F.out + cfg::O_DKS + (size_t)b * 64 * 2048 + hh * 64;
            const float* vp = A.in[3] + (size_t)b * 2048 * 2048 + hh * 128; const float* vn = F.out + cfg::O_DVS + (size_t)b * 64 * 2048 + hh * 128;
            Src<float> S1{kp, kn, nullptr, nullptr, vp, vn, 32, 33};
            Src<float> S2{kp + 16 * 64, kn + 16 * 64, nullptr, nullptr, vp, vn, 32, 33};
            att::diff_unit<float>(QA, (long)cfg::TP + b * 64, hh, S1, S2, 34, 32, wid < 2, lam, g_subln, stash, OA, lds);
        }
    }
}

__global__ void __launch_bounds__(NWAVES * 64, 2) fwd(Args args) {
    extern __shared__ __attribute__((aligned(16))) unsigned char lds[];
    Frame F;
    F.lds = (LAS unsigned char*)lds; F.MISC = (volatile LAS unsigned*)(F.lds + MISC_OFF);
    F.tid = threadIdx.x; F.lane = F.tid & 63; F.wave = __builtin_amdgcn_readfirstlane(F.tid >> 6);
    F.G = gridDim.x; { const int bx = blockIdx.x; F.vcu = (F.G % 8 == 0) ? (bx % 8) * (F.G / 8) + bx / 8 : bx; }
    F.out = args.out; F.ws = args.ws; unsigned char* ws = args.ws;
    F.ctl = (gu32*)(ws + WS_CTL);
    for (int u = F.tid; u < (LDS_BYTES - LDSCTL_OFF) / 4; u += NWAVES * 64) ((LAS unsigned*)(F.lds + LDSCTL_OFF))[u] = 0u;
    __syncthreads();
    XcdBarrier bar; bar.bar = (unsigned*)(F.ctl + CW_BAR); bar.x = 0; bar.st = nullptr;
    if (N_LAUNCHES == 1) bar = xcd_barrier_post((unsigned*)(F.ctl + CW_BAR), F.MISC + 8);
#define GRID_BAR() do { if (N_LAUNCHES == 1) xcd_barrier(bar); } while (0)
    const int lo = args.ph_lo, hi = args.ph_hi;
#ifndef PH_MASK
#define PH_MASK 0xFFF
#endif
#define IN(k) (((PH_MASK >> (k)) & 1) && lo <= (k) && (k) < hi)
    typedef pg8::bf16_t pb;
    float* Y = args.out + cfg::O_Y;

    if (IN(0)) { p0_prologue(F, args); GRID_BAR(); }
#ifdef DUP_P0
    if (IN(0)) { p0_prologue(F, args); GRID_BAR(); }
#endif
#ifndef DUP_PH
#define DUP_PH -1
#endif
    if (IN(1)) {
        pg8::Gemm g{(const pb*)(ws + WS_XN), (const pb*)(ws + WS_WIN), cfg::M, cfg::NINP, 4096}; pg8::StaticOrder S; S.init(cfg::M, cfg::NINP, F.G, (int)blockIdx.x);
        pg8::EpiIn E{(pb*)(ws + WS_QA), (pb*)(ws + WS_KA), (pb*)(ws + WS_VA), (pb*)(ws + WS_G), (float*)(ws + WS_RAW), args.out, args.in[20], (const float*)(ws + WS_TABA)};
        pg8::gemm_phase<pg8::EpiIn, pg8::StaticOrder, true, PG8_SP2>(F.lds + RING_OFF, g, S, E);
        GRID_BAR();
    }
#if DUP_PH == 1
    if (IN(1)) {
        pg8::Gemm g{(const pb*)(ws + WS_XN), (const pb*)(ws + WS_WIN), cfg::M, cfg::NINP, 4096}; pg8::StaticOrder S; S.init(cfg::M, cfg::NINP, F.G, (int)blockIdx.x);
        pg8::EpiIn E{(pb*)(ws + WS_QA), (pb*)(ws + WS_KA), (pb*)(ws + WS_VA), (pb*)(ws + WS_G), (float*)(ws + WS_RAW), args.out, args.in[20], (const float*)(ws + WS_TABA)};
        pg8::gemm_phase<pg8::EpiIn, pg8::StaticOrder, true, PG8_SP2>(F.lds + RING_OFF, g, S, E);
        GRID_BAR();
    }
#endif
    if (IN(2)) { p2_latents(F, args); GRID_BAR(); }
    if (IN(3)) {
        { pg8::Gemm g{(const pb*)(ws + WS_CQN), (const pb*)(ws + WS_WQB), cfg::M, cfg::NQB, 896}; pg8::StaticOrder S; S.init(cfg::M, cfg::NQB, F.G, (int)blockIdx.x);
          pg8::EpiQB E{(pb*)(ws + WS_QB), (const float*)(ws + WS_TABB)};
          pg8::gemm_phase<pg8::EpiQB, pg8::StaticOrder, true, PG8_SP2>(F.lds + RING_OFF, g, S, E); }
        __syncthreads();
        { pg8::Gemm g{(const pb*)(ws + WS_CKV), (const pb*)(ws + WS_WKVB), cfg::MKV, cfg::NKVBO, 512}; pg8::StaticOrder S; S.init(cfg::MKV, cfg::NKVBO, F.G, (int)((blockIdx.x + F.G / 2) % F.G));
          pg8::EpiPlain E{(pb*)(ws + WS_KVB), cfg::NKVBO};
          pg8::gemm_phase<pg8::EpiPlain, pg8::StaticOrder, true, PG8_SP2>(F.lds + RING_OFF, g, S, E); }
        GRID_BAR();
    }
    if (IN(4)) { p4_attention(F, args, (char*)lds + RING_OFF); GRID_BAR(); }
#ifdef DUP_P4
    if (IN(4)) { p4_attention(F, args, (char*)lds + RING_OFF); GRID_BAR(); }
#endif
    if (IN(5)) {
        { pg8::Gemm g{(const pb*)(ws + WS_OA), (const pb*)(ws + WS_WBA), cfg::M, 4096, 2048}; pg8::StaticOrder S; S.init(cfg::M, 4096, F.G, (int)blockIdx.x);
          pg8::EpiYA E{(const pb*)(ws + WS_G), Y};
          pg8::gemm_phase<pg8::EpiYA, pg8::StaticOrder, true, PG8_SP2>(F.lds + RING_OFF, g, S, E); }
        __syncthreads();
#ifndef SKIP_YB
        { pg8::Gemm g{(const pb*)(ws + WS_OB), (const pb*)(ws + WS_WBB), cfg::M, 4096, 2048}; pg8::StaticOrder S; S.init(cfg::M, 4096, F.G, (int)blockIdx.x);
          pg8::EpiYB E{(const pb*)(ws + WS_G), Y, (pb*)(ws + WS_MB)};
          pg8::gemm_phase<pg8::EpiYB, pg8::StaticOrder, true, PG8_SP2>(F.lds + RING_OFF, g, S, E); }
#endif
        GRID_BAR();
    }
    if (IN(6)) {
        pg8::Gemm g{(const pb*)(ws + WS_MB), (const pb*)(ws + WS_WOUT), cfg::M, 4096, 4096}; pg8::StaticOrder S; S.init(cfg::M, 4096, F.G, (int)blockIdx.x);
        pg8::EpiRes E{args.in[0], args.in[1], Y};
        pg8::gemm_phase<pg8::EpiRes, pg8::StaticOrder, true, PG8_SP2>(F.lds + RING_OFF, g, S, E);
        GRID_BAR();
    }
#if DUP_PH == 6
    if (IN(6)) {
        pg8::Gemm g{(const pb*)(ws + WS_MB), (const pb*)(ws + WS_WOUT), cfg::M, 4096, 4096}; pg8::StaticOrder S; S.init(cfg::M, 4096, F.G, (int)blockIdx.x);
        pg8::EpiRes E{args.in[0], args.in[1], Y};
        pg8::gemm_phase<pg8::EpiRes, pg8::StaticOrder, true, PG8_SP2>(F.lds + RING_OFF, g, S, E);
        GRID_BAR();
    }
#endif
    if (IN(7)) {
        const int gw = F.vcu * NWAVES + F.wave, NGW = F.G * NWAVES;
        for (int m = gw; m < cfg::M; m += NGW) rms_row4096<bf16>(Y + (size_t)m * 4096, args.in[22], (bf16*)(ws + WS_XN) + (size_t)m * 4096, F.lane);
        GRID_BAR();
    }
    if (IN(8)) {
        pg8::Gemm g{(const pb*)(ws + WS_XN), (const pb*)(ws + WS_WGU), cfg::M, 2 * cfg::DFF, 4096}; pg8::StaticOrder S; S.init(cfg::M, 2 * cfg::DFF, F.G, (int)blockIdx.x);
        pg8::EpiGU E{(pb*)(ws + WS_UG), (pb*)(ws + WS_U), args.out};
        pg8::gemm_phase<pg8::EpiGU, pg8::StaticOrder, true, PG8_SP2>(F.lds + RING_OFF, g, S, E);
        GRID_BAR();
    }
#if DUP_PH == 8
    if (IN(8)) {
        pg8::Gemm g{(const pb*)(ws + WS_XN), (const pb*)(ws + WS_WGU), cfg::M, 2 * cfg::DFF, 4096}; pg8::StaticOrder S; S.init(cfg::M, 2 * cfg::DFF, F.G, (int)blockIdx.x);
        pg8::EpiGU E{(pb*)(ws + WS_UG), (pb*)(ws + WS_U), args.out};
        pg8::gemm_phase<pg8::EpiGU, pg8::StaticOrder, true, PG8_SP2>(F.lds + RING_OFF, g, S, E);
        GRID_BAR();
    }
#endif
    if (IN(9)) { p9_convact(F, args); GRID_BAR(); }
    if (IN(10)) {
        pg8::Gemm g{(const pb*)(ws + WS_U), (const pb*)(ws + WS_WFD), cfg::M, 4096, cfg::DFF}; pg8::StaticOrder S; S.init(cfg::M, 4096, F.G, (int)blockIdx.x);
        pg8::EpiRes E{Y, Y + (size_t)cfg::TP * 4096, Y};
        pg8::gemm_phase<pg8::EpiRes, pg8::StaticOrder, true, PG8_SP2>(F.lds + RING_OFF, g, S, E);
        GRID_BAR();
    }
#if DUP_PH == 10
    if (IN(10)) {
        pg8::Gemm g{(const pb*)(ws + WS_U), (const pb*)(ws + WS_WFD), cfg::M, 4096, cfg::DFF}; pg8::StaticOrder S; S.init(cfg::M, 4096, F.G, (int)blockIdx.x);
        pg8::EpiRes E{Y, Y + (size_t)cfg::TP * 4096, Y};
        pg8::gemm_phase<pg8::EpiRes, pg8::StaticOrder, true, PG8_SP2>(F.lds + RING_OFF, g, S, E);
        GRID_BAR();
    }
#endif
    if (IN(11)) {
        const int gw = F.vcu * NWAVES + F.wave, NGW = F.G * NWAVES;
        for (int m = gw; m < cfg::M; m += NGW) rms_row4096<float>(Y + (size_t)m * 4096, args.in[28], Y + (size_t)m * 4096, F.lane);
    }
#ifdef DBG_COPY
    if (lo <= DBG_COPY && DBG_COPY < hi) {
        const size_t gt = (size_t)(F.vcu * NWAVES + F.wave) * 64 + F.lane, NGT = (size_t)F.G * NWAVES * 64;
        const v4u* s0 = (const v4u*)(ws + WS_WQB); v4u* d0 = (v4u*)Y; const size_t n0 = (size_t)(WS_WGU - WS_WQB) / 16;
        for (size_t i = gt; i < n0; i += NGT) d0[i] = s0[i];
        const v4u* s1 = (const v4u*)(ws + WS_WFD); v4u* d1 = d0 + n0; const size_t n1 = (size_t)60000000 / 16;
        for (size_t i = gt; i < n1; i += NGT) d1[i] = s1[i];
    }
#endif
#undef IN
#undef GRID_BAR
}

extern "C" void kernel_launch(void* const* d_in, const int* in_sizes, int n_in, void* d_out, int out_size, void* d_ws, size_t ws_size, hipStream_t stream) {
    static int grid = 0;
    if (grid == 0) {
        if (n_in != 29 || in_sizes[0] != cfg::TP * 4096 || (size_t)out_size != cfg::O_END || ws_size < WS_END) {
            fprintf(stderr, "kernel_launch: shape mismatch: n_in %d in0 %d out %d ws %zu (need %zu); nothing launched\n", n_in, n_in > 0 ? in_sizes[0] : -1, out_size, ws_size, (size_t)WS_END); grid = -1; return; }
        int dev = 0, cus = 0, per_cu = 0;
        if (hipGetDevice(&dev) != hipSuccess || hipDeviceGetAttribute(&cus, hipDeviceAttributeMultiprocessorCount, dev) != hipSuccess) { grid = -1; return; }
        if (hipFuncSetAttribute((const void*)fwd, hipFuncAttributeMaxDynamicSharedMemorySize, LDS_BYTES) != hipSuccess) { fprintf(stderr, "kernel_launch: hipFuncSetAttribute failed\n"); grid = -1; return; }
        if (hipOccupancyMaxActiveBlocksPerMultiprocessor(&per_cu, (const void*)fwd, NWAVES * 64, LDS_BYTES) != hipSuccess || per_cu < 1)
            fprintf(stderr, "kernel_launch: note: occupancy query reports %d workgroups per CU\n", per_cu);
        (void)hipGetLastError();
        grid = cus;
    }
    if (grid < 0) return;
    if (hipMemsetAsync((char*)d_ws + WS_CTL, 0, CTL_ZERO_BYTES, stream) != hipSuccess) { fprintf(stderr, "kernel_launch: memset failed\n"); return; }
    Args a{};
    for (int i = 0; i < 29; ++i) a.in[i] = (const float*)d_in[i];
    a.out = (float*)d_out; a.ws = (unsigned char*)d_ws;
    for (int li = 0; li < N_LAUNCHES; ++li) {
        a.ph_lo = (N_LAUNCHES == 1) ? 0 : li; a.ph_hi = (N_LAUNCHES == 1) ? NPH : li + 1;
        hipLaunchKernelGGL(fwd, dim3(grid), dim3(NWAVES * 64), LDS_BYTES, stream, a);
        const hipError_t le = hipPeekAtLastError();
        if (le != hipSuccess) { fprintf(stderr, "kernel_launch: launch %d failed: %s\n", li, hipGetErrorName(le)); break; }
    }
}
```

```cpp
#include <hip/hip_runtime.h>
#include <hip/hip_bf16.h>
#include <cstdio>
#include <cstdint>

#define DUP_PH -1
#ifndef MK_N_LAUNCHES
#define MK_N_LAUNCHES 1
#endif

namespace cfg {
constexpr int DM = 4096, TP = 8192, NB = 8, TS = 64, PAST = 2048;
constexpr int MS = NB * TS;
constexpr int M = TP + MS;
constexpr int NQK = 2048, NVA = 2048, QL = 896, KVL = 512, DR = 64, NG = 8192;
constexpr int NINP = 15872;
constexpr int NRAW = 1536;
constexpr int NQB = 3072, NKVBO = 4096;
constexpr int MKV = TP + NB * (PAST + TS);
constexpr int DFF = 11008;
constexpr float EPS = 1e-6f;
constexpr size_t O_Y = 0, O_DKP = 35651584, O_DVP = 52428800, O_CKVP = 69206016, O_KPEP = 73400320, O_CONVP = 73924608,
                 O_DKS = 73946624, O_DVS = 74995200, O_CKVS = 76043776, O_KPES = 76305920, O_CONVS = 76338688, O_END = 76514816;
}
namespace pg8 {
#define PG8_LAS __attribute__((address_space(3)))
typedef unsigned short bf16_t;
typedef short bf16x8 __attribute__((ext_vector_type(8)));
typedef float f32x4 __attribute__((ext_vector_type(4)));
typedef unsigned u32x4 __attribute__((ext_vector_type(4)));
constexpr int BM = 256, BK = 64, HALF = 128, HTB = HALF * BK * 2  , STAGE_BYTES = 8 * HTB, NXCD = 8, WGM = 8;

__host__ __device__ __forceinline__ int lds_byte(int r, int c) { const int st = (r >> 4) * 2 + (c >> 5), rr = r & 15, cc = c & 31, ob = rr * 64 + cc * 2; return st * 1024 + (ob ^ (((ob >> 9) & 1) << 5)); }
__host__ __device__ __forceinline__ void stage_rc(int b, int& R, int& C) { const int st = b / 1024, sb = b % 1024, swz = sb ^ (((sb >> 9) & 1) << 5); R = (st >> 1) * 16 + swz / 64; C = (st & 1) * 32 + (swz % 64) / 2; }
__host__ __device__ __forceinline__ int perm32(int rho) { const int n = rho >> 4, i = rho & 15; return 8 * (i >> 2) + 4 * n + (i & 3); }

struct Unit { int pm, pn, kt0, ntk, split; };
struct Gemm { const bf16_t* A; const bf16_t* Bt; int M, N, K; };

struct StaticOrder {
    int nM, nN, nwg, G, c;
    __host__ __device__ void init(int M, int N, int G_, int c_) { nM = M / BM; nN = N / BM; nwg = nM * nN; G = G_; c = c_; }
    __host__ __device__ bool next(int i, Unit& u) const {
        const long L = (long)i * G + c; if (L >= nwg) return false;
        int wgid = (int)L; { const int q = nwg / NXCD, r = nwg % NXCD, xcd = wgid % NXCD, off = wgid / NXCD; wgid = (xcd < r ? xcd * (q + 1) : r * (q + 1) + (xcd - r) * q) + off; }
        const int nig = WGM * nN, gid = wgid / nig, fm = gid * WGM, gsz = (nM - fm) < WGM ? (nM - fm) : WGM;
        u.pm = fm + ((wgid % nig) % gsz); u.pn = (wgid % nig) / gsz; u.kt0 = 0; u.ntk = 0; u.split = 0; return true;
    }
    __device__ __forceinline__ void a_ready(const Unit&) const {}
    __device__ __forceinline__ void done(const Unit&) const {}
};

struct SplitTailOrder {
    StaticOrder so; int nt, c;
    __host__ __device__ void init(int K, int c_) { so.init(8192, 4096, 256, c_); nt = K / BK; c = c_; }
    __host__ __device__ bool next(int i, Unit& u) const {
        if (i < 2) return so.next(i, u);
        if (i > 2) return false;
        const int tt = c >> 3, s = c & 7, q = nt >> 1, qb = q >> 3, qr = q & 7;
        u.pm = 32 + (tt & 1); u.pn = tt >> 1; u.kt0 = 2 * (s * qb + (s < qr ? s : qr)); u.ntk = 2 * (qb + (s < qr ? 1 : 0)); u.split = s + 1; return true;
    }
    __device__ __forceinline__ void a_ready(const Unit&) const {}
    __device__ __forceinline__ void done(const Unit&) const {}
};
typedef float f32x2c_t __attribute__((ext_vector_type(2))); typedef __bf16 bf16x2c_t __attribute__((ext_vector_type(2)));
__device__ __forceinline__ unsigned cvt_pk_bf16(float lo, float hi) { f32x2c_t v = {lo, hi}; bf16x2c_t b = __builtin_convertvector(v, bf16x2c_t); return __builtin_bit_cast(unsigned, b); }
typedef float f32x2 __attribute__((ext_vector_type(2)));
__device__ __forceinline__ u32x4 pack8(const f32x4 v0, const f32x4 v1) { u32x4 w; w.x = cvt_pk_bf16(v0[0], v0[1]); w.y = cvt_pk_bf16(v0[2], v0[3]); w.z = cvt_pk_bf16(v1[0], v1[1]); w.w = cvt_pk_bf16(v1[2], v1[3]); return w; }
__device__ __forceinline__ void unpack8(const u32x4 w, f32x4& a, f32x4& b) {
    a[0] = __uint_as_float(w.x << 16); a[1] = __uint_as_float(w.x & 0xffff0000u); a[2] = __uint_as_float(w.y << 16); a[3] = __uint_as_float(w.y & 0xffff0000u);
    b[0] = __uint_as_float(w.z << 16); b[1] = __uint_as_float(w.z & 0xffff0000u); b[2] = __uint_as_float(w.w << 16); b[3] = __uint_as_float(w.w & 0xffff0000u); }
__device__ __forceinline__ float sigmoidf_(float x) { return __builtin_amdgcn_rcpf(1.0f + __expf(-x)); }

struct EpiPlain {
    static constexpr bool PERM = true, AFTER_DRAIN = false;
    bf16_t* O; int ldc;
    __device__ __forceinline__ void operator()(const f32x4 (&acc)[2][2][4][2], const Unit& u, int wr, int wc, int fr, int fq) const {
        const int row0 = u.pm * BM + wr * 64 + fr, col0 = u.pn * BM + wc * 32 + 8 * fq;
#pragma unroll
        for (int ai = 0; ai < 2; ++ai)
#pragma unroll
            for (int m = 0; m < 4; ++m) { bf16_t* rowp = O + (size_t)(row0 + ai * HALF + m * 16) * ldc + col0;
#pragma unroll
                for (int bj = 0; bj < 2; ++bj) *(u32x4*)(rowp + bj * HALF) = pack8(acc[ai][bj][m][0], acc[ai][bj][m][1]); }
    }
};

struct EpiIn {
    static constexpr bool PERM = true, AFTER_DRAIN = false;
    bf16_t* QA; bf16_t* KA; bf16_t* VA; bf16_t* G; float* RAW; float* out; const float* b_gate; const float* tabA;
    __device__ __forceinline__ void operator()(const f32x4 (&acc)[2][2][4][2], const Unit& u, int wr, int wc, int fr, int fq) const {
        const int pn = u.pn; const bool smp = u.pm >= 32;
        const int row0 = u.pm * BM + wr * 64 + fr, cw = wc * 32 + 8 * fq;
        if (pn < 16) {
            const bool isk = pn >= 8; bf16_t* dst = isk ? KA : QA; const int cb = (pn & 7) * BM + cw;
            float* fo = out + (smp ? (cfg::O_DKS - (size_t)cfg::TP * 2048) : cfg::O_DKP);
            const bool ropew = (wc & 1) == 0;
#pragma unroll
            for (int ah = 0; ah < 4; ++ah) {
                const int ai = ah >> 1, mh = ah & 1;
                f32x4 tq[2][4];
                if (ropew) {
#pragma unroll
                    for (int mm = 0; mm < 2; ++mm) { const int row = row0 + ai * HALF + (mh * 2 + mm) * 16; const int pos = smp ? 2048 + (row & 63) : row; const f32x4* tp = (const f32x4*)(tabA + (size_t)pos * 16);
                        tq[mm][0] = tp[0]; tq[mm][1] = tp[1]; tq[mm][2] = tp[2]; tq[mm][3] = tp[3]; } }
#pragma unroll
                for (int mm = 0; mm < 2; ++mm) {
                    const int m = mh * 2 + mm; const int row = row0 + ai * HALF + m * 16;
                    f32x4 t0 = {1.f, 0.f, 1.f, 0.f}, t1 = t0, t2 = t0, t3 = t0;
                    if (ropew) { t0 = tq[mm][0]; t1 = tq[mm][1]; t2 = tq[mm][2]; t3 = tq[mm][3]; }
#pragma unroll
                    for (int bj = 0; bj < 2; ++bj) {
                        f32x4 v0 = acc[ai][bj][m][0], v1 = acc[ai][bj][m][1];
                        if (ropew) {
                            f32x4 p0, p1;
#pragma unroll
                            for (int e = 0; e < 4; ++e) { p0[e] = __shfl_xor(v0[e], 16); p1[e] = __shfl_xor(v1[e], 16); }
                            const float sg = (fq == 0) ? -1.f : 1.f;
                            if (fq < 2) {
                                v0[0] = v0[0] * t0[0] + sg * p0[0] * t0[1]; v0[1] = v0[1] * t0[2] + sg * p0[1] * t0[3];
                                v0[2] = v0[2] * t1[0] + sg * p0[2] * t1[1]; v0[3] = v0[3] * t1[2] + sg * p0[3] * t1[3];
                                v1[0] = v1[0] * t2[0] + sg * p1[0] * t2[1]; v1[1] = v1[1] * t2[2] + sg * p1[1] * t2[3];
                                v1[2] = v1[2] * t3[0] + sg * p1[2] * t3[1]; v1[3] = v1[3] * t3[2] + sg * p1[3] * t3[3];
                            }
                        }
                        const size_t off = (size_t)row * 2048 + cb + bj * HALF;
                        *(u32x4*)(dst + off) = pack8(v0, v1);
                        if (isk) { *(f32x4*)(fo + off) = v0; *(f32x4*)(fo + off + 4) = v1; }
                    }
                }
            }
        } else if (pn < 24) {
            const int cb = (pn - 16) * BM + cw; float* fo = out + (smp ? (cfg::O_DVS - (size_t)cfg::TP * 2048) : cfg::O_DVP);
#pragma unroll
            for (int ai = 0; ai < 2; ++ai)
#pragma unroll
                for (int m = 0; m < 4; ++m) { const int row = row0 + ai * HALF + m * 16;
#pragma unroll
                    for (int bj = 0; bj < 2; ++bj) { const size_t off = (size_t)row * 2048 + cb + bj * HALF; const f32x4 v0 = acc[ai][bj][m][0], v1 = acc[ai][bj][m][1];
                        *(u32x4*)(VA + off) = pack8(v0, v1); *(f32x4*)(fo + off) = v0; *(f32x4*)(fo + off + 4) = v1; } }
        } else if (pn < 56) {
            const int cb = (pn - 24) * BM + cw;
            f32x4 bv[2][2];
#pragma unroll
            for (int bj = 0; bj < 2; ++bj) { bv[bj][0] = *(const f32x4*)(b_gate + cb + bj * HALF); bv[bj][1] = *(const f32x4*)(b_gate + cb + bj * HALF + 4); }
#pragma unroll
            for (int ai = 0; ai < 2; ++ai)
#pragma unroll
                for (int m = 0; m < 4; ++m) { const int row = row0 + ai * HALF + m * 16;
#pragma unroll
                    for (int bj = 0; bj < 2; ++bj) { f32x4 v0 = acc[ai][bj][m][0] + bv[bj][0], v1 = acc[ai][bj][m][1] + bv[bj][1];
#pragma unroll
                        for (int e = 0; e < 4; ++e) { v0[e] = sigmoidf_(v0[e]); v1[e] = sigmoidf_(v1[e]); }
                        *(u32x4*)(G + (size_t)row * 8192 + cb + bj * HALF) = pack8(v0, v1); } }
        } else {
            const int cb = (pn - 56) * BM + cw;
#pragma unroll
            for (int ai = 0; ai < 2; ++ai)
#pragma unroll
                for (int m = 0; m < 4; ++m) { const int row = row0 + ai * HALF + m * 16;
#pragma unroll
                    for (int bj = 0; bj < 2; ++bj) { float* p = RAW + (size_t)row * cfg::NRAW + cb + bj * HALF; *(f32x4*)p = acc[ai][bj][m][0]; *(f32x4*)(p + 4) = acc[ai][bj][m][1]; } }
        }
    }
};

struct EpiQB {
    static constexpr bool PERM = true, AFTER_DRAIN = false;
    bf16_t* QB; const float* tabB;
    __device__ __forceinline__ void operator()(const f32x4 (&acc)[2][2][4][2], const Unit& u, int wr, int wc, int fr, int fq) const {
        const bool smp = u.pm >= 32; const int row0 = u.pm * BM + wr * 64 + fr, col0 = u.pn * BM + wc * 32 + 8 * fq;
#pragma unroll
        for (int bj = 0; bj < 2; ++bj) {
            const int g6 = (u.pn * 8 + bj * 4 + wc) % 6; const bool pe = g6 >= 4; const int i0 = 16 * (g6 - 4) + 4 * fq;
#pragma unroll
            for (int ai = 0; ai < 2; ++ai)
#pragma unroll
                for (int m = 0; m < 4; ++m) { const int row = row0 + ai * HALF + m * 16; const int pos = smp ? 2048 + (row & 63) : row;
                    f32x4 v0 = acc[ai][bj][m][0], v1 = acc[ai][bj][m][1];
                    if (pe) { const f32x4* tp = (const f32x4*)(tabB + ((size_t)pos * 32 + i0) * 2); const f32x4 ta = tp[0], tb = tp[1];
                        f32x4 w0, w1;
                        w0[0] = v0[0] * ta[0] - v0[1] * ta[1]; w0[1] = v0[1] * ta[0] + v0[0] * ta[1];
                        w0[2] = v0[2] * ta[2] - v0[3] * ta[3]; w0[3] = v0[3] * ta[2] + v0[2] * ta[3];
                        w1[0] = v1[0] * tb[0] - v1[1] * tb[1]; w1[1] = v1[1] * tb[0] + v1[0] * tb[1];
                        w1[2] = v1[2] * tb[2] - v1[3] * tb[3]; w1[3] = v1[3] * tb[2] + v1[2] * tb[3];
                        v0 = w0; v1 = w1; }
                    *(u32x4*)(QB + (size_t)row * cfg::NQB + col0 + bj * HALF) = pack8(v0, v1); }
        }
    }
};

__device__ __forceinline__ void slab_store(float* slab, const f32x4 (&acc)[2][2][4][2], const Unit& u, int wr, int wc, int fr, int fq) {
    const int row0 = (u.pm - 32) * BM + wr * 64 + fr, col0 = u.pn * BM + wc * 32 + 8 * fq; float* sb = slab + (size_t)(u.split - 1) * 512 * 4096;
#pragma unroll
    for (int ai = 0; ai < 2; ++ai)
#pragma unroll
        for (int m = 0; m < 4; ++m)
#pragma unroll
            for (int bj = 0; bj < 2; ++bj) { float* p = sb + (size_t)(row0 + ai * HALF + m * 16) * 4096 + col0 + bj * HALF; *(f32x4*)p = acc[ai][bj][m][0]; *(f32x4*)(p + 4) = acc[ai][bj][m][1]; }
}
struct EpiYA {
    static constexpr bool PERM = true, AFTER_DRAIN = false;
    const bf16_t* G; float* P; float* slab;
    __device__ __forceinline__ void operator()(const f32x4 (&acc)[2][2][4][2], const Unit& u, int wr, int wc, int fr, int fq) const {
        if (u.split) { slab_store(slab, acc, u, wr, wc, fr, fq); return; }
        const int row0 = u.pm * BM + wr * 64 + fr, col0 = u.pn * BM + wc * 32 + 8 * fq;
#pragma unroll
        for (int ai = 0; ai < 2; ++ai) {
            u32x4 gq[4][2];
#pragma unroll
            for (int m = 0; m < 4; ++m)
#pragma unroll
                for (int bj = 0; bj < 2; ++bj) gq[m][bj] = *(const u32x4*)(G + (size_t)(row0 + ai * HALF + m * 16) * 8192 + col0 + bj * HALF);
#pragma unroll
            for (int m = 0; m < 4; ++m) { const int row = row0 + ai * HALF + m * 16;
#pragma unroll
                for (int bj = 0; bj < 2; ++bj) { const int col = col0 + bj * HALF; f32x4 g0, g1; unpack8(gq[m][bj], g0, g1);
                    float* p = P + (size_t)row * 4096 + col; *(f32x4*)p = acc[ai][bj][m][0] * g0; *(f32x4*)(p + 4) = acc[ai][bj][m][1] * g1; } }
        }
    }
};
struct EpiYB {
    static constexpr bool PERM = true, AFTER_DRAIN = false;
    const bf16_t* G; const float* P; bf16_t* MB; float* slab;
    __device__ __forceinline__ void operator()(const f32x4 (&acc)[2][2][4][2], const Unit& u, int wr, int wc, int fr, int fq) const {
        if (u.split) { slab_store(slab, acc, u, wr, wc, fr, fq); return; }
        const int row0 = u.pm * BM + wr * 64 + fr, col0 = u.pn * BM + wc * 32 + 8 * fq;
#pragma unroll
        for (int ai = 0; ai < 2; ++ai)
#pragma unroll
            for (int mh = 0; mh < 2; ++mh) {
                u32x4 gq[2][2]; f32x4 pq[2][2][2];
#pragma unroll
                for (int mm = 0; mm < 2; ++mm)
#pragma unroll
                    for (int bj = 0; bj < 2; ++bj) { const int row = row0 + ai * HALF + (mh * 2 + mm) * 16, col = col0 + bj * HALF;
                        gq[mm][bj] = *(const u32x4*)(G + (size_t)row * 8192 + 4096 + col);
                        const float* p = P + (size_t)row * 4096 + col; pq[mm][bj][0] = *(const f32x4*)p; pq[mm][bj][1] = *(const f32x4*)(p + 4); }
#pragma unroll
                for (int mm = 0; mm < 2; ++mm)
#pragma unroll
                    for (int bj = 0; bj < 2; ++bj) { const int m = mh * 2 + mm; const int row = row0 + ai * HALF + m * 16, col = col0 + bj * HALF; f32x4 g0, g1; unpack8(gq[mm][bj], g0, g1);
                        const f32x4 a = pq[mm][bj][0] + acc[ai][bj][m][0] * g0, b = pq[mm][bj][1] + acc[ai][bj][m][1] * g1;
                        *(u32x4*)(MB + (size_t)row * 4096 + col) = pack8(a, b); }
            }
    }
};
struct EpiRes {
    static constexpr bool PERM = true, AFTER_DRAIN = false;
    const float* base_p; const float* base_s; float* out; float* slab;
    __device__ __forceinline__ void operator()(const f32x4 (&acc)[2][2][4][2], const Unit& u, int wr, int wc, int fr, int fq) const {
        if (u.split) { slab_store(slab, acc, u, wr, wc, fr, fq); return; }
        const int row0 = u.pm * BM + wr * 64 + fr, col0 = u.pn * BM + wc * 32 + 8 * fq; const bool smp = u.pm >= 32;
        const float* bs = smp ? base_s - (size_t)cfg::TP * 4096 : base_p;
#pragma unroll
        for (int ai = 0; ai < 2; ++ai)
#pragma unroll
            for (int mh = 0; mh < 2; ++mh) {
                f32x4 bq[2][2][2];
#pragma unroll
                for (int mm = 0; mm < 2; ++mm)
#pragma unroll
                    for (int bj = 0; bj < 2; ++bj) { const size_t off = (size_t)(row0 + ai * HALF + (mh * 2 + mm) * 16) * 4096 + col0 + bj * HALF;
                        bq[mm][bj][0] = *(const f32x4*)(bs + off); bq[mm][bj][1] = *(const f32x4*)(bs + off + 4); }
#pragma unroll
                for (int mm = 0; mm < 2; ++mm)
#pragma unroll
                    for (int bj = 0; bj < 2; ++bj) { const int m = mh * 2 + mm; const size_t off = (size_t)(row0 + ai * HALF + m * 16) * 4096 + col0 + bj * HALF;
                        *(f32x4*)(out + off) = bq[mm][bj][0] + acc[ai][bj][m][0]; *(f32x4*)(out + off + 4) = bq[mm][bj][1] + acc[ai][bj][m][1]; }
            }
    }
};
struct EpiGU {
    static constexpr bool PERM = true, AFTER_DRAIN = false;
    bf16_t* UG; bf16_t* U; float* out;
    __device__ __forceinline__ void operator()(const f32x4 (&acc)[2][2][4][2], const Unit& u, int wr, int wc, int fr, int fq) const {
        const bool up = u.pn >= 43; bf16_t* dst = up ? U : UG; const int colt = (up ? u.pn - 43 : u.pn) * BM;
        const int row0 = u.pm * BM + wr * 64 + fr, col0 = colt + wc * 32 + 8 * fq;
#pragma unroll
        for (int ai = 0; ai < 2; ++ai)
#pragma unroll
            for (int m = 0; m < 4; ++m) { const int row = row0 + ai * HALF + m * 16;
#pragma unroll
                for (int bj = 0; bj < 2; ++bj) { const int col = col0 + bj * HALF;
                    *(u32x4*)(dst + (size_t)row * cfg::DFF + col) = pack8(acc[ai][bj][m][0], acc[ai][bj][m][1]);
                    if (!up && (row & 63) >= 62 && (row >= cfg::TP || row >= cfg::TP - 2)) {
                        float* p = (row < cfg::TP) ? out + cfg::O_CONVP + (size_t)(row - (cfg::TP - 2)) * cfg::DFF + col
                                                   : out + cfg::O_CONVS + (size_t)(((row - cfg::TP) >> 6) * 2 + ((row & 63) - 62)) * cfg::DFF + col;
                        *(f32x4*)p = acc[ai][bj][m][0]; *(f32x4*)(p + 4) = acc[ai][bj][m][1]; } } }
    }
};
template <class Epi, class Sched, bool ALIGN_EPI = false, bool SP2 = false>
__device__ __forceinline__ void gemm_phase(PG8_LAS unsigned char* lds, const Gemm g, const Sched& S, const Epi& E) {
    const int tid = threadIdx.x, wid = __builtin_amdgcn_readfirstlane(tid >> 6), lane = tid & 63, wr = wid >> 2, wc = wid & 3, fr = lane & 15, fq = lane >> 4;
    const int K = g.K, nt = K / BK;
    unsigned voffA[2], voffB[2];
#pragma unroll
    for (int i = 0; i < 2; ++i) { int R, C; stage_rc(tid * 16 + i * 8192, R, C); const int Rb = Epi::PERM ? ((R & ~31) + perm32(R & 31)) : R;
        voffA[i] = (unsigned)(R * K + C) * 2u; voffB[i] = (unsigned)(Rb * K + C) * 2u; }
    const size_t kstep = (size_t)(BK * 2);
    const size_t hstep = (size_t)HALF * K * 2;
    const size_t tstep = 2 * hstep;
    const unsigned ldsw = (unsigned)wid * 1024u;
    const int aoff = lds_byte(wr * 64 + fr, fq * 8), boff = lds_byte(wc * 32 + fr, fq * 8);
#define PG8_SA(b, h) (((b) * 2 + (h)) * HTB)
#define PG8_SB(b, h) ((4 + (b) * 2 + (h)) * HTB)
#define PG8_STAGE(bufoff, gbase, voff) do { _Pragma("unroll") for (int _i = 0; _i < 2; ++_i) \
        __builtin_amdgcn_global_load_lds((const unsigned*)((const char*)(gbase) + (voff)[_i]), (PG8_LAS unsigned*)(lds + (bufoff) + ldsw + _i * 8192), 16, 0, 0); } while (0)
#define PG8_LDA(dst, b, h) do { _Pragma("unroll") for (int m = 0; m < 4; ++m) _Pragma("unroll") for (int k = 0; k < 2; ++k) dst[m][k] = *(const PG8_LAS bf16x8*)(lds + PG8_SA(b, h) + aoff + m * 2048 + k * 1024); } while (0)
#define PG8_LDB(dst, b, h) do { _Pragma("unroll") for (int n = 0; n < 2; ++n) _Pragma("unroll") for (int k = 0; k < 2; ++k) dst[n][k] = *(const PG8_LAS bf16x8*)(lds + PG8_SB(b, h) + boff + n * 2048 + k * 1024); } while (0)
#define PG8_MMA(ai, bj, At, Bt) do { __builtin_amdgcn_s_setprio(1); _Pragma("unroll") for (int m = 0; m < 4; ++m) _Pragma("unroll") for (int n = 0; n < 2; ++n) _Pragma("unroll") for (int k = 0; k < 2; ++k) \
        acc[ai][bj][m][n] = __builtin_amdgcn_mfma_f32_16x16x32_bf16(Bt[n][k], At[m][k], acc[ai][bj][m][n], 0, 0, 0); __builtin_amdgcn_s_setprio(0); } while (0)
#define PG8_WAIT_V(n) asm volatile("s_waitcnt vmcnt(" #n ")" ::: "memory")
#define PG8_WAIT_L(n) asm volatile("s_waitcnt lgkmcnt(" #n ")" ::: "memory")
#define PG8_BAR __builtin_amdgcn_s_barrier()
#define PG8_SCHED __builtin_amdgcn_sched_barrier(0)
    Unit cur, nxt; int ui = 0;
    if (!S.next(0, cur)) return;
    f32x4 acc[2][2][4][2];
#pragma unroll
    for (int a = 0; a < 2; ++a)
#pragma unroll
        for (int b = 0; b < 2; ++b)
#pragma unroll
            for (int m = 0; m < 4; ++m)
#pragma unroll
                for (int n = 0; n < 2; ++n) acc[a][b][m][n] = (f32x4){0.f, 0.f, 0.f, 0.f};
    bf16x8 At[4][2], B0[2][2], B1[2][2];
    const char* cA = (const char*)g.A + (size_t)cur.pm * tstep + (size_t)cur.kt0 * kstep; const char* cB = (const char*)g.Bt + (size_t)cur.pn * tstep + (size_t)cur.kt0 * kstep;
    S.a_ready(cur);
    if constexpr (SP2) {
        PG8_STAGE(PG8_SB(0, 0), cB, voffB); PG8_STAGE(PG8_SB(0, 1), cB + hstep, voffB); PG8_STAGE(PG8_SA(0, 0), cA, voffA); PG8_STAGE(PG8_SA(0, 1), cA + hstep, voffA);
        if (wr == 1) PG8_BAR;
        PG8_WAIT_V(2); PG8_BAR;
        PG8_STAGE(PG8_SB(1, 0), cB + kstep, voffB); PG8_STAGE(PG8_SA(1, 0), cA + kstep, voffA); PG8_STAGE(PG8_SB(1, 1), cB + hstep + kstep, voffB);
        PG8_WAIT_V(6); PG8_BAR;
    } else {
        PG8_STAGE(PG8_SB(0, 0), cB, voffB); PG8_STAGE(PG8_SA(0, 0), cA, voffA); PG8_STAGE(PG8_SB(0, 1), cB + hstep, voffB); PG8_STAGE(PG8_SA(0, 1), cA + hstep, voffA);
        if (wr == 1) PG8_BAR;
        PG8_WAIT_V(4); PG8_BAR;
        PG8_STAGE(PG8_SB(1, 0), cB + kstep, voffB); PG8_STAGE(PG8_SA(1, 0), cA + kstep, voffA); PG8_STAGE(PG8_SB(1, 1), cB + hstep + kstep, voffB);
        PG8_WAIT_V(6); PG8_BAR;
    }
    for (;;) {
        const bool has_next = S.next(ui + 1, nxt);
        const char* nA = has_next ? (const char*)g.A + (size_t)nxt.pm * tstep + (size_t)nxt.kt0 * kstep : cA; const char* nB = has_next ? (const char*)g.Bt + (size_t)nxt.pn * tstep + (size_t)nxt.kt0 * kstep : cB;
        const int ntu = cur.ntk ? cur.ntk : nt;
        for (int t = 0; t < ntu; t += 2) {
            const bool last = (t == ntu - 2);
            const char* a1 = cA + (size_t)(t + 1) * kstep;
            const char* a2 = last ? nA : cA + (size_t)(t + 2) * kstep; const char* b2 = last ? nB : cB + (size_t)(t + 2) * kstep;
            const char* a3 = a2 + kstep; const char* b3 = b2 + kstep;
            if (last && has_next) S.a_ready(nxt);
            if constexpr (SP2) {
            PG8_LDB(B0, 0, 0); PG8_LDB(B1, 0, 1); PG8_SCHED; PG8_LDA(At, 0, 0); PG8_STAGE(PG8_SA(1, 1), a1 + hstep, voffA);
            PG8_WAIT_V(8); PG8_WAIT_L(0); PG8_BAR; PG8_MMA(0, 0, At, B0); PG8_MMA(0, 1, At, B1); PG8_BAR; PG8_SCHED;
            PG8_LDA(At, 0, 1); PG8_STAGE(PG8_SB(0, 0), b2, voffB); PG8_STAGE(PG8_SB(0, 1), b2 + hstep, voffB); PG8_STAGE(PG8_SA(0, 0), a2, voffA);
            PG8_WAIT_V(8); PG8_WAIT_L(0); PG8_BAR; PG8_MMA(1, 0, At, B0); PG8_MMA(1, 1, At, B1); PG8_BAR; PG8_SCHED;
            PG8_LDB(B0, 1, 0); PG8_LDB(B1, 1, 1); PG8_SCHED; PG8_LDA(At, 1, 0); PG8_STAGE(PG8_SA(0, 1), a2 + hstep, voffA);
            PG8_WAIT_V(8); PG8_WAIT_L(0); PG8_BAR; PG8_MMA(0, 0, At, B0); PG8_MMA(0, 1, At, B1); PG8_BAR; PG8_SCHED;
            PG8_LDA(At, 1, 1); PG8_STAGE(PG8_SB(1, 0), b3, voffB); PG8_STAGE(PG8_SB(1, 1), b3 + hstep, voffB); PG8_STAGE(PG8_SA(1, 0), a3, voffA);
            PG8_WAIT_V(8); PG8_WAIT_L(0); PG8_BAR; PG8_MMA(1, 0, At, B0); PG8_MMA(1, 1, At, B1); PG8_BAR; PG8_SCHED;
            } else {
            PG8_LDB(B0, 0, 0); PG8_SCHED; PG8_LDA(At, 0, 0); PG8_STAGE(PG8_SA(1, 1), a1 + hstep, voffA);
            PG8_WAIT_L(8); PG8_BAR; PG8_WAIT_L(0); PG8_MMA(0, 0, At, B0); PG8_BAR; PG8_SCHED;
            PG8_LDB(B1, 0, 1); PG8_STAGE(PG8_SB(0, 0), b2, voffB);
            PG8_BAR; PG8_WAIT_L(0); PG8_MMA(0, 1, At, B1); PG8_BAR;
            PG8_LDA(At, 0, 1); PG8_STAGE(PG8_SA(0, 0), a2, voffA);
            PG8_BAR; PG8_WAIT_L(0); PG8_MMA(1, 0, At, B0); PG8_BAR; PG8_SCHED;
            PG8_STAGE(PG8_SB(0, 1), b2 + hstep, voffB);
            PG8_WAIT_V(6); PG8_BAR; PG8_MMA(1, 1, At, B1); PG8_BAR;
            PG8_LDB(B0, 1, 0); PG8_SCHED; PG8_LDA(At, 1, 0); PG8_STAGE(PG8_SA(0, 1), a2 + hstep, voffA);
            PG8_WAIT_L(8); PG8_BAR; PG8_WAIT_L(0); PG8_MMA(0, 0, At, B0); PG8_BAR; PG8_SCHED;
            PG8_LDB(B1, 1, 1); PG8_STAGE(PG8_SB(1, 0), b3, voffB);
            PG8_BAR; PG8_WAIT_L(0); PG8_MMA(0, 1, At, B1); PG8_BAR;
            PG8_LDA(At, 1, 1); PG8_STAGE(PG8_SA(1, 0), a3, voffA);
            PG8_BAR; PG8_WAIT_L(0); PG8_MMA(1, 0, At, B0); PG8_BAR; PG8_SCHED;
            PG8_STAGE(PG8_SB(1, 1), b3 + hstep, voffB);
            PG8_WAIT_V(6); PG8_BAR; PG8_MMA(1, 1, At, B1); PG8_BAR;
            }
        }
        if constexpr (ALIGN_EPI) { if (wr == 0) PG8_BAR; }
        if constexpr (!Epi::AFTER_DRAIN) { E(acc, cur, wr, wc, fr, fq); S.done(cur); }
        if (!has_next) break;
#pragma unroll
        for (int a = 0; a < 2; ++a)
#pragma unroll
            for (int b = 0; b < 2; ++b)
#pragma unroll
                for (int m = 0; m < 4; ++m)
#pragma unroll
                    for (int n = 0; n < 2; ++n) acc[a][b][m][n] = (f32x4){0.f, 0.f, 0.f, 0.f};
        cur = nxt; cA = nA; cB = nB; ++ui;
        if constexpr (ALIGN_EPI) { if (wr == 1) PG8_BAR; }
    }
    PG8_WAIT_V(0);
    if constexpr (!ALIGN_EPI) { if (wr == 0) PG8_BAR; }
    PG8_BAR;
    if constexpr (Epi::AFTER_DRAIN) { E.fused(acc, cur, wr, wc, fr, fq, lds, wid, lane); S.done(cur); }
#undef PG8_SA
#undef PG8_SB
#undef PG8_STAGE
#undef PG8_LDA
#undef PG8_LDB
#undef PG8_MMA
#undef PG8_WAIT_V
#undef PG8_WAIT_L
#undef PG8_BAR
#undef PG8_SCHED
}
}
#define GAS __attribute__((address_space(1)))
#define LAS __attribute__((address_space(3)))
typedef unsigned short bf16;
typedef unsigned v4u __attribute__((ext_vector_type(4)));
typedef float f32x4 __attribute__((ext_vector_type(4)));
typedef short bf16x8 __attribute__((ext_vector_type(8)));
typedef GAS unsigned gu32;
typedef GAS unsigned long long gu64;
#define RLX_AGENT __ATOMIC_RELAXED, __HIP_MEMORY_SCOPE_AGENT
#define LDS_WAIT() asm volatile("s_waitcnt lgkmcnt(0)" ::: "memory")
#define VM_WAIT() asm volatile("s_waitcnt vmcnt(0)" ::: "memory")
__device__ __forceinline__ unsigned long long rt() { return __builtin_amdgcn_s_memrealtime(); }
__device__ __forceinline__ unsigned f2bf(float f) { unsigned u = __builtin_bit_cast(unsigned, f); return (u + 0x7fffu + ((u >> 16) & 1u)) >> 16; }
__device__ __forceinline__ unsigned pk2(float lo, float hi) { return f2bf(lo) | (f2bf(hi) << 16); }

#define XB_TMO      128
#define XB_XCNT(j)  (256  + 64 * (j))
#define XB_XSUB(j)  (1280 + 64 * (j))
#define XB_XGEN(j)  (2304 + 64 * (j))
#define XB_TOP      3328
#define XB_TOPGEN   3392
#define XCD_BAR_WORDS 3456
#define XB_SPIN_CAP (1u << 18)

__device__ __forceinline__ unsigned xb_ld(unsigned* p)              { return __hip_atomic_load(p, __ATOMIC_RELAXED, __HIP_MEMORY_SCOPE_AGENT); }
__device__ __forceinline__ unsigned xb_add(unsigned* p, unsigned v) { return __hip_atomic_fetch_add(p, v, __ATOMIC_RELAXED, __HIP_MEMORY_SCOPE_AGENT); }
__device__ __forceinline__ unsigned xb_xcc_id() { return (unsigned)__builtin_amdgcn_s_getreg((3 << 11) | 20) & 0xFu; }
#define XB_SPIN(cond, bar) do { unsigned _sp = 0; while (cond) { __builtin_amdgcn_s_sleep(1); \
    if ((++_sp & 255u) == 0u) { if (xb_ld(&(bar)[XB_TMO])) break; if (_sp > XB_SPIN_CAP) { atomicAdd(&(bar)[XB_TMO], 1u); break; } } } } while (0)

struct XcdBarrier {
    unsigned* bar; unsigned x;
    volatile LAS unsigned* st;
};

__device__ __forceinline__ XcdBarrier xcd_barrier_post(unsigned* bar, volatile LAS unsigned* st) {
    XcdBarrier b; b.bar = bar; b.x = xb_xcc_id(); b.st = st;
    if (threadIdx.x == 0) (void)xb_add(&bar[XB_XCNT(b.x)], 1u);
    return b;
}
__device__ __forceinline__ void xcd_barrier_complete(unsigned* bar, unsigned x, unsigned& nloc, unsigned& nx) {
    const unsigned G = gridDim.x * gridDim.y * gridDim.z;
    unsigned sum, cnt, mine, sp = 0u;
    for (;;) {
        sum = 0u; cnt = 0u; mine = 0u;
#pragma unroll
        for (unsigned j = 0; j < 16; ++j) { const unsigned c = xb_ld(&bar[XB_XCNT(j)]); sum += c; cnt += (c > 0u) ? 1u : 0u; mine = (j == x) ? c : mine; }
        if (sum == G) break;
        __builtin_amdgcn_s_sleep(1);
        if ((++sp & 255u) == 0u) { if (xb_ld(&bar[XB_TMO])) break; if (sp > XB_SPIN_CAP) { atomicAdd(&bar[XB_TMO], 1u); break; } }
    }
    nloc = mine > 0u ? mine : 1u; nx = cnt > 0u ? cnt : 1u;
}

__device__ __forceinline__ void xcd_barrier(const XcdBarrier& b) {
    asm volatile("s_waitcnt vmcnt(0)" ::: "memory");
    __syncthreads();
    if (threadIdx.x == 0) {
        unsigned* bar = b.bar;
        __builtin_amdgcn_s_waitcnt(0);
        unsigned nloc = b.st[0], nx = b.st[1];
        if (nloc == 0u) { xcd_barrier_complete(bar, b.x, nloc, nx); b.st[0] = nloc; b.st[1] = nx; }
        const unsigned old = xb_add(&bar[XB_XSUB(b.x)], 1u);
        const unsigned gen = old / nloc;
        if (old + 1u == (gen + 1u) * nloc) {
            __builtin_amdgcn_fence(__ATOMIC_RELEASE, "agent");
            asm volatile("s_waitcnt vmcnt(0)" ::: "memory");
            const unsigned og = xb_add(&bar[XB_TOP], 1u);
            const unsigned tg = og / nx;
            if (og + 1u == (tg + 1u) * nx) xb_add(&bar[XB_TOPGEN], 1u);
            else XB_SPIN(xb_ld(&bar[XB_TOPGEN]) == tg, bar);
            __builtin_amdgcn_fence(__ATOMIC_ACQUIRE, "agent");
            xb_add(&bar[XB_XGEN(b.x)], 1u);
            asm volatile("s_waitcnt vmcnt(0)" ::: "memory");
        } else {
            XB_SPIN(xb_ld(&bar[XB_XGEN(b.x)]) == gen, bar);
            __builtin_amdgcn_fence(__ATOMIC_ACQUIRE, "agent");
            asm volatile("s_waitcnt vmcnt(0)" ::: "memory");
        }
    }
    __syncthreads();
}
namespace att {
typedef unsigned short bf16_t;
using bf16x8 = __attribute__((ext_vector_type(8))) short;
using s16x4  = __attribute__((ext_vector_type(4))) short;
using f32x16 = __attribute__((ext_vector_type(16))) float;
using f32x8  = __attribute__((ext_vector_type(8))) float;
using u32x4  = __attribute__((ext_vector_type(4))) unsigned;
constexpr int NW = 8, QBLK = 32, KVBLK = 64;
constexpr int SHM_V = KVBLK * 128 * 2;
constexpr int SHM_KMAX = KVBLK * 192 * 2;
constexpr int LDS_V = 0, LDS_K = 2 * SHM_V, LDS_WS = LDS_K + 2 * SHM_KMAX, LDS_BYTES = LDS_WS + NW * 64 * 4;
#define ASBAR() __builtin_amdgcn_sched_barrier(0)
__device__ __forceinline__ int crow(int r, int hi) { return (r & 3) + 8 * (r >> 2) + 4 * hi; }
typedef float f32x2c_t __attribute__((ext_vector_type(2))); typedef __bf16 bf16x2c_t __attribute__((ext_vector_type(2)));
__device__ __forceinline__ unsigned cvtpk(float lo, float hi) { f32x2c_t v = {lo, hi}; bf16x2c_t b = __builtin_convertvector(v, bf16x2c_t); return __builtin_bit_cast(unsigned, b); }
template <typename TIn> struct Stage;
template <> struct Stage<bf16_t> { using T = bf16x8; static constexpr int NLD = 1;
  __device__ static __forceinline__ T ld8(const bf16_t* p) { return *reinterpret_cast<const bf16x8*>(p); }
  __device__ static __forceinline__ bf16x8 tobf(T x) { return x; } };
template <> struct Stage<float> { using T = f32x8; static constexpr int NLD = 2;
  __device__ static __forceinline__ T ld8(const float* p) { return *reinterpret_cast<const f32x8*>(p); }
  __device__ static __forceinline__ bf16x8 tobf(T x) { u32x4 w = {cvtpk(x[0], x[1]), cvtpk(x[2], x[3]), cvtpk(x[4], x[5]), cvtpk(x[6], x[7])}; return *reinterpret_cast<bf16x8*>(&w); } };

template <int NDQ> __device__ __forceinline__ int kswz(int row, int ch) { return row * (32 * NDQ) + ((ch ^ ((row >> 1) & 7)) << 4); }

__device__ __forceinline__ void partialSM(f32x16& p0, f32x16& p1, float& m_reg, float& mn, float& alpha, const float C, const float THRS) {
  float pmax = p0[0];
#pragma unroll
  for (int r = 1; r < 16; ++r) pmax = fmaxf(pmax, p0[r]);
#pragma unroll
  for (int r = 0; r < 16; ++r) pmax = fmaxf(pmax, p1[r]);
  { auto rr = __builtin_amdgcn_permlane32_swap(__float_as_uint(pmax), __float_as_uint(pmax), false, false);
    pmax = fmaxf(__uint_as_float(rr[0]), __uint_as_float(rr[1])); }
  if (__builtin_expect(__all(pmax - m_reg <= THRS), 1)) { mn = m_reg; alpha = 1.f; }
  else { mn = fmaxf(m_reg, pmax); alpha = __builtin_amdgcn_exp2f((m_reg - mn) * C); m_reg = mn; }
  const float mnC = -mn * C;
#pragma unroll
  for (int r = 0; r < 16; ++r) p0[r] = fmaf(p0[r], C, mnC);
#pragma unroll
  for (int r = 0; r < 16; ++r) p1[r] = fmaf(p1[r], C, mnC);
#pragma unroll
  for (int r = 0; r < 16; ++r) p0[r] = __builtin_amdgcn_exp2f(p0[r]);
}
__device__ __forceinline__ void finishSM(f32x16& p0, f32x16& p1, float alpha, float& l_reg, bf16x8& pa0, bf16x8& pa1, bf16x8& pa2, bf16x8& pa3) {
#pragma unroll
  for (int r = 0; r < 16; ++r) p1[r] = __builtin_amdgcn_exp2f(p1[r]);
  float ps = 0;
#pragma unroll
  for (int r = 0; r < 16; ++r) ps += p0[r];
#pragma unroll
  for (int r = 0; r < 16; ++r) ps += p1[r];
  { auto rr = __builtin_amdgcn_permlane32_swap(__float_as_uint(ps), __float_as_uint(ps), false, false);
    ps = __uint_as_float(rr[0]) + __uint_as_float(rr[1]); }
  l_reg = l_reg * alpha + ps;
#define ATT_PK4(P, BASE, OUT) do { unsigned a0 = cvtpk(P[BASE + 0], P[BASE + 1]), a1 = cvtpk(P[BASE + 2], P[BASE + 3]);   \
    unsigned b0 = cvtpk(P[BASE + 4], P[BASE + 5]), b1 = cvtpk(P[BASE + 6], P[BASE + 7]);                              \
    auto r0 = __builtin_amdgcn_permlane32_swap(a0, b0, false, false); auto r1 = __builtin_amdgcn_permlane32_swap(a1, b1, false, false); \
    u32x4 w = {r0[0], r1[0], r0[1], r1[1]}; OUT = *reinterpret_cast<bf16x8*>(&w); } while (0)
  ATT_PK4(p0, 0, pa0); ATT_PK4(p0, 8, pa1); ATT_PK4(p1, 0, pa2); ATT_PK4(p1, 8, pa3);
#undef ATT_PK4
}
template <int NDQ> __device__ __forceinline__ void qkt(f32x16& p0, f32x16& p1, const char* Ks, const bf16x8 (&qr)[NDQ], int r32, int hi) {
  p0 = f32x16{}; p1 = f32x16{};
  const int f = (r32 >> 1) & 7; int kb[4];
#pragma unroll
  for (int q = 0; q < 4; ++q) kb[q] = r32 * (32 * NDQ) + (((2 * q + hi) ^ f) << 4);
#pragma unroll
  for (int d0 = 0; d0 < NDQ; ++d0) { const char* kp = Ks + kb[d0 & 3] + 128 * (d0 >> 2);
    const bf16x8 b0 = *reinterpret_cast<const bf16x8*>(kp);
    const bf16x8 b1 = *reinterpret_cast<const bf16x8*>(kp + 32 * 32 * NDQ);
    p0 = __builtin_amdgcn_mfma_f32_32x32x16_bf16(b0, qr[d0], p0, 0, 0, 0);
    p1 = __builtin_amdgcn_mfma_f32_32x32x16_bf16(b1, qr[d0], p1, 0, 0, 0); }
}
__device__ __forceinline__ int v_st(int k, int c) { const int kk = (k & ~0xC) | ((k & 4) << 1) | ((k & 8) >> 1); return ((kk >> 3) * 4 + (c >> 5)) * 512 + ((kk & 7) * 32 + (c & 31)) * 2; }
__device__ __forceinline__ int v_rd_base(int lane) { return ((lane & 3) << 3) | (((lane >> 2) & 3) << 6) | (((lane >> 4) & 1) << 5) | (((lane >> 5) & 1) << 8); }
constexpr int v_rd_off(int d0, int ks, int half) { return d0 * 512 + ks * 4096 + half * 2048; }
template <int OFF> __device__ __forceinline__ s16x4 tr_read(int vb) { s16x4 r; asm volatile("ds_read_b64_tr_b16 %0, %1 offset:%2" : "=&v"(r) : "v"(vb), "i"(OFF) : "memory"); return r; }
template <int D0> __device__ __forceinline__ void pv_one(f32x16& od, int vb, bf16x8 pa0, bf16x8 pa1, bf16x8 pa2, bf16x8 pa3) {
  const s16x4 l0 = tr_read<v_rd_off(D0, 0, 0)>(vb), h0 = tr_read<v_rd_off(D0, 0, 1)>(vb), l1 = tr_read<v_rd_off(D0, 1, 0)>(vb), h1 = tr_read<v_rd_off(D0, 1, 1)>(vb);
  const s16x4 l2 = tr_read<v_rd_off(D0, 2, 0)>(vb), h2 = tr_read<v_rd_off(D0, 2, 1)>(vb), l3 = tr_read<v_rd_off(D0, 3, 0)>(vb), h3 = tr_read<v_rd_off(D0, 3, 1)>(vb);
  asm volatile("s_waitcnt lgkmcnt(0)" ::: "memory"); ASBAR();
#define ATT_PK(L, H) (bf16x8){L[0], L[1], L[2], L[3], H[0], H[1], H[2], H[3]}
  od = __builtin_amdgcn_mfma_f32_32x32x16_bf16(pa0, ATT_PK(l0, h0), od, 0, 0, 0);
  od = __builtin_amdgcn_mfma_f32_32x32x16_bf16(pa1, ATT_PK(l1, h1), od, 0, 0, 0);
  od = __builtin_amdgcn_mfma_f32_32x32x16_bf16(pa2, ATT_PK(l2, h2), od, 0, 0, 0);
  od = __builtin_amdgcn_mfma_f32_32x32x16_bf16(pa3, ATT_PK(l3, h3), od, 0, 0, 0);
#undef ATT_PK
}
__device__ __forceinline__ void pv_d0(f32x16 (&o)[4], int vb, bf16x8 pa0, bf16x8 pa1, bf16x8 pa2, bf16x8 pa3) {
  pv_one<0>(o[0], vb, pa0, pa1, pa2, pa3); pv_one<1>(o[1], vb, pa0, pa1, pa2, pa3); pv_one<2>(o[2], vb, pa0, pa1, pa2, pa3); pv_one<3>(o[3], vb, pa0, pa1, pa2, pa3);
}

template <typename TKV> struct Src { const TKV* kp; const TKV* kn; const TKV* k2p; const TKV* k2n; const TKV* vp; const TKV* vn; int npast, nvalid; };

template <int NDQ, typename TKV, int LDK, int LDK2, int LDV>
__device__ __forceinline__ void attn_core(const bf16x8 (&qr)[NDQ], const Src<TKV>& S, const int NT, const int limit, const bool active, const float C, const float THRS,
                                          char* lds, f32x16 (&o)[4], float& l_reg) {
  using St = Stage<TKV>;
  constexpr int SHM_K = KVBLK * 32 * NDQ;
  int tid_ = threadIdx.x; asm volatile("" : "+v"(tid_));
  const int tid = tid_, wid = tid >> 6, lane = tid & 63, r32 = lane & 31, hi = lane >> 5;
  char* V_lds = lds + LDS_V; char* K_lds = lds + LDS_K;
  float* al_l = (float*)(lds + LDS_WS) + wid * 64 + 32;
  float m_reg = -1e30f; l_reg = 0.f;
#pragma unroll
  for (int d = 0; d < 4; ++d) o[d] = f32x16{};
  const int sr = tid >> 4, sc = (tid & 15) * 8, vst0 = v_st(sr, sc), vst1 = v_st(32 + sr, sc);
  const int kr8 = tid >> 3, kc8 = tid & 7;
  const int vb0 = (int)(uintptr_t)V_lds + v_rd_base(lane);
  struct Slot { typename St::T vs0, vs1, ks0, ks1, ks2; } sl[1];
#define ATT_SLOAD(i, j) do { const int jj_ = (j) < S.nvalid ? (j) : S.nvalid - 1; const bool ps_ = jj_ < S.npast; const long r0_ = ps_ ? (long)jj_ * 64 : (long)(jj_ - S.npast) * 64; \
    const TKV* vb_ = ps_ ? S.vp : S.vn; const TKV* kb_ = ps_ ? S.kp : S.kn; \
    sl[i].vs0 = St::ld8(vb_ + (r0_ + sr) * LDV + sc); sl[i].vs1 = St::ld8(vb_ + (r0_ + 32 + sr) * LDV + sc); \
    if constexpr (NDQ == 4) { sl[i].ks0 = St::ld8(kb_ + (r0_ + kr8) * LDK + kc8 * 8); } \
    else { const TKV* k2_ = ps_ ? S.k2p : S.k2n; sl[i].ks0 = St::ld8(kb_ + (r0_ + sr) * LDK + sc); sl[i].ks1 = St::ld8(kb_ + (r0_ + 32 + sr) * LDK + sc); sl[i].ks2 = St::ld8(k2_ + (r0_ + kr8) * LDK2 + kc8 * 8); } } while (0)
#define ATT_SWRITE(b, i) do { *(bf16x8*)(V_lds + (b) * SHM_V + vst0) = St::tobf(sl[i].vs0); *(bf16x8*)(V_lds + (b) * SHM_V + vst1) = St::tobf(sl[i].vs1); \
    if constexpr (NDQ == 4) { *(bf16x8*)(K_lds + (b) * SHM_K + kswz<NDQ>(kr8, kc8)) = St::tobf(sl[i].ks0); } \
    else { *(bf16x8*)(K_lds + (b) * SHM_K + kswz<NDQ>(sr, tid & 15)) = St::tobf(sl[i].ks0); *(bf16x8*)(K_lds + (b) * SHM_K + kswz<NDQ>(32 + sr, tid & 15)) = St::tobf(sl[i].ks1); \
           *(bf16x8*)(K_lds + (b) * SHM_K + kswz<NDQ>(kr8, 16 + kc8)) = St::tobf(sl[i].ks2); } } while (0)
#define ATT_RESC(a) do { if (__any((a) < 1.f)) { if (hi == 0) al_l[r32] = (a); asm volatile("s_waitcnt lgkmcnt(0)" ::: "memory"); \
    _Pragma("unroll") for (int d = 0; d < 4; ++d) _Pragma("unroll") for (int r = 0; r < 16; ++r) o[d][r] *= al_l[crow(r, hi)]; } } while (0)
#define ATT_MASK(P0, P1, j) do { if ((j) > limit) { _Pragma("unroll") for (int r = 0; r < 16; ++r) { P0[r] = -1e30f; P1[r] = -1e30f; } } } while (0)
  f32x16 pA0, pA1; float mnA, alA = 1.f; bf16x8 pa0, pa1, pa2, pa3;
  ATT_SLOAD(0, 0); asm volatile("s_waitcnt vmcnt(0)" ::: "memory"); ATT_SWRITE(0, 0); __syncthreads();
#pragma unroll 1
  for (int j = 0; j < NT; ++j) {
    const int cur = j & 1;
    if (j + 1 < NT) ATT_SLOAD(0, j + 1);
    ASBAR();
    if (active) {
      qkt<NDQ>(pA0, pA1, K_lds + cur * SHM_K, qr, r32, hi); ATT_MASK(pA0, pA1, j);
      partialSM(pA0, pA1, m_reg, mnA, alA, C, THRS);
      ATT_RESC(alA);
      finishSM(pA0, pA1, alA, l_reg, pa0, pa1, pa2, pa3);
      ASBAR();
      pv_d0(o, vb0 + cur * SHM_V, pa0, pa1, pa2, pa3);
    }
    ASBAR();
    if (j + 1 < NT) ATT_SWRITE(cur ^ 1, 0);
    __syncthreads();
  }
#undef ATT_SLOAD
#undef ATT_SWRITE
#undef ATT_RESC
#undef ATT_MASK
}
__device__ __forceinline__ void normalize(f32x16 (&o)[4], float l_reg, char* lds, int wid, int r32, int hi) {
  float* li_l = (float*)(lds + LDS_WS) + wid * 64;
  if (hi == 0) li_l[r32] = l_reg;
  asm volatile("s_waitcnt lgkmcnt(0)" ::: "memory");
#pragma unroll
  for (int r = 0; r < 16; ++r) { const float rl = __builtin_amdgcn_rcpf(li_l[crow(r, hi)]);
#pragma unroll
    for (int d = 0; d < 4; ++d) o[d][r] *= rl; }
}
__device__ __forceinline__ unsigned short f2bf1(float f) { unsigned u = __builtin_bit_cast(unsigned, f); return (unsigned short)((u + 0x7fffu + ((u >> 16) & 1u)) >> 16); }

constexpr float LOG2E = 1.4426950408889634f;
constexpr float SCALE_A = 0.125f, SCALE_B = 0.07216878364870322f;
constexpr float THR = 8.f;

template <typename TKV>
__device__ __forceinline__ void diff_unit(const bf16_t* QA, long qrow0, int h, const Src<TKV>& S1, const Src<TKV>& S2, int NT, int limit, bool active, float lam,
                                          const float* g_subln, float* stash, bf16_t* OA, char* lds) {
  asm volatile("" : "+s"(h), "+s"(qrow0));
  const int tid = threadIdx.x, wid = tid >> 6, lane = tid & 63, r32 = lane & 31, hi = lane >> 5;
  const long qrow = qrow0 + (active ? wid * QBLK : 0) + r32;
  f32x16 o[4]; float l_reg; float* st = stash + wid * 4096;
  {
    bf16x8 qr[4];
#pragma unroll
    for (int d0 = 0; d0 < 4; ++d0) qr[d0] = *reinterpret_cast<const bf16x8*>(QA + qrow * 2048 + h * 64 + d0 * 16 + hi * 8);
    attn_core<4, TKV, 2048, 64, 2048>(qr, S1, NT, limit, active, SCALE_A * LOG2E, THR / SCALE_A, lds, o, l_reg);
  }
  if (active) { normalize(o, l_reg, lds, wid, r32, hi);
    __attribute__((address_space(1))) float* st1 = (__attribute__((address_space(1))) float*)(st + lane); asm volatile("" : "+v"(st1));
#pragma unroll
    for (int d = 0; d < 4; ++d)
#pragma unroll
      for (int r = 0; r < 16; ++r) st1[(d * 16 + r) * 64] = o[d][r]; }
  {
    bf16x8 qr[4];
#pragma unroll
    for (int d0 = 0; d0 < 4; ++d0) qr[d0] = *reinterpret_cast<const bf16x8*>(QA + qrow * 2048 + (16 + h) * 64 + d0 * 16 + hi * 8);
    attn_core<4, TKV, 2048, 64, 2048>(qr, S2, NT, limit, active, SCALE_A * LOG2E, THR / SCALE_A, lds, o, l_reg);
  }
  if (active) { normalize(o, l_reg, lds, wid, r32, hi);
    float ss[16];
    const __attribute__((address_space(1))) float* st2 = (const __attribute__((address_space(1))) float*)(st + lane); asm volatile("" : "+v"(st2));
#pragma unroll
    for (int r = 0; r < 16; ++r) ss[r] = 0.f;
#pragma unroll
    for (int d = 0; d < 4; ++d)
#pragma unroll
      for (int r = 0; r < 16; ++r) { const float a = st2[(d * 16 + r) * 64] - lam * o[d][r]; o[d][r] = a; ss[r] += a * a; }
#pragma unroll
    for (int r = 0; r < 16; ++r) { float s = ss[r]; s += __shfl_xor(s, 1); s += __shfl_xor(s, 2); s += __shfl_xor(s, 4); s += __shfl_xor(s, 8); s += __shfl_xor(s, 16);
      ss[r] = 0.8f * rsqrtf(s * (1.f / 128.f) + cfg::EPS); }
    __attribute__((address_space(1))) bf16_t* op = (__attribute__((address_space(1))) bf16_t*)(OA + (qrow0 + wid * QBLK + 4 * hi) * 2048 + h * 128 + r32); asm volatile("" : "+v"(op));
#pragma unroll
    for (int d = 0; d < 4; ++d) { const float g = g_subln[d * 32 + r32];
#pragma unroll
      for (int r = 0; r < 16; ++r) op[((r & 3) + 8 * (r >> 2)) * 2048 + d * 32] = f2bf1(o[d][r] * ss[r] * g); }
  }
}
__device__ __forceinline__ void mla_unit(const bf16_t* QB, long qrow0, int h, const Src<bf16_t>& S, int NT, int limit, bool active, bf16_t* OB, char* lds) {
  asm volatile("" : "+s"(h), "+s"(qrow0));
  const int tid = threadIdx.x, wid = tid >> 6, lane = tid & 63, r32 = lane & 31, hi = lane >> 5;
  const long qrow = qrow0 + (active ? wid * QBLK : 0) + r32;
  f32x16 o[4]; float l_reg;
  bf16x8 qr[12];
#pragma unroll
  for (int d0 = 0; d0 < 12; ++d0) qr[d0] = *reinterpret_cast<const bf16x8*>(QB + qrow * 3072 + h * 192 + d0 * 16 + hi * 8);
  attn_core<12, bf16_t, 4096, 64, 4096>(qr, S, NT, limit, active, SCALE_B * LOG2E, THR / SCALE_B, lds, o, l_reg);
  if (active) { normalize(o, l_reg, lds, wid, r32, hi);
    __attribute__((address_space(1))) bf16_t* op = (__attribute__((address_space(1))) bf16_t*)(OB + (qrow0 + wid * QBLK + 4 * hi) * 2048 + h * 128 + r32); asm volatile("" : "+v"(op));
#pragma unroll
    for (int d = 0; d < 4; ++d)
#pragma unroll
      for (int r = 0; r < 16; ++r) op[((r & 3) + 8 * (r >> 2)) * 2048 + d * 32] = f2bf1(o[d][r]); }
}
#undef ASBAR
}
#ifndef PG8_SP2
#define PG8_SP2 true
#endif
constexpr int NWAVES = 8;
constexpr int NPH = 12;
constexpr int N_LAUNCHES = MK_N_LAUNCHES;
static_assert(N_LAUNCHES == 1 || N_LAUNCHES == NPH, "MK_N_LAUNCHES is 1 or 12");

constexpr size_t MiB = 1u << 20;
constexpr size_t WS_CTL = 0, CTL_ZERO_BYTES = 1 * MiB;
constexpr size_t WS_WIN = 1 * MiB;
constexpr size_t WS_WQB = WS_WIN + (size_t)cfg::NINP * 4096 * 2;
constexpr size_t WS_WKVB = WS_WQB + (size_t)3072 * 896 * 2;
constexpr size_t WS_WBA = WS_WKVB + (size_t)4096 * 512 * 2;
constexpr size_t WS_WBB = WS_WBA + (size_t)4096 * 2048 * 2;
constexpr size_t WS_WOUT = WS_WBB + (size_t)4096 * 2048 * 2;
constexpr size_t WS_WGU = WS_WOUT + (size_t)4096 * 4096 * 2;
constexpr size_t WS_WFD = WS_WGU + (size_t)22016 * 4096 * 2;
constexpr size_t WS_TABA = WS_WFD + (size_t)4096 * 11008 * 2;
constexpr size_t WS_TABB = WS_TABA + (size_t)8192 * 8 * 8;
constexpr size_t WS_XN = WS_TABB + (size_t)8192 * 32 * 8;
constexpr size_t WS_R0 = WS_XN + (size_t)cfg::M * 4096 * 2;
constexpr size_t WS_QA = WS_R0;
constexpr size_t WS_KA = WS_QA + (size_t)cfg::M * 2048 * 2;
constexpr size_t WS_VA = WS_KA + (size_t)cfg::M * 2048 * 2;
constexpr size_t WS_RAW = WS_VA + (size_t)cfg::M * 2048 * 2;
constexpr size_t WS_CQN = WS_RAW + (size_t)cfg::M * cfg::NRAW * 4;
constexpr size_t WS_CKV = WS_CQN + (size_t)cfg::M * 896 * 2;
constexpr size_t WS_KPE = WS_CKV + (size_t)cfg::MKV * 512 * 2;
constexpr size_t WS_QB = WS_KPE + (size_t)cfg::MKV * 64 * 2;
constexpr size_t WS_KVB = WS_QB + (size_t)cfg::M * 3072 * 2;
constexpr size_t WS_G = WS_KVB + (size_t)cfg::MKV * 4096 * 2;
constexpr size_t WS_OA = WS_G + (size_t)cfg::M * 8192 * 2;
constexpr size_t WS_OB = WS_OA + (size_t)cfg::M * 2048 * 2;
constexpr size_t WS_STASH = WS_OB + (size_t)cfg::M * 2048 * 2;
constexpr size_t WS_END = WS_STASH + (size_t)256 * 8 * 4096 * 4;
constexpr size_t WS_MB = WS_QA;
constexpr size_t WS_UG = WS_R0;
constexpr size_t WS_U = WS_UG + (size_t)cfg::M * cfg::DFF * 2;
static_assert(WS_U + (size_t)cfg::M * cfg::DFF * 2 <= WS_END, "FFN overlay fits");
static_assert(WS_END < (size_t)1390 * 1000 * 1000, "workspace budget");
constexpr size_t SLAB_BYTES = (size_t)8 * 512 * 4096 * 4;
constexpr size_t WS_SLAB_A = WS_KVB, WS_SLAB_B = WS_KVB + SLAB_BYTES;
constexpr size_t WS_SLAB_D = WS_UG;
static_assert(2 * SLAB_BYTES <= (size_t)cfg::MKV * 4096 * 2 && SLAB_BYTES <= (size_t)cfg::M * cfg::DFF * 2, "slab overlays fit");
constexpr int CW_TMO = 0, CW_CODE = 1, CW_BAR = 4096;

constexpr int RING_OFF = 0, RING_BYTES = 131072;
constexpr int LDSCTL_OFF = RING_BYTES, MISC_OFF = LDSCTL_OFF + 320;
constexpr int LDS_BYTES = 147456;
static_assert(att::LDS_BYTES <= RING_BYTES && pg8::STAGE_BYTES <= RING_BYTES, "phase scratch fits the ring region");

struct Args { const float* in[29]; float* out; unsigned char* ws; int ph_lo, ph_hi; };
struct Frame {
    LAS unsigned char* lds; volatile LAS unsigned* MISC; gu32* ctl;
    int tid, lane, wave, vcu, G;
    float* out; unsigned char* ws;
};
__device__ __forceinline__ float wave_sum(float v) {
#pragma unroll
    for (int o = 1; o < 64; o <<= 1) v += __shfl_xor(v, o);
    return v;
}
template <int MAP> __device__ __forceinline__ int src_col(int n) {
    if (MAP == 1) { if (n < 6144) return n; if (n < 14336) return 7616 + (n - 6144); if (n < 15808) return 6144 + (n - 14336); return -1; }
    if (MAP == 2) { const int h = n / 192, d = n - h * 192; if (d < 128) return n; const int e = d - 128; return h * 192 + 128 + (e >> 1) + 32 * (e & 1); }
    return n;
}
template <int MAP> __device__ __forceinline__ void p0_transpose_item(const float* W, int K, int Nsrc, int Ndst, bf16* WT, int row_off, LAS float* scr, int item, int lane) {
    const int nblk = Ndst / 32, kb = item / nblk, nb = item - kb * nblk, k0 = 64 * kb, n0 = 32 * nb;
    if constexpr (MAP == 2) {
        const int sn = src_col<MAP>(n0 + (lane & 31));
#pragma unroll 8
        for (int i = 0; i < 32; ++i) { const int kk = 2 * i + (lane >> 5); scr[kk * 33 + (lane & 31)] = W[(size_t)(k0 + kk) * Nsrc + sn]; }
    } else {
        const int n4 = 4 * (lane & 7), kq = lane >> 3;
        const int sn = src_col<MAP>(n0 + n4);
        f32x4 v[8];
#pragma unroll
        for (int i = 0; i < 8; ++i) v[i] = sn >= 0 ? *(const GAS f32x4*)(W + (size_t)(k0 + 8 * i + kq) * Nsrc + sn) : (f32x4){0.f, 0.f, 0.f, 0.f};
#pragma unroll
        for (int i = 0; i < 8; ++i) { LAS float* d = scr + (8 * i + kq) * 33 + n4; d[0] = v[i].x; d[1] = v[i].y; d[2] = v[i].z; d[3] = v[i].w; }
    }
    LDS_WAIT(); asm volatile("" ::: "memory");
    const int c = lane & 7;
#pragma unroll
    for (int j = 0; j < 4; ++j) { const int n = (lane >> 3) + 8 * j; const LAS float* s = scr + (8 * c) * 33 + n;
        v4u o; o.x = pk2(s[0 * 33], s[1 * 33]); o.y = pk2(s[2 * 33], s[3 * 33]); o.z = pk2(s[4 * 33], s[5 * 33]); o.w = pk2(s[6 * 33], s[7 * 33]);
        *(GAS v4u*)(WT + (size_t)(row_off + n0 + n) * K + k0 + 8 * c) = o; }
    LDS_WAIT(); asm volatile("" ::: "memory");
}
template <typename TO> __device__ __forceinline__ void rms_row4096(const float* xrow, const float* gain, TO* orow, int lane) {
    const GAS f32x4* xr = (const GAS f32x4*)xrow + lane; const GAS f32x4* gr = (const GAS f32x4*)gain + lane;
    f32x4 v[16]; float s = 0.f;
#pragma unroll
    for (int j = 0; j < 16; ++j) { v[j] = xr[64 * j]; s += (v[j].x * v[j].x + v[j].y * v[j].y) + (v[j].z * v[j].z + v[j].w * v[j].w); }
    const float rstd = rsqrtf(wave_sum(s) * (1.f / 4096.f) + cfg::EPS);
#pragma unroll
    for (int j = 0; j < 16; ++j) { const f32x4 g = gr[64 * j]; const f32x4 y = v[j] * rstd * g;
        if constexpr (sizeof(TO) == 2) { ((GAS unsigned long long*)orow)[64 * j + lane] = (unsigned long long)pk2(y.x, y.y) | ((unsigned long long)pk2(y.z, y.w) << 32); }
        else { ((GAS f32x4*)orow)[64 * j + lane] = y; } }
}
__device__ __forceinline__ void slab_sum4(const float* slab, int srow, int q, int lane, f32x4 (&v)[4]) {
#pragma unroll
    for (int s = 0; s < 8; ++s) { const GAS f32x4* p = (const GAS f32x4*)(slab + ((size_t)s * 512 + srow) * 4096 + 1024 * q) + lane;
#pragma unroll
        for (int j = 0; j < 4; ++j) v[j] += p[64 * j]; }
}
__device__ __forceinline__ void p5c_merge_sample(Frame& F) {
    const int srow = 2 * F.vcu + (F.wave >> 2), q = F.wave & 3, lane = F.lane; if (F.vcu >= 256) return;
    f32x4 a[4], b[4];
#pragma unroll
    for (int j = 0; j < 4; ++j) { a[j] = (f32x4){0.f, 0.f, 0.f, 0.f}; b[j] = a[j]; }
    slab_sum4((const float*)(F.ws + WS_SLAB_A), srow, q, lane, a); slab_sum4((const float*)(F.ws + WS_SLAB_B), srow, q, lane, b);
    const bf16* G = (const bf16*)(F.ws + WS_G) + (size_t)(cfg::TP + srow) * 8192 + 1024 * q; bf16* MB = (bf16*)(F.ws + WS_MB) + (size_t)(cfg::TP + srow) * 4096 + 1024 * q;
#pragma unroll
    for (int j = 0; j < 4; ++j) { const int c = 4 * lane + 256 * j; const unsigned long long g0 = *(const GAS unsigned long long*)(G + c), g1 = *(const GAS unsigned long long*)(G + 4096 + c);
        const float g00 = __uint_as_float((unsigned)g0 << 16), g01 = __uint_as_float((unsigned)g0 & 0xffff0000u), g02 = __uint_as_float((unsigned)(g0 >> 32) << 16), g03 = __uint_as_float((unsigned)(g0 >> 32) & 0xffff0000u);
        const float g10 = __uint_as_float((unsigned)g1 << 16), g11 = __uint_as_float((unsigned)g1 & 0xffff0000u), g12 = __uint_as_float((unsigned)(g1 >> 32) << 16), g13 = __uint_as_float((unsigned)(g1 >> 32) & 0xffff0000u);
        const float m0 = g00 * a[j].x + g10 * b[j].x, m1 = g01 * a[j].y + g11 * b[j].y, m2 = g02 * a[j].z + g12 * b[j].z, m3 = g03 * a[j].w + g13 * b[j].w;
        *(GAS unsigned long long*)(MB + c) = (unsigned long long)pk2(m0, m1) | ((unsigned long long)pk2(m2, m3) << 32); }
}
template <typename TO> __device__ __forceinline__ void sample_rows_norm(Frame& F, const float* base_rows  , const float* slab, float* hout_rows  , const float* gain, TO* yout_rows  , LAS float* xch) {
    const int srow = 2 * (F.vcu & 255) + (F.wave >> 2), q = F.wave & 3, lane = F.lane;
    f32x4 v[4];
    { const GAS f32x4* p = (const GAS f32x4*)(base_rows + (size_t)srow * 4096 + 1024 * q) + lane;
#pragma unroll
      for (int j = 0; j < 4; ++j) v[j] = p[64 * j]; }
    slab_sum4(slab, srow, q, lane, v);
    float s = 0.f;
#pragma unroll
    for (int j = 0; j < 4; ++j) s += (v[j].x * v[j].x + v[j].y * v[j].y) + (v[j].z * v[j].z + v[j].w * v[j].w);
    s = wave_sum(s);
    if (lane == 0) xch[F.wave] = s;
    LDS_WAIT(); __syncthreads();
    const int w0 = F.wave & 4; const float tot = (xch[w0] + xch[w0 + 1]) + (xch[w0 + 2] + xch[w0 + 3]);
    const float rstd = rsqrtf(tot * (1.f / 4096.f) + cfg::EPS);
    const GAS f32x4* gr = (const GAS f32x4*)(gain + 1024 * q) + lane;
    if constexpr (sizeof(TO) == 2) { GAS f32x4* ho = (GAS f32x4*)(hout_rows + (size_t)srow * 4096 + 1024 * q) + lane;
#pragma unroll
        for (int j = 0; j < 4; ++j) ho[64 * j] = v[j]; }
#pragma unroll
    for (int j = 0; j < 4; ++j) { const f32x4 y = v[j] * rstd * gr[64 * j];
        if constexpr (sizeof(TO) == 2) ((GAS unsigned long long*)(yout_rows + (size_t)srow * 4096 + 1024 * q))[64 * j + lane] = (unsigned long long)pk2(y.x, y.y) | ((unsigned long long)pk2(y.z, y.w) << 32);
        else ((GAS f32x4*)(yout_rows + (size_t)srow * 4096 + 1024 * q))[64 * j + lane] = y; }
    __syncthreads();
}
__device__ __forceinline__ void p0_prologue(Frame& F, const Args& A) {
    LAS float* scr = (LAS float*)(F.lds + RING_OFF + F.wave * 16384);
    const int gw = F.vcu * NWAVES + F.wave, NGW = F.G * NWAVES;
    unsigned char* ws = F.ws;
    constexpr int I_IN = 64 * (cfg::NINP / 32), I_QB = 14 * 96, I_KVB = 8 * 128, I_BR = 32 * 128, I_OUT = 64 * 128, I_FF = 64 * 344, I_FD = 172 * 128;
    constexpr int NITEMS = I_IN + I_QB + I_KVB + 2 * I_BR + I_OUT + 2 * I_FF + I_FD;
    for (int it = gw; it < NITEMS; it += NGW) {
        int r = it;
        if (r < I_IN) { p0_transpose_item<1>(A.in[8], 4096, 15808, cfg::NINP, (bf16*)(ws + WS_WIN), 0, scr, r, F.lane); continue; } r -= I_IN;
        if (r < I_QB) { p0_transpose_item<2>(A.in[16], 896, 3072, 3072, (bf16*)(ws + WS_WQB), 0, scr, r, F.lane); continue; } r -= I_QB;
        if (r < I_KVB) { p0_transpose_item<0>(A.in[18], 512, 4096, 4096, (bf16*)(ws + WS_WKVB), 0, scr, r, F.lane); continue; } r -= I_KVB;
        if (r < I_BR) { p0_transpose_item<0>(A.in[14], 2048, 4096, 4096, (bf16*)(ws + WS_WBA), 0, scr, r, F.lane); continue; } r -= I_BR;
        if (r < I_BR) { p0_transpose_item<0>(A.in[19], 2048, 4096, 4096, (bf16*)(ws + WS_WBB), 0, scr, r, F.lane); continue; } r -= I_BR;
        if (r < I_OUT) { p0_transpose_item<0>(A.in[21], 4096, 4096, 4096, (bf16*)(ws + WS_WOUT), 0, scr, r, F.lane); continue; } r -= I_OUT;
        if (r < I_FF) { p0_transpose_item<0>(A.in[23], 4096, cfg::DFF, cfg::DFF, (bf16*)(ws + WS_WGU), 0, scr, r, F.lane); continue; } r -= I_FF;
        if (r < I_FF) { p0_transpose_item<0>(A.in[24], 4096, cfg::DFF, cfg::DFF, (bf16*)(ws + WS_WGU), cfg::DFF, scr, r, F.lane); continue; } r -= I_FF;
        p0_transpose_item<0>(A.in[27], cfg::DFF, 4096, 4096, (bf16*)(ws + WS_WFD), 0, scr, r, F.lane);
    }
    for (int m = gw; m < cfg::M; m += NGW) { const float* xr = m < cfg::TP ? A.in[0] + (size_t)m * 4096 : A.in[1] + (size_t)(m - cfg::TP) * 4096;
        rms_row4096<bf16>(xr, A.in[7], (bf16*)(ws + WS_XN) + (size_t)m * 4096, F.lane); }
    const int gt = gw * 64 + F.lane, NGT = NGW * 64;
    float* tabA = (float*)(ws + WS_TABA); float* tabB = (float*)(ws + WS_TABB);
    for (int i = gt; i < 8192 * 40; i += NGT) {
        int pos, fi; float ex; float* dst;
        if (i < 8192 * 8) { pos = i >> 3; fi = i & 7; ex = (float)fi * (1.f / 8.f); dst = tabA + (size_t)i * 2; }
        else { const int k = i - 8192 * 8; pos = k >> 5; fi = k & 31; ex = (float)fi * (1.f / 32.f); dst = tabB + (size_t)k * 2; }
        const float inv = exp2f(-ex * 18.931568569324174f);
        const float ang = (float)pos * inv;
        double rev = (double)ang * 0.15915494309189535; rev -= __builtin_floor(rev);
        const float fr = (float)rev;
        dst[0] = __builtin_amdgcn_cosf(fr); dst[1] = __builtin_amdgcn_sinf(fr);
    }
    { const float* src = A.in[4]; bf16* dst = (bf16*)(ws + WS_CKV) + (size_t)cfg::TP * 512;
      for (int i = gt; i < 16384 * 512 / 8; i += NGT) { const f32x4 a = *(const GAS f32x4*)(src + (size_t)i * 8), b = *(const GAS f32x4*)(src + (size_t)i * 8 + 4);
          v4u o; o.x = pk2(a.x, a.y); o.y = pk2(a.z, a.w); o.z = pk2(b.x, b.y); o.w = pk2(b.z, b.w); *(GAS v4u*)(dst + (size_t)i * 8) = o; } }
    { const float* src = A.in[5]; bf16* dst = (bf16*)(ws + WS_KPE) + (size_t)cfg::TP * 64;
      for (int i = gt; i < 16384 * 8; i += NGT) { const int row = i >> 3, c = i & 7; const f32x4 a = *(const GAS f32x4*)(src + (size_t)row * 64 + 4 * c), b = *(const GAS f32x4*)(src + (size_t)row * 64 + 32 + 4 * c);
          v4u o; o.x = pk2(a.x, b.x); o.y = pk2(a.y, b.y); o.z = pk2(a.z, b.z); o.w = pk2(a.w, b.w); *(GAS v4u*)(dst + (size_t)row * 64 + 8 * c) = o; } }
}
__device__ __forceinline__ void p2_latents(Frame& F, const Args& A) {
    const int gw = F.vcu * NWAVES + F.wave, NGW = F.G * NWAVES, lane = F.lane;
    unsigned char* ws = F.ws; const float* g_qa = A.in[15]; const float* g_kva = A.in[17]; const float* tabB = (const float*)(ws + WS_TABB);
    for (int m = gw; m < cfg::M; m += NGW) {
        const float* raw = (const float*)(ws + WS_RAW) + (size_t)m * cfg::NRAW;
        const bool smp = m >= cfg::TP; const int pos = smp ? 2048 + (m & 63) : m; const size_t mk = smp ? (size_t)m + 16384 : (size_t)m;
        float v[14]; float s = 0.f;
#pragma unroll
        for (int j = 0; j < 14; ++j) { v[j] = raw[64 * j + lane]; s += v[j] * v[j]; }
        float rstd = rsqrtf(wave_sum(s) * (1.f / 896.f) + cfg::EPS);
        bf16* cq = (bf16*)(ws + WS_CQN) + (size_t)m * 896;
#pragma unroll
        for (int j = 0; j < 14; ++j) cq[64 * j + lane] = (bf16)f2bf(v[j] * rstd * g_qa[64 * j + lane]);
        float w[8]; s = 0.f;
#pragma unroll
        for (int j = 0; j < 8; ++j) { w[j] = raw[896 + 64 * j + lane]; s += w[j] * w[j]; }
        rstd = rsqrtf(wave_sum(s) * (1.f / 512.f) + cfg::EPS);
        float* co = smp ? F.out + cfg::O_CKVS + (size_t)(m - cfg::TP) * 512 : F.out + cfg::O_CKVP + (size_t)m * 512;
        bf16* ck = (bf16*)(ws + WS_CKV) + mk * 512;
#pragma unroll
        for (int j = 0; j < 8; ++j) { const float y = w[j] * rstd * g_kva[64 * j + lane]; co[64 * j + lane] = y; ck[64 * j + lane] = (bf16)f2bf(y); }
        if (lane < 32) { const float x1 = raw[1408 + lane], x2 = raw[1440 + lane]; const float c = tabB[((size_t)pos * 32 + lane) * 2], sn = tabB[((size_t)pos * 32 + lane) * 2 + 1];
            const float o1 = x1 * c - x2 * sn, o2 = x2 * c + x1 * sn;
            float* ko = smp ? F.out + cfg::O_KPES + (size_t)(m - cfg::TP) * 64 : F.out + cfg::O_KPEP + (size_t)m * 64;
            ko[lane] = o1; ko[32 + lane] = o2;
            ((GAS unsigned*)((bf16*)(ws + WS_KPE) + mk * 64))[lane] = pk2(o1, o2); }
    }
}
__device__ __forceinline__ void unpack8f(const v4u w, float (&f)[8]) {
    f[0] = __uint_as_float(w.x << 16); f[1] = __uint_as_float(w.x & 0xffff0000u); f[2] = __uint_as_float(w.y << 16); f[3] = __uint_as_float(w.y & 0xffff0000u);
    f[4] = __uint_as_float(w.z << 16); f[5] = __uint_as_float(w.z & 0xffff0000u); f[6] = __uint_as_float(w.w << 16); f[7] = __uint_as_float(w.w & 0xffff0000u); }
__device__ __forceinline__ void p9_convact(Frame& F, const Args& A) {
    const int gt = (F.vcu * NWAVES + F.wave) * 64 + F.lane, NGT = F.G * NWAVES * 64;
    const bf16* UG = (const bf16*)(F.ws + WS_UG); bf16* U = (bf16*)(F.ws + WS_U);
    const float* wc = A.in[25]; const float* bc = A.in[26]; const float* stc = A.in[6];
    constexpr int NCC = cfg::DFF / 8, NRB = cfg::M / 16;
    for (int it = gt; it < NRB * NCC; it += NGT) {
        const int rb = it / NCC, cc = it - rb * NCC, m0 = rb * 16, col = cc * 8;
        float w0[8], w1[8], w2[8], b[8], p2[8], p1[8];
#pragma unroll
        for (int e = 0; e < 8; ++e) { w0[e] = wc[col + e]; w1[e] = wc[cfg::DFF + col + e]; w2[e] = wc[2 * cfg::DFF + col + e]; b[e] = bc[col + e]; }
        const bool start = (m0 == 0) || (m0 >= cfg::TP && (m0 & 63) == 0);
        if (start) {
            if (m0 == 0) {
#pragma unroll
                for (int e = 0; e < 8; ++e) { p2[e] = 0.f; p1[e] = 0.f; }
            } else { const int bb = (m0 - cfg::TP) >> 6;
#pragma unroll
                for (int e = 0; e < 8; ++e) { p2[e] = stc[(size_t)(bb * 2 + 0) * cfg::DFF + col + e]; p1[e] = stc[(size_t)(bb * 2 + 1) * cfg::DFF + col + e]; } }
        } else { unpack8f(*(const GAS v4u*)(UG + (size_t)(m0 - 2) * cfg::DFF + col), p2); unpack8f(*(const GAS v4u*)(UG + (size_t)(m0 - 1) * cfg::DFF + col), p1); }
#pragma unroll 4
        for (int i = 0; i < 16; ++i) { const size_t off = (size_t)(m0 + i) * cfg::DFF + col; float cur[8], uu[8], a[8];
            unpack8f(*(const GAS v4u*)(UG + off), cur); unpack8f(*(const GAS v4u*)(U + off), uu);
#pragma unroll
            for (int e = 0; e < 8; ++e) { const float c = b[e] + w0[e] * p2[e] + w1[e] * p1[e] + w2[e] * cur[e]; a[e] = c * __builtin_amdgcn_rcpf(1.f + __expf(-c)) * uu[e]; p2[e] = p1[e]; p1[e] = cur[e]; }
            v4u o; o.x = pk2(a[0], a[1]); o.y = pk2(a[2], a[3]); o.z = pk2(a[4], a[5]); o.w = pk2(a[6], a[7]); *(GAS v4u*)(U + off) = o; }
    }
}
__device__ __forceinline__ void p4_attention(Frame& F, const Args& A, char* lds) {
    using att::bf16_t; using att::Src;
    unsigned char* ws = F.ws; const int wid = F.wave;
    const bf16_t* QA = (const bf16_t*)(ws + WS_QA); const bf16_t* KA = (const bf16_t*)(ws + WS_KA); const bf16_t* VA = (const bf16_t*)(ws + WS_VA);
    const bf16_t* QB = (const bf16_t*)(ws + WS_QB); const bf16_t* KVB = (const bf16_t*)(ws + WS_KVB); const bf16_t* KPE = (const bf16_t*)(ws + WS_KPE);
    bf16_t* OA = (bf16_t*)(ws + WS_OA); bf16_t* OB = (bf16_t*)(ws + WS_OB);
    float lam;
    { const float a = A.in[9][F.lane] * A.in[10][F.lane], b = A.in[11][F.lane] * A.in[12][F.lane]; lam = __expf(wave_sum(a)) - __expf(wave_sum(b)) + 0.2f; }
    const float* g_subln = A.in[13];
    { const int v = F.vcu & 255;
        float* stash = (float*)(ws + WS_STASH) + (size_t)v * 8 * 4096;
        const int h = v >> 4, s = v & 15;
#ifndef ATT_SEL
#define ATT_SEL 7
#endif
#pragma unroll 1
        for (int k = 0; k < ((ATT_SEL & 1) ? 2 : 0); ++k) {
            const int qb = k ? 31 - s : s, NT = 4 * qb + 4, limit = 4 * qb + (wid >> 1);
            Src<bf16_t> S1{KA + h * 64, KA + h * 64, nullptr, nullptr, VA + h * 128, VA + h * 128, NT, NT};
            Src<bf16_t> S2{KA + (16 + h) * 64, KA + (16 + h) * 64, nullptr, nullptr, VA + h * 128, VA + h * 128, NT, NT};
            att::diff_unit<bf16_t>(QA, (long)qb * 256, h, S1, S2, NT, limit, true, lam, g_subln, stash, OA, lds);
        }
#pragma unroll 1
        for (int k = 0; k < ((ATT_SEL & 2) ? 3 : 0); ++k) {
            if (k < 2) { const int qb = k ? 31 - s : s, NT = 4 * qb + 4, limit = 4 * qb + (wid >> 1);
                Src<bf16_t> S{KVB + h * 256, KVB + h * 256, KPE, KPE, KVB + h * 256 + 128, KVB + h * 256 + 128, NT, NT};
                att::mla_unit(QB, (long)qb * 256, h, S, NT, limit, true, OB, lds);
            } else if (v >= 128) { const int b = (v - 128) >> 4, hh = v & 15;
                const bf16_t* kp = KVB + (size_t)(cfg::TP + b * 2048) * 4096 + hh * 256; const bf16_t* kn = KVB + (size_t)(cfg::TP + 16384 + b * 64) * 4096 + hh * 256;
                Src<bf16_t> S{kp, kn, KPE + (size_t)(cfg::TP + b * 2048) * 64, KPE + (size_t)(cfg::TP + 16384 + b * 64) * 64, kp + 128, kn + 128, 32, 33};
                att::mla_unit(QB, (long)cfg::TP + b * 64, hh, S, 34, 32, wid < 2, OB, lds);
            }
        }
        if ((ATT_SEL & 4) && v < 128) { const int b = v >> 4, hh = v & 15;
            const float* kp = A.in[2] + (size_t)b * 2048 * 2048 + hh * 64; const float* kn = F.out + cfg::O_DKS + (size_t)b * 64 * 2048 + hh * 64;
            const float* vp = A.in[3] + (size_t)b * 2048 * 2048 + hh * 128; const float* vn = F.out + cfg::O_DVS + (size_t)b * 64 * 2048 + hh * 128;
            Src<float> S1{kp, kn, nullptr, nullptr, vp, vn, 32, 33};
            Src<float> S2{kp + 16 * 64, kn + 16 * 64, nullptr, nullptr, vp, vn, 32, 33};
            att::diff_unit<float>(QA, (long)cfg::TP + b * 64, hh, S1, S2, 34, 32, wid < 2, lam, g_subln, stash, OA, lds);
        }
    }
}

__global__ void __launch_bounds__(NWAVES * 64, 2) fwd(Args args) {
    extern __shared__ __attribute__((aligned(16))) unsigned char lds[];
    Frame F;
    F.lds = (LAS unsigned char*)lds; F.MISC = (volatile LAS unsigned*)(F.lds + MISC_OFF);
    F.tid = threadIdx.x; F.lane = F.tid & 63; F.wave = __builtin_amdgcn_readfirstlane(F.tid >> 6);
    F.G = gridDim.x; { const int bx = blockIdx.x; F.vcu = (F.G % 8 == 0) ? (bx % 8) * (F.G / 8) + bx / 8 : bx; }
    F.out = args.out; F.ws = args.ws; unsigned char* ws = args.ws;
    F.ctl = (gu32*)(ws + WS_CTL);
    for (int u = F.tid; u < (LDS_BYTES - LDSCTL_OFF) / 4; u += NWAVES * 64) ((LAS unsigned*)(F.lds + LDSCTL_OFF))[u] = 0u;
    __syncthreads();
    XcdBarrier bar; bar.bar = (unsigned*)(F.ctl + CW_BAR); bar.x = 0; bar.st = nullptr;
    if (N_LAUNCHES == 1) bar = xcd_barrier_post((unsigned*)(F.ctl + CW_BAR), F.MISC + 8);
#define GRID_BAR() do { if (N_LAUNCHES == 1) xcd_barrier(bar); } while (0)
    const int lo = args.ph_lo, hi = args.ph_hi;
#ifndef PH_MASK
#define PH_MASK 0xFFF
#endif
#define IN(k) (((PH_MASK >> (k)) & 1) && lo <= (k) && (k) < hi)
    typedef pg8::bf16_t pb;
    float* Y = args.out + cfg::O_Y;

    if (IN(0)) { p0_prologue(F, args); GRID_BAR(); }
#ifdef DUP_P0
    if (IN(0)) { p0_prologue(F, args); GRID_BAR(); }
#endif
#ifndef DUP_PH
#define DUP_PH -1
#endif
    if (IN(1)) {
        pg8::Gemm g{(const pb*)(ws + WS_XN), (const pb*)(ws + WS_WIN), cfg::M, cfg::NINP, 4096}; pg8::StaticOrder S; S.init(cfg::M, cfg::NINP, F.G, (int)blockIdx.x);
        pg8::EpiIn E{(pb*)(ws + WS_QA), (pb*)(ws + WS_KA), (pb*)(ws + WS_VA), (pb*)(ws + WS_G), (float*)(ws + WS_RAW), args.out, args.in[20], (const float*)(ws + WS_TABA)};
        pg8::gemm_phase<pg8::EpiIn, pg8::StaticOrder, true, PG8_SP2>(F.lds + RING_OFF, g, S, E);
        GRID_BAR();
    }
#if DUP_PH == 1
    if (IN(1)) {
        pg8::Gemm g{(const pb*)(ws + WS_XN), (const pb*)(ws + WS_WIN), cfg::M, cfg::NINP, 4096}; pg8::StaticOrder S; S.init(cfg::M, cfg::NINP, F.G, (int)blockIdx.x);
        pg8::EpiIn E{(pb*)(ws + WS_QA), (pb*)(ws + WS_KA), (pb*)(ws + WS_VA), (pb*)(ws + WS_G), (float*)(ws + WS_RAW), args.out, args.in[20], (const float*)(ws + WS_TABA)};
        pg8::gemm_phase<pg8::EpiIn, pg8::StaticOrder, true, PG8_SP2>(F.lds + RING_OFF, g, S, E);
        GRID_BAR();
    }
#endif
    if (IN(2)) { p2_latents(F, args); GRID_BAR(); }
    if (IN(3)) {
        { pg8::Gemm g{(const pb*)(ws + WS_CQN), (const pb*)(ws + WS_WQB), cfg::M, cfg::NQB, 896}; pg8::StaticOrder S; S.init(cfg::M, cfg::NQB, F.G, (int)blockIdx.x);
          pg8::EpiQB E{(pb*)(ws + WS_QB), (const float*)(ws + WS_TABB)};
          pg8::gemm_phase<pg8::EpiQB, pg8::StaticOrder, true, PG8_SP2>(F.lds + RING_OFF, g, S, E); }
        __syncthreads();
        { pg8::Gemm g{(const pb*)(ws + WS_CKV), (const pb*)(ws + WS_WKVB), cfg::MKV, cfg::NKVBO, 512}; pg8::StaticOrder S; S.init(cfg::MKV, cfg::NKVBO, F.G, (int)((blockIdx.x + F.G / 2) % F.G));
          pg8::EpiPlain E{(pb*)(ws + WS_KVB), cfg::NKVBO};
          pg8::gemm_phase<pg8::EpiPlain, pg8::StaticOrder, true, PG8_SP2>(F.lds + RING_OFF, g, S, E); }
        GRID_BAR();
    }
    if (IN(4)) { p4_attention(F, args, (char*)lds + RING_OFF); GRID_BAR(); }
#ifdef DUP_P4
    if (IN(4)) { p4_attention(F, args, (char*)lds + RING_OFF); GRID_BAR(); }
#endif
    if (IN(5)) {
        { pg8::Gemm g{(const pb*)(ws + WS_OA), (const pb*)(ws + WS_WBA), cfg::M, 4096, 2048}; pg8::SplitTailOrder S; S.init(2048, (int)blockIdx.x);
          pg8::EpiYA E{(const pb*)(ws + WS_G), Y, (float*)(ws + WS_SLAB_A)};
          pg8::gemm_phase<pg8::EpiYA, pg8::SplitTailOrder, true, PG8_SP2>(F.lds + RING_OFF, g, S, E); }
        __syncthreads();
        { pg8::Gemm g{(const pb*)(ws + WS_OB), (const pb*)(ws + WS_WBB), cfg::M, 4096, 2048}; pg8::SplitTailOrder S; S.init(2048, (int)blockIdx.x);
          pg8::EpiYB E{(const pb*)(ws + WS_G), Y, (pb*)(ws + WS_MB), (float*)(ws + WS_SLAB_B)};
          pg8::gemm_phase<pg8::EpiYB, pg8::SplitTailOrder, true, PG8_SP2>(F.lds + RING_OFF, g, S, E); }
        GRID_BAR();
        p5c_merge_sample(F);
        GRID_BAR();
    }
    if (IN(6)) {
        pg8::Gemm g{(const pb*)(ws + WS_MB), (const pb*)(ws + WS_WOUT), cfg::M, 4096, 4096}; pg8::SplitTailOrder S; S.init(4096, (int)blockIdx.x);
        pg8::EpiRes E{args.in[0], args.in[1], Y, (float*)(ws + WS_SLAB_A)};
        pg8::gemm_phase<pg8::EpiRes, pg8::SplitTailOrder, true, PG8_SP2>(F.lds + RING_OFF, g, S, E);
        GRID_BAR();
    }
#if DUP_PH == 6
    if (IN(6)) {
        pg8::Gemm g{(const pb*)(ws + WS_MB), (const pb*)(ws + WS_WOUT), cfg::M, 4096, 4096}; pg8::SplitTailOrder S; S.init(4096, (int)blockIdx.x);
        pg8::EpiRes E{args.in[0], args.in[1], Y, (float*)(ws + WS_SLAB_A)};
        pg8::gemm_phase<pg8::EpiRes, pg8::SplitTailOrder, true, PG8_SP2>(F.lds + RING_OFF, g, S, E);
        GRID_BAR();
    }
#endif
    if (IN(7)) {
        const int gw = F.vcu * NWAVES + F.wave, NGW = F.G * NWAVES;
        sample_rows_norm<bf16>(F, args.in[1], (const float*)(ws + WS_SLAB_A), Y + (size_t)cfg::TP * 4096, args.in[22], (bf16*)(ws + WS_XN) + (size_t)cfg::TP * 4096, (LAS float*)(F.lds + RING_OFF));
        for (int m = gw; m < cfg::TP; m += NGW) rms_row4096<bf16>(Y + (size_t)m * 4096, args.in[22], (bf16*)(ws + WS_XN) + (size_t)m * 4096, F.lane);
        GRID_BAR();
    }
    if (IN(8)) {
        pg8::Gemm g{(const pb*)(ws + WS_XN), (const pb*)(ws + WS_WGU), cfg::M, 2 * cfg::DFF, 4096}; pg8::StaticOrder S; S.init(cfg::M, 2 * cfg::DFF, F.G, (int)blockIdx.x);
        pg8::EpiGU E{(pb*)(ws + WS_UG), (pb*)(ws + WS_U), args.out};
        pg8::gemm_phase<pg8::EpiGU, pg8::StaticOrder, true, PG8_SP2>(F.lds + RING_OFF, g, S, E);
        GRID_BAR();
    }
#if DUP_PH == 8
    if (IN(8)) {
        pg8::Gemm g{(const pb*)(ws + WS_XN), (const pb*)(ws + WS_WGU), cfg::M, 2 * cfg::DFF, 4096}; pg8::StaticOrder S; S.init(cfg::M, 2 * cfg::DFF, F.G, (int)blockIdx.x);
        pg8::EpiGU E{(pb*)(ws + WS_UG), (pb*)(ws + WS_U), args.out};
        pg8::gemm_phase<pg8::EpiGU, pg8::StaticOrder, true, PG8_SP2>(F.lds + RING_OFF, g, S, E);
        GRID_BAR();
    }
#endif
    if (IN(9)) { p9_convact(F, args); GRID_BAR(); }
    if (IN(10)) {
        pg8::Gemm g{(const pb*)(ws + WS_U), (const pb*)(ws + WS_WFD), cfg::M, 4096, cfg::DFF}; pg8::SplitTailOrder S; S.init(cfg::DFF, (int)blockIdx.x);
        pg8::EpiRes E{Y, Y + (size_t)cfg::TP * 4096, Y, (float*)(ws + WS_SLAB_D)};
        pg8::gemm_phase<pg8::EpiRes, pg8::SplitTailOrder, true, PG8_SP2>(F.lds + RING_OFF, g, S, E);
        GRID_BAR();
    }
#if DUP_PH == 10
    if (IN(10)) {
        pg8::Gemm g{(const pb*)(ws + WS_U), (const pb*)(ws + WS_WFD), cfg::M, 4096, cfg::DFF}; pg8::SplitTailOrder S; S.init(cfg::DFF, (int)blockIdx.x);
        pg8::EpiRes E{Y, Y + (size_t)cfg::TP * 4096, Y, (float*)(ws + WS_SLAB_D)};
        pg8::gemm_phase<pg8::EpiRes, pg8::SplitTailOrder, true, PG8_SP2>(F.lds + RING_OFF, g, S, E);
        GRID_BAR();
    }
#endif
    if (IN(11)) {
        const int gw = F.vcu * NWAVES + F.wave, NGW = F.G * NWAVES;
        sample_rows_norm<float>(F, Y + (size_t)cfg::TP * 4096, (const float*)(ws + WS_SLAB_D), Y + (size_t)cfg::TP * 4096, args.in[28], Y + (size_t)cfg::TP * 4096, (LAS float*)(F.lds + RING_OFF));
        for (int m = gw; m < cfg::TP; m += NGW) rms_row4096<float>(Y + (size_t)m * 4096, args.in[28], Y + (size_t)m * 4096, F.lane);
    }
#ifdef DBG_COPY
    if (lo <= DBG_COPY && DBG_COPY < hi) {
        const size_t gt = (size_t)(F.vcu * NWAVES + F.wave) * 64 + F.lane, NGT = (size_t)F.G * NWAVES * 64;
        const v4u* s0 = (const v4u*)(ws + WS_WQB); v4u* d0 = (v4u*)Y; const size_t n0 = (size_t)(WS_WGU - WS_WQB) / 16;
        for (size_t i = gt; i < n0; i += NGT) d0[i] = s0[i];
        const v4u* s1 = (const v4u*)(ws + WS_WFD); v4u* d1 = d0 + n0; const size_t n1 = (size_t)60000000 / 16;
        for (size_t i = gt; i < n1; i += NGT) d1[i] = s1[i];
    }
#endif
#undef IN
#undef GRID_BAR
}

extern "C" void kernel_launch(void* const* d_in, const int* in_sizes, int n_in, void* d_out, int out_size, void* d_ws, size_t ws_size, hipStream_t stream) {
    static int grid = 0;
    if (grid == 0) {
        if (n_in != 29 || in_sizes[0] != cfg::TP * 4096 || (size_t)out_size != cfg::O_END || ws_size < WS_END) {
            fprintf(stderr, "kernel_launch: shape mismatch: n_in %d in0 %d out %d ws %zu (need %zu); nothing launched\n", n_in, n_in > 0 ? in_sizes[0] : -1, out_size, ws_size, (size_t)WS_END); grid = -1; return; }
        int dev = 0, cus = 0, per_cu = 0;
        if (hipGetDevice(&dev) != hipSuccess || hipDeviceGetAttribute(&cus, hipDeviceAttributeMultiprocessorCount, dev) != hipSuccess) { grid = -1; return; }
        if (hipFuncSetAttribute((const void*)fwd, hipFuncAttributeMaxDynamicSharedMemorySize, LDS_BYTES) != hipSuccess) { fprintf(stderr, "kernel_launch: hipFuncSetAttribute failed\n"); grid = -1; return; }
        if (hipOccupancyMaxActiveBlocksPerMultiprocessor(&per_cu, (const void*)fwd, NWAVES * 64, LDS_BYTES) != hipSuccess || per_cu < 1)
            fprintf(stderr, "kernel_launch: note: occupancy query reports %d workgroups per CU\n", per_cu);
        (void)hipGetLastError();
        if (cus < 256) { fprintf(stderr, "kernel_launch: built for a 256-CU device (got %d); nothing launched\n", cus); grid = -1; return; }
        grid = 256;
    }
    if (grid < 0) return;
    if (hipMemsetAsync((char*)d_ws + WS_CTL, 0, CTL_ZERO_BYTES, stream) != hipSuccess) { fprintf(stderr, "kernel_launch: memset failed\n"); return; }
    Args a{};
    for (int i = 0; i < 29; ++i) a.in[i] = (const float*)d_in[i];
    a.out = (float*)d_out; a.ws = (unsigned char*)d_ws;
    for (int li = 0; li < N_LAUNCHES; ++li) {
        a.ph_lo = (N_LAUNCHES == 1) ? 0 : li; a.ph_hi = (N_LAUNCHES == 1) ? NPH : li + 1;
        hipLaunchKernelGGL(fwd, dim3(grid), dim3(NWAVES * 64), LDS_BYTES, stream, a);
        const hipError_t le = hipPeekAtLastError();
        if (le != hipSuccess) { fprintf(stderr, "kernel_launch: launch %d failed: %s\n", li, hipGetErrorName(le)); break; }
    }
}
```

```cpp
#include <hip/hip_runtime.h>
#include <hip/hip_bf16.h>
#include <cstdio>
#include <cstdint>

#define DUP_PH -1
#ifndef MK_N_LAUNCHES
#define MK_N_LAUNCHES 1
#endif

namespace cfg {
constexpr int DM = 4096, TP = 8192, NB = 8, TS = 64, PAST = 2048;
constexpr int MS = NB * TS;
constexpr int M = TP + MS;
constexpr int NQK = 2048, NVA = 2048, QL = 896, KVL = 512, DR = 64, NG = 8192;
constexpr int NINP = 15872;
constexpr int NRAW = 1536;
constexpr int NQB = 3072, NKVBO = 4096;
constexpr int MKV = TP + NB * (PAST + TS);
constexpr int DFF = 11008;
constexpr float EPS = 1e-6f;
constexpr size_t O_Y = 0, O_DKP = 35651584, O_DVP = 52428800, O_CKVP = 69206016, O_KPEP = 73400320, O_CONVP = 73924608,
                 O_DKS = 73946624, O_DVS = 74995200, O_CKVS = 76043776, O_KPES = 76305920, O_CONVS = 76338688, O_END = 76514816;
}
namespace pg8 {
#define PG8_LAS __attribute__((address_space(3)))
typedef unsigned short bf16_t;
typedef short bf16x8 __attribute__((ext_vector_type(8)));
typedef float f32x4 __attribute__((ext_vector_type(4)));
typedef unsigned u32x4 __attribute__((ext_vector_type(4)));
constexpr int BM = 256, BK = 64, HALF = 128, HTB = HALF * BK * 2  , STAGE_BYTES = 8 * HTB, NXCD = 8, WGM = 8;

__host__ __device__ __forceinline__ int lds_byte(int r, int c) { const int st = (r >> 4) * 2 + (c >> 5), rr = r & 15, cc = c & 31, ob = rr * 64 + cc * 2; return st * 1024 + (ob ^ (((ob >> 9) & 1) << 5)); }
__host__ __device__ __forceinline__ void stage_rc(int b, int& R, int& C) { const int st = b / 1024, sb = b % 1024, swz = sb ^ (((sb >> 9) & 1) << 5); R = (st >> 1) * 16 + swz / 64; C = (st & 1) * 32 + (swz % 64) / 2; }
__host__ __device__ __forceinline__ int perm32(int rho) { const int n = rho >> 4, i = rho & 15; return 8 * (i >> 2) + 4 * n + (i & 3); }

struct Unit { int pm, pn, kt0, ntk, split; };
struct Gemm { const bf16_t* A; const bf16_t* Bt; int M, N, K; };

struct StaticOrder {
    int nM, nN, nwg, G, c;
    __host__ __device__ void init(int M, int N, int G_, int c_) { nM = M / BM; nN = N / BM; nwg = nM * nN; G = G_; c = c_; }
    __host__ __device__ bool next(int i, Unit& u) const {
        const long L = (long)i * G + c; if (L >= nwg) return false;
        int wgid = (int)L; { const int q = nwg / NXCD, r = nwg % NXCD, xcd = wgid % NXCD, off = wgid / NXCD; wgid = (xcd < r ? xcd * (q + 1) : r * (q + 1) + (xcd - r) * q) + off; }
        const int nig = WGM * nN, gid = wgid / nig, fm = gid * WGM, gsz = (nM - fm) < WGM ? (nM - fm) : WGM;
        u.pm = fm + ((wgid % nig) % gsz); u.pn = (wgid % nig) / gsz; u.kt0 = 0; u.ntk = 0; u.split = 0; return true;
    }
    __device__ __forceinline__ void a_ready(const Unit&) const {}
    __device__ __forceinline__ void done(const Unit&) const {}
};

struct SplitTailOrder {
    StaticOrder so; int nt, c;
    __host__ __device__ void init(int K, int c_) { so.init(8192, 4096, 256, c_); nt = K / BK; c = c_; }
    __host__ __device__ bool next(int i, Unit& u) const {
        if (i < 2) return so.next(i, u);
        if (i > 2) return false;
        const int tt = c >> 3, s = c & 7, q = nt >> 1, qb = q >> 3, qr = q & 7;
        u.pm = 32 + (tt & 1); u.pn = tt >> 1; u.kt0 = 2 * (s * qb + (s < qr ? s : qr)); u.ntk = 2 * (qb + (s < qr ? 1 : 0)); u.split = s + 1; return true;
    }
    __device__ __forceinline__ void a_ready(const Unit&) const {}
    __device__ __forceinline__ void done(const Unit&) const {}
};
typedef float f32x2c_t __attribute__((ext_vector_type(2))); typedef __bf16 bf16x2c_t __attribute__((ext_vector_type(2)));
__device__ __forceinline__ unsigned cvt_pk_bf16(float lo, float hi) { f32x2c_t v = {lo, hi}; bf16x2c_t b = __builtin_convertvector(v, bf16x2c_t); return __builtin_bit_cast(unsigned, b); }
typedef float f32x2 __attribute__((ext_vector_type(2)));
__device__ __forceinline__ u32x4 pack8(const f32x4 v0, const f32x4 v1) { u32x4 w; w.x = cvt_pk_bf16(v0[0], v0[1]); w.y = cvt_pk_bf16(v0[2], v0[3]); w.z = cvt_pk_bf16(v1[0], v1[1]); w.w = cvt_pk_bf16(v1[2], v1[3]); return w; }
__device__ __forceinline__ void unpack8(const u32x4 w, f32x4& a, f32x4& b) {
    a[0] = __uint_as_float(w.x << 16); a[1] = __uint_as_float(w.x & 0xffff0000u); a[2] = __uint_as_float(w.y << 16); a[3] = __uint_as_float(w.y & 0xffff0000u);
    b[0] = __uint_as_float(w.z << 16); b[1] = __uint_as_float(w.z & 0xffff0000u); b[2] = __uint_as_float(w.w << 16); b[3] = __uint_as_float(w.w & 0xffff0000u); }
__device__ __forceinline__ float sigmoidf_(float x) { return __builtin_amdgcn_rcpf(1.0f + __expf(-x)); }

struct EpiPlain {
    static constexpr bool PERM = true, AFTER_DRAIN = false;
    bf16_t* O; int ldc;
    __device__ __forceinline__ void operator()(const f32x4 (&acc)[2][2][4][2], const Unit& u, int wr, int wc, int fr, int fq) const {
        const int row0 = u.pm * BM + wr * 64 + fr, col0 = u.pn * BM + wc * 32 + 8 * fq;
#pragma unroll
        for (int ai = 0; ai < 2; ++ai)
#pragma unroll
            for (int m = 0; m < 4; ++m) { bf16_t* rowp = O + (size_t)(row0 + ai * HALF + m * 16) * ldc + col0;
#pragma unroll
                for (int bj = 0; bj < 2; ++bj) *(u32x4*)(rowp + bj * HALF) = pack8(acc[ai][bj][m][0], acc[ai][bj][m][1]); }
    }
};

constexpr float QSCALE_A = 0.125f * 1.4426950408889634f;
struct EpiIn {
    static constexpr bool PERM = true, AFTER_DRAIN = false;
    bf16_t* QA; bf16_t* KA; bf16_t* VA; bf16_t* G; float* RAW; float* out; const float* b_gate; const float* tabA;
    __device__ __forceinline__ void operator()(const f32x4 (&acc)[2][2][4][2], const Unit& u, int wr, int wc, int fr, int fq) const {
        const int pn = u.pn; const bool smp = u.pm >= 32;
        const int row0 = u.pm * BM + wr * 64 + fr, cw = wc * 32 + 8 * fq;
        if (pn < 16) {
            const bool isk = pn >= 8; bf16_t* dst = isk ? KA : QA; const int cb = (pn & 7) * BM + cw;
            float* fo = out + (smp ? (cfg::O_DKS - (size_t)cfg::TP * 2048) : cfg::O_DKP);
            const bool ropew = (wc & 1) == 0;
#pragma unroll
            for (int ah = 0; ah < 4; ++ah) {
                const int ai = ah >> 1, mh = ah & 1;
                f32x4 tq[2][4];
                if (ropew) {
#pragma unroll
                    for (int mm = 0; mm < 2; ++mm) { const int row = row0 + ai * HALF + (mh * 2 + mm) * 16; const int pos = smp ? 2048 + (row & 63) : row; const f32x4* tp = (const f32x4*)(tabA + (size_t)pos * 16);
                        tq[mm][0] = tp[0]; tq[mm][1] = tp[1]; tq[mm][2] = tp[2]; tq[mm][3] = tp[3]; } }
#pragma unroll
                for (int mm = 0; mm < 2; ++mm) {
                    const int m = mh * 2 + mm; const int row = row0 + ai * HALF + m * 16;
                    f32x4 t0 = {1.f, 0.f, 1.f, 0.f}, t1 = t0, t2 = t0, t3 = t0;
                    if (ropew) { t0 = tq[mm][0]; t1 = tq[mm][1]; t2 = tq[mm][2]; t3 = tq[mm][3]; }
#pragma unroll
                    for (int bj = 0; bj < 2; ++bj) {
                        f32x4 v0 = acc[ai][bj][m][0], v1 = acc[ai][bj][m][1];
                        if (ropew) {
                            f32x4 p0, p1;
#pragma unroll
                            for (int e = 0; e < 4; ++e) { p0[e] = __shfl_xor(v0[e], 16); p1[e] = __shfl_xor(v1[e], 16); }
                            const float sg = (fq == 0) ? -1.f : 1.f;
                            if (fq < 2) {
                                v0[0] = v0[0] * t0[0] + sg * p0[0] * t0[1]; v0[1] = v0[1] * t0[2] + sg * p0[1] * t0[3];
                                v0[2] = v0[2] * t1[0] + sg * p0[2] * t1[1]; v0[3] = v0[3] * t1[2] + sg * p0[3] * t1[3];
                                v1[0] = v1[0] * t2[0] + sg * p1[0] * t2[1]; v1[1] = v1[1] * t2[2] + sg * p1[1] * t2[3];
                                v1[2] = v1[2] * t3[0] + sg * p1[2] * t3[1]; v1[3] = v1[3] * t3[2] + sg * p1[3] * t3[3];
                            }
                        }
                        const size_t off = (size_t)row * 2048 + cb + bj * HALF;
                        if (isk) { *(u32x4*)(dst + off) = pack8(v0, v1); *(f32x4*)(fo + off) = v0; *(f32x4*)(fo + off + 4) = v1; }
                        else *(u32x4*)(dst + off) = pack8(v0 * QSCALE_A, v1 * QSCALE_A);
                    }
                }
            }
        } else if (pn < 24) {
            const int cb = (pn - 16) * BM + cw; float* fo = out + (smp ? (cfg::O_DVS - (size_t)cfg::TP * 2048) : cfg::O_DVP);
#pragma unroll
            for (int ai = 0; ai < 2; ++ai)
#pragma unroll
                for (int m = 0; m < 4; ++m) { const int row = row0 + ai * HALF + m * 16;
#pragma unroll
                    for (int bj = 0; bj < 2; ++bj) { const size_t off = (size_t)row * 2048 + cb + bj * HALF; const f32x4 v0 = acc[ai][bj][m][0], v1 = acc[ai][bj][m][1];
                        *(u32x4*)(VA + off) = pack8(v0, v1); *(f32x4*)(fo + off) = v0; *(f32x4*)(fo + off + 4) = v1; } }
        } else if (pn < 56) {
            const int cb = (pn - 24) * BM + cw;
            f32x4 bv[2][2];
#pragma unroll
            for (int bj = 0; bj < 2; ++bj) { bv[bj][0] = *(const f32x4*)(b_gate + cb + bj * HALF); bv[bj][1] = *(const f32x4*)(b_gate + cb + bj * HALF + 4); }
#pragma unroll
            for (int ai = 0; ai < 2; ++ai)
#pragma unroll
                for (int m = 0; m < 4; ++m) { const int row = row0 + ai * HALF + m * 16;
#pragma unroll
                    for (int bj = 0; bj < 2; ++bj) { f32x4 v0 = acc[ai][bj][m][0] + bv[bj][0], v1 = acc[ai][bj][m][1] + bv[bj][1];
#pragma unroll
                        for (int e = 0; e < 4; ++e) { v0[e] = sigmoidf_(v0[e]); v1[e] = sigmoidf_(v1[e]); }
                        *(u32x4*)(G + (size_t)row * 8192 + cb + bj * HALF) = pack8(v0, v1); } }
        } else {
            const int cb = (pn - 56) * BM + cw;
#pragma unroll
            for (int ai = 0; ai < 2; ++ai)
#pragma unroll
                for (int m = 0; m < 4; ++m) { const int row = row0 + ai * HALF + m * 16;
#pragma unroll
                    for (int bj = 0; bj < 2; ++bj) { float* p = RAW + (size_t)row * cfg::NRAW + cb + bj * HALF; *(f32x4*)p = acc[ai][bj][m][0]; *(f32x4*)(p + 4) = acc[ai][bj][m][1]; } }
        }
    }
};

struct EpiQB {
    static constexpr bool PERM = true, AFTER_DRAIN = false;
    bf16_t* QB; const float* tabB;
    __device__ __forceinline__ void operator()(const f32x4 (&acc)[2][2][4][2], const Unit& u, int wr, int wc, int fr, int fq) const {
        const bool smp = u.pm >= 32; const int row0 = u.pm * BM + wr * 64 + fr, col0 = u.pn * BM + wc * 32 + 8 * fq;
#pragma unroll
        for (int bj = 0; bj < 2; ++bj) {
            const int g6 = (u.pn * 8 + bj * 4 + wc) % 6; const bool pe = g6 >= 4; const int i0 = 16 * (g6 - 4) + 4 * fq;
#pragma unroll
            for (int ai = 0; ai < 2; ++ai)
#pragma unroll
                for (int m = 0; m < 4; ++m) { const int row = row0 + ai * HALF + m * 16; const int pos = smp ? 2048 + (row & 63) : row;
                    f32x4 v0 = acc[ai][bj][m][0], v1 = acc[ai][bj][m][1];
                    if (pe) { const f32x4* tp = (const f32x4*)(tabB + ((size_t)pos * 32 + i0) * 2); const f32x4 ta = tp[0], tb = tp[1];
                        f32x4 w0, w1;
                        w0[0] = v0[0] * ta[0] - v0[1] * ta[1]; w0[1] = v0[1] * ta[0] + v0[0] * ta[1];
                        w0[2] = v0[2] * ta[2] - v0[3] * ta[3]; w0[3] = v0[3] * ta[2] + v0[2] * ta[3];
                        w1[0] = v1[0] * tb[0] - v1[1] * tb[1]; w1[1] = v1[1] * tb[0] + v1[0] * tb[1];
                        w1[2] = v1[2] * tb[2] - v1[3] * tb[3]; w1[3] = v1[3] * tb[2] + v1[2] * tb[3];
                        v0 = w0; v1 = w1; }
                    *(u32x4*)(QB + (size_t)row * cfg::NQB + col0 + bj * HALF) = pack8(v0, v1); }
        }
    }
};

__device__ __forceinline__ void slab_store(float* slab, const f32x4 (&acc)[2][2][4][2], const Unit& u, int wr, int wc, int fr, int fq) {
    const int row0 = (u.pm - 32) * BM + wr * 64 + fr, col0 = u.pn * BM + wc * 32 + 8 * fq; float* sb = slab + (size_t)(u.split - 1) * 512 * 4096;
#pragma unroll
    for (int ai = 0; ai < 2; ++ai)
#pragma unroll
        for (int m = 0; m < 4; ++m)
#pragma unroll
            for (int bj = 0; bj < 2; ++bj) { float* p = sb + (size_t)(row0 + ai * HALF + m * 16) * 4096 + col0 + bj * HALF; *(f32x4*)p = acc[ai][bj][m][0]; *(f32x4*)(p + 4) = acc[ai][bj][m][1]; }
}
struct EpiYA {
    static constexpr bool PERM = true, AFTER_DRAIN = false;
    const bf16_t* G; float* P; float* slab;
    __device__ __forceinline__ void operator()(const f32x4 (&acc)[2][2][4][2], const Unit& u, int wr, int wc, int fr, int fq) const {
        if (u.split) { slab_store(slab, acc, u, wr, wc, fr, fq); return; }
        const int row0 = u.pm * BM + wr * 64 + fr, col0 = u.pn * BM + wc * 32 + 8 * fq;
#pragma unroll
        for (int ai = 0; ai < 2; ++ai) {
            u32x4 gq[4][2];
#pragma unroll
            for (int m = 0; m < 4; ++m)
#pragma unroll
                for (int bj = 0; bj < 2; ++bj) gq[m][bj] = *(const u32x4*)(G + (size_t)(row0 + ai * HALF + m * 16) * 8192 + col0 + bj * HALF);
#pragma unroll
            for (int m = 0; m < 4; ++m) { const int row = row0 + ai * HALF + m * 16;
#pragma unroll
                for (int bj = 0; bj < 2; ++bj) { const int col = col0 + bj * HALF; f32x4 g0, g1; unpack8(gq[m][bj], g0, g1);
                    float* p = P + (size_t)row * 4096 + col; *(f32x4*)p = acc[ai][bj][m][0] * g0; *(f32x4*)(p + 4) = acc[ai][bj][m][1] * g1; } }
        }
    }
};
struct EpiYB {
    static constexpr bool PERM = true, AFTER_DRAIN = false;
    const bf16_t* G; const float* P; bf16_t* MB; float* slab;
    __device__ __forceinline__ void operator()(const f32x4 (&acc)[2][2][4][2], const Unit& u, int wr, int wc, int fr, int fq) const {
        if (u.split) { slab_store(slab, acc, u, wr, wc, fr, fq); return; }
        const int row0 = u.pm * BM + wr * 64 + fr, col0 = u.pn * BM + wc * 32 + 8 * fq;
#pragma unroll
        for (int ai = 0; ai < 2; ++ai)
#pragma unroll
            for (int mh = 0; mh < 2; ++mh) {
                u32x4 gq[2][2]; f32x4 pq[2][2][2];
#pragma unroll
                for (int mm = 0; mm < 2; ++mm)
#pragma unroll
                    for (int bj = 0; bj < 2; ++bj) { const int row = row0 + ai * HALF + (mh * 2 + mm) * 16, col = col0 + bj * HALF;
                        gq[mm][bj] = *(const u32x4*)(G + (size_t)row * 8192 + 4096 + col);
                        const float* p = P + (size_t)row * 4096 + col; pq[mm][bj][0] = *(const f32x4*)p; pq[mm][bj][1] = *(const f32x4*)(p + 4); }
#pragma unroll
                for (int mm = 0; mm < 2; ++mm)
#pragma unroll
                    for (int bj = 0; bj < 2; ++bj) { const int m = mh * 2 + mm; const int row = row0 + ai * HALF + m * 16, col = col0 + bj * HALF; f32x4 g0, g1; unpack8(gq[mm][bj], g0, g1);
                        const f32x4 a = pq[mm][bj][0] + acc[ai][bj][m][0] * g0, b = pq[mm][bj][1] + acc[ai][bj][m][1] * g1;
                        *(u32x4*)(MB + (size_t)row * 4096 + col) = pack8(a, b); }
            }
    }
};
struct EpiRes {
    static constexpr bool PERM = true, AFTER_DRAIN = false;
    const float* base_p; const float* base_s; float* out; float* slab;
    __device__ __forceinline__ void operator()(const f32x4 (&acc)[2][2][4][2], const Unit& u, int wr, int wc, int fr, int fq) const {
        if (u.split) { slab_store(slab, acc, u, wr, wc, fr, fq); return; }
        const int row0 = u.pm * BM + wr * 64 + fr, col0 = u.pn * BM + wc * 32 + 8 * fq; const bool smp = u.pm >= 32;
        const float* bs = smp ? base_s - (size_t)cfg::TP * 4096 : base_p;
#pragma unroll
        for (int ai = 0; ai < 2; ++ai)
#pragma unroll
            for (int mh = 0; mh < 2; ++mh) {
                f32x4 bq[2][2][2];
#pragma unroll
                for (int mm = 0; mm < 2; ++mm)
#pragma unroll
                    for (int bj = 0; bj < 2; ++bj) { const size_t off = (size_t)(row0 + ai * HALF + (mh * 2 + mm) * 16) * 4096 + col0 + bj * HALF;
                        bq[mm][bj][0] = *(const f32x4*)(bs + off); bq[mm][bj][1] = *(const f32x4*)(bs + off + 4); }
#pragma unroll
                for (int mm = 0; mm < 2; ++mm)
#pragma unroll
                    for (int bj = 0; bj < 2; ++bj) { const int m = mh * 2 + mm; const size_t off = (size_t)(row0 + ai * HALF + m * 16) * 4096 + col0 + bj * HALF;
                        *(f32x4*)(out + off) = bq[mm][bj][0] + acc[ai][bj][m][0]; *(f32x4*)(out + off + 4) = bq[mm][bj][1] + acc[ai][bj][m][1]; }
            }
    }
};
__device__ __forceinline__ float dpp_ror1(float x) { return __int_as_float(__builtin_amdgcn_update_dpp(0, __float_as_int(x), 0x121, 0xf, 0xf, false)); }
__device__ __forceinline__ float dpp_ror2(float x) { return __int_as_float(__builtin_amdgcn_update_dpp(0, __float_as_int(x), 0x122, 0xf, 0xf, false)); }
struct EpiGU2 {
    static constexpr bool PERM = true, AFTER_DRAIN = false;
    bf16_t* ACT; float* out; const float* wconv; const float* bconv; const float* stc; float* topug; float* topu; float* bot; PG8_LAS float* xch;
    __device__ __forceinline__ void operator()(const f32x4 (&acc)[2][2][4][2], const Unit& u, int wr, int wc, int fr, int fq) const {
        const int pm = u.pm, chl = wc * 32 + 8 * fq, ch0 = u.pn * HALF + chl; const bool smp = pm >= 32;
        const int row0 = pm * BM + wr * 64 + fr;
        if (fr >= 14) {
#pragma unroll
            for (int ai = 0; ai < 2; ++ai)
#pragma unroll
                for (int n = 0; n < 2; ++n) *(PG8_LAS f32x4*)(xch + ((ai * 2 + wr) * 2 + (fr - 14)) * 128 + chl + 4 * n) = acc[ai][0][3][n];
        }
        f32x4 w0[2], w1[2], w2[2], bb[2];
#pragma unroll
        for (int n = 0; n < 2; ++n) { w0[n] = *(const f32x4*)(wconv + ch0 + 4 * n); w1[n] = *(const f32x4*)(wconv + cfg::DFF + ch0 + 4 * n); w2[n] = *(const f32x4*)(wconv + 2 * cfg::DFF + ch0 + 4 * n); bb[n] = *(const f32x4*)(bconv + ch0 + 4 * n); }
        asm volatile("s_waitcnt lgkmcnt(0)" ::: "memory"); __builtin_amdgcn_s_barrier(); asm volatile("" ::: "memory");
#pragma unroll
        for (int ai = 0; ai < 2; ++ai) {
            f32x4 H1[2], H2[2];
            if (smp) { const int b = (pm - 32) * 4 + ai * 2 + wr;
#pragma unroll
                for (int n = 0; n < 2; ++n) { H2[n] = *(const f32x4*)(stc + (size_t)(b * 2 + 0) * cfg::DFF + ch0 + 4 * n); H1[n] = *(const f32x4*)(stc + (size_t)(b * 2 + 1) * cfg::DFF + ch0 + 4 * n); } }
            else if (ai == 0 && wr == 0) {
#pragma unroll
                for (int n = 0; n < 2; ++n) { H1[n] = (f32x4){0.f, 0.f, 0.f, 0.f}; H2[n] = H1[n]; } }
            else { const int sa = wr ? ai : ai - 1, sw = wr ? 0 : 1;
#pragma unroll
                for (int n = 0; n < 2; ++n) { H2[n] = *(const PG8_LAS f32x4*)(xch + ((sa * 2 + sw) * 2 + 0) * 128 + chl + 4 * n); H1[n] = *(const PG8_LAS f32x4*)(xch + ((sa * 2 + sw) * 2 + 1) * 128 + chl + 4 * n); } }
            if (!smp && ai == 0 && wr == 0 && pm >= 1 && fr < 2) {
#pragma unroll
                for (int n = 0; n < 2; ++n) { *(f32x4*)(topug + (size_t)(pm * 2 + fr) * cfg::DFF + ch0 + 4 * n) = acc[0][0][0][n]; *(f32x4*)(topu + (size_t)(pm * 2 + fr) * cfg::DFF + ch0 + 4 * n) = acc[0][1][0][n]; } }
            if (!smp && ai == 1 && wr == 1 && fr >= 14) {
#pragma unroll
                for (int n = 0; n < 2; ++n) *(f32x4*)(bot + (size_t)(pm * 2 + (fr - 14)) * cfg::DFF + ch0 + 4 * n) = acc[1][0][3][n]; }
#pragma unroll
            for (int m = 0; m < 4; ++m) { const int row = row0 + ai * HALF + m * 16;
                f32x4 a[2];
#pragma unroll
                for (int n = 0; n < 2; ++n)
#pragma unroll
                    for (int e = 0; e < 4; ++e) { const float x = acc[ai][0][m][n][e];
                        const float r1 = dpp_ror1(x), r2 = dpp_ror2(x);
                        float q1, q2;
                        if (m > 0) { q1 = dpp_ror1(acc[ai][0][m > 0 ? m - 1 : 0][n][e]); q2 = dpp_ror2(acc[ai][0][m > 0 ? m - 1 : 0][n][e]); }
                        else { q1 = H1[n][e]; q2 = (fr == 1) ? H1[n][e] : H2[n][e]; }
                        const float p1 = fr >= 1 ? r1 : q1, p2 = fr >= 2 ? r2 : q2;
                        const float c = bb[n][e] + w0[n][e] * p2 + w1[n][e] * p1 + w2[n][e] * x;
                        a[n][e] = c * __builtin_amdgcn_rcpf(1.f + __expf(-c)) * acc[ai][1][m][n][e]; }
                *(u32x4*)(ACT + (size_t)row * cfg::DFF + ch0) = pack8(a[0], a[1]);
                if ((row & 63) >= 62 && row >= cfg::TP - 2) {
                    float* p = (row < cfg::TP) ? out + cfg::O_CONVP + (size_t)(row - (cfg::TP - 2)) * cfg::DFF + ch0
                                               : out + cfg::O_CONVS + (size_t)(((row - cfg::TP) >> 6) * 2 + ((row & 63) - 62)) * cfg::DFF + ch0;
                    *(f32x4*)p = acc[ai][0][m][0]; *(f32x4*)(p + 4) = acc[ai][0][m][1]; } }
        }
        asm volatile("s_waitcnt lgkmcnt(0)" ::: "memory"); __builtin_amdgcn_s_barrier(); asm volatile("" ::: "memory");
    }
};
template <class Epi, class Sched, bool ALIGN_EPI = false, bool SP2 = false>
__device__ __forceinline__ void gemm_phase(PG8_LAS unsigned char* lds, const Gemm g, const Sched& S, const Epi& E) {
    const int tid = threadIdx.x, wid = __builtin_amdgcn_readfirstlane(tid >> 6), lane = tid & 63, wr = wid >> 2, wc = wid & 3, fr = lane & 15, fq = lane >> 4;
    const int K = g.K, nt = K / BK;
    unsigned voffA[2], voffB[2];
#pragma unroll
    for (int i = 0; i < 2; ++i) { int R, C; stage_rc(tid * 16 + i * 8192, R, C); const int Rb = Epi::PERM ? ((R & ~31) + perm32(R & 31)) : R;
        voffA[i] = (unsigned)(R * K + C) * 2u; voffB[i] = (unsigned)(Rb * K + C) * 2u; }
    const size_t kstep = (size_t)(BK * 2);
    const size_t hstep = (size_t)HALF * K * 2;
    const size_t tstep = 2 * hstep;
    const unsigned ldsw = (unsigned)wid * 1024u;
    const int aoff = lds_byte(wr * 64 + fr, fq * 8), boff = lds_byte(wc * 32 + fr, fq * 8);
#define PG8_SA(b, h) (((b) * 2 + (h)) * HTB)
#define PG8_SB(b, h) ((4 + (b) * 2 + (h)) * HTB)
#define PG8_STAGE(bufoff, gbase, voff) do { _Pragma("unroll") for (int _i = 0; _i < 2; ++_i) \
        __builtin_amdgcn_global_load_lds((const unsigned*)((const char*)(gbase) + (voff)[_i]), (PG8_LAS unsigned*)(lds + (bufoff) + ldsw + _i * 8192), 16, 0, 0); } while (0)
#define PG8_LDA(dst, b, h) do { _Pragma("unroll") for (int m = 0; m < 4; ++m) _Pragma("unroll") for (int k = 0; k < 2; ++k) dst[m][k] = *(const PG8_LAS bf16x8*)(lds + PG8_SA(b, h) + aoff + m * 2048 + k * 1024); } while (0)
#define PG8_LDB(dst, b, h) do { _Pragma("unroll") for (int n = 0; n < 2; ++n) _Pragma("unroll") for (int k = 0; k < 2; ++k) dst[n][k] = *(const PG8_LAS bf16x8*)(lds + PG8_SB(b, h) + boff + n * 2048 + k * 1024); } while (0)
#define PG8_MMA(ai, bj, At, Bt) do { __builtin_amdgcn_s_setprio(1); _Pragma("unroll") for (int m = 0; m < 4; ++m) _Pragma("unroll") for (int n = 0; n < 2; ++n) _Pragma("unroll") for (int k = 0; k < 2; ++k) \
        acc[ai][bj][m][n] = __builtin_amdgcn_mfma_f32_16x16x32_bf16(Bt[n][k], At[m][k], acc[ai][bj][m][n], 0, 0, 0); __builtin_amdgcn_s_setprio(0); } while (0)
#define PG8_WAIT_V(n) asm volatile("s_waitcnt vmcnt(" #n ")" ::: "memory")
#define PG8_WAIT_L(n) asm volatile("s_waitcnt lgkmcnt(" #n ")" ::: "memory")
#define PG8_BAR __builtin_amdgcn_s_barrier()
#define PG8_SCHED __builtin_amdgcn_sched_barrier(0)
    Unit cur, nxt; int ui = 0;
    if (!S.next(0, cur)) return;
    f32x4 acc[2][2][4][2];
#pragma unroll
    for (int a = 0; a < 2; ++a)
#pragma unroll
        for (int b = 0; b < 2; ++b)
#pragma unroll
            for (int m = 0; m < 4; ++m)
#pragma unroll
                for (int n = 0; n < 2; ++n) acc[a][b][m][n] = (f32x4){0.f, 0.f, 0.f, 0.f};
    bf16x8 At[4][2], B0[2][2], B1[2][2];
    const char* cA = (const char*)g.A + (size_t)cur.pm * tstep + (size_t)cur.kt0 * kstep; const char* cB = (const char*)g.Bt + (size_t)cur.pn * tstep + (size_t)cur.kt0 * kstep;
    S.a_ready(cur);
    if constexpr (SP2) {
        PG8_STAGE(PG8_SB(0, 0), cB, voffB); PG8_STAGE(PG8_SB(0, 1), cB + hstep, voffB); PG8_STAGE(PG8_SA(0, 0), cA, voffA); PG8_STAGE(PG8_SA(0, 1), cA + hstep, voffA);
        if (wr == 1) PG8_BAR;
        PG8_WAIT_V(2); PG8_BAR;
        PG8_STAGE(PG8_SB(1, 0), cB + kstep, voffB); PG8_STAGE(PG8_SA(1, 0), cA + kstep, voffA); PG8_STAGE(PG8_SB(1, 1), cB + hstep + kstep, voffB);
        PG8_WAIT_V(6); PG8_BAR;
    } else {
        PG8_STAGE(PG8_SB(0, 0), cB, voffB); PG8_STAGE(PG8_SA(0, 0), cA, voffA); PG8_STAGE(PG8_SB(0, 1), cB + hstep, voffB); PG8_STAGE(PG8_SA(0, 1), cA + hstep, voffA);
        if (wr == 1) PG8_BAR;
        PG8_WAIT_V(4); PG8_BAR;
        PG8_STAGE(PG8_SB(1, 0), cB + kstep, voffB); PG8_STAGE(PG8_SA(1, 0), cA + kstep, voffA); PG8_STAGE(PG8_SB(1, 1), cB + hstep + kstep, voffB);
        PG8_WAIT_V(6); PG8_BAR;
    }
    for (;;) {
        const bool has_next = S.next(ui + 1, nxt);
        const char* nA = has_next ? (const char*)g.A + (size_t)nxt.pm * tstep + (size_t)nxt.kt0 * kstep : cA; const char* nB = has_next ? (const char*)g.Bt + (size_t)nxt.pn * tstep + (size_t)nxt.kt0 * kstep : cB;
        const int ntu = cur.ntk ? cur.ntk : nt;
        for (int t = 0; t < ntu; t += 2) {
            const bool last = (t == ntu - 2);
            const char* a1 = cA + (size_t)(t + 1) * kstep;
            const char* a2 = last ? nA : cA + (size_t)(t + 2) * kstep; const char* b2 = last ? nB : cB + (size_t)(t + 2) * kstep;
            const char* a3 = a2 + kstep; const char* b3 = b2 + kstep;
            if (last && has_next) S.a_ready(nxt);
            if constexpr (SP2) {
            PG8_LDB(B0, 0, 0); PG8_LDB(B1, 0, 1); PG8_SCHED; PG8_LDA(At, 0, 0); PG8_STAGE(PG8_SA(1, 1), a1 + hstep, voffA);
            PG8_WAIT_V(8); PG8_WAIT_L(0); PG8_BAR; PG8_MMA(0, 0, At, B0); PG8_MMA(0, 1, At, B1); PG8_BAR; PG8_SCHED;
            PG8_LDA(At, 0, 1); PG8_STAGE(PG8_SB(0, 0), b2, voffB); PG8_STAGE(PG8_SB(0, 1), b2 + hstep, voffB); PG8_STAGE(PG8_SA(0, 0), a2, voffA);
            PG8_WAIT_V(8); PG8_WAIT_L(0); PG8_BAR; PG8_MMA(1, 0, At, B0); PG8_MMA(1, 1, At, B1); PG8_BAR; PG8_SCHED;
            PG8_LDB(B0, 1, 0); PG8_LDB(B1, 1, 1); PG8_SCHED; PG8_LDA(At, 1, 0); PG8_STAGE(PG8_SA(0, 1), a2 + hstep, voffA);
            PG8_WAIT_V(8); PG8_WAIT_L(0); PG8_BAR; PG8_MMA(0, 0, At, B0); PG8_MMA(0, 1, At, B1); PG8_BAR; PG8_SCHED;
            PG8_LDA(At, 1, 1); PG8_STAGE(PG8_SB(1, 0), b3, voffB); PG8_STAGE(PG8_SB(1, 1), b3 + hstep, voffB); PG8_STAGE(PG8_SA(1, 0), a3, voffA);
            PG8_WAIT_V(8); PG8_WAIT_L(0); PG8_BAR; PG8_MMA(1, 0, At, B0); PG8_MMA(1, 1, At, B1); PG8_BAR; PG8_SCHED;
            } else {
            PG8_LDB(B0, 0, 0); PG8_SCHED; PG8_LDA(At, 0, 0); PG8_STAGE(PG8_SA(1, 1), a1 + hstep, voffA);
            PG8_WAIT_L(8); PG8_BAR; PG8_WAIT_L(0); PG8_MMA(0, 0, At, B0); PG8_BAR; PG8_SCHED;
            PG8_LDB(B1, 0, 1); PG8_STAGE(PG8_SB(0, 0), b2, voffB);
            PG8_BAR; PG8_WAIT_L(0); PG8_MMA(0, 1, At, B1); PG8_BAR;
            PG8_LDA(At, 0, 1); PG8_STAGE(PG8_SA(0, 0), a2, voffA);
            PG8_BAR; PG8_WAIT_L(0); PG8_MMA(1, 0, At, B0); PG8_BAR; PG8_SCHED;
            PG8_STAGE(PG8_SB(0, 1), b2 + hstep, voffB);
            PG8_WAIT_V(6); PG8_BAR; PG8_MMA(1, 1, At, B1); PG8_BAR;
            PG8_LDB(B0, 1, 0); PG8_SCHED; PG8_LDA(At, 1, 0); PG8_STAGE(PG8_SA(0, 1), a2 + hstep, voffA);
            PG8_WAIT_L(8); PG8_BAR; PG8_WAIT_L(0); PG8_MMA(0, 0, At, B0); PG8_BAR; PG8_SCHED;
            PG8_LDB(B1, 1, 1); PG8_STAGE(PG8_SB(1, 0), b3, voffB);
            PG8_BAR; PG8_WAIT_L(0); PG8_MMA(0, 1, At, B1); PG8_BAR;
            PG8_LDA(At, 1, 1); PG8_STAGE(PG8_SA(1, 0), a3, voffA);
            PG8_BAR; PG8_WAIT_L(0); PG8_MMA(1, 0, At, B0); PG8_BAR; PG8_SCHED;
            PG8_STAGE(PG8_SB(1, 1), b3 + hstep, voffB);
            PG8_WAIT_V(6); PG8_BAR; PG8_MMA(1, 1, At, B1); PG8_BAR;
            }
        }
        if constexpr (ALIGN_EPI) { if (wr == 0) PG8_BAR; }
        if constexpr (!Epi::AFTER_DRAIN) { E(acc, cur, wr, wc, fr, fq); S.done(cur); }
        if (!has_next) break;
#pragma unroll
        for (int a = 0; a < 2; ++a)
#pragma unroll
            for (int b = 0; b < 2; ++b)
#pragma unroll
                for (int m = 0; m < 4; ++m)
#pragma unroll
                    for (int n = 0; n < 2; ++n) acc[a][b][m][n] = (f32x4){0.f, 0.f, 0.f, 0.f};
        cur = nxt; cA = nA; cB = nB; ++ui;
        if constexpr (ALIGN_EPI) { if (wr == 1) PG8_BAR; }
    }
    PG8_WAIT_V(0);
    if constexpr (!ALIGN_EPI) { if (wr == 0) PG8_BAR; }
    PG8_BAR;
    if constexpr (Epi::AFTER_DRAIN) { E.fused(acc, cur, wr, wc, fr, fq, lds, wid, lane); S.done(cur); }
#undef PG8_SA
#undef PG8_SB
#undef PG8_STAGE
#undef PG8_LDA
#undef PG8_LDB
#undef PG8_MMA
#undef PG8_WAIT_V
#undef PG8_WAIT_L
#undef PG8_BAR
#undef PG8_SCHED
}
}
#define GAS __attribute__((address_space(1)))
#define LAS __attribute__((address_space(3)))
typedef unsigned short bf16;
typedef unsigned v4u __attribute__((ext_vector_type(4)));
typedef float f32x4 __attribute__((ext_vector_type(4)));
typedef short bf16x8 __attribute__((ext_vector_type(8)));
typedef GAS unsigned gu32;
typedef GAS unsigned long long gu64;
#define RLX_AGENT __ATOMIC_RELAXED, __HIP_MEMORY_SCOPE_AGENT
#define LDS_WAIT() asm volatile("s_waitcnt lgkmcnt(0)" ::: "memory")
#define VM_WAIT() asm volatile("s_waitcnt vmcnt(0)" ::: "memory")
__device__ __forceinline__ unsigned long long rt() { return __builtin_amdgcn_s_memrealtime(); }
__device__ __forceinline__ unsigned f2bf(float f) { unsigned u = __builtin_bit_cast(unsigned, f); return (u + 0x7fffu + ((u >> 16) & 1u)) >> 16; }
__device__ __forceinline__ unsigned pk2(float lo, float hi) { return f2bf(lo) | (f2bf(hi) << 16); }

#define XB_TMO      128
#define XB_XCNT(j)  (256  + 64 * (j))
#define XB_XSUB(j)  (1280 + 64 * (j))
#define XB_XGEN(j)  (2304 + 64 * (j))
#define XB_TOP      3328
#define XB_TOPGEN   3392
#define XCD_BAR_WORDS 3456
#define XB_SPIN_CAP (1u << 18)

__device__ __forceinline__ unsigned xb_ld(unsigned* p)              { return __hip_atomic_load(p, __ATOMIC_RELAXED, __HIP_MEMORY_SCOPE_AGENT); }
__device__ __forceinline__ unsigned xb_add(unsigned* p, unsigned v) { return __hip_atomic_fetch_add(p, v, __ATOMIC_RELAXED, __HIP_MEMORY_SCOPE_AGENT); }
__device__ __forceinline__ unsigned xb_xcc_id() { return (unsigned)__builtin_amdgcn_s_getreg((3 << 11) | 20) & 0xFu; }
#define XB_SPIN(cond, bar) do { unsigned _sp = 0; while (cond) { __builtin_amdgcn_s_sleep(1); \
    if ((++_sp & 255u) == 0u) { if (xb_ld(&(bar)[XB_TMO])) break; if (_sp > XB_SPIN_CAP) { atomicAdd(&(bar)[XB_TMO], 1u); break; } } } } while (0)

struct XcdBarrier {
    unsigned* bar; unsigned x;
    volatile LAS unsigned* st;
};

__device__ __forceinline__ XcdBarrier xcd_barrier_post(unsigned* bar, volatile LAS unsigned* st) {
    XcdBarrier b; b.bar = bar; b.x = xb_xcc_id(); b.st = st;
    if (threadIdx.x == 0) (void)xb_add(&bar[XB_XCNT(b.x)], 1u);
    return b;
}
__device__ __forceinline__ void xcd_barrier_complete(unsigned* bar, unsigned x, unsigned& nloc, unsigned& nx) {
    const unsigned G = gridDim.x * gridDim.y * gridDim.z;
    unsigned sum, cnt, mine, sp = 0u;
    for (;;) {
        sum = 0u; cnt = 0u; mine = 0u;
#pragma unroll
        for (unsigned j = 0; j < 16; ++j) { const unsigned c = xb_ld(&bar[XB_XCNT(j)]); sum += c; cnt += (c > 0u) ? 1u : 0u; mine = (j == x) ? c : mine; }
        if (sum == G) break;
        __builtin_amdgcn_s_sleep(1);
        if ((++sp & 255u) == 0u) { if (xb_ld(&bar[XB_TMO])) break; if (sp > XB_SPIN_CAP) { atomicAdd(&bar[XB_TMO], 1u); break; } }
    }
    nloc = mine > 0u ? mine : 1u; nx = cnt > 0u ? cnt : 1u;
}

__device__ __forceinline__ void xcd_barrier(const XcdBarrier& b) {
    asm volatile("s_waitcnt vmcnt(0)" ::: "memory");
    __syncthreads();
    if (threadIdx.x == 0) {
        unsigned* bar = b.bar;
        __builtin_amdgcn_s_waitcnt(0);
        unsigned nloc = b.st[0], nx = b.st[1];
        if (nloc == 0u) { xcd_barrier_complete(bar, b.x, nloc, nx); b.st[0] = nloc; b.st[1] = nx; }
        const unsigned old = xb_add(&bar[XB_XSUB(b.x)], 1u);
        const unsigned gen = old / nloc;
        if (old + 1u == (gen + 1u) * nloc) {
            __builtin_amdgcn_fence(__ATOMIC_RELEASE, "agent");
            asm volatile("s_waitcnt vmcnt(0)" ::: "memory");
            const unsigned og = xb_add(&bar[XB_TOP], 1u);
            const unsigned tg = og / nx;
            if (og + 1u == (tg + 1u) * nx) xb_add(&bar[XB_TOPGEN], 1u);
            else XB_SPIN(xb_ld(&bar[XB_TOPGEN]) == tg, bar);
            __builtin_amdgcn_fence(__ATOMIC_ACQUIRE, "agent");
            xb_add(&bar[XB_XGEN(b.x)], 1u);
            asm volatile("s_waitcnt vmcnt(0)" ::: "memory");
        } else {
            XB_SPIN(xb_ld(&bar[XB_XGEN(b.x)]) == gen, bar);
            __builtin_amdgcn_fence(__ATOMIC_ACQUIRE, "agent");
            asm volatile("s_waitcnt vmcnt(0)" ::: "memory");
        }
    }
    __syncthreads();
}
namespace att {
typedef unsigned short bf16_t;
using bf16x8 = __attribute__((ext_vector_type(8))) short;
using s16x4  = __attribute__((ext_vector_type(4))) short;
using f32x16 = __attribute__((ext_vector_type(16))) float;
using f32x8  = __attribute__((ext_vector_type(8))) float;
using u32x4  = __attribute__((ext_vector_type(4))) unsigned;
constexpr int NW = 8, QBLK = 32, KVBLK = 64;
constexpr int SHM_V = KVBLK * 128 * 2;
constexpr int SHM_KMAX = KVBLK * 192 * 2;
constexpr int LDS_V = 0, LDS_K = 2 * SHM_V, LDS_WS = LDS_K + 2 * SHM_KMAX, LDS_BYTES = LDS_WS + NW * 64 * 4;
#define ASBAR() __builtin_amdgcn_sched_barrier(0)
__device__ __forceinline__ int crow(int r, int hi) { return (r & 3) + 8 * (r >> 2) + 4 * hi; }
typedef float f32x2c_t __attribute__((ext_vector_type(2))); typedef __bf16 bf16x2c_t __attribute__((ext_vector_type(2)));
__device__ __forceinline__ unsigned cvtpk(float lo, float hi) { f32x2c_t v = {lo, hi}; bf16x2c_t b = __builtin_convertvector(v, bf16x2c_t); return __builtin_bit_cast(unsigned, b); }
template <typename TIn> struct Stage;
template <> struct Stage<bf16_t> { using T = bf16x8; static constexpr int NLD = 1;
  __device__ static __forceinline__ T ld8(const bf16_t* p) { return *reinterpret_cast<const bf16x8*>(p); }
  __device__ static __forceinline__ bf16x8 tobf(T x) { return x; } };
template <> struct Stage<float> { using T = f32x8; static constexpr int NLD = 2;
  __device__ static __forceinline__ T ld8(const float* p) { return *reinterpret_cast<const f32x8*>(p); }
  __device__ static __forceinline__ bf16x8 tobf(T x) { u32x4 w = {cvtpk(x[0], x[1]), cvtpk(x[2], x[3]), cvtpk(x[4], x[5]), cvtpk(x[6], x[7])}; return *reinterpret_cast<bf16x8*>(&w); } };

template <int NDQ> __device__ __forceinline__ int kswz(int row, int ch) { return row * (32 * NDQ) + ((ch ^ ((row >> 1) & 7)) << 4); }

__device__ __forceinline__ void partialSM(f32x16& p0, f32x16& p1, float& m_reg, float& mn, float& alpha, const float C, const float THRS) {
  float pmax = p0[0];
#pragma unroll
  for (int r = 1; r < 16; ++r) pmax = fmaxf(pmax, p0[r]);
#pragma unroll
  for (int r = 0; r < 16; ++r) pmax = fmaxf(pmax, p1[r]);
  { auto rr = __builtin_amdgcn_permlane32_swap(__float_as_uint(pmax), __float_as_uint(pmax), false, false);
    pmax = fmaxf(__uint_as_float(rr[0]), __uint_as_float(rr[1])); }
  if (__builtin_expect(__all(pmax - m_reg <= THRS), 1)) { mn = m_reg; alpha = 1.f; }
  else { mn = fmaxf(m_reg, pmax); alpha = __builtin_amdgcn_exp2f((m_reg - mn) * C); m_reg = mn; }
  const float mnC = -mn * C;
#pragma unroll
  for (int r = 0; r < 16; ++r) p0[r] = fmaf(p0[r], C, mnC);
#pragma unroll
  for (int r = 0; r < 16; ++r) p1[r] = fmaf(p1[r], C, mnC);
#pragma unroll
  for (int r = 0; r < 16; ++r) p0[r] = __builtin_amdgcn_exp2f(p0[r]);
}
__device__ __forceinline__ void finishSM(f32x16& p0, f32x16& p1, float alpha, float& l_reg, bf16x8& pa0, bf16x8& pa1, bf16x8& pa2, bf16x8& pa3) {
#pragma unroll
  for (int r = 0; r < 16; ++r) p1[r] = __builtin_amdgcn_exp2f(p1[r]);
  float ps = 0;
#pragma unroll
  for (int r = 0; r < 16; ++r) ps += p0[r];
#pragma unroll
  for (int r = 0; r < 16; ++r) ps += p1[r];
  { auto rr = __builtin_amdgcn_permlane32_swap(__float_as_uint(ps), __float_as_uint(ps), false, false);
    ps = __uint_as_float(rr[0]) + __uint_as_float(rr[1]); }
  l_reg = l_reg * alpha + ps;
#define ATT_PK4(P, BASE, OUT) do { unsigned a0 = cvtpk(P[BASE + 0], P[BASE + 1]), a1 = cvtpk(P[BASE + 2], P[BASE + 3]);   \
    unsigned b0 = cvtpk(P[BASE + 4], P[BASE + 5]), b1 = cvtpk(P[BASE + 6], P[BASE + 7]);                              \
    auto r0 = __builtin_amdgcn_permlane32_swap(a0, b0, false, false); auto r1 = __builtin_amdgcn_permlane32_swap(a1, b1, false, false); \
    u32x4 w = {r0[0], r1[0], r0[1], r1[1]}; OUT = *reinterpret_cast<bf16x8*>(&w); } while (0)
  ATT_PK4(p0, 0, pa0); ATT_PK4(p0, 8, pa1); ATT_PK4(p1, 0, pa2); ATT_PK4(p1, 8, pa3);
#undef ATT_PK4
}
__device__ __forceinline__ void partialSM_neg(f32x16& p0, f32x16& p1, float& mhat, f32x16& negm, float& alpha, const bool first, const float THR2) {
  float pmax = p0[0];
#pragma unroll
  for (int r = 1; r < 16; ++r) pmax = fmaxf(pmax, p0[r]);
#pragma unroll
  for (int r = 0; r < 16; ++r) pmax = fmaxf(pmax, p1[r]);
  { auto rr = __builtin_amdgcn_permlane32_swap(__float_as_uint(pmax), __float_as_uint(pmax), false, false);
    pmax = fmaxf(__uint_as_float(rr[0]), __uint_as_float(rr[1])); }
  if (__builtin_expect(!first && __all(pmax <= THR2), 1)) { alpha = 1.f; }
  else { const float d = first ? pmax : fmaxf(pmax, 0.f); mhat += d; alpha = first ? 1.f : __builtin_amdgcn_exp2f(-d);
#pragma unroll
    for (int r = 0; r < 16; ++r) { p0[r] -= d; p1[r] -= d; }
#pragma unroll
    for (int r = 0; r < 16; ++r) negm[r] = -mhat; }
#pragma unroll
  for (int r = 0; r < 16; ++r) p0[r] = __builtin_amdgcn_exp2f(p0[r]);
}
template <int NDQ> __device__ __forceinline__ void qkt(f32x16& p0, f32x16& p1, const char* Ks, const bf16x8 (&qr)[NDQ], int r32, int hi, const f32x16 cin = f32x16{}) {
  p0 = cin; p1 = cin;
  const int f = (r32 >> 1) & 7; int kb[4];
#pragma unroll
  for (int q = 0; q < 4; ++q) kb[q] = r32 * (32 * NDQ) + (((2 * q + hi) ^ f) << 4);
#pragma unroll
  for (int d0 = 0; d0 < NDQ; ++d0) { const char* kp = Ks + kb[d0 & 3] + 128 * (d0 >> 2);
    const bf16x8 b0 = *reinterpret_cast<const bf16x8*>(kp);
    const bf16x8 b1 = *reinterpret_cast<const bf16x8*>(kp + 32 * 32 * NDQ);
    p0 = __builtin_amdgcn_mfma_f32_32x32x16_bf16(b0, qr[d0], p0, 0, 0, 0);
    p1 = __builtin_amdgcn_mfma_f32_32x32x16_bf16(b1, qr[d0], p1, 0, 0, 0); }
}
__device__ __forceinline__ int v_st(int k, int c) { const int kk = (k & ~0xC) | ((k & 4) << 1) | ((k & 8) >> 1); return ((kk >> 3) * 4 + (c >> 5)) * 512 + ((kk & 7) * 32 + (c & 31)) * 2; }
__device__ __forceinline__ int v_rd_base(int lane) { return ((lane & 3) << 3) | (((lane >> 2) & 3) << 6) | (((lane >> 4) & 1) << 5) | (((lane >> 5) & 1) << 8); }
constexpr int v_rd_off(int d0, int ks, int half) { return d0 * 512 + ks * 4096 + half * 2048; }
template <int OFF> __device__ __forceinline__ s16x4 tr_read(int vb) { s16x4 r; asm volatile("ds_read_b64_tr_b16 %0, %1 offset:%2" : "=&v"(r) : "v"(vb), "i"(OFF) : "memory"); return r; }
template <int D0> __device__ __forceinline__ void pv_one(f32x16& od, int vb, bf16x8 pa0, bf16x8 pa1, bf16x8 pa2, bf16x8 pa3) {
  const s16x4 l0 = tr_read<v_rd_off(D0, 0, 0)>(vb), h0 = tr_read<v_rd_off(D0, 0, 1)>(vb), l1 = tr_read<v_rd_off(D0, 1, 0)>(vb), h1 = tr_read<v_rd_off(D0, 1, 1)>(vb);
  const s16x4 l2 = tr_read<v_rd_off(D0, 2, 0)>(vb), h2 = tr_read<v_rd_off(D0, 2, 1)>(vb), l3 = tr_read<v_rd_off(D0, 3, 0)>(vb), h3 = tr_read<v_rd_off(D0, 3, 1)>(vb);
  asm volatile("s_waitcnt lgkmcnt(0)" ::: "memory"); ASBAR();
#define ATT_PK(L, H) (bf16x8){L[0], L[1], L[2], L[3], H[0], H[1], H[2], H[3]}
  od = __builtin_amdgcn_mfma_f32_32x32x16_bf16(pa0, ATT_PK(l0, h0), od, 0, 0, 0);
  od = __builtin_amdgcn_mfma_f32_32x32x16_bf16(pa1, ATT_PK(l1, h1), od, 0, 0, 0);
  od = __builtin_amdgcn_mfma_f32_32x32x16_bf16(pa2, ATT_PK(l2, h2), od, 0, 0, 0);
  od = __builtin_amdgcn_mfma_f32_32x32x16_bf16(pa3, ATT_PK(l3, h3), od, 0, 0, 0);
#undef ATT_PK
}
__device__ __forceinline__ void pv_d0(f32x16 (&o)[4], int vb, bf16x8 pa0, bf16x8 pa1, bf16x8 pa2, bf16x8 pa3) {
  pv_one<0>(o[0], vb, pa0, pa1, pa2, pa3); pv_one<1>(o[1], vb, pa0, pa1, pa2, pa3); pv_one<2>(o[2], vb, pa0, pa1, pa2, pa3); pv_one<3>(o[3], vb, pa0, pa1, pa2, pa3);
}

template <typename TKV> struct Src { const TKV* kp; const TKV* kn; const TKV* k2p; const TKV* k2n; const TKV* vp; const TKV* vn; int npast, nvalid; };

template <int NDQ, typename TKV, int LDK, int LDK2, int LDV>
__device__ __forceinline__ void attn_core(const bf16x8 (&qr)[NDQ], const Src<TKV>& S, const int NT, const int limit, const bool active, const float C, const float THRS,
                                          char* lds, f32x16 (&o)[4], float& l_reg) {
  using St = Stage<TKV>;
  constexpr int SHM_K = KVBLK * 32 * NDQ;
  int tid_ = threadIdx.x; asm volatile("" : "+v"(tid_));
  const int tid = tid_, wid = tid >> 6, lane = tid & 63, r32 = lane & 31, hi = lane >> 5;
  char* V_lds = lds + LDS_V; char* K_lds = lds + LDS_K;
  float* al_l = (float*)(lds + LDS_WS) + wid * 64 + 32;
  float m_reg = -1e30f; l_reg = 0.f;
#pragma unroll
  for (int d = 0; d < 4; ++d) o[d] = f32x16{};
  const int sr = tid >> 4, sc = (tid & 15) * 8, vst0 = v_st(sr, sc), vst1 = v_st(32 + sr, sc);
  const int kr8 = tid >> 3, kc8 = tid & 7;
  const int vb0 = (int)(uintptr_t)V_lds + v_rd_base(lane);
  struct Slot { typename St::T vs0, vs1, ks0, ks1, ks2; } sl[1];
#define ATT_SLOAD(i, j) do { const int jj_ = (j) < S.nvalid ? (j) : S.nvalid - 1; const bool ps_ = jj_ < S.npast; const long r0_ = ps_ ? (long)jj_ * 64 : (long)(jj_ - S.npast) * 64; \
    const TKV* vb_ = ps_ ? S.vp : S.vn; const TKV* kb_ = ps_ ? S.kp : S.kn; \
    sl[i].vs0 = St::ld8(vb_ + (r0_ + sr) * LDV + sc); sl[i].vs1 = St::ld8(vb_ + (r0_ + 32 + sr) * LDV + sc); \
    if constexpr (NDQ == 4) { sl[i].ks0 = St::ld8(kb_ + (r0_ + kr8) * LDK + kc8 * 8); } \
    else { const TKV* k2_ = ps_ ? S.k2p : S.k2n; sl[i].ks0 = St::ld8(kb_ + (r0_ + sr) * LDK + sc); sl[i].ks1 = St::ld8(kb_ + (r0_ + 32 + sr) * LDK + sc); sl[i].ks2 = St::ld8(k2_ + (r0_ + kr8) * LDK2 + kc8 * 8); } } while (0)
#define ATT_SWRITE(b, i) do { *(bf16x8*)(V_lds + (b) * SHM_V + vst0) = St::tobf(sl[i].vs0); *(bf16x8*)(V_lds + (b) * SHM_V + vst1) = St::tobf(sl[i].vs1); \
    if constexpr (NDQ == 4) { *(bf16x8*)(K_lds + (b) * SHM_K + kswz<NDQ>(kr8, kc8)) = St::tobf(sl[i].ks0); } \
    else { *(bf16x8*)(K_lds + (b) * SHM_K + kswz<NDQ>(sr, tid & 15)) = St::tobf(sl[i].ks0); *(bf16x8*)(K_lds + (b) * SHM_K + kswz<NDQ>(32 + sr, tid & 15)) = St::tobf(sl[i].ks1); \
           *(bf16x8*)(K_lds + (b) * SHM_K + kswz<NDQ>(kr8, 16 + kc8)) = St::tobf(sl[i].ks2); } } while (0)
#define ATT_RESC(a) do { if (__any((a) < 1.f)) { if (hi == 0) al_l[r32] = (a); asm volatile("s_waitcnt lgkmcnt(0)" ::: "memory"); \
    _Pragma("unroll") for (int d = 0; d < 4; ++d) _Pragma("unroll") for (int r = 0; r < 16; ++r) o[d][r] *= al_l[crow(r, hi)]; } } while (0)
#define ATT_MASK(P0, P1, j) do { if ((j) > limit) { _Pragma("unroll") for (int r = 0; r < 16; ++r) { P0[r] = -1e30f; P1[r] = -1e30f; } } } while (0)
  f32x16 pA0, pA1; float mnA, alA = 1.f; bf16x8 pa0, pa1, pa2, pa3;
  f32x16 negm = f32x16{}; if constexpr (NDQ == 4) m_reg = 0.f;
  ATT_SLOAD(0, 0); asm volatile("s_waitcnt vmcnt(0)" ::: "memory"); ATT_SWRITE(0, 0); __syncthreads();
#pragma unroll 1
  for (int j = 0; j < NT; ++j) {
    const int cur = j & 1;
    if (j + 1 < NT) ATT_SLOAD(0, j + 1);
    ASBAR();
    if (active && j <= limit) {
      if constexpr (NDQ == 4) { qkt<NDQ>(pA0, pA1, K_lds + cur * SHM_K, qr, r32, hi, negm); partialSM_neg(pA0, pA1, m_reg, negm, alA, j == 0, THRS * C); }
      else { qkt<NDQ>(pA0, pA1, K_lds + cur * SHM_K, qr, r32, hi); partialSM(pA0, pA1, m_reg, mnA, alA, C, THRS); }
      ATT_RESC(alA);
      finishSM(pA0, pA1, alA, l_reg, pa0, pa1, pa2, pa3);
      ASBAR();
      pv_d0(o, vb0 + cur * SHM_V, pa0, pa1, pa2, pa3);
    }
    ASBAR();
    if (j + 1 < NT) ATT_SWRITE(cur ^ 1, 0);
    __syncthreads();
  }
#undef ATT_SLOAD
#undef ATT_SWRITE
#undef ATT_RESC
#undef ATT_MASK
}
__device__ __forceinline__ void normalize(f32x16 (&o)[4], float l_reg, char* lds, int wid, int r32, int hi) {
  float* li_l = (float*)(lds + LDS_WS) + wid * 64;
  if (hi == 0) li_l[r32] = l_reg;
  asm volatile("s_waitcnt lgkmcnt(0)" ::: "memory");
#pragma unroll
  for (int r = 0; r < 16; ++r) { const float rl = __builtin_amdgcn_rcpf(li_l[crow(r, hi)]);
#pragma unroll
    for (int d = 0; d < 4; ++d) o[d][r] *= rl; }
}
__device__ __forceinline__ unsigned short f2bf1(float f) { unsigned u = __builtin_bit_cast(unsigned, f); return (unsigned short)((u + 0x7fffu + ((u >> 16) & 1u)) >> 16); }

constexpr float LOG2E = 1.4426950408889634f;
constexpr float SCALE_A = 0.125f, SCALE_B = 0.07216878364870322f;
constexpr float THR = 8.f;

template <typename TKV>
__device__ __forceinline__ void diff_unit(const bf16_t* QA, long qrow0, int h, const Src<TKV>& S1, const Src<TKV>& S2, int NT, int limit, bool active, float lam,
                                          const float* g_subln, float* stash, bf16_t* OA, char* lds) {
  asm volatile("" : "+s"(h), "+s"(qrow0));
  const int tid = threadIdx.x, wid = tid >> 6, lane = tid & 63, r32 = lane & 31, hi = lane >> 5;
  const long qrow = qrow0 + (active ? wid * QBLK : 0) + r32;
  f32x16 o[4]; float l_reg; float* st = stash + wid * 4096;
  {
    bf16x8 qr[4];
#pragma unroll
    for (int d0 = 0; d0 < 4; ++d0) qr[d0] = *reinterpret_cast<const bf16x8*>(QA + qrow * 2048 + h * 64 + d0 * 16 + hi * 8);
    attn_core<4, TKV, 2048, 64, 2048>(qr, S1, NT, limit, active, SCALE_A * LOG2E, THR / SCALE_A, lds, o, l_reg);
  }
  if (active) { normalize(o, l_reg, lds, wid, r32, hi);
    __attribute__((address_space(1))) float* st1 = (__attribute__((address_space(1))) float*)(st + lane); asm volatile("" : "+v"(st1));
#pragma unroll
    for (int d = 0; d < 4; ++d)
#pragma unroll
      for (int r = 0; r < 16; ++r) st1[(d * 16 + r) * 64] = o[d][r]; }
  {
    bf16x8 qr[4];
#pragma unroll
    for (int d0 = 0; d0 < 4; ++d0) qr[d0] = *reinterpret_cast<const bf16x8*>(QA + qrow * 2048 + (16 + h) * 64 + d0 * 16 + hi * 8);
    attn_core<4, TKV, 2048, 64, 2048>(qr, S2, NT, limit, active, SCALE_A * LOG2E, THR / SCALE_A, lds, o, l_reg);
  }
  if (active) { normalize(o, l_reg, lds, wid, r32, hi);
    float ss[16];
    const __attribute__((address_space(1))) float* st2 = (const __attribute__((address_space(1))) float*)(st + lane); asm volatile("" : "+v"(st2));
#pragma unroll
    for (int r = 0; r < 16; ++r) ss[r] = 0.f;
#pragma unroll
    for (int d = 0; d < 4; ++d)
#pragma unroll
      for (int r = 0; r < 16; ++r) { const float a = st2[(d * 16 + r) * 64] - lam * o[d][r]; o[d][r] = a; ss[r] += a * a; }
#pragma unroll
    for (int r = 0; r < 16; ++r) { float s = ss[r]; s += __shfl_xor(s, 1); s += __shfl_xor(s, 2); s += __shfl_xor(s, 4); s += __shfl_xor(s, 8); s += __shfl_xor(s, 16);
      ss[r] = 0.8f * rsqrtf(s * (1.f / 128.f) + cfg::EPS); }
    __attribute__((address_space(1))) bf16_t* op = (__attribute__((address_space(1))) bf16_t*)(OA + (qrow0 + wid * QBLK + 4 * hi) * 2048 + h * 128 + r32); asm volatile("" : "+v"(op));
#pragma unroll
    for (int d = 0; d < 4; ++d) { const float g = g_subln[d * 32 + r32];
#pragma unroll
      for (int r = 0; r < 16; ++r) op[((r & 3) + 8 * (r >> 2)) * 2048 + d * 32] = f2bf1(o[d][r] * ss[r] * g); }
  }
}
__device__ __forceinline__ void mla_unit(const bf16_t* QB, long qrow0, int h, const Src<bf16_t>& S, int NT, int limit, bool active, bf16_t* OB, char* lds) {
  asm volatile("" : "+s"(h), "+s"(qrow0));
  const int tid = threadIdx.x, wid = tid >> 6, lane = tid & 63, r32 = lane & 31, hi = lane >> 5;
  const long qrow = qrow0 + (active ? wid * QBLK : 0) + r32;
  f32x16 o[4]; float l_reg;
  bf16x8 qr[12];
#pragma unroll
  for (int d0 = 0; d0 < 12; ++d0) qr[d0] = *reinterpret_cast<const bf16x8*>(QB + qrow * 3072 + h * 192 + d0 * 16 + hi * 8);
  attn_core<12, bf16_t, 4096, 64, 4096>(qr, S, NT, limit, active, SCALE_B * LOG2E, THR / SCALE_B, lds, o, l_reg);
  if (active) { normalize(o, l_reg, lds, wid, r32, hi);
    __attribute__((address_space(1))) bf16_t* op = (__attribute__((address_space(1))) bf16_t*)(OB + (qrow0 + wid * QBLK + 4 * hi) * 2048 + h * 128 + r32); asm volatile("" : "+v"(op));
#pragma unroll
    for (int d = 0; d < 4; ++d)
#pragma unroll
      for (int r = 0; r < 16; ++r) op[((r & 3) + 8 * (r >> 2)) * 2048 + d * 32] = f2bf1(o[d][r]); }
}
#undef ASBAR
}
#ifndef PG8_SP2
#define PG8_SP2 true
#endif
constexpr int NWAVES = 8;
constexpr int NPH = 12;
constexpr int N_LAUNCHES = MK_N_LAUNCHES;
static_assert(N_LAUNCHES == 1 || N_LAUNCHES == NPH, "MK_N_LAUNCHES is 1 or 12");

constexpr size_t MiB = 1u << 20;
constexpr size_t WS_CTL = 0, CTL_ZERO_BYTES = 1 * MiB;
constexpr size_t WS_WIN = 1 * MiB;
constexpr size_t WS_WQB = WS_WIN + (size_t)cfg::NINP * 4096 * 2;
constexpr size_t WS_WKVB = WS_WQB + (size_t)3072 * 896 * 2;
constexpr size_t WS_WBA = WS_WKVB + (size_t)4096 * 512 * 2;
constexpr size_t WS_WBB = WS_WBA + (size_t)4096 * 2048 * 2;
constexpr size_t WS_WOUT = WS_WBB + (size_t)4096 * 2048 * 2;
constexpr size_t WS_WGU = WS_WOUT + (size_t)4096 * 4096 * 2;
constexpr size_t WS_WFD = WS_WGU + (size_t)22016 * 4096 * 2;
constexpr size_t WS_TABA = WS_WFD + (size_t)4096 * 11008 * 2;
constexpr size_t WS_TABB = WS_TABA + (size_t)8192 * 8 * 8;
constexpr size_t WS_XN = WS_TABB + (size_t)8192 * 32 * 8;
constexpr size_t WS_R0 = WS_XN + (size_t)cfg::M * 4096 * 2;
constexpr size_t WS_QA = WS_R0;
constexpr size_t WS_KA = WS_QA + (size_t)cfg::M * 2048 * 2;
constexpr size_t WS_VA = WS_KA + (size_t)cfg::M * 2048 * 2;
constexpr size_t WS_RAW = WS_VA + (size_t)cfg::M * 2048 * 2;
constexpr size_t WS_CQN = WS_RAW + (size_t)cfg::M * cfg::NRAW * 4;
constexpr size_t WS_CKV = WS_CQN + (size_t)cfg::M * 896 * 2;
constexpr size_t WS_KPE = WS_CKV + (size_t)cfg::MKV * 512 * 2;
constexpr size_t WS_QB = WS_KPE + (size_t)cfg::MKV * 64 * 2;
constexpr size_t WS_KVB = WS_QB + (size_t)cfg::M * 3072 * 2;
constexpr size_t WS_G = WS_KVB + (size_t)cfg::MKV * 4096 * 2;
constexpr size_t WS_OA = WS_G + (size_t)cfg::M * 8192 * 2;
constexpr size_t WS_OB = WS_OA + (size_t)cfg::M * 2048 * 2;
constexpr size_t WS_STASH = WS_OB + (size_t)cfg::M * 2048 * 2;
constexpr size_t WS_TOPUG = WS_STASH + (size_t)256 * 8 * 4096 * 4;
constexpr size_t WS_TOPU = WS_TOPUG + (size_t)64 * cfg::DFF * 4;
constexpr size_t WS_BOT = WS_TOPU + (size_t)64 * cfg::DFF * 4;
constexpr size_t WS_END = WS_BOT + (size_t)64 * cfg::DFF * 4;
constexpr size_t WS_MB = WS_QA;
constexpr size_t WS_UG = WS_R0;
constexpr size_t WS_U = WS_UG + (size_t)cfg::M * cfg::DFF * 2;
static_assert(WS_U + (size_t)cfg::M * cfg::DFF * 2 <= WS_END, "FFN overlay fits");
static_assert(WS_END < (size_t)1390 * 1000 * 1000, "workspace budget");
constexpr size_t SLAB_BYTES = (size_t)8 * 512 * 4096 * 4;
constexpr size_t WS_SLAB_A = WS_KVB, WS_SLAB_B = WS_KVB + SLAB_BYTES;
constexpr size_t WS_SLAB_D = WS_UG;
static_assert(2 * SLAB_BYTES <= (size_t)cfg::MKV * 4096 * 2 && SLAB_BYTES <= (size_t)cfg::M * cfg::DFF * 2, "slab overlays fit");
constexpr int CW_TMO = 0, CW_CODE = 1, CW_BAR = 4096;

constexpr int RING_OFF = 0, RING_BYTES = 131072;
constexpr int LDSCTL_OFF = RING_BYTES, MISC_OFF = LDSCTL_OFF + 320;
constexpr int XCH_OFF = RING_BYTES + 1024;
constexpr int LDS_BYTES = 147456;
static_assert(att::LDS_BYTES <= RING_BYTES && pg8::STAGE_BYTES <= RING_BYTES, "phase scratch fits the ring region");

struct Args { const float* in[29]; float* out; unsigned char* ws; int ph_lo, ph_hi; };
struct Frame {
    LAS unsigned char* lds; volatile LAS unsigned* MISC; gu32* ctl;
    int tid, lane, wave, vcu, G;
    float* out; unsigned char* ws;
};
__device__ __forceinline__ float wave_sum(float v) {
#pragma unroll
    for (int o = 1; o < 64; o <<= 1) v += __shfl_xor(v, o);
    return v;
}
template <int MAP> __device__ __forceinline__ int src_col(int n) {
    if (MAP == 1) { if (n < 6144) return n; if (n < 14336) return 7616 + (n - 6144); if (n < 15808) return 6144 + (n - 14336); return -1; }
    if (MAP == 2) { const int h = n / 192, d = n - h * 192; if (d < 128) return n; const int e = d - 128; return h * 192 + 128 + (e >> 1) + 32 * (e & 1); }
    return n;
}
template <int MAP> __device__ __forceinline__ void p0_transpose_item(const float* W, int K, int Nsrc, int Ndst, bf16* WT, int row_off, LAS float* scr, int item, int lane) {
    const int nblk = Ndst / 32, kb = item / nblk, nb = item - kb * nblk, k0 = 64 * kb, n0 = 32 * nb;
    if constexpr (MAP == 2) {
        const int sn = src_col<MAP>(n0 + (lane & 31));
#pragma unroll 8
        for (int i = 0; i < 32; ++i) { const int kk = 2 * i + (lane >> 5); scr[kk * 33 + (lane & 31)] = W[(size_t)(k0 + kk) * Nsrc + sn]; }
    } else {
        const int n4 = 4 * (lane & 7), kq = lane >> 3;
        const int sn = src_col<MAP>(n0 + n4);
        f32x4 v[8];
#pragma unroll
        for (int i = 0; i < 8; ++i) v[i] = sn >= 0 ? __builtin_nontemporal_load((const GAS f32x4*)(W + (size_t)(k0 + 8 * i + kq) * Nsrc + sn)) : (f32x4){0.f, 0.f, 0.f, 0.f};
#pragma unroll
        for (int i = 0; i < 8; ++i) { LAS float* d = scr + (8 * i + kq) * 33 + n4; d[0] = v[i].x; d[1] = v[i].y; d[2] = v[i].z; d[3] = v[i].w; }
    }
    LDS_WAIT(); asm volatile("" ::: "memory");
    const int c = lane & 7;
#pragma unroll
    for (int j = 0; j < 4; ++j) { const int n = (lane >> 3) + 8 * j; const LAS float* s = scr + (8 * c) * 33 + n;
        v4u o; o.x = pk2(s[0 * 33], s[1 * 33]); o.y = pk2(s[2 * 33], s[3 * 33]); o.z = pk2(s[4 * 33], s[5 * 33]); o.w = pk2(s[6 * 33], s[7 * 33]);
        *(GAS v4u*)(WT + (size_t)(row_off + n0 + n) * K + k0 + 8 * c) = o; }
    LDS_WAIT(); asm volatile("" ::: "memory");
}
struct XItem { const float* W; bf16* WT; int K, Nsrc, Ndst, row_off, item, ilv; };
__device__ __forceinline__ void xitem_load(const XItem& x, int lane, f32x4 (&v)[8]) {
    const int nblk = x.Ndst / 32, kb = x.item / nblk, nb = x.item - kb * nblk, k0 = 64 * kb, n0 = 32 * nb;
    const int n4 = 4 * (lane & 7), kq = lane >> 3;
#pragma unroll
    for (int i = 0; i < 8; ++i) v[i] = __builtin_nontemporal_load((const GAS f32x4*)(x.W + (size_t)(k0 + 8 * i + kq) * x.Nsrc + n0 + n4));
}
__device__ __forceinline__ void xitem_finish(const XItem& x, int lane, const f32x4 (&v)[8], LAS float* scr) {
    const int nblk = x.Ndst / 32, kb = x.item / nblk, nb = x.item - kb * nblk, k0 = 64 * kb, n0 = 32 * nb;
    const int n4 = 4 * (lane & 7), kq = lane >> 3;
#pragma unroll
    for (int i = 0; i < 8; ++i) { LAS float* d = scr + (8 * i + kq) * 33 + n4; d[0] = v[i].x; d[1] = v[i].y; d[2] = v[i].z; d[3] = v[i].w; }
    LDS_WAIT(); asm volatile("" ::: "memory");
    const int c = lane & 7;
#pragma unroll
    for (int j = 0; j < 4; ++j) { const int n = (lane >> 3) + 8 * j; const LAS float* s = scr + (8 * c) * 33 + n;
        v4u o; o.x = pk2(s[0 * 33], s[1 * 33]); o.y = pk2(s[2 * 33], s[3 * 33]); o.z = pk2(s[4 * 33], s[5 * 33]); o.w = pk2(s[6 * 33], s[7 * 33]);
        const int nn = n0 + n, drow = x.ilv ? ((nn >> 7) << 8) + (nn & 127) + x.row_off : x.row_off + nn;
        *(GAS v4u*)(x.WT + (size_t)drow * x.K + k0 + 8 * c) = o; }
    LDS_WAIT(); asm volatile("" ::: "memory");
}
template <typename TO> __device__ __forceinline__ void rms_row4096(const float* xrow, const float* gain, TO* orow, int lane) {
    const GAS f32x4* xr = (const GAS f32x4*)xrow + lane; const GAS f32x4* gr = (const GAS f32x4*)gain + lane;
    f32x4 v[16]; float s = 0.f;
#pragma unroll
    for (int j = 0; j < 16; ++j) { v[j] = xr[64 * j]; s += (v[j].x * v[j].x + v[j].y * v[j].y) + (v[j].z * v[j].z + v[j].w * v[j].w); }
    const float rstd = rsqrtf(wave_sum(s) * (1.f / 4096.f) + cfg::EPS);
#pragma unroll
    for (int j = 0; j < 16; ++j) { const f32x4 g = gr[64 * j]; const f32x4 y = v[j] * rstd * g;
        if constexpr (sizeof(TO) == 2) { ((GAS unsigned long long*)orow)[64 * j + lane] = (unsigned long long)pk2(y.x, y.y) | ((unsigned long long)pk2(y.z, y.w) << 32); }
        else { ((GAS f32x4*)orow)[64 * j + lane] = y; } }
}
__device__ __forceinline__ void slab_sum4(const float* slab, int srow, int q, int lane, f32x4 (&v)[4]) {
#pragma unroll
    for (int s = 0; s < 8; ++s) { const GAS f32x4* p = (const GAS f32x4*)(slab + ((size_t)s * 512 + srow) * 4096 + 1024 * q) + lane;
#pragma unroll
        for (int j = 0; j < 4; ++j) v[j] += p[64 * j]; }
}
__device__ __forceinline__ void p5c_merge_sample(Frame& F) {
    const int srow = 2 * F.vcu + (F.wave >> 2), q = F.wave & 3, lane = F.lane; if (F.vcu >= 256) return;
    f32x4 a[4], b[4];
#pragma unroll
    for (int j = 0; j < 4; ++j) { a[j] = (f32x4){0.f, 0.f, 0.f, 0.f}; b[j] = a[j]; }
    slab_sum4((const float*)(F.ws + WS_SLAB_A), srow, q, lane, a); slab_sum4((const float*)(F.ws + WS_SLAB_B), srow, q, lane, b);
    const bf16* G = (const bf16*)(F.ws + WS_G) + (size_t)(cfg::TP + srow) * 8192 + 1024 * q; bf16* MB = (bf16*)(F.ws + WS_MB) + (size_t)(cfg::TP + srow) * 4096 + 1024 * q;
#pragma unroll
    for (int j = 0; j < 4; ++j) { const int c = 4 * lane + 256 * j; const unsigned long long g0 = *(const GAS unsigned long long*)(G + c), g1 = *(const GAS unsigned long long*)(G + 4096 + c);
        const float g00 = __uint_as_float((unsigned)g0 << 16), g01 = __uint_as_float((unsigned)g0 & 0xffff0000u), g02 = __uint_as_float((unsigned)(g0 >> 32) << 16), g03 = __uint_as_float((unsigned)(g0 >> 32) & 0xffff0000u);
        const float g10 = __uint_as_float((unsigned)g1 << 16), g11 = __uint_as_float((unsigned)g1 & 0xffff0000u), g12 = __uint_as_float((unsigned)(g1 >> 32) << 16), g13 = __uint_as_float((unsigned)(g1 >> 32) & 0xffff0000u);
        const float m0 = g00 * a[j].x + g10 * b[j].x, m1 = g01 * a[j].y + g11 * b[j].y, m2 = g02 * a[j].z + g12 * b[j].z, m3 = g03 * a[j].w + g13 * b[j].w;
        *(GAS unsigned long long*)(MB + c) = (unsigned long long)pk2(m0, m1) | ((unsigned long long)pk2(m2, m3) << 32); }
}
template <typename TO> __device__ __forceinline__ void sample_rows_norm(Frame& F, const float* base_rows  , const float* slab, float* hout_rows  , const float* gain, TO* yout_rows  , LAS float* xch) {
    const int srow = 2 * (F.vcu & 255) + (F.wave >> 2), q = F.wave & 3, lane = F.lane;
    f32x4 v[4];
    { const GAS f32x4* p = (const GAS f32x4*)(base_rows + (size_t)srow * 4096 + 1024 * q) + lane;
#pragma unroll
      for (int j = 0; j < 4; ++j) v[j] = p[64 * j]; }
    slab_sum4(slab, srow, q, lane, v);
    float s = 0.f;
#pragma unroll
    for (int j = 0; j < 4; ++j) s += (v[j].x * v[j].x + v[j].y * v[j].y) + (v[j].z * v[j].z + v[j].w * v[j].w);
    s = wave_sum(s);
    if (lane == 0) xch[F.wave] = s;
    LDS_WAIT(); __syncthreads();
    const int w0 = F.wave & 4; const float tot = (xch[w0] + xch[w0 + 1]) + (xch[w0 + 2] + xch[w0 + 3]);
    const float rstd = rsqrtf(tot * (1.f / 4096.f) + cfg::EPS);
    const GAS f32x4* gr = (const GAS f32x4*)(gain + 1024 * q) + lane;
    if constexpr (sizeof(TO) == 2) { GAS f32x4* ho = (GAS f32x4*)(hout_rows + (size_t)srow * 4096 + 1024 * q) + lane;
#pragma unroll
        for (int j = 0; j < 4; ++j) ho[64 * j] = v[j]; }
#pragma unroll
    for (int j = 0; j < 4; ++j) { const f32x4 y = v[j] * rstd * gr[64 * j];
        if constexpr (sizeof(TO) == 2) ((GAS unsigned long long*)(yout_rows + (size_t)srow * 4096 + 1024 * q))[64 * j + lane] = (unsigned long long)pk2(y.x, y.y) | ((unsigned long long)pk2(y.z, y.w) << 32);
        else ((GAS f32x4*)(yout_rows + (size_t)srow * 4096 + 1024 * q))[64 * j + lane] = y; }
    __syncthreads();
}
constexpr int I_IN = 64 * (cfg::NINP / 32), I_QB = 14 * 96, I_KVB = 8 * 128, I_BR = 32 * 128, I_OUT = 64 * 128, I_FF = 64 * 344, I_FD = 172 * 128;
constexpr int NITEMS1 = I_QB + I_KVB + 2 * I_BR + I_OUT + 2 * I_FF, NITEMS2 = I_FD;
constexpr int CW_Q1 = 1024, CW_Q2 = 1088;
#ifndef P8_GEMM_WGS
#define P8_GEMM_WGS 248
#endif
#ifndef P1_GEMM_WGS
#define P1_GEMM_WGS 240
#endif
template <int LIST> __device__ __forceinline__ XItem list_item(const Args& A, unsigned char* ws, int r) {
    if (LIST == 2) return XItem{A.in[27], (bf16*)(ws + WS_WFD), cfg::DFF, 4096, 4096, 0, r, 0};
    r -= I_QB;
    if (r < I_KVB) return XItem{A.in[18], (bf16*)(ws + WS_WKVB), 512, 4096, 4096, 0, r, 0}; r -= I_KVB;
    if (r < I_BR) return XItem{A.in[14], (bf16*)(ws + WS_WBA), 2048, 4096, 4096, 0, r, 0}; r -= I_BR;
    if (r < I_BR) return XItem{A.in[19], (bf16*)(ws + WS_WBB), 2048, 4096, 4096, 0, r, 0}; r -= I_BR;
    if (r < I_OUT) return XItem{A.in[21], (bf16*)(ws + WS_WOUT), 4096, 4096, 4096, 0, r, 0}; r -= I_OUT;
    if (r < I_FF) return XItem{A.in[23], (bf16*)(ws + WS_WGU), 4096, cfg::DFF, cfg::DFF, 0, r, 1}; r -= I_FF;
    return XItem{A.in[24], (bf16*)(ws + WS_WGU), 4096, cfg::DFF, cfg::DFF, 128, r, 1};
}
template <int LIST> __device__ __forceinline__ void convert_queue(Frame& F, const Args& A) {
    constexpr int QCH = 8, NIT = LIST == 1 ? NITEMS1 : NITEMS2, NSC = LIST == 1 ? I_QB : 0;
    LAS float* scr = (LAS float*)(F.lds + RING_OFF + F.wave * 16384);
    gu32* head = F.ctl + (LIST == 1 ? CW_Q1 : CW_Q2);
    for (;;) {
        unsigned base = 0u; if (F.lane == 0) base = __hip_atomic_fetch_add(head, (unsigned)QCH, RLX_AGENT);
        base = (unsigned)__builtin_amdgcn_readfirstlane((int)base);
        if (base >= (unsigned)NIT) break;
        const int lo = (int)base, hi = lo + QCH;
        static_assert(NITEMS1 % 8 == 0 && NITEMS2 % 8 == 0 && I_QB % 8 == 0, "chunks never straddle a list end or the scalar-path boundary");
        if (lo < NSC) {
#pragma unroll 1
            for (int it = lo; it < hi; ++it) p0_transpose_item<2>(A.in[16], 896, 3072, 3072, (bf16*)(F.ws + WS_WQB), 0, scr, it, F.lane);
        } else {
            f32x4 va[8], vb[8];
            { const XItem x = list_item<LIST>(A, F.ws, lo); xitem_load(x, F.lane, va); }
#pragma unroll 1
            for (int it = lo; it < hi; it += 2) {
                { const XItem x = list_item<LIST>(A, F.ws, it + 1); xitem_load(x, F.lane, vb); }
                { const XItem x = list_item<LIST>(A, F.ws, it); xitem_finish(x, F.lane, va, scr); }
                if (it + 2 < hi) { const XItem x = list_item<LIST>(A, F.ws, it + 2); xitem_load(x, F.lane, va); }
                { const XItem x = list_item<LIST>(A, F.ws, it + 1); xitem_finish(x, F.lane, vb, scr); }
            }
        }
    }
}
__device__ __forceinline__ void p0_prologue(Frame& F, const Args& A) {
    LAS float* scr = (LAS float*)(F.lds + RING_OFF + F.wave * 16384);
    const int gw = F.vcu * NWAVES + F.wave, NGW = F.G * NWAVES;
    unsigned char* ws = F.ws;
    for (int it = gw; it < I_IN; it += NGW) p0_transpose_item<1>(A.in[8], 4096, 15808, cfg::NINP, (bf16*)(ws + WS_WIN), 0, scr, it, F.lane);
    for (int m = gw; m < cfg::M; m += NGW) { const float* xr = m < cfg::TP ? A.in[0] + (size_t)m * 4096 : A.in[1] + (size_t)(m - cfg::TP) * 4096;
        rms_row4096<bf16>(xr, A.in[7], (bf16*)(ws + WS_XN) + (size_t)m * 4096, F.lane); }
    const int gt = gw * 64 + F.lane, NGT = NGW * 64;
    float* tabA = (float*)(ws + WS_TABA); float* tabB = (float*)(ws + WS_TABB);
    for (int i = gt; i < 8192 * 40; i += NGT) {
        int pos, fi; float ex; float* dst;
        if (i < 8192 * 8) { pos = i >> 3; fi = i & 7; ex = (float)fi * (1.f / 8.f); dst = tabA + (size_t)i * 2; }
        else { const int k = i - 8192 * 8; pos = k >> 5; fi = k & 31; ex = (float)fi * (1.f / 32.f); dst = tabB + (size_t)k * 2; }
        const float inv = exp2f(-ex * 18.931568569324174f);
        const float ang = (float)pos * inv;
        double rev = (double)ang * 0.15915494309189535; rev -= __builtin_floor(rev);
        const float fr = (float)rev;
        dst[0] = __builtin_amdgcn_cosf(fr); dst[1] = __builtin_amdgcn_sinf(fr);
    }
    { const float* src = A.in[4]; bf16* dst = (bf16*)(ws + WS_CKV) + (size_t)cfg::TP * 512;
      for (int i = gt; i < 16384 * 512 / 8; i += NGT) { const f32x4 a = *(const GAS f32x4*)(src + (size_t)i * 8), b = *(const GAS f32x4*)(src + (size_t)i * 8 + 4);
          v4u o; o.x = pk2(a.x, a.y); o.y = pk2(a.z, a.w); o.z = pk2(b.x, b.y); o.w = pk2(b.z, b.w); *(GAS v4u*)(dst + (size_t)i * 8) = o; } }
    { const float* src = A.in[5]; bf16* dst = (bf16*)(ws + WS_KPE) + (size_t)cfg::TP * 64;
      for (int i = gt; i < 16384 * 8; i += NGT) { const int row = i >> 3, c = i & 7; const f32x4 a = *(const GAS f32x4*)(src + (size_t)row * 64 + 4 * c), b = *(const GAS f32x4*)(src + (size_t)row * 64 + 32 + 4 * c);
          v4u o; o.x = pk2(a.x, b.x); o.y = pk2(a.y, b.y); o.z = pk2(a.z, b.z); o.w = pk2(a.w, b.w); *(GAS v4u*)(dst + (size_t)row * 64 + 8 * c) = o; } }
}
__device__ __forceinline__ void p2_latents(Frame& F, const Args& A) {
    const int gw = F.vcu * NWAVES + F.wave, NGW = F.G * NWAVES, lane = F.lane;
    unsigned char* ws = F.ws; const float* g_qa = A.in[15]; const float* g_kva = A.in[17]; const float* tabB = (const float*)(ws + WS_TABB);
    for (int m = gw; m < cfg::M; m += NGW) {
        const float* raw = (const float*)(ws + WS_RAW) + (size_t)m * cfg::NRAW;
        const bool smp = m >= cfg::TP; const int pos = smp ? 2048 + (m & 63) : m; const size_t mk = smp ? (size_t)m + 16384 : (size_t)m;
        float v[14]; float s = 0.f;
#pragma unroll
        for (int j = 0; j < 14; ++j) { v[j] = raw[64 * j + lane]; s += v[j] * v[j]; }
        float rstd = rsqrtf(wave_sum(s) * (1.f / 896.f) + cfg::EPS);
        bf16* cq = (bf16*)(ws + WS_CQN) + (size_t)m * 896;
#pragma unroll
        for (int j = 0; j < 14; ++j) cq[64 * j + lane] = (bf16)f2bf(v[j] * rstd * g_qa[64 * j + lane]);
        float w[8]; s = 0.f;
#pragma unroll
        for (int j = 0; j < 8; ++j) { w[j] = raw[896 + 64 * j + lane]; s += w[j] * w[j]; }
        rstd = rsqrtf(wave_sum(s) * (1.f / 512.f) + cfg::EPS);
        float* co = smp ? F.out + cfg::O_CKVS + (size_t)(m - cfg::TP) * 512 : F.out + cfg::O_CKVP + (size_t)m * 512;
        bf16* ck = (bf16*)(ws + WS_CKV) + mk * 512;
#pragma unroll
        for (int j = 0; j < 8; ++j) { const float y = w[j] * rstd * g_kva[64 * j + lane]; co[64 * j + lane] = y; ck[64 * j + lane] = (bf16)f2bf(y); }
        if (lane < 32) { const float x1 = raw[1408 + lane], x2 = raw[1440 + lane]; const float c = tabB[((size_t)pos * 32 + lane) * 2], sn = tabB[((size_t)pos * 32 + lane) * 2 + 1];
            const float o1 = x1 * c - x2 * sn, o2 = x2 * c + x1 * sn;
            float* ko = smp ? F.out + cfg::O_KPES + (size_t)(m - cfg::TP) * 64 : F.out + cfg::O_KPEP + (size_t)m * 64;
            ko[lane] = o1; ko[32 + lane] = o2;
            ((GAS unsigned*)((bf16*)(ws + WS_KPE) + mk * 64))[lane] = pk2(o1, o2); }
    }
}
__device__ __forceinline__ void p9_fix(Frame& F, const Args& A) {
    const int gt = (F.vcu * NWAVES + F.wave) * 64 + F.lane, NGT = F.G * NWAVES * 64;
    const float* topug = (const float*)(F.ws + WS_TOPUG); const float* topu = (const float*)(F.ws + WS_TOPU); const float* bot = (const float*)(F.ws + WS_BOT);
    bf16* ACT = (bf16*)(F.ws + WS_U); const float* wc = A.in[25]; const float* bc = A.in[26];
    constexpr int NCC = cfg::DFF / 8;
    for (int it = gt; it < 31 * 2 * NCC; it += NGT) {
        const int pj = it / NCC, cc = it - pj * NCC, pm = 1 + (pj >> 1), j = pj & 1, col = cc * 8;
        const float* x0 = topug + (size_t)(pm * 2 + j) * cfg::DFF + col;
        const float* x1 = j ? topug + (size_t)(pm * 2) * cfg::DFF + col : bot + (size_t)((pm - 1) * 2 + 1) * cfg::DFF + col;
        const float* x2 = j ? bot + (size_t)((pm - 1) * 2 + 1) * cfg::DFF + col : bot + (size_t)((pm - 1) * 2) * cfg::DFF + col;
        const float* uu = topu + (size_t)(pm * 2 + j) * cfg::DFF + col;
        float a[8];
#pragma unroll
        for (int e = 0; e < 8; ++e) { const float c = bc[col + e] + wc[col + e] * x2[e] + wc[cfg::DFF + col + e] * x1[e] + wc[2 * cfg::DFF + col + e] * x0[e]; a[e] = c * __builtin_amdgcn_rcpf(1.f + __expf(-c)) * uu[e]; }
        v4u o; o.x = pk2(a[0], a[1]); o.y = pk2(a[2], a[3]); o.z = pk2(a[4], a[5]); o.w = pk2(a[6], a[7]);
        *(GAS v4u*)(ACT + (size_t)(pm * 256 + j) * cfg::DFF + col) = o;
    }
}
__device__ __forceinline__ void p4_attention(Frame& F, const Args& A, char* lds) {
    using att::bf16_t; using att::Src;
    unsigned char* ws = F.ws; const int wid = F.wave;
    const bf16_t* QA = (const bf16_t*)(ws + WS_QA); const bf16_t* KA = (const bf16_t*)(ws + WS_KA); const bf16_t* VA = (const bf16_t*)(ws + WS_VA);
    const bf16_t* QB = (const bf16_t*)(ws + WS_QB); const bf16_t* KVB = (const bf16_t*)(ws + WS_KVB); const bf16_t* KPE = (const bf16_t*)(ws + WS_KPE);
    bf16_t* OA = (bf16_t*)(ws + WS_OA); bf16_t* OB = (bf16_t*)(ws + WS_OB);
    float lam;
    { const float a = A.in[9][F.lane] * A.in[10][F.lane], b = A.in[11][F.lane] * A.in[12][F.lane]; lam = __expf(wave_sum(a)) - __expf(wave_sum(b)) + 0.2f; }
    const float* g_subln = A.in[13];
    { const int v = F.vcu & 255;
        float* stash = (float*)(ws + WS_STASH) + (size_t)v * 8 * 4096;
        const int h = v >> 4, s = v & 15;
#ifndef ATT_SEL
#define ATT_SEL 7
#endif
#pragma unroll 1
        for (int k = 0; k < ((ATT_SEL & 1) ? 2 : 0); ++k) {
            const int qb = k ? 31 - s : s, NT = 4 * qb + 4, limit = 4 * qb + (wid >> 1);
            Src<bf16_t> S1{KA + h * 64, KA + h * 64, nullptr, nullptr, VA + h * 128, VA + h * 128, NT, NT};
            Src<bf16_t> S2{KA + (16 + h) * 64, KA + (16 + h) * 64, nullptr, nullptr, VA + h * 128, VA + h * 128, NT, NT};
            att::diff_unit<bf16_t>(QA, (long)qb * 256, h, S1, S2, NT, limit, true, lam, g_subln, stash, OA, lds);
        }
#pragma unroll 1
        for (int k = 0; k < ((ATT_SEL & 2) ? 3 : 0); ++k) {
            if (k < 2) { const int qb = k ? 31 - s : s, NT = 4 * qb + 4, limit = 4 * qb + (wid >> 1);
                Src<bf16_t> S{KVB + h * 256, KVB + h * 256, KPE, KPE, KVB + h * 256 + 128, KVB + h * 256 + 128, NT, NT};
                att::mla_unit(QB, (long)qb * 256, h, S, NT, limit, true, OB, lds);
            } else if (v >= 128) { const int b = (v - 128) >> 4, hh = v & 15;
                const bf16_t* kp = KVB + (size_t)(cfg::TP + b * 2048) * 4096 + hh * 256; const bf16_t* kn = KVB + (size_t)(cfg::TP + 16384 + b * 64) * 4096 + hh * 256;
                Src<bf16_t> S{kp, kn, KPE + (size_t)(cfg::TP + b * 2048) * 64, KPE + (size_t)(cfg::TP + 16384 + b * 64) * 64, kp + 128, kn + 128, 32, 33};
                att::mla_unit(QB, (long)cfg::TP + b * 64, hh, S, 34, 32, wid < 2, OB, lds);
            }
        }
        if ((ATT_SEL & 4) && v < 128) { const int b = v >> 4, hh = v & 15;
            const float* kp = A.in[2] + (size_t)b * 2048 * 2048 + hh * 64; const float* kn = F.out + cfg::O_DKS + (size_t)b * 64 * 2048 + hh * 64;
            const float* vp = A.in[3] + (size_t)b * 2048 * 2048 + hh * 128; const float* vn = F.out + cfg::O_DVS + (size_t)b * 64 * 2048 + hh * 128;
            Src<float> S1{kp, kn, nullptr, nullptr, vp, vn, 32, 33};
            Src<float> S2{kp + 16 * 64, kn + 16 * 64, nullptr, nullptr, vp, vn, 32, 33};
            att::diff_unit<float>(QA, (long)cfg::TP + b * 64, hh, S1, S2, 34, 32, wid < 2, lam, g_subln, stash, OA, lds);
        }
    }
}

__global__ void __launch_bounds__(NWAVES * 64, 2) fwd(Args args) {
    extern __shared__ __attribute__((aligned(16))) unsigned char lds[];
    Frame F;
    F.lds = (LAS unsigned char*)lds; F.MISC = (volatile LAS unsigned*)(F.lds + MISC_OFF);
    F.tid = threadIdx.x; F.lane = F.tid & 63; F.wave = __builtin_amdgcn_readfirstlane(F.tid >> 6);
    F.G = gridDim.x; { const int bx = blockIdx.x; F.vcu = (F.G % 8 == 0) ? (bx % 8) * (F.G / 8) + bx / 8 : bx; }
    F.out = args.out; F.ws = args.ws; unsigned char* ws = args.ws;
    F.ctl = (gu32*)(ws + WS_CTL);
    for (int u = F.tid; u < (LDS_BYTES - LDSCTL_OFF) / 4; u += NWAVES * 64) ((LAS unsigned*)(F.lds + LDSCTL_OFF))[u] = 0u;
    __syncthreads();
    XcdBarrier bar; bar.bar = (unsigned*)(F.ctl + CW_BAR); bar.x = 0; bar.st = nullptr;
    if (N_LAUNCHES == 1) bar = xcd_barrier_post((unsigned*)(F.ctl + CW_BAR), F.MISC + 8);
#define GRID_BAR() do { if (N_LAUNCHES == 1) xcd_barrier(bar); } while (0)
    const int lo = args.ph_lo, hi = args.ph_hi;
#ifndef PH_MASK
#define PH_MASK 0xFFF
#endif
#define IN(k) (((PH_MASK >> (k)) & 1) && lo <= (k) && (k) < hi)
    typedef pg8::bf16_t pb;
    float* Y = args.out + cfg::O_Y;

    if (IN(0)) { p0_prologue(F, args); GRID_BAR(); }
#ifdef DUP_P0
    if (IN(0)) { p0_prologue(F, args); GRID_BAR(); }
#endif
#ifndef DUP_PH
#define DUP_PH -1
#endif
    if (IN(1)) {
        if (blockIdx.x < P1_GEMM_WGS) {
        pg8::Gemm g{(const pb*)(ws + WS_XN), (const pb*)(ws + WS_WIN), cfg::M, cfg::NINP, 4096}; pg8::StaticOrder S; S.init(cfg::M, cfg::NINP, P1_GEMM_WGS, (int)blockIdx.x);
        pg8::EpiIn E{(pb*)(ws + WS_QA), (pb*)(ws + WS_KA), (pb*)(ws + WS_VA), (pb*)(ws + WS_G), (float*)(ws + WS_RAW), args.out, args.in[20], (const float*)(ws + WS_TABA)};
        pg8::gemm_phase<pg8::EpiIn, pg8::StaticOrder, true, PG8_SP2>(F.lds + RING_OFF, g, S, E);
        }
        __syncthreads(); convert_queue<1>(F, args);
        GRID_BAR();
    }
#if DUP_PH == 1
    if (IN(1)) {
        if (blockIdx.x < P1_GEMM_WGS) {
        pg8::Gemm g{(const pb*)(ws + WS_XN), (const pb*)(ws + WS_WIN), cfg::M, cfg::NINP, 4096}; pg8::StaticOrder S; S.init(cfg::M, cfg::NINP, P1_GEMM_WGS, (int)blockIdx.x);
        pg8::EpiIn E{(pb*)(ws + WS_QA), (pb*)(ws + WS_KA), (pb*)(ws + WS_VA), (pb*)(ws + WS_G), (float*)(ws + WS_RAW), args.out, args.in[20], (const float*)(ws + WS_TABA)};
        pg8::gemm_phase<pg8::EpiIn, pg8::StaticOrder, true, PG8_SP2>(F.lds + RING_OFF, g, S, E);
        }
        __syncthreads(); convert_queue<1>(F, args);
        GRID_BAR();
    }
#endif
    if (IN(2)) { p2_latents(F, args); GRID_BAR(); }
    if (IN(3)) {
        { pg8::Gemm g{(const pb*)(ws + WS_CQN), (const pb*)(ws + WS_WQB), cfg::M, cfg::NQB, 896}; pg8::StaticOrder S; S.init(cfg::M, cfg::NQB, F.G, (int)blockIdx.x);
          pg8::EpiQB E{(pb*)(ws + WS_QB), (const float*)(ws + WS_TABB)};
          pg8::gemm_phase<pg8::EpiQB, pg8::StaticOrder, true, PG8_SP2>(F.lds + RING_OFF, g, S, E); }
        __syncthreads();
        { pg8::Gemm g{(const pb*)(ws + WS_CKV), (const pb*)(ws + WS_WKVB), cfg::MKV, cfg::NKVBO, 512}; pg8::StaticOrder S; S.init(cfg::MKV, cfg::NKVBO, F.G, (int)((blockIdx.x + F.G / 2) % F.G));
          pg8::EpiPlain E{(pb*)(ws + WS_KVB), cfg::NKVBO};
          pg8::gemm_phase<pg8::EpiPlain, pg8::StaticOrder, true, PG8_SP2>(F.lds + RING_OFF, g, S, E); }
        GRID_BAR();
    }
    if (IN(4)) { p4_attention(F, args, (char*)lds + RING_OFF); GRID_BAR(); }
#ifdef DUP_P4
    if (IN(4)) { p4_attention(F, args, (char*)lds + RING_OFF); GRID_BAR(); }
#endif
    if (IN(5)) {
        { pg8::Gemm g{(const pb*)(ws + WS_OA), (const pb*)(ws + WS_WBA), cfg::M, 4096, 2048}; pg8::SplitTailOrder S; S.init(2048, (int)blockIdx.x);
          pg8::EpiYA E{(const pb*)(ws + WS_G), Y, (float*)(ws + WS_SLAB_A)};
          pg8::gemm_phase<pg8::EpiYA, pg8::SplitTailOrder, true, PG8_SP2>(F.lds + RING_OFF, g, S, E); }
        __syncthreads();
        { pg8::Gemm g{(const pb*)(ws + WS_OB), (const pb*)(ws + WS_WBB), cfg::M, 4096, 2048}; pg8::SplitTailOrder S; S.init(2048, (int)blockIdx.x);
          pg8::EpiYB E{(const pb*)(ws + WS_G), Y, (pb*)(ws + WS_MB), (float*)(ws + WS_SLAB_B)};
          pg8::gemm_phase<pg8::EpiYB, pg8::SplitTailOrder, true, PG8_SP2>(F.lds + RING_OFF, g, S, E); }
        GRID_BAR();
        p5c_merge_sample(F);
        GRID_BAR();
    }
    if (IN(6)) {
        pg8::Gemm g{(const pb*)(ws + WS_MB), (const pb*)(ws + WS_WOUT), cfg::M, 4096, 4096}; pg8::SplitTailOrder S; S.init(4096, (int)blockIdx.x);
        pg8::EpiRes E{args.in[0], args.in[1], Y, (float*)(ws + WS_SLAB_A)};
        pg8::gemm_phase<pg8::EpiRes, pg8::SplitTailOrder, true, PG8_SP2>(F.lds + RING_OFF, g, S, E);
        GRID_BAR();
    }
#if DUP_PH == 6
    if (IN(6)) {
        pg8::Gemm g{(const pb*)(ws + WS_MB), (const pb*)(ws + WS_WOUT), cfg::M, 4096, 4096}; pg8::SplitTailOrder S; S.init(4096, (int)blockIdx.x);
        pg8::EpiRes E{args.in[0], args.in[1], Y, (float*)(ws + WS_SLAB_A)};
        pg8::gemm_phase<pg8::EpiRes, pg8::SplitTailOrder, true, PG8_SP2>(F.lds + RING_OFF, g, S, E);
        GRID_BAR();
    }
#endif
    if (IN(7)) {
        const int gw = F.vcu * NWAVES + F.wave, NGW = F.G * NWAVES;
        sample_rows_norm<bf16>(F, args.in[1], (const float*)(ws + WS_SLAB_A), Y + (size_t)cfg::TP * 4096, args.in[22], (bf16*)(ws + WS_XN) + (size_t)cfg::TP * 4096, (LAS float*)(F.lds + RING_OFF));
        for (int m = gw; m < cfg::TP; m += NGW) rms_row4096<bf16>(Y + (size_t)m * 4096, args.in[22], (bf16*)(ws + WS_XN) + (size_t)m * 4096, F.lane);
        GRID_BAR();
    }
    if (IN(8)) {
        if (blockIdx.x < P8_GEMM_WGS) {
        pg8::Gemm g{(const pb*)(ws + WS_XN), (const pb*)(ws + WS_WGU), cfg::M, 2 * cfg::DFF, 4096}; pg8::StaticOrder S; S.init(cfg::M, 2 * cfg::DFF, P8_GEMM_WGS, (int)blockIdx.x);
        pg8::EpiGU2 E{(pb*)(ws + WS_U), args.out, args.in[25], args.in[26], args.in[6], (float*)(ws + WS_TOPUG), (float*)(ws + WS_TOPU), (float*)(ws + WS_BOT), (LAS float*)(F.lds + XCH_OFF)};
        pg8::gemm_phase<pg8::EpiGU2, pg8::StaticOrder, true, PG8_SP2>(F.lds + RING_OFF, g, S, E);
        }
        __syncthreads(); convert_queue<2>(F, args);
        GRID_BAR();
    }
#if DUP_PH == 8
    if (IN(8)) {
        if (blockIdx.x < P8_GEMM_WGS) {
        pg8::Gemm g{(const pb*)(ws + WS_XN), (const pb*)(ws + WS_WGU), cfg::M, 2 * cfg::DFF, 4096}; pg8::StaticOrder S; S.init(cfg::M, 2 * cfg::DFF, P8_GEMM_WGS, (int)blockIdx.x);
        pg8::EpiGU2 E{(pb*)(ws + WS_U), args.out, args.in[25], args.in[26], args.in[6], (float*)(ws + WS_TOPUG), (float*)(ws + WS_TOPU), (float*)(ws + WS_BOT), (LAS float*)(F.lds + XCH_OFF)};
        pg8::gemm_phase<pg8::EpiGU2, pg8::StaticOrder, true, PG8_SP2>(F.lds + RING_OFF, g, S, E);
        }
        __syncthreads(); convert_queue<2>(F, args);
        GRID_BAR();
    }
#endif
    if (IN(9)) { p9_fix(F, args); GRID_BAR(); }
    if (IN(10)) {
        pg8::Gemm g{(const pb*)(ws + WS_U), (const pb*)(ws + WS_WFD), cfg::M, 4096, cfg::DFF}; pg8::SplitTailOrder S; S.init(cfg::DFF, (int)blockIdx.x);
        pg8::EpiRes E{Y, Y + (size_t)cfg::TP * 4096, Y, (float*)(ws + WS_SLAB_D)};
        pg8::gemm_phase<pg8::EpiRes, pg8::SplitTailOrder, true, PG8_SP2>(F.lds + RING_OFF, g, S, E);
        GRID_BAR();
    }
#if DUP_PH == 10
    if (IN(10)) {
        pg8::Gemm g{(const pb*)(ws + WS_U), (const pb*)(ws + WS_WFD), cfg::M, 4096, cfg::DFF}; pg8::SplitTailOrder S; S.init(cfg::DFF, (int)blockIdx.x);
        pg8::EpiRes E{Y, Y + (size_t)cfg::TP * 4096, Y, (float*)(ws + WS_SLAB_D)};
        pg8::gemm_phase<pg8::EpiRes, pg8::SplitTailOrder, true, PG8_SP2>(F.lds + RING_OFF, g, S, E);
        GRID_BAR();
    }
#endif
    if (IN(11)) {
        const int gw = F.vcu * NWAVES + F.wave, NGW = F.G * NWAVES;
        sample_rows_norm<float>(F, Y + (size_t)cfg::TP * 4096, (const float*)(ws + WS_SLAB_D), Y + (size_t)cfg::TP * 4096, args.in[28], Y + (size_t)cfg::TP * 4096, (LAS float*)(F.lds + RING_OFF));
        for (int m = gw; m < cfg::TP; m += NGW) rms_row4096<float>(Y + (size_t)m * 4096, args.in[28], Y + (size_t)m * 4096, F.lane);
    }
#ifdef DBG_COPY
    if (lo <= DBG_COPY && DBG_COPY < hi) {
        const size_t gt = (size_t)(F.vcu * NWAVES + F.wave) * 64 + F.lane, NGT = (size_t)F.G * NWAVES * 64;
        const v4u* s0 = (const v4u*)(ws + WS_WQB); v4u* d0 = (v4u*)Y; const size_t n0 = (size_t)(WS_WGU - WS_WQB) / 16;
        for (size_t i = gt; i < n0; i += NGT) d0[i] = s0[i];
        const v4u* s1 = (const v4u*)(ws + WS_WFD); v4u* d1 = d0 + n0; const size_t n1 = (size_t)60000000 / 16;
        for (size_t i = gt; i < n1; i += NGT) d1[i] = s1[i];
    }
#endif
#undef IN
#undef GRID_BAR
}

extern "C" void kernel_launch(void* const* d_in, const int* in_sizes, int n_in, void* d_out, int out_size, void* d_ws, size_t ws_size, hipStream_t stream) {
    static int grid = 0;
    if (grid == 0) {
        if (n_in != 29 || in_sizes[0] != cfg::TP * 4096 || (size_t)out_size != cfg::O_END || ws_size < WS_END) {
            fprintf(stderr, "kernel_launch: shape mismatch: n_in %d in0 %d out %d ws %zu (need %zu); nothing launched\n", n_in, n_in > 0 ? in_sizes[0] : -1, out_size, ws_size, (size_t)WS_END); grid = -1; return; }
        int dev = 0, cus = 0, per_cu = 0;
        if (hipGetDevice(&dev) != hipSuccess || hipDeviceGetAttribute(&cus, hipDeviceAttributeMultiprocessorCount, dev) != hipSuccess) { grid = -1; return; }
        if (hipFuncSetAttribute((const void*)fwd, hipFuncAttributeMaxDynamicSharedMemorySize, LDS_BYTES) != hipSuccess) { fprintf(stderr, "kernel_launch: hipFuncSetAttribute failed\n"); grid = -1; return; }
        if (hipOccupancyMaxActiveBlocksPerMultiprocessor(&per_cu, (const void*)fwd, NWAVES * 64, LDS_BYTES) != hipSuccess || per_cu < 1)
            fprintf(stderr, "kernel_launch: note: occupancy query reports %d workgroups per CU\n", per_cu);
        (void)hipGetLastError();
        if (cus < 256) { fprintf(stderr, "kernel_launch: built for a 256-CU device (got %d); nothing launched\n", cus); grid = -1; return; }
        grid = 256;
    }
    if (grid < 0) return;
    if (hipMemsetAsync((char*)d_ws + WS_CTL, 0, CTL_ZERO_BYTES, stream) != hipSuccess) { fprintf(stderr, "kernel_launch: memset failed\n"); return; }
    Args a{};
    for (int i = 0; i < 29; ++i) a.in[i] = (const float*)d_in[i];
    a.out = (float*)d_out; a.ws = (unsigned char*)d_ws;
    for (int li = 0; li < N_LAUNCHES; ++li) {
        a.ph_lo = (N_LAUNCHES == 1) ? 0 : li; a.ph_hi = (N_LAUNCHES == 1) ? NPH : li + 1;
        hipLaunchKernelGGL(fwd, dim3(grid), dim3(NWAVES * 64), LDS_BYTES, stream, a);
        const hipError_t le = hipPeekAtLastError();
        if (le != hipSuccess) { fprintf(stderr, "kernel_launch: launch %d failed: %s\n", li, hipGetErrorName(le)); break; }
    }
}
```

```cpp
#include <hip/hip_runtime.h>
#include <hip/hip_bf16.h>
#include <cstdio>
#include <cstdint>

#define DUP_PH -1
#ifndef MK_N_LAUNCHES
#define MK_N_LAUNCHES 1
#endif

namespace cfg {
constexpr int DM = 4096, TP = 8192, NB = 8, TS = 64, PAST = 2048;
constexpr int MS = NB * TS;
constexpr int M = TP + MS;
constexpr int NQK = 2048, NVA = 2048, QL = 896, KVL = 512, DR = 64, NG = 8192;
constexpr int NINP = 15872;
constexpr int NRAW = 1536;
constexpr int NQB = 3072, NKVBO = 4096;
constexpr int MKV = TP + NB * (PAST + TS);
constexpr int DFF = 11008;
constexpr float EPS = 1e-6f;
constexpr size_t O_Y = 0, O_DKP = 35651584, O_DVP = 52428800, O_CKVP = 69206016, O_KPEP = 73400320, O_CONVP = 73924608,
                 O_DKS = 73946624, O_DVS = 74995200, O_CKVS = 76043776, O_KPES = 76305920, O_CONVS = 76338688, O_END = 76514816;
}
namespace pg8 {
#define PG8_LAS __attribute__((address_space(3)))
typedef unsigned short bf16_t;
typedef short bf16x8 __attribute__((ext_vector_type(8)));
typedef float f32x4 __attribute__((ext_vector_type(4)));
typedef unsigned u32x4 __attribute__((ext_vector_type(4)));
constexpr int BM = 256, BK = 64, HALF = 128, HTB = HALF * BK * 2  , STAGE_BYTES = 8 * HTB, NXCD = 8, WGM = 8;

__host__ __device__ __forceinline__ int lds_byte(int r, int c) { const int st = (r >> 4) * 2 + (c >> 5), rr = r & 15, cc = c & 31, ob = rr * 64 + cc * 2; return st * 1024 + (ob ^ (((ob >> 9) & 1) << 5)); }
__host__ __device__ __forceinline__ void stage_rc(int b, int& R, int& C) { const int st = b / 1024, sb = b % 1024, swz = sb ^ (((sb >> 9) & 1) << 5); R = (st >> 1) * 16 + swz / 64; C = (st & 1) * 32 + (swz % 64) / 2; }
__host__ __device__ __forceinline__ int perm32(int rho) { const int n = rho >> 4, i = rho & 15; return 8 * (i >> 2) + 4 * n + (i & 3); }

struct Unit { int pm, pn, kt0, ntk, split, part; };
struct Gemm { const bf16_t* A; const bf16_t* Bt; int M, N, K; };

struct StaticOrder {
    int nM, nN, nwg, G, c;
    __host__ __device__ void init(int M, int N, int G_, int c_) { nM = M / BM; nN = N / BM; nwg = nM * nN; G = G_; c = c_; }
    __host__ __device__ bool next(int i, Unit& u) const {
        const long L = (long)i * G + c; if (L >= nwg) return false;
        int wgid = (int)L; { const int q = nwg / NXCD, r = nwg % NXCD, xcd = wgid % NXCD, off = wgid / NXCD; wgid = (xcd < r ? xcd * (q + 1) : r * (q + 1) + (xcd - r) * q) + off; }
        const int nig = WGM * nN, gid = wgid / nig, fm = gid * WGM, gsz = (nM - fm) < WGM ? (nM - fm) : WGM;
        u.pm = fm + ((wgid % nig) % gsz); u.pn = (wgid % nig) / gsz; u.kt0 = 0; u.ntk = 0; u.split = 0; u.part = 0; return true;
    }
    __device__ __forceinline__ void a_ready(const Unit&) const {}
    __device__ __forceinline__ void done(const Unit&) const {}
};

struct SplitTailOrder {
    StaticOrder so; int nt, c;
    __host__ __device__ void init(int K, int c_) { so.init(8192, 4096, 256, c_); nt = K / BK; c = c_; }
    __host__ __device__ bool next(int i, Unit& u) const {
        if (i < 2) return so.next(i, u);
        if (i > 2) return false;
        const int tt = c >> 3, s = c & 7, q = nt >> 1, qb = q >> 3, qr = q & 7;
        u.pm = 32 + (tt & 1); u.pn = tt >> 1; u.kt0 = 2 * (s * qb + (s < qr ? s : qr)); u.ntk = 2 * (qb + (s < qr ? 1 : 0)); u.split = s + 1; u.part = 0; return true;
    }
    __device__ __forceinline__ void a_ready(const Unit&) const {}
    __device__ __forceinline__ void done(const Unit&) const {}
};
struct SplitTailOrder2 {
    StaticOrder so; int nt, c;
    __host__ __device__ void init(int K, int c_) { so.init(8192, 4096, 256, c_); nt = K / BK; c = c_; }
    __host__ __device__ bool next(int i, Unit& u) const {
        if (i < 4) { if (!so.next(i >> 1, u)) return false; u.ntk = nt >> 1; u.kt0 = (i & 1) * (nt >> 1); u.part = 1 + (i & 1); return true; }
        if (i > 4) return false;
        const int tt = c >> 3, s = c & 7, q = nt >> 1, qb = q >> 3, qr = q & 7;
        u.pm = 32 + (tt & 1); u.pn = tt >> 1; u.kt0 = 2 * (s * qb + (s < qr ? s : qr)); u.ntk = 2 * (qb + (s < qr ? 1 : 0)); u.split = s + 1; u.part = 0; return true;
    }
    __device__ __forceinline__ void a_ready(const Unit&) const {}
    __device__ __forceinline__ void done(const Unit&) const {}
};
typedef float f32x2c_t __attribute__((ext_vector_type(2))); typedef __bf16 bf16x2c_t __attribute__((ext_vector_type(2)));
__device__ __forceinline__ unsigned cvt_pk_bf16(float lo, float hi) { f32x2c_t v = {lo, hi}; bf16x2c_t b = __builtin_convertvector(v, bf16x2c_t); return __builtin_bit_cast(unsigned, b); }
typedef float f32x2 __attribute__((ext_vector_type(2)));
__device__ __forceinline__ u32x4 pack8(const f32x4 v0, const f32x4 v1) { u32x4 w; w.x = cvt_pk_bf16(v0[0], v0[1]); w.y = cvt_pk_bf16(v0[2], v0[3]); w.z = cvt_pk_bf16(v1[0], v1[1]); w.w = cvt_pk_bf16(v1[2], v1[3]); return w; }
__device__ __forceinline__ void unpack8(const u32x4 w, f32x4& a, f32x4& b) {
    a[0] = __uint_as_float(w.x << 16); a[1] = __uint_as_float(w.x & 0xffff0000u); a[2] = __uint_as_float(w.y << 16); a[3] = __uint_as_float(w.y & 0xffff0000u);
    b[0] = __uint_as_float(w.z << 16); b[1] = __uint_as_float(w.z & 0xffff0000u); b[2] = __uint_as_float(w.w << 16); b[3] = __uint_as_float(w.w & 0xffff0000u); }
__device__ __forceinline__ float sigmoidf_(float x) { return __builtin_amdgcn_rcpf(1.0f + __expf(-x)); }

struct EpiPlain {
    static constexpr bool PERM = true, AFTER_DRAIN = false;
    bf16_t* O; int ldc;
    __device__ __forceinline__ void operator()(const f32x4 (&acc)[2][2][4][2], const Unit& u, int wr, int wc, int fr, int fq) const {
        const int row0 = u.pm * BM + wr * 64 + fr, col0 = u.pn * BM + wc * 32 + 8 * fq;
#pragma unroll
        for (int ai = 0; ai < 2; ++ai)
#pragma unroll
            for (int m = 0; m < 4; ++m) { bf16_t* rowp = O + (size_t)(row0 + ai * HALF + m * 16) * ldc + col0;
#pragma unroll
                for (int bj = 0; bj < 2; ++bj) *(u32x4*)(rowp + bj * HALF) = pack8(acc[ai][bj][m][0], acc[ai][bj][m][1]); }
    }
};

constexpr float QSCALE_A = 0.125f * 1.4426950408889634f;
struct EpiIn {
    static constexpr bool PERM = true, AFTER_DRAIN = false;
    bf16_t* QA; bf16_t* KA; bf16_t* VA; bf16_t* G; float* RAW; float* out; const float* b_gate; const float* tabA;
    __device__ __forceinline__ void operator()(const f32x4 (&acc)[2][2][4][2], const Unit& u, int wr, int wc, int fr, int fq) const {
        const int pn = u.pn; const bool smp = u.pm >= 32;
        const int row0 = u.pm * BM + wr * 64 + fr, cw = wc * 32 + 8 * fq;
        if (pn < 16) {
            const bool isk = pn >= 8; bf16_t* dst = isk ? KA : QA; const int cb = (pn & 7) * BM + cw;
            float* fo = out + (smp ? (cfg::O_DKS - (size_t)cfg::TP * 2048) : cfg::O_DKP);
            const bool ropew = (wc & 1) == 0;
#pragma unroll
            for (int ah = 0; ah < 4; ++ah) {
                const int ai = ah >> 1, mh = ah & 1;
                f32x4 tq[2][4];
                if (ropew) {
#pragma unroll
                    for (int mm = 0; mm < 2; ++mm) { const int row = row0 + ai * HALF + (mh * 2 + mm) * 16; const int pos = smp ? 2048 + (row & 63) : row; const f32x4* tp = (const f32x4*)(tabA + (size_t)pos * 16);
                        tq[mm][0] = tp[0]; tq[mm][1] = tp[1]; tq[mm][2] = tp[2]; tq[mm][3] = tp[3]; } }
#pragma unroll
                for (int mm = 0; mm < 2; ++mm) {
                    const int m = mh * 2 + mm; const int row = row0 + ai * HALF + m * 16;
                    f32x4 t0 = {1.f, 0.f, 1.f, 0.f}, t1 = t0, t2 = t0, t3 = t0;
                    if (ropew) { t0 = tq[mm][0]; t1 = tq[mm][1]; t2 = tq[mm][2]; t3 = tq[mm][3]; }
#pragma unroll
                    for (int bj = 0; bj < 2; ++bj) {
                        f32x4 v0 = acc[ai][bj][m][0], v1 = acc[ai][bj][m][1];
                        if (ropew) {
                            f32x4 p0, p1;
#pragma unroll
                            for (int e = 0; e < 4; ++e) { p0[e] = __shfl_xor(v0[e], 16); p1[e] = __shfl_xor(v1[e], 16); }
                            const float sg = (fq == 0) ? -1.f : 1.f;
                            if (fq < 2) {
                                v0[0] = v0[0] * t0[0] + sg * p0[0] * t0[1]; v0[1] = v0[1] * t0[2] + sg * p0[1] * t0[3];
                                v0[2] = v0[2] * t1[0] + sg * p0[2] * t1[1]; v0[3] = v0[3] * t1[2] + sg * p0[3] * t1[3];
                                v1[0] = v1[0] * t2[0] + sg * p1[0] * t2[1]; v1[1] = v1[1] * t2[2] + sg * p1[1] * t2[3];
                                v1[2] = v1[2] * t3[0] + sg * p1[2] * t3[1]; v1[3] = v1[3] * t3[2] + sg * p1[3] * t3[3];
                            }
                        }
                        const size_t off = (size_t)row * 2048 + cb + bj * HALF;
                        if (isk) { *(u32x4*)(dst + off) = pack8(v0, v1); *(f32x4*)(fo + off) = v0; *(f32x4*)(fo + off + 4) = v1; }
                        else *(u32x4*)(dst + off) = pack8(v0 * QSCALE_A, v1 * QSCALE_A);
                    }
                }
            }
        } else if (pn < 24) {
            const int cb = (pn - 16) * BM + cw; float* fo = out + (smp ? (cfg::O_DVS - (size_t)cfg::TP * 2048) : cfg::O_DVP);
#pragma unroll
            for (int ai = 0; ai < 2; ++ai)
#pragma unroll
                for (int m = 0; m < 4; ++m) { const int row = row0 + ai * HALF + m * 16;
#pragma unroll
                    for (int bj = 0; bj < 2; ++bj) { const size_t off = (size_t)row * 2048 + cb + bj * HALF; const f32x4 v0 = acc[ai][bj][m][0], v1 = acc[ai][bj][m][1];
                        *(u32x4*)(VA + off) = pack8(v0, v1); *(f32x4*)(fo + off) = v0; *(f32x4*)(fo + off + 4) = v1; } }
        } else if (pn < 56) {
            const int cb = (pn - 24) * BM + cw;
            f32x4 bv[2][2];
#pragma unroll
            for (int bj = 0; bj < 2; ++bj) { bv[bj][0] = *(const f32x4*)(b_gate + cb + bj * HALF); bv[bj][1] = *(const f32x4*)(b_gate + cb + bj * HALF + 4); }
#pragma unroll
            for (int ai = 0; ai < 2; ++ai)
#pragma unroll
                for (int m = 0; m < 4; ++m) { const int row = row0 + ai * HALF + m * 16;
#pragma unroll
                    for (int bj = 0; bj < 2; ++bj) { f32x4 v0 = acc[ai][bj][m][0] + bv[bj][0], v1 = acc[ai][bj][m][1] + bv[bj][1];
#pragma unroll
                        for (int e = 0; e < 4; ++e) { v0[e] = sigmoidf_(v0[e]); v1[e] = sigmoidf_(v1[e]); }
                        *(u32x4*)(G + (size_t)row * 8192 + cb + bj * HALF) = pack8(v0, v1); } }
        } else {
            const int cb = (pn - 56) * BM + cw;
#pragma unroll
            for (int ai = 0; ai < 2; ++ai)
#pragma unroll
                for (int m = 0; m < 4; ++m) { const int row = row0 + ai * HALF + m * 16;
#pragma unroll
                    for (int bj = 0; bj < 2; ++bj) { float* p = RAW + (size_t)row * cfg::NRAW + cb + bj * HALF; *(f32x4*)p = acc[ai][bj][m][0]; *(f32x4*)(p + 4) = acc[ai][bj][m][1]; } }
        }
    }
};

struct EpiQB {
    static constexpr bool PERM = true, AFTER_DRAIN = false;
    bf16_t* QB; const float* tabB;
    __device__ __forceinline__ void operator()(const f32x4 (&acc)[2][2][4][2], const Unit& u, int wr, int wc, int fr, int fq) const {
        const bool smp = u.pm >= 32; const int row0 = u.pm * BM + wr * 64 + fr, col0 = u.pn * BM + wc * 32 + 8 * fq;
#pragma unroll
        for (int bj = 0; bj < 2; ++bj) {
            const int g6 = (u.pn * 8 + bj * 4 + wc) % 6; const bool pe = g6 >= 4; const int i0 = 16 * (g6 - 4) + 4 * fq;
#pragma unroll
            for (int ai = 0; ai < 2; ++ai)
#pragma unroll
                for (int m = 0; m < 4; ++m) { const int row = row0 + ai * HALF + m * 16; const int pos = smp ? 2048 + (row & 63) : row;
                    f32x4 v0 = acc[ai][bj][m][0], v1 = acc[ai][bj][m][1];
                    if (pe) { const f32x4* tp = (const f32x4*)(tabB + ((size_t)pos * 32 + i0) * 2); const f32x4 ta = tp[0], tb = tp[1];
                        f32x4 w0, w1;
                        w0[0] = v0[0] * ta[0] - v0[1] * ta[1]; w0[1] = v0[1] * ta[0] + v0[0] * ta[1];
                        w0[2] = v0[2] * ta[2] - v0[3] * ta[3]; w0[3] = v0[3] * ta[2] + v0[2] * ta[3];
                        w1[0] = v1[0] * tb[0] - v1[1] * tb[1]; w1[1] = v1[1] * tb[0] + v1[0] * tb[1];
                        w1[2] = v1[2] * tb[2] - v1[3] * tb[3]; w1[3] = v1[3] * tb[2] + v1[2] * tb[3];
                        v0 = w0; v1 = w1; }
                    *(u32x4*)(QB + (size_t)row * cfg::NQB + col0 + bj * HALF) = pack8(v0, v1); }
        }
    }
};

__device__ __forceinline__ void slab_store(float* slab, const f32x4 (&acc)[2][2][4][2], const Unit& u, int wr, int wc, int fr, int fq) {
    const int row0 = (u.pm - 32) * BM + wr * 64 + fr, col0 = u.pn * BM + wc * 32 + 8 * fq; float* sb = slab + (size_t)(u.split - 1) * 512 * 4096;
#pragma unroll
    for (int ai = 0; ai < 2; ++ai)
#pragma unroll
        for (int m = 0; m < 4; ++m)
#pragma unroll
            for (int bj = 0; bj < 2; ++bj) { float* p = sb + (size_t)(row0 + ai * HALF + m * 16) * 4096 + col0 + bj * HALF; *(f32x4*)p = acc[ai][bj][m][0]; *(f32x4*)(p + 4) = acc[ai][bj][m][1]; }
}
struct EpiY {
    static constexpr bool PERM = true, AFTER_DRAIN = false;
    const bf16_t* G; bf16_t* MB; float* slab;
    __device__ __forceinline__ void operator()(f32x4 (&acc)[2][2][4][2], const Unit& u, int wr, int wc, int fr, int fq) const {
        if (u.split) { slab_store(slab, acc, u, wr, wc, fr, fq); return; }
        const int row0 = u.pm * BM + wr * 64 + fr, col0 = u.pn * BM + wc * 32 + 8 * fq;
#pragma unroll
        for (int ai = 0; ai < 2; ++ai)
#pragma unroll
            for (int mh = 0; mh < 2; ++mh) {
                u32x4 g0q[2][2], g1q[2][2];
#pragma unroll
                for (int mm = 0; mm < 2; ++mm)
#pragma unroll
                    for (int bj = 0; bj < 2; ++bj) { const bf16_t* gp = G + (size_t)(row0 + ai * HALF + (mh * 2 + mm) * 16) * 8192 + col0 + bj * HALF;
                        g1q[mm][bj] = *(const u32x4*)(gp + 4096); if (u.part == 1) g0q[mm][bj] = *(const u32x4*)gp; }
#pragma unroll
                for (int mm = 0; mm < 2; ++mm)
#pragma unroll
                    for (int bj = 0; bj < 2; ++bj) { const int m = mh * 2 + mm; f32x4 a1, b1; unpack8(g1q[mm][bj], a1, b1);
                        if (u.part == 1) { f32x4 a0, b0; unpack8(g0q[mm][bj], a0, b0);
#pragma unroll
                            for (int e = 0; e < 4; ++e) { acc[ai][bj][m][0][e] *= a0[e] * __builtin_amdgcn_rcpf(fmaxf(a1[e], 1e-30f)); acc[ai][bj][m][1][e] *= b0[e] * __builtin_amdgcn_rcpf(fmaxf(b1[e], 1e-30f)); } }
                        else { const int row = row0 + ai * HALF + m * 16, col = col0 + bj * HALF;
                            *(u32x4*)(MB + (size_t)row * 4096 + col) = pack8(acc[ai][bj][m][0] * a1, acc[ai][bj][m][1] * b1); } }
            }
    }
};
struct EpiRes {
    static constexpr bool PERM = true, AFTER_DRAIN = false;
    const float* base_p; const float* base_s; float* out; float* slab;
    __device__ __forceinline__ void operator()(const f32x4 (&acc)[2][2][4][2], const Unit& u, int wr, int wc, int fr, int fq) const {
        if (u.split) { slab_store(slab, acc, u, wr, wc, fr, fq); return; }
        const int row0 = u.pm * BM + wr * 64 + fr, col0 = u.pn * BM + wc * 32 + 8 * fq; const bool smp = u.pm >= 32;
        const float* bs = smp ? base_s - (size_t)cfg::TP * 4096 : base_p;
#pragma unroll
        for (int ai = 0; ai < 2; ++ai)
#pragma unroll
            for (int mh = 0; mh < 2; ++mh) {
                f32x4 bq[2][2][2];
#pragma unroll
                for (int mm = 0; mm < 2; ++mm)
#pragma unroll
                    for (int bj = 0; bj < 2; ++bj) { const size_t off = (size_t)(row0 + ai * HALF + (mh * 2 + mm) * 16) * 4096 + col0 + bj * HALF;
                        bq[mm][bj][0] = *(const f32x4*)(bs + off); bq[mm][bj][1] = *(const f32x4*)(bs + off + 4); }
#pragma unroll
                for (int mm = 0; mm < 2; ++mm)
#pragma unroll
                    for (int bj = 0; bj < 2; ++bj) { const int m = mh * 2 + mm; const size_t off = (size_t)(row0 + ai * HALF + m * 16) * 4096 + col0 + bj * HALF;
                        *(f32x4*)(out + off) = bq[mm][bj][0] + acc[ai][bj][m][0]; *(f32x4*)(out + off + 4) = bq[mm][bj][1] + acc[ai][bj][m][1]; }
            }
    }
};
__device__ __forceinline__ float dpp_ror1(float x) { return __int_as_float(__builtin_amdgcn_update_dpp(0, __float_as_int(x), 0x121, 0xf, 0xf, false)); }
__device__ __forceinline__ float dpp_ror2(float x) { return __int_as_float(__builtin_amdgcn_update_dpp(0, __float_as_int(x), 0x122, 0xf, 0xf, false)); }
struct EpiGU2 {
    static constexpr bool PERM = true, AFTER_DRAIN = false;
    bf16_t* ACT; float* out; const float* wconv; const float* bconv; const float* stc; float* topug; float* topu; float* bot; PG8_LAS float* xch;
    __device__ __forceinline__ void operator()(const f32x4 (&acc)[2][2][4][2], const Unit& u, int wr, int wc, int fr, int fq) const {
        const int pm = u.pm, chl = wc * 32 + 8 * fq, ch0 = u.pn * HALF + chl; const bool smp = pm >= 32;
        const int row0 = pm * BM + wr * 64 + fr;
        if (fr >= 14) {
#pragma unroll
            for (int ai = 0; ai < 2; ++ai)
#pragma unroll
                for (int n = 0; n < 2; ++n) *(PG8_LAS f32x4*)(xch + ((ai * 2 + wr) * 2 + (fr - 14)) * 128 + chl + 4 * n) = acc[ai][0][3][n];
        }
        f32x4 w0[2], w1[2], w2[2], bb[2];
#pragma unroll
        for (int n = 0; n < 2; ++n) { w0[n] = *(const f32x4*)(wconv + ch0 + 4 * n); w1[n] = *(const f32x4*)(wconv + cfg::DFF + ch0 + 4 * n); w2[n] = *(const f32x4*)(wconv + 2 * cfg::DFF + ch0 + 4 * n); bb[n] = *(const f32x4*)(bconv + ch0 + 4 * n); }
        asm volatile("s_waitcnt lgkmcnt(0)" ::: "memory"); __builtin_amdgcn_s_barrier(); asm volatile("" ::: "memory");
#pragma unroll
        for (int ai = 0; ai < 2; ++ai) {
            f32x4 H1[2], H2[2];
            if (smp) { const int b = (pm - 32) * 4 + ai * 2 + wr;
#pragma unroll
                for (int n = 0; n < 2; ++n) { H2[n] = *(const f32x4*)(stc + (size_t)(b * 2 + 0) * cfg::DFF + ch0 + 4 * n); H1[n] = *(const f32x4*)(stc + (size_t)(b * 2 + 1) * cfg::DFF + ch0 + 4 * n); } }
            else if (ai == 0 && wr == 0) {
#pragma unroll
                for (int n = 0; n < 2; ++n) { H1[n] = (f32x4){0.f, 0.f, 0.f, 0.f}; H2[n] = H1[n]; } }
            else { const int sa = wr ? ai : ai - 1, sw = wr ? 0 : 1;
#pragma unroll
                for (int n = 0; n < 2; ++n) { H2[n] = *(const PG8_LAS f32x4*)(xch + ((sa * 2 + sw) * 2 + 0) * 128 + chl + 4 * n); H1[n] = *(const PG8_LAS f32x4*)(xch + ((sa * 2 + sw) * 2 + 1) * 128 + chl + 4 * n); } }
            if (!smp && ai == 0 && wr == 0 && pm >= 1 && fr < 2) {
#pragma unroll
                for (int n = 0; n < 2; ++n) { *(f32x4*)(topug + (size_t)(pm * 2 + fr) * cfg::DFF + ch0 + 4 * n) = acc[0][0][0][n]; *(f32x4*)(topu + (size_t)(pm * 2 + fr) * cfg::DFF + ch0 + 4 * n) = acc[0][1][0][n]; } }
            if (!smp && ai == 1 && wr == 1 && fr >= 14) {
#pragma unroll
                for (int n = 0; n < 2; ++n) *(f32x4*)(bot + (size_t)(pm * 2 + (fr - 14)) * cfg::DFF + ch0 + 4 * n) = acc[1][0][3][n]; }
#pragma unroll
            for (int m = 0; m < 4; ++m) { const int row = row0 + ai * HALF + m * 16;
                f32x4 a[2];
#pragma unroll
                for (int n = 0; n < 2; ++n)
#pragma unroll
                    for (int e = 0; e < 4; ++e) { const float x = acc[ai][0][m][n][e];
                        const float r1 = dpp_ror1(x), r2 = dpp_ror2(x);
                        float q1, q2;
                        if (m > 0) { q1 = dpp_ror1(acc[ai][0][m > 0 ? m - 1 : 0][n][e]); q2 = dpp_ror2(acc[ai][0][m > 0 ? m - 1 : 0][n][e]); }
                        else { q1 = H1[n][e]; q2 = (fr == 1) ? H1[n][e] : H2[n][e]; }
                        const float p1 = fr >= 1 ? r1 : q1, p2 = fr >= 2 ? r2 : q2;
                        const float c = bb[n][e] + w0[n][e] * p2 + w1[n][e] * p1 + w2[n][e] * x;
                        a[n][e] = c * __builtin_amdgcn_rcpf(1.f + __expf(-c)) * acc[ai][1][m][n][e]; }
                *(u32x4*)(ACT + (size_t)row * cfg::DFF + ch0) = pack8(a[0], a[1]);
                if ((row & 63) >= 62 && row >= cfg::TP - 2) {
                    float* p = (row < cfg::TP) ? out + cfg::O_CONVP + (size_t)(row - (cfg::TP - 2)) * cfg::DFF + ch0
                                               : out + cfg::O_CONVS + (size_t)(((row - cfg::TP) >> 6) * 2 + ((row & 63) - 62)) * cfg::DFF + ch0;
                    *(f32x4*)p = acc[ai][0][m][0]; *(f32x4*)(p + 4) = acc[ai][0][m][1]; } }
        }
        asm volatile("s_waitcnt lgkmcnt(0)" ::: "memory"); __builtin_amdgcn_s_barrier(); asm volatile("" ::: "memory");
    }
};
template <class Epi, class Sched, bool ALIGN_EPI = false, bool SP2 = false>
__device__ __forceinline__ void gemm_phase(PG8_LAS unsigned char* lds, const Gemm g, const Sched& S, const Epi& E) {
    const int tid = threadIdx.x, wid = __builtin_amdgcn_readfirstlane(tid >> 6), lane = tid & 63, wr = wid >> 2, wc = wid & 3, fr = lane & 15, fq = lane >> 4;
    const int K = g.K, nt = K / BK;
    unsigned voffA[2], voffB[2];
#pragma unroll
    for (int i = 0; i < 2; ++i) { int R, C; stage_rc(tid * 16 + i * 8192, R, C); const int Rb = Epi::PERM ? ((R & ~31) + perm32(R & 31)) : R;
        voffA[i] = (unsigned)(R * K + C) * 2u; voffB[i] = (unsigned)(Rb * K + C) * 2u; }
    const size_t kstep = (size_t)(BK * 2);
    const size_t hstep = (size_t)HALF * K * 2;
    const size_t tstep = 2 * hstep;
    const unsigned ldsw = (unsigned)wid * 1024u;
    const int aoff = lds_byte(wr * 64 + fr, fq * 8), boff = lds_byte(wc * 32 + fr, fq * 8);
#define PG8_SA(b, h) (((b) * 2 + (h)) * HTB)
#define PG8_SB(b, h) ((4 + (b) * 2 + (h)) * HTB)
#define PG8_STAGE(bufoff, gbase, voff) do { _Pragma("unroll") for (int _i = 0; _i < 2; ++_i) \
        __builtin_amdgcn_global_load_lds((const unsigned*)((const char*)(gbase) + (voff)[_i]), (PG8_LAS unsigned*)(lds + (bufoff) + ldsw + _i * 8192), 16, 0, 0); } while (0)
#define PG8_LDA(dst, b, h) do { _Pragma("unroll") for (int m = 0; m < 4; ++m) _Pragma("unroll") for (int k = 0; k < 2; ++k) dst[m][k] = *(const PG8_LAS bf16x8*)(lds + PG8_SA(b, h) + aoff + m * 2048 + k * 1024); } while (0)
#define PG8_LDB(dst, b, h) do { _Pragma("unroll") for (int n = 0; n < 2; ++n) _Pragma("unroll") for (int k = 0; k < 2; ++k) dst[n][k] = *(const PG8_LAS bf16x8*)(lds + PG8_SB(b, h) + boff + n * 2048 + k * 1024); } while (0)
#define PG8_MMA(ai, bj, At, Bt) do { __builtin_amdgcn_s_setprio(1); _Pragma("unroll") for (int m = 0; m < 4; ++m) _Pragma("unroll") for (int n = 0; n < 2; ++n) _Pragma("unroll") for (int k = 0; k < 2; ++k) \
        acc[ai][bj][m][n] = __builtin_amdgcn_mfma_f32_16x16x32_bf16(Bt[n][k], At[m][k], acc[ai][bj][m][n], 0, 0, 0); __builtin_amdgcn_s_setprio(0); } while (0)
#define PG8_WAIT_V(n) asm volatile("s_waitcnt vmcnt(" #n ")" ::: "memory")
#define PG8_WAIT_L(n) asm volatile("s_waitcnt lgkmcnt(" #n ")" ::: "memory")
#define PG8_BAR __builtin_amdgcn_s_barrier()
#define PG8_SCHED __builtin_amdgcn_sched_barrier(0)
    Unit cur, nxt; int ui = 0;
    if (!S.next(0, cur)) return;
    f32x4 acc[2][2][4][2];
#pragma unroll
    for (int a = 0; a < 2; ++a)
#pragma unroll
        for (int b = 0; b < 2; ++b)
#pragma unroll
            for (int m = 0; m < 4; ++m)
#pragma unroll
                for (int n = 0; n < 2; ++n) acc[a][b][m][n] = (f32x4){0.f, 0.f, 0.f, 0.f};
    bf16x8 At[4][2], B0[2][2], B1[2][2];
    const char* cA = (const char*)g.A + (size_t)cur.pm * tstep + (size_t)cur.kt0 * kstep; const char* cB = (const char*)g.Bt + (size_t)cur.pn * tstep + (size_t)cur.kt0 * kstep;
    S.a_ready(cur);
    if constexpr (SP2) {
        PG8_STAGE(PG8_SB(0, 0), cB, voffB); PG8_STAGE(PG8_SB(0, 1), cB + hstep, voffB); PG8_STAGE(PG8_SA(0, 0), cA, voffA); PG8_STAGE(PG8_SA(0, 1), cA + hstep, voffA);
        if (wr == 1) PG8_BAR;
        PG8_WAIT_V(2); PG8_BAR;
        PG8_STAGE(PG8_SB(1, 0), cB + kstep, voffB); PG8_STAGE(PG8_SA(1, 0), cA + kstep, voffA); PG8_STAGE(PG8_SB(1, 1), cB + hstep + kstep, voffB);
        PG8_WAIT_V(6); PG8_BAR;
    } else {
        PG8_STAGE(PG8_SB(0, 0), cB, voffB); PG8_STAGE(PG8_SA(0, 0), cA, voffA); PG8_STAGE(PG8_SB(0, 1), cB + hstep, voffB); PG8_STAGE(PG8_SA(0, 1), cA + hstep, voffA);
        if (wr == 1) PG8_BAR;
        PG8_WAIT_V(4); PG8_BAR;
        PG8_STAGE(PG8_SB(1, 0), cB + kstep, voffB); PG8_STAGE(PG8_SA(1, 0), cA + kstep, voffA); PG8_STAGE(PG8_SB(1, 1), cB + hstep + kstep, voffB);
        PG8_WAIT_V(6); PG8_BAR;
    }
    for (;;) {
        const bool has_next = S.next(ui + 1, nxt);
        const char* nA = has_next ? (const char*)g.A + (size_t)nxt.pm * tstep + (size_t)nxt.kt0 * kstep : cA; const char* nB = has_next ? (const char*)g.Bt + (size_t)nxt.pn * tstep + (size_t)nxt.kt0 * kstep : cB;
        const int ntu = cur.ntk ? cur.ntk : nt;
        for (int t = 0; t < ntu; t += 2) {
            const bool last = (t == ntu - 2);
            const char* a1 = cA + (size_t)(t + 1) * kstep;
            const char* a2 = last ? nA : cA + (size_t)(t + 2) * kstep; const char* b2 = last ? nB : cB + (size_t)(t + 2) * kstep;
            const char* a3 = a2 + kstep; const char* b3 = b2 + kstep;
            if (last && has_next) S.a_ready(nxt);
            if constexpr (SP2) {
            PG8_LDB(B0, 0, 0); PG8_LDB(B1, 0, 1); PG8_SCHED; PG8_LDA(At, 0, 0); PG8_STAGE(PG8_SA(1, 1), a1 + hstep, voffA);
            PG8_WAIT_V(8); PG8_WAIT_L(0); PG8_BAR; PG8_MMA(0, 0, At, B0); PG8_MMA(0, 1, At, B1); PG8_BAR; PG8_SCHED;
            PG8_LDA(At, 0, 1); PG8_STAGE(PG8_SB(0, 0), b2, voffB); PG8_STAGE(PG8_SB(0, 1), b2 + hstep, voffB); PG8_STAGE(PG8_SA(0, 0), a2, voffA);
            PG8_WAIT_V(8); PG8_WAIT_L(0); PG8_BAR; PG8_MMA(1, 0, At, B0); PG8_MMA(1, 1, At, B1); PG8_BAR; PG8_SCHED;
            PG8_LDB(B0, 1, 0); PG8_LDB(B1, 1, 1); PG8_SCHED; PG8_LDA(At, 1, 0); PG8_STAGE(PG8_SA(0, 1), a2 + hstep, voffA);
            PG8_WAIT_V(8); PG8_WAIT_L(0); PG8_BAR; PG8_MMA(0, 0, At, B0); PG8_MMA(0, 1, At, B1); PG8_BAR; PG8_SCHED;
            PG8_LDA(At, 1, 1); PG8_STAGE(PG8_SB(1, 0), b3, voffB); PG8_STAGE(PG8_SB(1, 1), b3 + hstep, voffB); PG8_STAGE(PG8_SA(1, 0), a3, voffA);
            PG8_WAIT_V(8); PG8_WAIT_L(0); PG8_BAR; PG8_MMA(1, 0, At, B0); PG8_MMA(1, 1, At, B1); PG8_BAR; PG8_SCHED;
            } else {
            PG8_LDB(B0, 0, 0); PG8_SCHED; PG8_LDA(At, 0, 0); PG8_STAGE(PG8_SA(1, 1), a1 + hstep, voffA);
            PG8_WAIT_L(8); PG8_BAR; PG8_WAIT_L(0); PG8_MMA(0, 0, At, B0); PG8_BAR; PG8_SCHED;
            PG8_LDB(B1, 0, 1); PG8_STAGE(PG8_SB(0, 0), b2, voffB);
            PG8_BAR; PG8_WAIT_L(0); PG8_MMA(0, 1, At, B1); PG8_BAR;
            PG8_LDA(At, 0, 1); PG8_STAGE(PG8_SA(0, 0), a2, voffA);
            PG8_BAR; PG8_WAIT_L(0); PG8_MMA(1, 0, At, B0); PG8_BAR; PG8_SCHED;
            PG8_STAGE(PG8_SB(0, 1), b2 + hstep, voffB);
            PG8_WAIT_V(6); PG8_BAR; PG8_MMA(1, 1, At, B1); PG8_BAR;
            PG8_LDB(B0, 1, 0); PG8_SCHED; PG8_LDA(At, 1, 0); PG8_STAGE(PG8_SA(0, 1), a2 + hstep, voffA);
            PG8_WAIT_L(8); PG8_BAR; PG8_WAIT_L(0); PG8_MMA(0, 0, At, B0); PG8_BAR; PG8_SCHED;
            PG8_LDB(B1, 1, 1); PG8_STAGE(PG8_SB(1, 0), b3, voffB);
            PG8_BAR; PG8_WAIT_L(0); PG8_MMA(0, 1, At, B1); PG8_BAR;
            PG8_LDA(At, 1, 1); PG8_STAGE(PG8_SA(1, 0), a3, voffA);
            PG8_BAR; PG8_WAIT_L(0); PG8_MMA(1, 0, At, B0); PG8_BAR; PG8_SCHED;
            PG8_STAGE(PG8_SB(1, 1), b3 + hstep, voffB);
            PG8_WAIT_V(6); PG8_BAR; PG8_MMA(1, 1, At, B1); PG8_BAR;
            }
        }
        if constexpr (ALIGN_EPI) { if (wr == 0) PG8_BAR; }
        if constexpr (!Epi::AFTER_DRAIN) { E(acc, cur, wr, wc, fr, fq); S.done(cur); }
        if (!has_next) break;
        if (cur.part != 1)
#pragma unroll
        for (int a = 0; a < 2; ++a)
#pragma unroll
            for (int b = 0; b < 2; ++b)
#pragma unroll
                for (int m = 0; m < 4; ++m)
#pragma unroll
                    for (int n = 0; n < 2; ++n) acc[a][b][m][n] = (f32x4){0.f, 0.f, 0.f, 0.f};
        cur = nxt; cA = nA; cB = nB; ++ui;
        if constexpr (ALIGN_EPI) { if (wr == 1) PG8_BAR; }
    }
    PG8_WAIT_V(0);
    if constexpr (!ALIGN_EPI) { if (wr == 0) PG8_BAR; }
    PG8_BAR;
    if constexpr (Epi::AFTER_DRAIN) { E.fused(acc, cur, wr, wc, fr, fq, lds, wid, lane); S.done(cur); }
#undef PG8_SA
#undef PG8_SB
#undef PG8_STAGE
#undef PG8_LDA
#undef PG8_LDB
#undef PG8_MMA
#undef PG8_WAIT_V
#undef PG8_WAIT_L
#undef PG8_BAR
#undef PG8_SCHED
}
}
#define GAS __attribute__((address_space(1)))
#define LAS __attribute__((address_space(3)))
typedef unsigned short bf16;
typedef unsigned v4u __attribute__((ext_vector_type(4)));
typedef float f32x4 __attribute__((ext_vector_type(4)));
typedef short bf16x8 __attribute__((ext_vector_type(8)));
typedef GAS unsigned gu32;
typedef GAS unsigned long long gu64;
#define RLX_AGENT __ATOMIC_RELAXED, __HIP_MEMORY_SCOPE_AGENT
#define LDS_WAIT() asm volatile("s_waitcnt lgkmcnt(0)" ::: "memory")
#define VM_WAIT() asm volatile("s_waitcnt vmcnt(0)" ::: "memory")
__device__ __forceinline__ unsigned long long rt() { return __builtin_amdgcn_s_memrealtime(); }
__device__ __forceinline__ unsigned f2bf(float f) { unsigned u = __builtin_bit_cast(unsigned, f); return (u + 0x7fffu + ((u >> 16) & 1u)) >> 16; }
__device__ __forceinline__ unsigned pk2(float lo, float hi) { return f2bf(lo) | (f2bf(hi) << 16); }

#define XB_TMO      128
#define XB_XCNT(j)  (256  + 64 * (j))
#define XB_XSUB(j)  (1280 + 64 * (j))
#define XB_XGEN(j)  (2304 + 64 * (j))
#define XB_TOP      3328
#define XB_TOPGEN   3392
#define XCD_BAR_WORDS 3456
#define XB_SPIN_CAP (1u << 18)

__device__ __forceinline__ unsigned xb_ld(unsigned* p)              { return __hip_atomic_load(p, __ATOMIC_RELAXED, __HIP_MEMORY_SCOPE_AGENT); }
__device__ __forceinline__ unsigned xb_add(unsigned* p, unsigned v) { return __hip_atomic_fetch_add(p, v, __ATOMIC_RELAXED, __HIP_MEMORY_SCOPE_AGENT); }
__device__ __forceinline__ unsigned xb_xcc_id() { return (unsigned)__builtin_amdgcn_s_getreg((3 << 11) | 20) & 0xFu; }
#define XB_SPIN(cond, bar) do { unsigned _sp = 0; while (cond) { __builtin_amdgcn_s_sleep(1); \
    if ((++_sp & 255u) == 0u) { if (xb_ld(&(bar)[XB_TMO])) break; if (_sp > XB_SPIN_CAP) { atomicAdd(&(bar)[XB_TMO], 1u); break; } } } } while (0)

struct XcdBarrier {
    unsigned* bar; unsigned x;
    volatile LAS unsigned* st;
};

__device__ __forceinline__ XcdBarrier xcd_barrier_post(unsigned* bar, volatile LAS unsigned* st) {
    XcdBarrier b; b.bar = bar; b.x = xb_xcc_id(); b.st = st;
    if (threadIdx.x == 0) (void)xb_add(&bar[XB_XCNT(b.x)], 1u);
    return b;
}
__device__ __forceinline__ void xcd_barrier_complete(unsigned* bar, unsigned x, unsigned& nloc, unsigned& nx) {
    const unsigned G = gridDim.x * gridDim.y * gridDim.z;
    unsigned sum, cnt, mine, sp = 0u;
    for (;;) {
        sum = 0u; cnt = 0u; mine = 0u;
#pragma unroll
        for (unsigned j = 0; j < 16; ++j) { const unsigned c = xb_ld(&bar[XB_XCNT(j)]); sum += c; cnt += (c > 0u) ? 1u : 0u; mine = (j == x) ? c : mine; }
        if (sum == G) break;
        __builtin_amdgcn_s_sleep(1);
        if ((++sp & 255u) == 0u) { if (xb_ld(&bar[XB_TMO])) break; if (sp > XB_SPIN_CAP) { atomicAdd(&bar[XB_TMO], 1u); break; } }
    }
    nloc = mine > 0u ? mine : 1u; nx = cnt > 0u ? cnt : 1u;
}

__device__ __forceinline__ void xcd_barrier(const XcdBarrier& b) {
    asm volatile("s_waitcnt vmcnt(0)" ::: "memory");
    __syncthreads();
    if (threadIdx.x == 0) {
        unsigned* bar = b.bar;
        __builtin_amdgcn_s_waitcnt(0);
        unsigned nloc = b.st[0], nx = b.st[1];
        if (nloc == 0u) { xcd_barrier_complete(bar, b.x, nloc, nx); b.st[0] = nloc; b.st[1] = nx; }
        const unsigned old = xb_add(&bar[XB_XSUB(b.x)], 1u);
        const unsigned gen = old / nloc;
        if (old + 1u == (gen + 1u) * nloc) {
            __builtin_amdgcn_fence(__ATOMIC_RELEASE, "agent");
            asm volatile("s_waitcnt vmcnt(0)" ::: "memory");
            const unsigned og = xb_add(&bar[XB_TOP], 1u);
            const unsigned tg = og / nx;
            if (og + 1u == (tg + 1u) * nx) xb_add(&bar[XB_TOPGEN], 1u);
            else XB_SPIN(xb_ld(&bar[XB_TOPGEN]) == tg, bar);
            __builtin_amdgcn_fence(__ATOMIC_ACQUIRE, "agent");
            xb_add(&bar[XB_XGEN(b.x)], 1u);
            asm volatile("s_waitcnt vmcnt(0)" ::: "memory");
        } else {
            XB_SPIN(xb_ld(&bar[XB_XGEN(b.x)]) == gen, bar);
            __builtin_amdgcn_fence(__ATOMIC_ACQUIRE, "agent");
            asm volatile("s_waitcnt vmcnt(0)" ::: "memory");
        }
    }
    __syncthreads();
}
namespace att {
typedef unsigned short bf16_t;
using bf16x8 = __attribute__((ext_vector_type(8))) short;
using s16x4  = __attribute__((ext_vector_type(4))) short;
using f32x16 = __attribute__((ext_vector_type(16))) float;
using f32x8  = __attribute__((ext_vector_type(8))) float;
using u32x4  = __attribute__((ext_vector_type(4))) unsigned;
constexpr int NW = 8, QBLK = 32, KVBLK = 64;
constexpr int SHM_V = KVBLK * 128 * 2;
constexpr int SHM_KMAX = KVBLK * 192 * 2;
constexpr int LDS_V = 0, LDS_K = 2 * SHM_V, LDS_WS = LDS_K + 2 * SHM_KMAX, LDS_BYTES = LDS_WS + NW * 64 * 4;
#define ASBAR() __builtin_amdgcn_sched_barrier(0)
__device__ __forceinline__ int crow(int r, int hi) { return (r & 3) + 8 * (r >> 2) + 4 * hi; }
typedef float f32x2c_t __attribute__((ext_vector_type(2))); typedef __bf16 bf16x2c_t __attribute__((ext_vector_type(2)));
__device__ __forceinline__ unsigned cvtpk(float lo, float hi) { f32x2c_t v = {lo, hi}; bf16x2c_t b = __builtin_convertvector(v, bf16x2c_t); return __builtin_bit_cast(unsigned, b); }
template <typename TIn> struct Stage;
template <> struct Stage<bf16_t> { using T = bf16x8; static constexpr int NLD = 1;
  __device__ static __forceinline__ T ld8(const bf16_t* p) { return *reinterpret_cast<const bf16x8*>(p); }
  __device__ static __forceinline__ bf16x8 tobf(T x) { return x; } };
template <> struct Stage<float> { using T = f32x8; static constexpr int NLD = 2;
  __device__ static __forceinline__ T ld8(const float* p) { return *reinterpret_cast<const f32x8*>(p); }
  __device__ static __forceinline__ bf16x8 tobf(T x) { u32x4 w = {cvtpk(x[0], x[1]), cvtpk(x[2], x[3]), cvtpk(x[4], x[5]), cvtpk(x[6], x[7])}; return *reinterpret_cast<bf16x8*>(&w); } };

template <int NDQ> __device__ __forceinline__ int kswz(int row, int ch) { return row * (32 * NDQ) + ((ch ^ ((row >> 1) & 7)) << 4); }

__device__ __forceinline__ void partialSM(f32x16& p0, f32x16& p1, float& m_reg, float& mn, float& alpha, const float C, const float THRS) {
  float pmax = p0[0];
#pragma unroll
  for (int r = 1; r < 16; ++r) pmax = fmaxf(pmax, p0[r]);
#pragma unroll
  for (int r = 0; r < 16; ++r) pmax = fmaxf(pmax, p1[r]);
  { auto rr = __builtin_amdgcn_permlane32_swap(__float_as_uint(pmax), __float_as_uint(pmax), false, false);
    pmax = fmaxf(__uint_as_float(rr[0]), __uint_as_float(rr[1])); }
  if (__builtin_expect(__all(pmax - m_reg <= THRS), 1)) { mn = m_reg; alpha = 1.f; }
  else { mn = fmaxf(m_reg, pmax); alpha = __builtin_amdgcn_exp2f((m_reg - mn) * C); m_reg = mn; }
  const float mnC = -mn * C;
#pragma unroll
  for (int r = 0; r < 16; ++r) p0[r] = fmaf(p0[r], C, mnC);
#pragma unroll
  for (int r = 0; r < 16; ++r) p1[r] = fmaf(p1[r], C, mnC);
#pragma unroll
  for (int r = 0; r < 16; ++r) p0[r] = __builtin_amdgcn_exp2f(p0[r]);
}
__device__ __forceinline__ void finishSM(f32x16& p0, f32x16& p1, float alpha, float& l_reg, bf16x8& pa0, bf16x8& pa1, bf16x8& pa2, bf16x8& pa3) {
#pragma unroll
  for (int r = 0; r < 16; ++r) p1[r] = __builtin_amdgcn_exp2f(p1[r]);
  float ps = 0;
#pragma unroll
  for (int r = 0; r < 16; ++r) ps += p0[r];
#pragma unroll
  for (int r = 0; r < 16; ++r) ps += p1[r];
  { auto rr = __builtin_amdgcn_permlane32_swap(__float_as_uint(ps), __float_as_uint(ps), false, false);
    ps = __uint_as_float(rr[0]) + __uint_as_float(rr[1]); }
  l_reg = l_reg * alpha + ps;
#define ATT_PK4(P, BASE, OUT) do { unsigned a0 = cvtpk(P[BASE + 0], P[BASE + 1]), a1 = cvtpk(P[BASE + 2], P[BASE + 3]);   \
    unsigned b0 = cvtpk(P[BASE + 4], P[BASE + 5]), b1 = cvtpk(P[BASE + 6], P[BASE + 7]);                              \
    auto r0 = __builtin_amdgcn_permlane32_swap(a0, b0, false, false); auto r1 = __builtin_amdgcn_permlane32_swap(a1, b1, false, false); \
    u32x4 w = {r0[0], r1[0], r0[1], r1[1]}; OUT = *reinterpret_cast<bf16x8*>(&w); } while (0)
  ATT_PK4(p0, 0, pa0); ATT_PK4(p0, 8, pa1); ATT_PK4(p1, 0, pa2); ATT_PK4(p1, 8, pa3);
#undef ATT_PK4
}
__device__ __forceinline__ void partialSM_neg(f32x16& p0, f32x16& p1, float& mhat, f32x16& negm, float& alpha, const bool first, const float THR2) {
  float pmax = p0[0];
#pragma unroll
  for (int r = 1; r < 16; ++r) pmax = fmaxf(pmax, p0[r]);
#pragma unroll
  for (int r = 0; r < 16; ++r) pmax = fmaxf(pmax, p1[r]);
  { auto rr = __builtin_amdgcn_permlane32_swap(__float_as_uint(pmax), __float_as_uint(pmax), false, false);
    pmax = fmaxf(__uint_as_float(rr[0]), __uint_as_float(rr[1])); }
  if (__builtin_expect(!first && __all(pmax <= THR2), 1)) { alpha = 1.f; }
  else { const float d = first ? pmax : fmaxf(pmax, 0.f); mhat += d; alpha = first ? 1.f : __builtin_amdgcn_exp2f(-d);
#pragma unroll
    for (int r = 0; r < 16; ++r) { p0[r] -= d; p1[r] -= d; }
#pragma unroll
    for (int r = 0; r < 16; ++r) negm[r] = -mhat; }
#pragma unroll
  for (int r = 0; r < 16; ++r) p0[r] = __builtin_amdgcn_exp2f(p0[r]);
}
template <int NDQ> __device__ __forceinline__ void qkt(f32x16& p0, f32x16& p1, const char* Ks, const bf16x8 (&qr)[NDQ], int r32, int hi, const f32x16 cin = f32x16{}) {
  p0 = cin; p1 = cin;
  const int f = (r32 >> 1) & 7; int kb[4];
#pragma unroll
  for (int q = 0; q < 4; ++q) kb[q] = r32 * (32 * NDQ) + (((2 * q + hi) ^ f) << 4);
#pragma unroll
  for (int d0 = 0; d0 < NDQ; ++d0) { const char* kp = Ks + kb[d0 & 3] + 128 * (d0 >> 2);
    const bf16x8 b0 = *reinterpret_cast<const bf16x8*>(kp);
    const bf16x8 b1 = *reinterpret_cast<const bf16x8*>(kp + 32 * 32 * NDQ);
    p0 = __builtin_amdgcn_mfma_f32_32x32x16_bf16(b0, qr[d0], p0, 0, 0, 0);
    p1 = __builtin_amdgcn_mfma_f32_32x32x16_bf16(b1, qr[d0], p1, 0, 0, 0); }
}
__device__ __forceinline__ int v_st(int k, int c) { const int kk = (k & ~0xC) | ((k & 4) << 1) | ((k & 8) >> 1); return ((kk >> 3) * 4 + (c >> 5)) * 512 + ((kk & 7) * 32 + (c & 31)) * 2; }
__device__ __forceinline__ int v_rd_base(int lane) { return ((lane & 3) << 3) | (((lane >> 2) & 3) << 6) | (((lane >> 4) & 1) << 5) | (((lane >> 5) & 1) << 8); }
constexpr int v_rd_off(int d0, int ks, int half) { return d0 * 512 + ks * 4096 + half * 2048; }
template <int OFF> __device__ __forceinline__ s16x4 tr_read(int vb) { s16x4 r; asm volatile("ds_read_b64_tr_b16 %0, %1 offset:%2" : "=&v"(r) : "v"(vb), "i"(OFF) : "memory"); return r; }
template <int D0> __device__ __forceinline__ void pv_one(f32x16& od, int vb, bf16x8 pa0, bf16x8 pa1, bf16x8 pa2, bf16x8 pa3) {
  const s16x4 l0 = tr_read<v_rd_off(D0, 0, 0)>(vb), h0 = tr_read<v_rd_off(D0, 0, 1)>(vb), l1 = tr_read<v_rd_off(D0, 1, 0)>(vb), h1 = tr_read<v_rd_off(D0, 1, 1)>(vb);
  const s16x4 l2 = tr_read<v_rd_off(D0, 2, 0)>(vb), h2 = tr_read<v_rd_off(D0, 2, 1)>(vb), l3 = tr_read<v_rd_off(D0, 3, 0)>(vb), h3 = tr_read<v_rd_off(D0, 3, 1)>(vb);
  asm volatile("s_waitcnt lgkmcnt(0)" ::: "memory"); ASBAR();
#define ATT_PK(L, H) (bf16x8){L[0], L[1], L[2], L[3], H[0], H[1], H[2], H[3]}
  od = __builtin_amdgcn_mfma_f32_32x32x16_bf16(pa0, ATT_PK(l0, h0), od, 0, 0, 0);
  od = __builtin_amdgcn_mfma_f32_32x32x16_bf16(pa1, ATT_PK(l1, h1), od, 0, 0, 0);
  od = __builtin_amdgcn_mfma_f32_32x32x16_bf16(pa2, ATT_PK(l2, h2), od, 0, 0, 0);
  od = __builtin_amdgcn_mfma_f32_32x32x16_bf16(pa3, ATT_PK(l3, h3), od, 0, 0, 0);
#undef ATT_PK
}
__device__ __forceinline__ void pv_d0(f32x16 (&o)[4], int vb, bf16x8 pa0, bf16x8 pa1, bf16x8 pa2, bf16x8 pa3) {
  pv_one<0>(o[0], vb, pa0, pa1, pa2, pa3); pv_one<1>(o[1], vb, pa0, pa1, pa2, pa3); pv_one<2>(o[2], vb, pa0, pa1, pa2, pa3); pv_one<3>(o[3], vb, pa0, pa1, pa2, pa3);
}

template <typename TKV> struct Src { const TKV* kp; const TKV* kn; const TKV* k2p; const TKV* k2n; const TKV* vp; const TKV* vn; int npast, nvalid; };

template <int NDQ, typename TKV, int LDK, int LDK2, int LDV>
__device__ __forceinline__ void attn_core(const bf16x8 (&qr)[NDQ], const Src<TKV>& S, const int NT, const int limit, const bool active, const float C, const float THRS,
                                          char* lds, f32x16 (&o)[4], float& l_reg) {
  using St = Stage<TKV>;
  constexpr int SHM_K = KVBLK * 32 * NDQ;
  int tid_ = threadIdx.x; asm volatile("" : "+v"(tid_));
  const int tid = tid_, wid = tid >> 6, lane = tid & 63, r32 = lane & 31, hi = lane >> 5;
  char* V_lds = lds + LDS_V; char* K_lds = lds + LDS_K;
  float* al_l = (float*)(lds + LDS_WS) + wid * 64 + 32;
  float m_reg = -1e30f; l_reg = 0.f;
#pragma unroll
  for (int d = 0; d < 4; ++d) o[d] = f32x16{};
  const int sr = tid >> 4, sc = (tid & 15) * 8;
  const int vr = (sr & ~3) + (tid & 3), vc = ((sr & 3) * 4 + ((tid & 15) >> 2)) * 8, vst0 = v_st(vr, vc), vst1 = v_st(32 + vr, vc);
  const int kr8 = tid >> 3, kc8 = tid & 7;
  const int vb0 = (int)(uintptr_t)V_lds + v_rd_base(lane);
  struct Slot { typename St::T vs0, vs1, ks0, ks1, ks2; } sl[1];
#define ATT_SLOAD(i, j) do { const int jj_ = (j) < S.nvalid ? (j) : S.nvalid - 1; const bool ps_ = jj_ < S.npast; const long r0_ = ps_ ? (long)jj_ * 64 : (long)(jj_ - S.npast) * 64; \
    const TKV* vb_ = ps_ ? S.vp : S.vn; const TKV* kb_ = ps_ ? S.kp : S.kn; \
    sl[i].vs0 = St::ld8(vb_ + (r0_ + vr) * LDV + vc); sl[i].vs1 = St::ld8(vb_ + (r0_ + 32 + vr) * LDV + vc); \
    if constexpr (NDQ == 4) { sl[i].ks0 = St::ld8(kb_ + (r0_ + kr8) * LDK + kc8 * 8); } \
    else { const TKV* k2_ = ps_ ? S.k2p : S.k2n; sl[i].ks0 = St::ld8(kb_ + (r0_ + sr) * LDK + sc); sl[i].ks1 = St::ld8(kb_ + (r0_ + 32 + sr) * LDK + sc); sl[i].ks2 = St::ld8(k2_ + (r0_ + kr8) * LDK2 + kc8 * 8); } } while (0)
#define ATT_SWRITE(b, i) do { *(bf16x8*)(V_lds + (b) * SHM_V + vst0) = St::tobf(sl[i].vs0); *(bf16x8*)(V_lds + (b) * SHM_V + vst1) = St::tobf(sl[i].vs1); \
    if constexpr (NDQ == 4) { *(bf16x8*)(K_lds + (b) * SHM_K + kswz<NDQ>(kr8, kc8)) = St::tobf(sl[i].ks0); } \
    else { *(bf16x8*)(K_lds + (b) * SHM_K + kswz<NDQ>(sr, tid & 15)) = St::tobf(sl[i].ks0); *(bf16x8*)(K_lds + (b) * SHM_K + kswz<NDQ>(32 + sr, tid & 15)) = St::tobf(sl[i].ks1); \
           *(bf16x8*)(K_lds + (b) * SHM_K + kswz<NDQ>(kr8, 16 + kc8)) = St::tobf(sl[i].ks2); } } while (0)
#define ATT_RESC(a) do { if (__any((a) < 1.f)) { if (hi == 0) al_l[r32] = (a); asm volatile("s_waitcnt lgkmcnt(0)" ::: "memory"); \
    _Pragma("unroll") for (int d = 0; d < 4; ++d) _Pragma("unroll") for (int r = 0; r < 16; ++r) o[d][r] *= al_l[crow(r, hi)]; } } while (0)
#define ATT_MASK(P0, P1, j) do { if ((j) > limit) { _Pragma("unroll") for (int r = 0; r < 16; ++r) { P0[r] = -1e30f; P1[r] = -1e30f; } } } while (0)
  f32x16 pA0, pA1; float mnA, alA = 1.f; bf16x8 pa0, pa1, pa2, pa3;
  f32x16 negm = f32x16{}; if constexpr (NDQ == 4) m_reg = 0.f;
  ATT_SLOAD(0, 0); asm volatile("s_waitcnt vmcnt(0)" ::: "memory"); ATT_SWRITE(0, 0); __syncthreads();
#pragma unroll 1
  for (int j = 0; j < NT; ++j) {
    const int cur = j & 1;
    if (j + 1 < NT) ATT_SLOAD(0, j + 1);
    ASBAR();
    if (active && j <= limit) {
      if constexpr (NDQ == 4) { qkt<NDQ>(pA0, pA1, K_lds + cur * SHM_K, qr, r32, hi, negm); partialSM_neg(pA0, pA1, m_reg, negm, alA, j == 0, THRS * C); }
      else { qkt<NDQ>(pA0, pA1, K_lds + cur * SHM_K, qr, r32, hi); partialSM(pA0, pA1, m_reg, mnA, alA, C, THRS); }
      ATT_RESC(alA);
      finishSM(pA0, pA1, alA, l_reg, pa0, pa1, pa2, pa3);
      ASBAR();
      pv_d0(o, vb0 + cur * SHM_V, pa0, pa1, pa2, pa3);
    }
    ASBAR();
    if (j + 1 < NT) ATT_SWRITE(cur ^ 1, 0);
    __syncthreads();
  }
#undef ATT_SLOAD
#undef ATT_SWRITE
#undef ATT_RESC
#undef ATT_MASK
}
__device__ __forceinline__ void normalize(f32x16 (&o)[4], float l_reg, char* lds, int wid, int r32, int hi) {
  float* li_l = (float*)(lds + LDS_WS) + wid * 64;
  if (hi == 0) li_l[r32] = l_reg;
  asm volatile("s_waitcnt lgkmcnt(0)" ::: "memory");
#pragma unroll
  for (int r = 0; r < 16; ++r) { const float rl = __builtin_amdgcn_rcpf(li_l[crow(r, hi)]);
#pragma unroll
    for (int d = 0; d < 4; ++d) o[d][r] *= rl; }
}
__device__ __forceinline__ unsigned short f2bf1(float f) { unsigned u = __builtin_bit_cast(unsigned, f); return (unsigned short)((u + 0x7fffu + ((u >> 16) & 1u)) >> 16); }

constexpr float LOG2E = 1.4426950408889634f;
constexpr float SCALE_A = 0.125f, SCALE_B = 0.07216878364870322f;
constexpr float THR = 8.f;

template <typename TKV>
__device__ __forceinline__ void diff_unit(const bf16_t* QA, long qrow0, int h, const Src<TKV>& S1, const Src<TKV>& S2, int NT, int limit, bool active, float lam,
                                          const float* g_subln, float* stash, bf16_t* OA, char* lds) {
  asm volatile("" : "+s"(h), "+s"(qrow0));
  const int tid = threadIdx.x, wid = tid >> 6, lane = tid & 63, r32 = lane & 31, hi = lane >> 5;
  const long qrow = qrow0 + (active ? wid * QBLK : 0) + r32;
  f32x16 o[4]; float l_reg; float* st = stash + wid * 4096;
  {
    bf16x8 qr[4];
#pragma unroll
    for (int d0 = 0; d0 < 4; ++d0) qr[d0] = *reinterpret_cast<const bf16x8*>(QA + qrow * 2048 + h * 64 + d0 * 16 + hi * 8);
    attn_core<4, TKV, 2048, 64, 2048>(qr, S1, NT, limit, active, SCALE_A * LOG2E, THR / SCALE_A, lds, o, l_reg);
  }
  if (active) { normalize(o, l_reg, lds, wid, r32, hi);
    __attribute__((address_space(1))) float* st1 = (__attribute__((address_space(1))) float*)(st + lane); asm volatile("" : "+v"(st1));
#pragma unroll
    for (int d = 0; d < 4; ++d)
#pragma unroll
      for (int r = 0; r < 16; ++r) st1[(d * 16 + r) * 64] = o[d][r]; }
  {
    bf16x8 qr[4];
#pragma unroll
    for (int d0 = 0; d0 < 4; ++d0) qr[d0] = *reinterpret_cast<const bf16x8*>(QA + qrow * 2048 + (16 + h) * 64 + d0 * 16 + hi * 8);
    attn_core<4, TKV, 2048, 64, 2048>(qr, S2, NT, limit, active, SCALE_A * LOG2E, THR / SCALE_A, lds, o, l_reg);
  }
  if (active) { normalize(o, l_reg, lds, wid, r32, hi);
    float ss[16];
    const __attribute__((address_space(1))) float* st2 = (const __attribute__((address_space(1))) float*)(st + lane); asm volatile("" : "+v"(st2));
#pragma unroll
    for (int r = 0; r < 16; ++r) ss[r] = 0.f;
#pragma unroll
    for (int d = 0; d < 4; ++d)
#pragma unroll
      for (int r = 0; r < 16; ++r) { const float a = st2[(d * 16 + r) * 64] - lam * o[d][r]; o[d][r] = a; ss[r] += a * a; }
#pragma unroll
    for (int r = 0; r < 16; ++r) { float s = ss[r]; s += __shfl_xor(s, 1); s += __shfl_xor(s, 2); s += __shfl_xor(s, 4); s += __shfl_xor(s, 8); s += __shfl_xor(s, 16);
      ss[r] = 0.8f * rsqrtf(s * (1.f / 128.f) + cfg::EPS); }
    __attribute__((address_space(1))) bf16_t* op = (__attribute__((address_space(1))) bf16_t*)(OA + (qrow0 + wid * QBLK + 4 * hi) * 4096 + h * 128 + r32); asm volatile("" : "+v"(op));
#pragma unroll
    for (int d = 0; d < 4; ++d) { const float g = g_subln[d * 32 + r32];
#pragma unroll
      for (int r = 0; r < 16; ++r) op[((r & 3) + 8 * (r >> 2)) * 4096 + d * 32] = f2bf1(o[d][r] * ss[r] * g); }
  }
}
__device__ __forceinline__ void mla_unit(const bf16_t* QB, long qrow0, int h, const Src<bf16_t>& S, int NT, int limit, bool active, bf16_t* OB, char* lds) {
  asm volatile("" : "+s"(h), "+s"(qrow0));
  const int tid = threadIdx.x, wid = tid >> 6, lane = tid & 63, r32 = lane & 31, hi = lane >> 5;
  const long qrow = qrow0 + (active ? wid * QBLK : 0) + r32;
  f32x16 o[4]; float l_reg;
  bf16x8 qr[12];
#pragma unroll
  for (int d0 = 0; d0 < 12; ++d0) qr[d0] = *reinterpret_cast<const bf16x8*>(QB + qrow * 3072 + h * 192 + d0 * 16 + hi * 8);
  attn_core<12, bf16_t, 4096, 64, 4096>(qr, S, NT, limit, active, SCALE_B * LOG2E, THR / SCALE_B, lds, o, l_reg);
  if (active) { normalize(o, l_reg, lds, wid, r32, hi);
    __attribute__((address_space(1))) bf16_t* op = (__attribute__((address_space(1))) bf16_t*)(OB + (qrow0 + wid * QBLK + 4 * hi) * 4096 + h * 128 + r32); asm volatile("" : "+v"(op));
#pragma unroll
    for (int d = 0; d < 4; ++d)
#pragma unroll
      for (int r = 0; r < 16; ++r) op[((r & 3) + 8 * (r >> 2)) * 4096 + d * 32] = f2bf1(o[d][r]); }
}
#undef ASBAR
}
#ifndef PG8_SP2
#define PG8_SP2 true
#endif
constexpr int NWAVES = 8;
constexpr int NPH = 12;
constexpr int N_LAUNCHES = MK_N_LAUNCHES;
static_assert(N_LAUNCHES == 1 || N_LAUNCHES == NPH, "MK_N_LAUNCHES is 1 or 12");

constexpr size_t MiB = 1u << 20;
constexpr size_t WS_CTL = 0, CTL_ZERO_BYTES = 1 * MiB;
constexpr size_t WS_WIN = 1 * MiB;
constexpr size_t WS_WQB = WS_WIN + (size_t)cfg::NINP * 4096 * 2;
constexpr size_t WS_WKVB = WS_WQB + (size_t)3072 * 896 * 2;
constexpr size_t WS_WBA = WS_WKVB + (size_t)4096 * 512 * 2;
constexpr size_t WS_WBB = WS_WBA + (size_t)4096 * 2048 * 2;
constexpr size_t WS_WOUT = WS_WBB + (size_t)4096 * 2048 * 2;
constexpr size_t WS_WGU = WS_WOUT + (size_t)4096 * 4096 * 2;
constexpr size_t WS_WFD = WS_WGU + (size_t)22016 * 4096 * 2;
constexpr size_t WS_TABA = WS_WFD + (size_t)4096 * 11008 * 2;
constexpr size_t WS_TABB = WS_TABA + (size_t)8192 * 8 * 8;
constexpr size_t WS_XN = WS_TABB + (size_t)8192 * 32 * 8;
constexpr size_t WS_R0 = WS_XN + (size_t)cfg::M * 4096 * 2;
constexpr size_t WS_QA = WS_R0;
constexpr size_t WS_KA = WS_QA + (size_t)cfg::M * 2048 * 2;
constexpr size_t WS_VA = WS_KA + (size_t)cfg::M * 2048 * 2;
constexpr size_t WS_RAW = WS_VA + (size_t)cfg::M * 2048 * 2;
constexpr size_t WS_CQN = WS_RAW + (size_t)cfg::M * cfg::NRAW * 4;
constexpr size_t WS_CKV = WS_CQN + (size_t)cfg::M * 896 * 2;
constexpr size_t WS_KPE = WS_CKV + (size_t)cfg::MKV * 512 * 2;
constexpr size_t WS_QB = WS_KPE + (size_t)cfg::MKV * 64 * 2;
constexpr size_t WS_KVB = WS_QB + (size_t)cfg::M * 3072 * 2;
constexpr size_t WS_G = WS_KVB + (size_t)cfg::MKV * 4096 * 2;
constexpr size_t WS_OA = WS_G + (size_t)cfg::M * 8192 * 2;
constexpr size_t WS_OB = WS_OA + (size_t)cfg::M * 2048 * 2;
constexpr size_t WS_STASH = WS_OB + (size_t)cfg::M * 2048 * 2;
constexpr size_t WS_TOPUG = WS_STASH + (size_t)256 * 8 * 4096 * 4;
constexpr size_t WS_TOPU = WS_TOPUG + (size_t)64 * cfg::DFF * 4;
constexpr size_t WS_BOT = WS_TOPU + (size_t)64 * cfg::DFF * 4;
constexpr size_t WS_END = WS_BOT + (size_t)64 * cfg::DFF * 4;
constexpr size_t WS_MB = WS_QA;
constexpr size_t WS_UG = WS_R0;
constexpr size_t WS_U = WS_UG + (size_t)cfg::M * cfg::DFF * 2;
static_assert(WS_U + (size_t)cfg::M * cfg::DFF * 2 <= WS_END, "FFN overlay fits");
static_assert(WS_END < (size_t)1390 * 1000 * 1000, "workspace budget");
constexpr size_t SLAB_BYTES = (size_t)8 * 512 * 4096 * 4;
constexpr size_t WS_SLAB_A = WS_KVB, WS_SLAB_B = WS_KVB + SLAB_BYTES;
constexpr size_t WS_SLAB_D = WS_UG;
static_assert(2 * SLAB_BYTES <= (size_t)cfg::MKV * 4096 * 2 && SLAB_BYTES <= (size_t)cfg::M * cfg::DFF * 2, "slab overlays fit");
constexpr int CW_TMO = 0, CW_CODE = 1, CW_BAR = 4096;

constexpr int RING_OFF = 0, RING_BYTES = 131072;
constexpr int LDSCTL_OFF = RING_BYTES, MISC_OFF = LDSCTL_OFF + 320;
constexpr int XCH_OFF = RING_BYTES + 1024;
constexpr int LDS_BYTES = 147456;
static_assert(att::LDS_BYTES <= RING_BYTES && pg8::STAGE_BYTES <= RING_BYTES, "phase scratch fits the ring region");

struct Args { const float* in[29]; float* out; unsigned char* ws; int ph_lo, ph_hi; };
struct Frame {
    LAS unsigned char* lds; volatile LAS unsigned* MISC; gu32* ctl;
    int tid, wave, vcu, G;
    float* out; unsigned char* ws;
};
__device__ __forceinline__ int lane_id() { int t = threadIdx.x; asm volatile("" : "+v"(t)); return t & 63; }
__device__ __forceinline__ float wave_sum(float v) {
#pragma unroll
    for (int o = 1; o < 64; o <<= 1) v += __shfl_xor(v, o);
    return v;
}
template <int MAP> __device__ __forceinline__ int src_col(int n) {
    if (MAP == 1) { if (n < 6144) return n; if (n < 14336) return 7616 + (n - 6144); if (n < 15808) return 6144 + (n - 14336); return -1; }
    if (MAP == 2) { const int h = n / 192, d = n - h * 192; if (d < 128) return n; const int e = d - 128; return h * 192 + 128 + (e >> 1) + 32 * (e & 1); }
    return n;
}
template <int MAP> __device__ __forceinline__ void p0_transpose_item(const float* W, int K, int Nsrc, int Ndst, bf16* WT, int row_off, LAS float* scr, int item, int lane) {
    const int nblk = Ndst / 32, kb = item / nblk, nb = item - kb * nblk, k0 = 64 * kb, n0 = 32 * nb;
    if constexpr (MAP == 2) {
        const int sn = src_col<MAP>(n0 + (lane & 31));
#pragma unroll 8
        for (int i = 0; i < 32; ++i) { const int kk = 2 * i + (lane >> 5); scr[kk * 33 + (lane & 31)] = W[(size_t)(k0 + kk) * Nsrc + sn]; }
    } else {
        const int n4 = 4 * (lane & 7), kq = lane >> 3;
        const int sn = src_col<MAP>(n0 + n4);
        f32x4 v[8];
#pragma unroll
        for (int i = 0; i < 8; ++i) v[i] = sn >= 0 ? __builtin_nontemporal_load((const GAS f32x4*)(W + (size_t)(k0 + 8 * i + kq) * Nsrc + sn)) : (f32x4){0.f, 0.f, 0.f, 0.f};
#pragma unroll
        for (int i = 0; i < 8; ++i) { LAS float* d = scr + (8 * i + kq) * 33 + n4; d[0] = v[i].x; d[1] = v[i].y; d[2] = v[i].z; d[3] = v[i].w; }
    }
    LDS_WAIT(); asm volatile("" ::: "memory");
    const int c = lane & 7;
#pragma unroll
    for (int j = 0; j < 4; ++j) { const int n = (lane >> 3) + 8 * j; const LAS float* s = scr + (8 * c) * 33 + n;
        v4u o; o.x = pk2(s[0 * 33], s[1 * 33]); o.y = pk2(s[2 * 33], s[3 * 33]); o.z = pk2(s[4 * 33], s[5 * 33]); o.w = pk2(s[6 * 33], s[7 * 33]);
        *(GAS v4u*)(WT + (size_t)(row_off + n0 + n) * K + k0 + 8 * c) = o; }
    LDS_WAIT(); asm volatile("" ::: "memory");
}
struct XItem { const float* W; bf16* WT; int K, Nsrc, Ndst, row_off, item, ilv, Kp, koff; };
__device__ __forceinline__ void xitem_load(const XItem& x, int lane, f32x4 (&v)[8]) {
    const int nblk = x.Ndst / 32, kb = x.item / nblk, nb = x.item - kb * nblk, k0 = 64 * kb, n0 = 32 * nb;
    const int n4 = 4 * (lane & 7), kq = lane >> 3;
#pragma unroll
    for (int i = 0; i < 8; ++i) v[i] = __builtin_nontemporal_load((const GAS f32x4*)(x.W + (size_t)(k0 + 8 * i + kq) * x.Nsrc + n0 + n4));
}
__device__ __forceinline__ void xitem_finish(const XItem& x, int lane, const f32x4 (&v)[8], LAS float* scr) {
    const int nblk = x.Ndst / 32, kb = x.item / nblk, nb = x.item - kb * nblk, k0 = 64 * kb, n0 = 32 * nb;
    const int n4 = 4 * (lane & 7), kq = lane >> 3;
#pragma unroll
    for (int i = 0; i < 8; ++i) { LAS float* d = scr + (8 * i + kq) * 33 + n4; d[0] = v[i].x; d[1] = v[i].y; d[2] = v[i].z; d[3] = v[i].w; }
    LDS_WAIT(); asm volatile("" ::: "memory");
    const int c = lane & 7;
#pragma unroll
    for (int j = 0; j < 4; ++j) { const int n = (lane >> 3) + 8 * j; const LAS float* s = scr + (8 * c) * 33 + n;
        v4u o; o.x = pk2(s[0 * 33], s[1 * 33]); o.y = pk2(s[2 * 33], s[3 * 33]); o.z = pk2(s[4 * 33], s[5 * 33]); o.w = pk2(s[6 * 33], s[7 * 33]);
        const int nn = n0 + n, drow = x.ilv ? ((nn >> 7) << 8) + (nn & 127) + x.row_off : x.row_off + nn;
        *(GAS v4u*)(x.WT + (size_t)drow * x.Kp + x.koff + k0 + 8 * c) = o; }
    LDS_WAIT(); asm volatile("" ::: "memory");
}
template <typename TO> __device__ __forceinline__ void rms_row4096(const float* xrow, const float* gain, TO* orow, int lane) {
    const GAS f32x4* xr = (const GAS f32x4*)xrow + lane; const GAS f32x4* gr = (const GAS f32x4*)gain + lane;
    f32x4 v[16]; float s = 0.f;
#pragma unroll
    for (int j = 0; j < 16; ++j) { v[j] = xr[64 * j]; s += (v[j].x * v[j].x + v[j].y * v[j].y) + (v[j].z * v[j].z + v[j].w * v[j].w); }
    const float rstd = rsqrtf(wave_sum(s) * (1.f / 4096.f) + cfg::EPS);
#pragma unroll
    for (int j = 0; j < 16; ++j) { const f32x4 g = gr[64 * j]; const f32x4 y = v[j] * rstd * g;
        if constexpr (sizeof(TO) == 2) { ((GAS unsigned long long*)orow)[64 * j + lane] = (unsigned long long)pk2(y.x, y.y) | ((unsigned long long)pk2(y.z, y.w) << 32); }
        else { ((GAS f32x4*)orow)[64 * j + lane] = y; } }
}
template <int S0, int S1> __device__ __forceinline__ void slab_sum4(const float* slab, int srow, int q, int lane, f32x4 (&v)[4]) {
#pragma unroll
    for (int s = S0; s < S1; ++s) { const GAS f32x4* p = (const GAS f32x4*)(slab + ((size_t)s * 512 + srow) * 4096 + 1024 * q) + lane;
#pragma unroll
        for (int j = 0; j < 4; ++j) v[j] += p[64 * j]; }
}
__device__ __forceinline__ void p5c_merge_sample(Frame& F) {
    const int srow = 2 * F.vcu + (F.wave >> 2), q = F.wave & 3, lane = lane_id(); if (F.vcu >= 256) return;
    f32x4 a[4], b[4];
#pragma unroll
    for (int j = 0; j < 4; ++j) { a[j] = (f32x4){0.f, 0.f, 0.f, 0.f}; b[j] = a[j]; }
    slab_sum4<0, 4>((const float*)(F.ws + WS_SLAB_A), srow, q, lane, a); slab_sum4<4, 8>((const float*)(F.ws + WS_SLAB_A), srow, q, lane, b);
    const bf16* G = (const bf16*)(F.ws + WS_G) + (size_t)(cfg::TP + srow) * 8192 + 1024 * q; bf16* MB = (bf16*)(F.ws + WS_MB) + (size_t)(cfg::TP + srow) * 4096 + 1024 * q;
#pragma unroll
    for (int j = 0; j < 4; ++j) { const int c = 4 * lane + 256 * j; const unsigned long long g0 = *(const GAS unsigned long long*)(G + c), g1 = *(const GAS unsigned long long*)(G + 4096 + c);
        const float g00 = __uint_as_float((unsigned)g0 << 16), g01 = __uint_as_float((unsigned)g0 & 0xffff0000u), g02 = __uint_as_float((unsigned)(g0 >> 32) << 16), g03 = __uint_as_float((unsigned)(g0 >> 32) & 0xffff0000u);
        const float g10 = __uint_as_float((unsigned)g1 << 16), g11 = __uint_as_float((unsigned)g1 & 0xffff0000u), g12 = __uint_as_float((unsigned)(g1 >> 32) << 16), g13 = __uint_as_float((unsigned)(g1 >> 32) & 0xffff0000u);
        const float m0 = g00 * a[j].x + g10 * b[j].x, m1 = g01 * a[j].y + g11 * b[j].y, m2 = g02 * a[j].z + g12 * b[j].z, m3 = g03 * a[j].w + g13 * b[j].w;
        *(GAS unsigned long long*)(MB + c) = (unsigned long long)pk2(m0, m1) | ((unsigned long long)pk2(m2, m3) << 32); }
}
template <typename TO> __device__ __forceinline__ void sample_rows_norm(Frame& F, const float* base_rows  , const float* slab, float* hout_rows  , const float* gain, TO* yout_rows  , LAS float* xch) {
    const int srow = 2 * (F.vcu & 255) + (F.wave >> 2), q = F.wave & 3, lane = lane_id();
    f32x4 v[4];
    { const GAS f32x4* p = (const GAS f32x4*)(base_rows + (size_t)srow * 4096 + 1024 * q) + lane;
#pragma unroll
      for (int j = 0; j < 4; ++j) v[j] = p[64 * j]; }
    slab_sum4<0, 8>(slab, srow, q, lane, v);
    float s = 0.f;
#pragma unroll
    for (int j = 0; j < 4; ++j) s += (v[j].x * v[j].x + v[j].y * v[j].y) + (v[j].z * v[j].z + v[j].w * v[j].w);
    s = wave_sum(s);
    if (lane == 0) xch[F.wave] = s;
    LDS_WAIT(); __syncthreads();
    const int w0 = F.wave & 4; const float tot = (xch[w0] + xch[w0 + 1]) + (xch[w0 + 2] + xch[w0 + 3]);
    const float rstd = rsqrtf(tot * (1.f / 4096.f) + cfg::EPS);
    const GAS f32x4* gr = (const GAS f32x4*)(gain + 1024 * q) + lane;
    if constexpr (sizeof(TO) == 2) { GAS f32x4* ho = (GAS f32x4*)(hout_rows + (size_t)srow * 4096 + 1024 * q) + lane;
#pragma unroll
        for (int j = 0; j < 4; ++j) ho[64 * j] = v[j]; }
#pragma unroll
    for (int j = 0; j < 4; ++j) { const f32x4 y = v[j] * rstd * gr[64 * j];
        if constexpr (sizeof(TO) == 2) ((GAS unsigned long long*)(yout_rows + (size_t)srow * 4096 + 1024 * q))[64 * j + lane] = (unsigned long long)pk2(y.x, y.y) | ((unsigned long long)pk2(y.z, y.w) << 32);
        else ((GAS f32x4*)(yout_rows + (size_t)srow * 4096 + 1024 * q))[64 * j + lane] = y; }
    __syncthreads();
}
constexpr int I_IN = 64 * (cfg::NINP / 32), I_QB = 14 * 96, I_KVB = 8 * 128, I_BR = 32 * 128, I_OUT = 64 * 128, I_FF = 64 * 344, I_FD = 172 * 128;
constexpr int NITEMS1 = I_QB + I_KVB + 2 * I_BR + I_OUT + 2 * I_FF, NITEMS2 = I_FD;
constexpr int CW_Q1 = 1024, CW_Q2 = 1088;
#ifndef P8_GEMM_WGS
#define P8_GEMM_WGS 248
#endif
#ifndef P1_GEMM_WGS
#define P1_GEMM_WGS 240
#endif
template <int LIST> __device__ __forceinline__ XItem list_item(const Args& A, unsigned char* ws, int r) {
    if (LIST == 2) return XItem{A.in[27], (bf16*)(ws + WS_WFD), cfg::DFF, 4096, 4096, 0, r, 0, cfg::DFF, 0};
    r -= I_QB;
    if (r < I_KVB) return XItem{A.in[18], (bf16*)(ws + WS_WKVB), 512, 4096, 4096, 0, r, 0, 512, 0}; r -= I_KVB;
    if (r < I_BR) return XItem{A.in[14], (bf16*)(ws + WS_WBA), 2048, 4096, 4096, 0, r, 0, 4096, 0}; r -= I_BR;
    if (r < I_BR) return XItem{A.in[19], (bf16*)(ws + WS_WBA), 2048, 4096, 4096, 0, r, 0, 4096, 2048}; r -= I_BR;
    if (r < I_OUT) return XItem{A.in[21], (bf16*)(ws + WS_WOUT), 4096, 4096, 4096, 0, r, 0, 4096, 0}; r -= I_OUT;
    if (r < I_FF) return XItem{A.in[23], (bf16*)(ws + WS_WGU), 4096, cfg::DFF, cfg::DFF, 0, r, 1, 4096, 0}; r -= I_FF;
    return XItem{A.in[24], (bf16*)(ws + WS_WGU), 4096, cfg::DFF, cfg::DFF, 128, r, 1, 4096, 0};
}
template <int LIST> __device__ __forceinline__ void convert_queue(Frame& F, const Args& A) {
    constexpr int QCH = 8, NIT = LIST == 1 ? NITEMS1 : NITEMS2, NSC = LIST == 1 ? I_QB : 0;
    LAS float* scr = (LAS float*)(F.lds + RING_OFF + F.wave * 16384);
    gu32* head = F.ctl + (LIST == 1 ? CW_Q1 : CW_Q2);
    for (;;) {
        unsigned base = 0u; if (lane_id() == 0) base = __hip_atomic_fetch_add(head, (unsigned)QCH, RLX_AGENT);
        base = (unsigned)__builtin_amdgcn_readfirstlane((int)base);
        if (base >= (unsigned)NIT) break;
        const int lo = (int)base, hi = lo + QCH;
        static_assert(NITEMS1 % 8 == 0 && NITEMS2 % 8 == 0 && I_QB % 8 == 0, "chunks never straddle a list end or the scalar-path boundary");
        if (lo < NSC) {
#pragma unroll 1
            for (int it = lo; it < hi; ++it) p0_transpose_item<2>(A.in[16], 896, 3072, 3072, (bf16*)(F.ws + WS_WQB), 0, scr, it, lane_id());
        } else {
            f32x4 va[8], vb[8];
            { const XItem x = list_item<LIST>(A, F.ws, lo); xitem_load(x, lane_id(), va); }
#pragma unroll 1
            for (int it = lo; it < hi; it += 2) {
                { const XItem x = list_item<LIST>(A, F.ws, it + 1); xitem_load(x, lane_id(), vb); }
                { const XItem x = list_item<LIST>(A, F.ws, it); xitem_finish(x, lane_id(), va, scr); }
                if (it + 2 < hi) { const XItem x = list_item<LIST>(A, F.ws, it + 2); xitem_load(x, lane_id(), va); }
                { const XItem x = list_item<LIST>(A, F.ws, it + 1); xitem_finish(x, lane_id(), vb, scr); }
            }
        }
    }
}
__device__ __forceinline__ void p0_prologue(Frame& F, const Args& A) {
    LAS float* scr = (LAS float*)(F.lds + RING_OFF + F.wave * 16384);
    const int gw = F.vcu * NWAVES + F.wave, NGW = F.G * NWAVES;
    unsigned char* ws = F.ws;
    for (int it = gw; it < I_IN; it += NGW) p0_transpose_item<1>(A.in[8], 4096, 15808, cfg::NINP, (bf16*)(ws + WS_WIN), 0, scr, it, lane_id());
    for (int m = gw; m < cfg::M; m += NGW) { const float* xr = m < cfg::TP ? A.in[0] + (size_t)m * 4096 : A.in[1] + (size_t)(m - cfg::TP) * 4096;
        rms_row4096<bf16>(xr, A.in[7], (bf16*)(ws + WS_XN) + (size_t)m * 4096, lane_id()); }
    const int gt = gw * 64 + lane_id(), NGT = NGW * 64;
    float* tabA = (float*)(ws + WS_TABA); float* tabB = (float*)(ws + WS_TABB);
    for (int i = gt; i < 8192 * 40; i += NGT) {
        int pos, fi; float ex; float* dst;
        if (i < 8192 * 8) { pos = i >> 3; fi = i & 7; ex = (float)fi * (1.f / 8.f); dst = tabA + (size_t)i * 2; }
        else { const int k = i - 8192 * 8; pos = k >> 5; fi = k & 31; ex = (float)fi * (1.f / 32.f); dst = tabB + (size_t)k * 2; }
        const float inv = exp2f(-ex * 18.931568569324174f);
        const float ang = (float)pos * inv;
        double rev = (double)ang * 0.15915494309189535; rev -= __builtin_floor(rev);
        const float fr = (float)rev;
        dst[0] = __builtin_amdgcn_cosf(fr); dst[1] = __builtin_amdgcn_sinf(fr);
    }
    { const float* src = A.in[4]; bf16* dst = (bf16*)(ws + WS_CKV) + (size_t)cfg::TP * 512;
      for (int i = gt; i < 16384 * 512 / 8; i += NGT) { const f32x4 a = *(const GAS f32x4*)(src + (size_t)i * 8), b = *(const GAS f32x4*)(src + (size_t)i * 8 + 4);
          v4u o; o.x = pk2(a.x, a.y); o.y = pk2(a.z, a.w); o.z = pk2(b.x, b.y); o.w = pk2(b.z, b.w); *(GAS v4u*)(dst + (size_t)i * 8) = o; } }
    { const float* src = A.in[5]; bf16* dst = (bf16*)(ws + WS_KPE) + (size_t)cfg::TP * 64;
      for (int i = gt; i < 16384 * 8; i += NGT) { const int row = i >> 3, c = i & 7; const f32x4 a = *(const GAS f32x4*)(src + (size_t)row * 64 + 4 * c), b = *(const GAS f32x4*)(src + (size_t)row * 64 + 32 + 4 * c);
          v4u o; o.x = pk2(a.x, b.x); o.y = pk2(a.y, b.y); o.z = pk2(a.z, b.z); o.w = pk2(a.w, b.w); *(GAS v4u*)(dst + (size_t)row * 64 + 8 * c) = o; } }
}
__device__ __forceinline__ void p2_latents(Frame& F, const Args& A) {
    const int gw = F.vcu * NWAVES + F.wave, NGW = F.G * NWAVES, lane = lane_id();
    unsigned char* ws = F.ws; const float* g_qa = A.in[15]; const float* g_kva = A.in[17]; const float* tabB = (const float*)(ws + WS_TABB);
    for (int m = gw; m < cfg::M; m += NGW) {
        const float* raw = (const float*)(ws + WS_RAW) + (size_t)m * cfg::NRAW;
        const bool smp = m >= cfg::TP; const int pos = smp ? 2048 + (m & 63) : m; const size_t mk = smp ? (size_t)m + 16384 : (size_t)m;
        float v[14]; float s = 0.f;
#pragma unroll
        for (int j = 0; j < 14; ++j) { v[j] = raw[64 * j + lane]; s += v[j] * v[j]; }
        float rstd = rsqrtf(wave_sum(s) * (1.f / 896.f) + cfg::EPS);
        bf16* cq = (bf16*)(ws + WS_CQN) + (size_t)m * 896;
#pragma unroll
        for (int j = 0; j < 14; ++j) cq[64 * j + lane] = (bf16)f2bf(v[j] * rstd * g_qa[64 * j + lane]);
        float w[8]; s = 0.f;
#pragma unroll
        for (int j = 0; j < 8; ++j) { w[j] = raw[896 + 64 * j + lane]; s += w[j] * w[j]; }
        rstd = rsqrtf(wave_sum(s) * (1.f / 512.f) + cfg::EPS);
        float* co = smp ? F.out + cfg::O_CKVS + (size_t)(m - cfg::TP) * 512 : F.out + cfg::O_CKVP + (size_t)m * 512;
        bf16* ck = (bf16*)(ws + WS_CKV) + mk * 512;
#pragma unroll
        for (int j = 0; j < 8; ++j) { const float y = w[j] * rstd * g_kva[64 * j + lane]; co[64 * j + lane] = y; ck[64 * j + lane] = (bf16)f2bf(y); }
        if (lane < 32) { const float x1 = raw[1408 + lane], x2 = raw[1440 + lane]; const float c = tabB[((size_t)pos * 32 + lane) * 2], sn = tabB[((size_t)pos * 32 + lane) * 2 + 1];
            const float o1 = x1 * c - x2 * sn, o2 = x2 * c + x1 * sn;
            float* ko = smp ? F.out + cfg::O_KPES + (size_t)(m - cfg::TP) * 64 : F.out + cfg::O_KPEP + (size_t)m * 64;
            ko[lane] = o1; ko[32 + lane] = o2;
            ((GAS unsigned*)((bf16*)(ws + WS_KPE) + mk * 64))[lane] = pk2(o1, o2); }
    }
}
__device__ __forceinline__ void p9_fix(Frame& F, const Args& A) {
    const int gt = (F.vcu * NWAVES + F.wave) * 64 + lane_id(), NGT = F.G * NWAVES * 64;
    const float* topug = (const float*)(F.ws + WS_TOPUG); const float* topu = (const float*)(F.ws + WS_TOPU); const float* bot = (const float*)(F.ws + WS_BOT);
    bf16* ACT = (bf16*)(F.ws + WS_U); const float* wc = A.in[25]; const float* bc = A.in[26];
    constexpr int NCC = cfg::DFF / 8;
    for (int it = gt; it < 31 * 2 * NCC; it += NGT) {
        const int pj = it / NCC, cc = it - pj * NCC, pm = 1 + (pj >> 1), j = pj & 1, col = cc * 8;
        const float* x0 = topug + (size_t)(pm * 2 + j) * cfg::DFF + col;
        const float* x1 = j ? topug + (size_t)(pm * 2) * cfg::DFF + col : bot + (size_t)((pm - 1) * 2 + 1) * cfg::DFF + col;
        const float* x2 = j ? bot + (size_t)((pm - 1) * 2 + 1) * cfg::DFF + col : bot + (size_t)((pm - 1) * 2) * cfg::DFF + col;
        const float* uu = topu + (size_t)(pm * 2 + j) * cfg::DFF + col;
        float a[8];
#pragma unroll
        for (int e = 0; e < 8; ++e) { const float c = bc[col + e] + wc[col + e] * x2[e] + wc[cfg::DFF + col + e] * x1[e] + wc[2 * cfg::DFF + col + e] * x0[e]; a[e] = c * __builtin_amdgcn_rcpf(1.f + __expf(-c)) * uu[e]; }
        v4u o; o.x = pk2(a[0], a[1]); o.y = pk2(a[2], a[3]); o.z = pk2(a[4], a[5]); o.w = pk2(a[6], a[7]);
        *(GAS v4u*)(ACT + (size_t)(pm * 256 + j) * cfg::DFF + col) = o;
    }
}
__device__ __forceinline__ void p4_attention(Frame& F, const Args& A, char* lds) {
    using att::bf16_t; using att::Src;
    unsigned char* ws = F.ws; const int wid = F.wave;
    const bf16_t* QA = (const bf16_t*)(ws + WS_QA); const bf16_t* KA = (const bf16_t*)(ws + WS_KA); const bf16_t* VA = (const bf16_t*)(ws + WS_VA);
    const bf16_t* QB = (const bf16_t*)(ws + WS_QB); const bf16_t* KVB = (const bf16_t*)(ws + WS_KVB); const bf16_t* KPE = (const bf16_t*)(ws + WS_KPE);
    bf16_t* OA = (bf16_t*)(ws + WS_OA); bf16_t* OB = OA + 2048;
    float lam;
    { const float a = A.in[9][lane_id()] * A.in[10][lane_id()], b = A.in[11][lane_id()] * A.in[12][lane_id()]; lam = __expf(wave_sum(a)) - __expf(wave_sum(b)) + 0.2f; }
    const float* g_subln = A.in[13];
    { const int v = F.vcu & 255;
        float* stash = (float*)(ws + WS_STASH) + (size_t)v * 8 * 4096;
        const int h = v >> 4, s = v & 15;
#ifndef ATT_SEL
#define ATT_SEL 7
#endif
#pragma unroll 1
        for (int k = 0; k < ((ATT_SEL & 1) ? 2 : 0); ++k) {
            const int qb = k ? 31 - s : s, NT = 4 * qb + 4, limit = 4 * qb + (wid >> 1);
            Src<bf16_t> S1{KA + h * 64, KA + h * 64, nullptr, nullptr, VA + h * 128, VA + h * 128, NT, NT};
            Src<bf16_t> S2{KA + (16 + h) * 64, KA + (16 + h) * 64, nullptr, nullptr, VA + h * 128, VA + h * 128, NT, NT};
            att::diff_unit<bf16_t>(QA, (long)qb * 256, h, S1, S2, NT, limit, true, lam, g_subln, stash, OA, lds);
        }
#pragma unroll 1
        for (int k = 0; k < ((ATT_SEL & 2) ? 3 : 0); ++k) {
            if (k < 2) { const int qb = k ? 31 - s : s, NT = 4 * qb + 4, limit = 4 * qb + (wid >> 1);
                Src<bf16_t> S{KVB + h * 256, KVB + h * 256, KPE, KPE, KVB + h * 256 + 128, KVB + h * 256 + 128, NT, NT};
                att::mla_unit(QB, (long)qb * 256, h, S, NT, limit, true, OB, lds);
            } else if (v >= 128) { const int b = (v - 128) >> 4, hh = v & 15;
                const bf16_t* kp = KVB + (size_t)(cfg::TP + b * 2048) * 4096 + hh * 256; const bf16_t* kn = KVB + (size_t)(cfg::TP + 16384 + b * 64) * 4096 + hh * 256;
                Src<bf16_t> S{kp, kn, KPE + (size_t)(cfg::TP + b * 2048) * 64, KPE + (size_t)(cfg::TP + 16384 + b * 64) * 64, kp + 128, kn + 128, 32, 33};
                att::mla_unit(QB, (long)cfg::TP + b * 64, hh, S, 34, 32, wid < 2, OB, lds);
            }
        }
        if ((ATT_SEL & 4) && v < 128) { const int b = v >> 4, hh = v & 15;
            const float* kp = A.in[2] + (size_t)b * 2048 * 2048 + hh * 64; const float* kn = F.out + cfg::O_DKS + (size_t)b * 64 * 2048 + hh * 64;
            const float* vp = A.in[3] + (size_t)b * 2048 * 2048 + hh * 128; const float* vn = F.out + cfg::O_DVS + (size_t)b * 64 * 2048 + hh * 128;
            Src<float> S1{kp, kn, nullptr, nullptr, vp, vn, 32, 33};
            Src<float> S2{kp + 16 * 64, kn + 16 * 64, nullptr, nullptr, vp, vn, 32, 33};
            att::diff_unit<float>(QA, (long)cfg::TP + b * 64, hh, S1, S2, 34, 32, wid < 2, lam, g_subln, stash, OA, lds);
        }
    }
}

__global__ void __launch_bounds__(NWAVES * 64, 2) fwd(Args args) {
    extern __shared__ __attribute__((aligned(16))) unsigned char lds[];
    Frame F;
    F.lds = (LAS unsigned char*)lds; F.MISC = (volatile LAS unsigned*)(F.lds + MISC_OFF);
    F.tid = threadIdx.x; F.wave = __builtin_amdgcn_readfirstlane(F.tid >> 6);
    F.G = gridDim.x; { const int bx = blockIdx.x; F.vcu = (F.G % 8 == 0) ? (bx % 8) * (F.G / 8) + bx / 8 : bx; }
    F.out = args.out; F.ws = args.ws; unsigned char* ws = args.ws;
    F.ctl = (gu32*)(ws + WS_CTL);
    for (int u = F.tid; u < (LDS_BYTES - LDSCTL_OFF) / 4; u += NWAVES * 64) ((LAS unsigned*)(F.lds + LDSCTL_OFF))[u] = 0u;
    __syncthreads();
    XcdBarrier bar; bar.bar = (unsigned*)(F.ctl + CW_BAR); bar.x = 0; bar.st = nullptr;
    if (N_LAUNCHES == 1) bar = xcd_barrier_post((unsigned*)(F.ctl + CW_BAR), F.MISC + 8);
#define GRID_BAR() do { if (N_LAUNCHES == 1) xcd_barrier(bar); } while (0)
    const int lo = args.ph_lo, hi = args.ph_hi;
#ifndef PH_MASK
#define PH_MASK 0xFFF
#endif
#define IN(k) (((PH_MASK >> (k)) & 1) && lo <= (k) && (k) < hi)
    typedef pg8::bf16_t pb;
    float* Y = args.out + cfg::O_Y;

    if (IN(0)) { p0_prologue(F, args); GRID_BAR(); }
#ifdef DUP_P0
    if (IN(0)) { p0_prologue(F, args); GRID_BAR(); }
#endif
#ifndef DUP_PH
#define DUP_PH -1
#endif
    if (IN(1)) {
        if (blockIdx.x < P1_GEMM_WGS) {
        pg8::Gemm g{(const pb*)(ws + WS_XN), (const pb*)(ws + WS_WIN), cfg::M, cfg::NINP, 4096}; pg8::StaticOrder S; S.init(cfg::M, cfg::NINP, P1_GEMM_WGS, (int)blockIdx.x);
        pg8::EpiIn E{(pb*)(ws + WS_QA), (pb*)(ws + WS_KA), (pb*)(ws + WS_VA), (pb*)(ws + WS_G), (float*)(ws + WS_RAW), args.out, args.in[20], (const float*)(ws + WS_TABA)};
        pg8::gemm_phase<pg8::EpiIn, pg8::StaticOrder, true, PG8_SP2>(F.lds + RING_OFF, g, S, E);
        }
        __syncthreads(); convert_queue<1>(F, args);
        GRID_BAR();
    }
#if DUP_PH == 1
    if (IN(1)) {
        if (blockIdx.x < P1_GEMM_WGS) {
        pg8::Gemm g{(const pb*)(ws + WS_XN), (const pb*)(ws + WS_WIN), cfg::M, cfg::NINP, 4096}; pg8::StaticOrder S; S.init(cfg::M, cfg::NINP, P1_GEMM_WGS, (int)blockIdx.x);
        pg8::EpiIn E{(pb*)(ws + WS_QA), (pb*)(ws + WS_KA), (pb*)(ws + WS_VA), (pb*)(ws + WS_G), (float*)(ws + WS_RAW), args.out, args.in[20], (const float*)(ws + WS_TABA)};
        pg8::gemm_phase<pg8::EpiIn, pg8::StaticOrder, true, PG8_SP2>(F.lds + RING_OFF, g, S, E);
        }
        __syncthreads(); convert_queue<1>(F, args);
        GRID_BAR();
    }
#endif
    if (IN(2)) { p2_latents(F, args); GRID_BAR(); }
    if (IN(3)) {
        { pg8::Gemm g{(const pb*)(ws + WS_CQN), (const pb*)(ws + WS_WQB), cfg::M, cfg::NQB, 896}; pg8::StaticOrder S; S.init(cfg::M, cfg::NQB, F.G, (int)blockIdx.x);
          pg8::EpiQB E{(pb*)(ws + WS_QB), (const float*)(ws + WS_TABB)};
          pg8::gemm_phase<pg8::EpiQB, pg8::StaticOrder, true, PG8_SP2>(F.lds + RING_OFF, g, S, E); }
        __syncthreads();
        { pg8::Gemm g{(const pb*)(ws + WS_CKV), (const pb*)(ws + WS_WKVB), cfg::MKV, cfg::NKVBO, 512}; pg8::StaticOrder S; S.init(cfg::MKV, cfg::NKVBO, F.G, (int)((blockIdx.x + F.G / 2) % F.G));
          pg8::EpiPlain E{(pb*)(ws + WS_KVB), cfg::NKVBO};
          pg8::gemm_phase<pg8::EpiPlain, pg8::StaticOrder, true, PG8_SP2>(F.lds + RING_OFF, g, S, E); }
        GRID_BAR();
    }
    if (IN(4)) { p4_attention(F, args, (char*)lds + RING_OFF); GRID_BAR(); }
#ifdef DUP_P4
    if (IN(4)) { p4_attention(F, args, (char*)lds + RING_OFF); GRID_BAR(); }
#endif
    if (IN(5)) {
        { pg8::Gemm g{(const pb*)(ws + WS_OA), (const pb*)(ws + WS_WBA), cfg::M, 4096, 4096}; pg8::SplitTailOrder2 S; S.init(4096, (int)blockIdx.x);
          pg8::EpiY E{(const pb*)(ws + WS_G), (pb*)(ws + WS_MB), (float*)(ws + WS_SLAB_A)};
          pg8::gemm_phase<pg8::EpiY, pg8::SplitTailOrder2, true, PG8_SP2>(F.lds + RING_OFF, g, S, E); }
        GRID_BAR();
        p5c_merge_sample(F);
        GRID_BAR();
    }
    if (IN(6)) {
        pg8::Gemm g{(const pb*)(ws + WS_MB), (const pb*)(ws + WS_WOUT), cfg::M, 4096, 4096}; pg8::SplitTailOrder S; S.init(4096, (int)blockIdx.x);
        pg8::EpiRes E{args.in[0], args.in[1], Y, (float*)(ws + WS_SLAB_A)};
        pg8::gemm_phase<pg8::EpiRes, pg8::SplitTailOrder, true, PG8_SP2>(F.lds + RING_OFF, g, S, E);
        GRID_BAR();
    }
#if DUP_PH == 6
    if (IN(6)) {
        pg8::Gemm g{(const pb*)(ws + WS_MB), (const pb*)(ws + WS_WOUT), cfg::M, 4096, 4096}; pg8::SplitTailOrder S; S.init(4096, (int)blockIdx.x);
        pg8::EpiRes E{args.in[0], args.in[1], Y, (float*)(ws + WS_SLAB_A)};
        pg8::gemm_phase<pg8::EpiRes, pg8::SplitTailOrder, true, PG8_SP2>(F.lds + RING_OFF, g, S, E);
        GRID_BAR();
    }
#endif
    if (IN(7)) {
        const int gw = F.vcu * NWAVES + F.wave, NGW = F.G * NWAVES;
        sample_rows_norm<bf16>(F, args.in[1], (const float*)(ws + WS_SLAB_A), Y + (size_t)cfg::TP * 4096, args.in[22], (bf16*)(ws + WS_XN) + (size_t)cfg::TP * 4096, (LAS float*)(F.lds + RING_OFF));
        for (int m = gw; m < cfg::TP; m += NGW) rms_row4096<bf16>(Y + (size_t)m * 4096, args.in[22], (bf16*)(ws + WS_XN) + (size_t)m * 4096, lane_id());
        GRID_BAR();
    }
    if (IN(8)) {
        if (blockIdx.x < P8_GEMM_WGS) {
        pg8::Gemm g{(const pb*)(ws + WS_XN), (const pb*)(ws + WS_WGU), cfg::M, 2 * cfg::DFF, 4096}; pg8::StaticOrder S; S.init(cfg::M, 2 * cfg::DFF, P8_GEMM_WGS, (int)blockIdx.x);
        pg8::EpiGU2 E{(pb*)(ws + WS_U), args.out, args.in[25], args.in[26], args.in[6], (float*)(ws + WS_TOPUG), (float*)(ws + WS_TOPU), (float*)(ws + WS_BOT), (LAS float*)(F.lds + XCH_OFF)};
        pg8::gemm_phase<pg8::EpiGU2, pg8::StaticOrder, true, PG8_SP2>(F.lds + RING_OFF, g, S, E);
        }
        __syncthreads(); convert_queue<2>(F, args);
        GRID_BAR();
    }
#if DUP_PH == 8
    if (IN(8)) {
        if (blockIdx.x < P8_GEMM_WGS) {
        pg8::Gemm g{(const pb*)(ws + WS_XN), (const pb*)(ws + WS_WGU), cfg::M, 2 * cfg::DFF, 4096}; pg8::StaticOrder S; S.init(cfg::M, 2 * cfg::DFF, P8_GEMM_WGS, (int)blockIdx.x);
        pg8::EpiGU2 E{(pb*)(ws + WS_U), args.out, args.in[25], args.in[26], args.in[6], (float*)(ws + WS_TOPUG), (float*)(ws + WS_TOPU), (float*)(ws + WS_BOT), (LAS float*)(F.lds + XCH_OFF)};
        pg8::gemm_phase<pg8::EpiGU2, pg8::StaticOrder, true, PG8_SP2>(F.lds + RING_OFF, g, S, E);
        }
        __syncthreads(); convert_queue<2>(F, args);
        GRID_BAR();
    }
#endif
    if (IN(9)) { p9_fix(F, args); GRID_BAR(); }
    if (IN(10)) {
        pg8::Gemm g{(const pb*)(ws + WS_U), (const pb*)(ws + WS_WFD), cfg::M, 4096, cfg::DFF}; pg8::SplitTailOrder S; S.init(cfg::DFF, (int)blockIdx.x);
        pg8::EpiRes E{Y, Y + (size_t)cfg::TP * 4096, Y, (float*)(ws + WS_SLAB_D)};
        pg8::gemm_phase<pg8::EpiRes, pg8::SplitTailOrder, true, PG8_SP2>(F.lds + RING_OFF, g, S, E);
        GRID_BAR();
    }
#if DUP_PH == 10
    if (IN(10)) {
        pg8::Gemm g{(const pb*)(ws + WS_U), (const pb*)(ws + WS_WFD), cfg::M, 4096, cfg::DFF}; pg8::SplitTailOrder S; S.init(cfg::DFF, (int)blockIdx.x);
        pg8::EpiRes E{Y, Y + (size_t)cfg::TP * 4096, Y, (float*)(ws + WS_SLAB_D)};
        pg8::gemm_phase<pg8::EpiRes, pg8::SplitTailOrder, true, PG8_SP2>(F.lds + RING_OFF, g, S, E);
        GRID_BAR();
    }
#endif
    if (IN(11)) {
        const int gw = F.vcu * NWAVES + F.wave, NGW = F.G * NWAVES;
        sample_rows_norm<float>(F, Y + (size_t)cfg::TP * 4096, (const float*)(ws + WS_SLAB_D), Y + (size_t)cfg::TP * 4096, args.in[28], Y + (size_t)cfg::TP * 4096, (LAS float*)(F.lds + RING_OFF));
        for (int m = gw; m < cfg::TP; m += NGW) rms_row4096<float>(Y + (size_t)m * 4096, args.in[28], Y + (size_t)m * 4096, lane_id());
    }
#ifdef DBG_COPY
    if (lo <= DBG_COPY && DBG_COPY < hi) {
        const size_t gt = (size_t)(F.vcu * NWAVES + F.wave) * 64 + lane_id(), NGT = (size_t)F.G * NWAVES * 64;
        const v4u* s0 = (const v4u*)(ws + WS_WQB); v4u* d0 = (v4u*)Y; const size_t n0 = (size_t)(WS_WGU - WS_WQB) / 16;
        for (size_t i = gt; i < n0; i += NGT) d0[i] = s0[i];
        const v4u* s1 = (const v4u*)(ws + WS_WFD); v4u* d1 = d0 + n0; const size_t n1 = (size_t)60000000 / 16;
        for (size_t i = gt; i < n1; i += NGT) d1[i] = s1[i];
    }
#endif
#undef IN
#undef GRID_BAR
}

extern "C" void kernel_launch(void* const* d_in, const int* in_sizes, int n_in, void* d_out, int out_size, void* d_ws, size_t ws_size, hipStream_t stream) {
    static int grid = 0;
    if (grid == 0) {
        if (n_in != 29 || in_sizes[0] != cfg::TP * 4096 || (size_t)out_size != cfg::O_END || ws_size < WS_END) {
            fprintf(stderr, "kernel_launch: shape mismatch: n_in %d in0 %d out %d ws %zu (need %zu); nothing launched\n", n_in, n_in > 0 ? in_sizes[0] : -1, out_size, ws_size, (size_t)WS_END); grid = -1; return; }
        int dev = 0, cus = 0, per_cu = 0;
        if (hipGetDevice(&dev) != hipSuccess || hipDeviceGetAttribute(&cus, hipDeviceAttributeMultiprocessorCount, dev) != hipSuccess) { grid = -1; return; }
        if (hipFuncSetAttribute((const void*)fwd, hipFuncAttributeMaxDynamicSharedMemorySize, LDS_BYTES) != hipSuccess) { fprintf(stderr, "kernel_launch: hipFuncSetAttribute failed\n"); grid = -1; return; }
        if (hipOccupancyMaxActiveBlocksPerMultiprocessor(&per_cu, (const void*)fwd, NWAVES * 64, LDS_BYTES) != hipSuccess || per_cu < 1)
            fprintf(stderr, "kernel_launch: note: occupancy query reports %d workgroups per CU\n", per_cu);
        (void)hipGetLastError();
        if (cus < 256) { fprintf(stderr, "kernel_launch: built for a 256-CU device (got %d); nothing launched\n", cus); grid = -1; return; }
        grid = 256;
    }
    if (grid < 0) return;
    if (hipMemsetAsync((char*)d_ws + WS_CTL, 0, CTL_ZERO_BYTES, stream) != hipSuccess) { fprintf(stderr, "kernel_launch: memset failed\n"); return; }
    Args a{};
    for (int i = 0; i < 29; ++i) a.in[i] = (const float*)d_in[i];
    a.out = (float*)d_out; a.ws = (unsigned char*)d_ws;
    for (int li = 0; li < N_LAUNCHES; ++li) {
        a.ph_lo = (N_LAUNCHES == 1) ? 0 : li; a.ph_hi = (N_LAUNCHES == 1) ? NPH : li + 1;
        hipLaunchKernelGGL(fwd, dim3(grid), dim3(NWAVES * 64), LDS_BYTES, stream, a);
        const hipError_t le = hipPeekAtLastError();
        if (le != hipSuccess) { fprintf(stderr, "kernel_launch: launch %d failed: %s\n", li, hipGetErrorName(le)); break; }
    }
}
```

```cpp
#include <hip/hip_runtime.h>
#include <hip/hip_bf16.h>
#include <cstdio>
#include <cstdint>

#define DUP_PH -1
#ifndef MK_N_LAUNCHES
#define MK_N_LAUNCHES 1
#endif

namespace cfg {
constexpr int DM = 4096, TP = 8192, NB = 8, TS = 64, PAST = 2048;
constexpr int MS = NB * TS;
constexpr int M = TP + MS;
constexpr int NQK = 2048, NVA = 2048, QL = 896, KVL = 512, DR = 64, NG = 8192;
constexpr int NINP = 15872;
constexpr int NRAW = 1536;
constexpr int NQB = 3072, NKVBO = 4096;
constexpr int MKV = TP + NB * (PAST + TS);
constexpr int DFF = 11008;
constexpr float EPS = 1e-6f;
constexpr size_t O_Y = 0, O_DKP = 35651584, O_DVP = 52428800, O_CKVP = 69206016, O_KPEP = 73400320, O_CONVP = 73924608,
                 O_DKS = 73946624, O_DVS = 74995200, O_CKVS = 76043776, O_KPES = 76305920, O_CONVS = 76338688, O_END = 76514816;
}
namespace pg8 {
#define PG8_LAS __attribute__((address_space(3)))
typedef unsigned short bf16_t;
typedef short bf16x8 __attribute__((ext_vector_type(8)));
typedef float f32x4 __attribute__((ext_vector_type(4)));
typedef unsigned u32x4 __attribute__((ext_vector_type(4)));
constexpr int BM = 256, BK = 64, HALF = 128, HTB = HALF * BK * 2  , STAGE_BYTES = 8 * HTB, NXCD = 8, WGM = 8;

__host__ __device__ __forceinline__ int lds_byte(int r, int c) { const int st = (r >> 4) * 2 + (c >> 5), rr = r & 15, cc = c & 31, ob = rr * 64 + cc * 2; return st * 1024 + (ob ^ (((ob >> 9) & 1) << 5)); }
__host__ __device__ __forceinline__ void stage_rc(int b, int& R, int& C) { const int st = b / 1024, sb = b % 1024, swz = sb ^ (((sb >> 9) & 1) << 5); R = (st >> 1) * 16 + swz / 64; C = (st & 1) * 32 + (swz % 64) / 2; }
__host__ __device__ __forceinline__ int perm32(int rho) { const int n = rho >> 4, i = rho & 15; return 8 * (i >> 2) + 4 * n + (i & 3); }

struct Unit { int pm, pn, kt0, ntk, split, part; };
struct Gemm { const bf16_t* A; const bf16_t* Bt; int M, N, K; };

struct StaticOrder {
    int nM, nN, nwg, G, c;
    __host__ __device__ void init(int M, int N, int G_, int c_) { nM = M / BM; nN = N / BM; nwg = nM * nN; G = G_; c = c_; }
    __host__ __device__ bool next(int i, Unit& u) const {
        const long L = (long)i * G + c; if (L >= nwg) return false;
        int wgid = (int)L; { const int q = nwg / NXCD, r = nwg % NXCD, xcd = wgid % NXCD, off = wgid / NXCD; wgid = (xcd < r ? xcd * (q + 1) : r * (q + 1) + (xcd - r) * q) + off; }
        const int nig = WGM * nN, gid = wgid / nig, fm = gid * WGM, gsz = (nM - fm) < WGM ? (nM - fm) : WGM;
        u.pm = fm + ((wgid % nig) % gsz); u.pn = (wgid % nig) / gsz; u.kt0 = 0; u.ntk = 0; u.split = 0; u.part = 0; return true;
    }
    __device__ __forceinline__ void a_ready(const Unit&) const {}
    __device__ __forceinline__ void done(const Unit&) const {}
};

struct SplitTailOrder {
    StaticOrder so; int nt, c;
    __host__ __device__ void init(int K, int c_) { so.init(8192, 4096, 256, c_); nt = K / BK; c = c_; }
    __host__ __device__ bool next(int i, Unit& u) const {
        if (i < 2) return so.next(i, u);
        if (i > 2) return false;
        const int tt = c >> 3, s = c & 7, q = nt >> 1, qb = q >> 3, qr = q & 7;
        u.pm = 32 + (tt & 1); u.pn = tt >> 1; u.kt0 = 2 * (s * qb + (s < qr ? s : qr)); u.ntk = 2 * (qb + (s < qr ? 1 : 0)); u.split = s + 1; u.part = 0; return true;
    }
    __device__ __forceinline__ void a_ready(const Unit&) const {}
    __device__ __forceinline__ void done(const Unit&) const {}
};
struct SplitTailOrder2 {
    StaticOrder so; int nt, c;
    __host__ __device__ void init(int K, int c_) { so.init(8192, 4096, 256, c_); nt = K / BK; c = c_; }
    __host__ __device__ bool next(int i, Unit& u) const {
        if (i < 4) { if (!so.next(i >> 1, u)) return false; u.ntk = nt >> 1; u.kt0 = (i & 1) * (nt >> 1); u.part = 1 + (i & 1); return true; }
        if (i > 4) return false;
        const int tt = c >> 3, s = c & 7, q = nt >> 1, qb = q >> 3, qr = q & 7;
        u.pm = 32 + (tt & 1); u.pn = tt >> 1; u.kt0 = 2 * (s * qb + (s < qr ? s : qr)); u.ntk = 2 * (qb + (s < qr ? 1 : 0)); u.split = s + 1; u.part = 0; return true;
    }
    __device__ __forceinline__ void a_ready(const Unit&) const {}
    __device__ __forceinline__ void done(const Unit&) const {}
};
typedef float f32x2c_t __attribute__((ext_vector_type(2))); typedef __bf16 bf16x2c_t __attribute__((ext_vector_type(2)));
__device__ __forceinline__ unsigned cvt_pk_bf16(float lo, float hi) { f32x2c_t v = {lo, hi}; bf16x2c_t b = __builtin_convertvector(v, bf16x2c_t); return __builtin_bit_cast(unsigned, b); }
typedef float f32x2 __attribute__((ext_vector_type(2)));
__device__ __forceinline__ u32x4 pack8(const f32x4 v0, const f32x4 v1) { u32x4 w; w.x = cvt_pk_bf16(v0[0], v0[1]); w.y = cvt_pk_bf16(v0[2], v0[3]); w.z = cvt_pk_bf16(v1[0], v1[1]); w.w = cvt_pk_bf16(v1[2], v1[3]); return w; }
__device__ __forceinline__ void unpack8(const u32x4 w, f32x4& a, f32x4& b) {
    a[0] = __uint_as_float(w.x << 16); a[1] = __uint_as_float(w.x & 0xffff0000u); a[2] = __uint_as_float(w.y << 16); a[3] = __uint_as_float(w.y & 0xffff0000u);
    b[0] = __uint_as_float(w.z << 16); b[1] = __uint_as_float(w.z & 0xffff0000u); b[2] = __uint_as_float(w.w << 16); b[3] = __uint_as_float(w.w & 0xffff0000u); }
__device__ __forceinline__ float sigmoidf_(float x) { return __builtin_amdgcn_rcpf(1.0f + __expf(-x)); }

struct EpiPlain {
    static constexpr bool PERM = true, AFTER_DRAIN = false;
    bf16_t* O; int ldc;
    __device__ __forceinline__ void operator()(const f32x4 (&acc)[2][2][4][2], const Unit& u, int wr, int wc, int fr, int fq) const {
        const int row0 = u.pm * BM + wr * 64 + fr, col0 = u.pn * BM + wc * 32 + 8 * fq;
#pragma unroll
        for (int ai = 0; ai < 2; ++ai)
#pragma unroll
            for (int m = 0; m < 4; ++m) { bf16_t* rowp = O + (size_t)(row0 + ai * HALF + m * 16) * ldc + col0;
#pragma unroll
                for (int bj = 0; bj < 2; ++bj) *(u32x4*)(rowp + bj * HALF) = pack8(acc[ai][bj][m][0], acc[ai][bj][m][1]); }
    }
};

constexpr float QSCALE_A = 0.125f * 1.4426950408889634f, QSCALE_B = 0.07216878364870322f * 1.4426950408889634f;
struct EpiIn {
    static constexpr bool PERM = true, AFTER_DRAIN = false;
    bf16_t* QA; bf16_t* KA; bf16_t* VA; bf16_t* G; float* RAW; float* out; const float* b_gate; const float* tabA;
    __device__ __forceinline__ void operator()(const f32x4 (&acc)[2][2][4][2], const Unit& u, int wr, int wc, int fr, int fq) const {
        const int pn = u.pn; const bool smp = u.pm >= 32;
        const int row0 = u.pm * BM + wr * 64 + fr, cw = wc * 32 + 8 * fq;
        if (pn < 16) {
            const bool isk = pn >= 8; bf16_t* dst = isk ? KA : QA; const int cb = (pn & 7) * BM + cw;
            float* fo = out + (smp ? (cfg::O_DKS - (size_t)cfg::TP * 2048) : cfg::O_DKP);
            const bool ropew = (wc & 1) == 0;
#pragma unroll
            for (int ah = 0; ah < 4; ++ah) {
                const int ai = ah >> 1, mh = ah & 1;
                f32x4 tq[2][4];
                if (ropew) {
#pragma unroll
                    for (int mm = 0; mm < 2; ++mm) { const int row = row0 + ai * HALF + (mh * 2 + mm) * 16; const int pos = smp ? 2048 + (row & 63) : row; const f32x4* tp = (const f32x4*)(tabA + (size_t)pos * 16);
                        tq[mm][0] = tp[0]; tq[mm][1] = tp[1]; tq[mm][2] = tp[2]; tq[mm][3] = tp[3]; } }
#pragma unroll
                for (int mm = 0; mm < 2; ++mm) {
                    const int m = mh * 2 + mm; const int row = row0 + ai * HALF + m * 16;
                    f32x4 t0 = {1.f, 0.f, 1.f, 0.f}, t1 = t0, t2 = t0, t3 = t0;
                    if (ropew) { t0 = tq[mm][0]; t1 = tq[mm][1]; t2 = tq[mm][2]; t3 = tq[mm][3]; }
#pragma unroll
                    for (int bj = 0; bj < 2; ++bj) {
                        f32x4 v0 = acc[ai][bj][m][0], v1 = acc[ai][bj][m][1];
                        if (ropew) {
                            f32x4 p0, p1;
#pragma unroll
                            for (int e = 0; e < 4; ++e) { p0[e] = __shfl_xor(v0[e], 16); p1[e] = __shfl_xor(v1[e], 16); }
                            const float sg = (fq == 0) ? -1.f : 1.f;
                            if (fq < 2) {
                                v0[0] = v0[0] * t0[0] + sg * p0[0] * t0[1]; v0[1] = v0[1] * t0[2] + sg * p0[1] * t0[3];
                                v0[2] = v0[2] * t1[0] + sg * p0[2] * t1[1]; v0[3] = v0[3] * t1[2] + sg * p0[3] * t1[3];
                                v1[0] = v1[0] * t2[0] + sg * p1[0] * t2[1]; v1[1] = v1[1] * t2[2] + sg * p1[1] * t2[3];
                                v1[2] = v1[2] * t3[0] + sg * p1[2] * t3[1]; v1[3] = v1[3] * t3[2] + sg * p1[3] * t3[3];
                            }
                        }
                        const size_t off = (size_t)row * 2048 + cb + bj * HALF;
                        if (isk) { *(u32x4*)(dst + off) = pack8(v0, v1); *(f32x4*)(fo + off) = v0; *(f32x4*)(fo + off + 4) = v1; }
                        else *(u32x4*)(dst + off) = pack8(v0 * QSCALE_A, v1 * QSCALE_A);
                    }
                }
            }
        } else if (pn < 24) {
            const int cb = (pn - 16) * BM + cw; float* fo = out + (smp ? (cfg::O_DVS - (size_t)cfg::TP * 2048) : cfg::O_DVP);
#pragma unroll
            for (int ai = 0; ai < 2; ++ai)
#pragma unroll
                for (int m = 0; m < 4; ++m) { const int row = row0 + ai * HALF + m * 16;
#pragma unroll
                    for (int bj = 0; bj < 2; ++bj) { const size_t off = (size_t)row * 2048 + cb + bj * HALF; const f32x4 v0 = acc[ai][bj][m][0], v1 = acc[ai][bj][m][1];
                        *(u32x4*)(VA + off) = pack8(v0, v1); *(f32x4*)(fo + off) = v0; *(f32x4*)(fo + off + 4) = v1; } }
        } else if (pn < 56) {
            const int cb = (pn - 24) * BM + cw;
            f32x4 bv[2][2];
#pragma unroll
            for (int bj = 0; bj < 2; ++bj) { bv[bj][0] = *(const f32x4*)(b_gate + cb + bj * HALF); bv[bj][1] = *(const f32x4*)(b_gate + cb + bj * HALF + 4); }
#pragma unroll
            for (int ai = 0; ai < 2; ++ai)
#pragma unroll
                for (int m = 0; m < 4; ++m) { const int row = row0 + ai * HALF + m * 16;
#pragma unroll
                    for (int bj = 0; bj < 2; ++bj) { f32x4 v0 = acc[ai][bj][m][0] + bv[bj][0], v1 = acc[ai][bj][m][1] + bv[bj][1];
#pragma unroll
                        for (int e = 0; e < 4; ++e) { v0[e] = sigmoidf_(v0[e]); v1[e] = sigmoidf_(v1[e]); }
                        *(u32x4*)(G + (size_t)row * 8192 + cb + bj * HALF) = pack8(v0, v1); } }
        } else {
            const int cb = (pn - 56) * BM + cw;
#pragma unroll
            for (int ai = 0; ai < 2; ++ai)
#pragma unroll
                for (int m = 0; m < 4; ++m) { const int row = row0 + ai * HALF + m * 16;
#pragma unroll
                    for (int bj = 0; bj < 2; ++bj) { float* p = RAW + (size_t)row * cfg::NRAW + cb + bj * HALF; *(f32x4*)p = acc[ai][bj][m][0]; *(f32x4*)(p + 4) = acc[ai][bj][m][1]; } }
        }
    }
};

struct EpiQB {
    static constexpr bool PERM = true, AFTER_DRAIN = false;
    bf16_t* QB; const float* tabB;
    __device__ __forceinline__ void operator()(const f32x4 (&acc)[2][2][4][2], const Unit& u, int wr, int wc, int fr, int fq) const {
        const bool smp = u.pm >= 32; const int row0 = u.pm * BM + wr * 64 + fr, col0 = u.pn * BM + wc * 32 + 8 * fq;
#pragma unroll
        for (int bj = 0; bj < 2; ++bj) {
            const int g6 = (u.pn * 8 + bj * 4 + wc) % 6; const bool pe = g6 >= 4; const int i0 = 16 * (g6 - 4) + 4 * fq;
#pragma unroll
            for (int ai = 0; ai < 2; ++ai)
#pragma unroll
                for (int m = 0; m < 4; ++m) { const int row = row0 + ai * HALF + m * 16; const int pos = smp ? 2048 + (row & 63) : row;
                    f32x4 v0 = acc[ai][bj][m][0], v1 = acc[ai][bj][m][1];
                    if (pe) { const f32x4* tp = (const f32x4*)(tabB + ((size_t)pos * 32 + i0) * 2); const f32x4 ta = tp[0], tb = tp[1];
                        f32x4 w0, w1;
                        w0[0] = v0[0] * ta[0] - v0[1] * ta[1]; w0[1] = v0[1] * ta[0] + v0[0] * ta[1];
                        w0[2] = v0[2] * ta[2] - v0[3] * ta[3]; w0[3] = v0[3] * ta[2] + v0[2] * ta[3];
                        w1[0] = v1[0] * tb[0] - v1[1] * tb[1]; w1[1] = v1[1] * tb[0] + v1[0] * tb[1];
                        w1[2] = v1[2] * tb[2] - v1[3] * tb[3]; w1[3] = v1[3] * tb[2] + v1[2] * tb[3];
                        v0 = w0; v1 = w1; }
                    *(u32x4*)(QB + (size_t)row * cfg::NQB + col0 + bj * HALF) = pack8(v0 * QSCALE_B, v1 * QSCALE_B); }
        }
    }
};

__device__ __forceinline__ void slab_store(float* slab, const f32x4 (&acc)[2][2][4][2], const Unit& u, int wr, int wc, int fr, int fq) {
    const int row0 = (u.pm - 32) * BM + wr * 64 + fr, col0 = u.pn * BM + wc * 32 + 8 * fq; float* sb = slab + (size_t)(u.split - 1) * 512 * 4096;
#pragma unroll
    for (int ai = 0; ai < 2; ++ai)
#pragma unroll
        for (int m = 0; m < 4; ++m)
#pragma unroll
            for (int bj = 0; bj < 2; ++bj) { float* p = sb + (size_t)(row0 + ai * HALF + m * 16) * 4096 + col0 + bj * HALF; *(f32x4*)p = acc[ai][bj][m][0]; *(f32x4*)(p + 4) = acc[ai][bj][m][1]; }
}
struct EpiY {
    static constexpr bool PERM = true, AFTER_DRAIN = false;
    const bf16_t* G; bf16_t* MB; float* slab;
    __device__ __forceinline__ void operator()(f32x4 (&acc)[2][2][4][2], const Unit& u, int wr, int wc, int fr, int fq) const {
        if (u.split) { slab_store(slab, acc, u, wr, wc, fr, fq); return; }
        const int row0 = u.pm * BM + wr * 64 + fr, col0 = u.pn * BM + wc * 32 + 8 * fq;
#pragma unroll
        for (int ai = 0; ai < 2; ++ai)
#pragma unroll
            for (int mh = 0; mh < 2; ++mh) {
                u32x4 g0q[2][2], g1q[2][2];
#pragma unroll
                for (int mm = 0; mm < 2; ++mm)
#pragma unroll
                    for (int bj = 0; bj < 2; ++bj) { const bf16_t* gp = G + (size_t)(row0 + ai * HALF + (mh * 2 + mm) * 16) * 8192 + col0 + bj * HALF;
                        g1q[mm][bj] = *(const u32x4*)(gp + 4096); if (u.part == 1) g0q[mm][bj] = *(const u32x4*)gp; }
#pragma unroll
                for (int mm = 0; mm < 2; ++mm)
#pragma unroll
                    for (int bj = 0; bj < 2; ++bj) { const int m = mh * 2 + mm; f32x4 a1, b1; unpack8(g1q[mm][bj], a1, b1);
                        if (u.part == 1) { f32x4 a0, b0; unpack8(g0q[mm][bj], a0, b0);
#pragma unroll
                            for (int e = 0; e < 4; ++e) { acc[ai][bj][m][0][e] *= a0[e] * __builtin_amdgcn_rcpf(fmaxf(a1[e], 1e-30f)); acc[ai][bj][m][1][e] *= b0[e] * __builtin_amdgcn_rcpf(fmaxf(b1[e], 1e-30f)); } }
                        else { const int row = row0 + ai * HALF + m * 16, col = col0 + bj * HALF;
                            *(u32x4*)(MB + (size_t)row * 4096 + col) = pack8(acc[ai][bj][m][0] * a1, acc[ai][bj][m][1] * b1); } }
            }
    }
};
struct EpiRes {
    static constexpr bool PERM = true, AFTER_DRAIN = false;
    const float* base_p; const float* base_s; float* out; float* slab;
    __device__ __forceinline__ void operator()(const f32x4 (&acc)[2][2][4][2], const Unit& u, int wr, int wc, int fr, int fq) const {
        if (u.split) { slab_store(slab, acc, u, wr, wc, fr, fq); return; }
        const int row0 = u.pm * BM + wr * 64 + fr, col0 = u.pn * BM + wc * 32 + 8 * fq; const bool smp = u.pm >= 32;
        const float* bs = smp ? base_s - (size_t)cfg::TP * 4096 : base_p;
#pragma unroll
        for (int ai = 0; ai < 2; ++ai)
#pragma unroll
            for (int mh = 0; mh < 2; ++mh) {
                f32x4 bq[2][2][2];
#pragma unroll
                for (int mm = 0; mm < 2; ++mm)
#pragma unroll
                    for (int bj = 0; bj < 2; ++bj) { const size_t off = (size_t)(row0 + ai * HALF + (mh * 2 + mm) * 16) * 4096 + col0 + bj * HALF;
                        bq[mm][bj][0] = *(const f32x4*)(bs + off); bq[mm][bj][1] = *(const f32x4*)(bs + off + 4); }
#pragma unroll
                for (int mm = 0; mm < 2; ++mm)
#pragma unroll
                    for (int bj = 0; bj < 2; ++bj) { const int m = mh * 2 + mm; const size_t off = (size_t)(row0 + ai * HALF + m * 16) * 4096 + col0 + bj * HALF;
                        *(f32x4*)(out + off) = bq[mm][bj][0] + acc[ai][bj][m][0]; *(f32x4*)(out + off + 4) = bq[mm][bj][1] + acc[ai][bj][m][1]; }
            }
    }
};
__device__ __forceinline__ float dpp_ror1(float x) { return __int_as_float(__builtin_amdgcn_update_dpp(0, __float_as_int(x), 0x121, 0xf, 0xf, false)); }
__device__ __forceinline__ float dpp_ror2(float x) { return __int_as_float(__builtin_amdgcn_update_dpp(0, __float_as_int(x), 0x122, 0xf, 0xf, false)); }
struct EpiGU2 {
    static constexpr bool PERM = true, AFTER_DRAIN = false;
    bf16_t* ACT; float* out; const float* wconv; const float* bconv; const float* stc; float* topug; float* topu; float* bot; PG8_LAS float* xch;
    __device__ __forceinline__ void operator()(const f32x4 (&acc)[2][2][4][2], const Unit& u, int wr, int wc, int fr, int fq) const {
        const int pm = u.pm, chl = wc * 32 + 8 * fq, ch0 = u.pn * HALF + chl; const bool smp = pm >= 32;
        const int row0 = pm * BM + wr * 64 + fr;
        if (fr >= 14) {
#pragma unroll
            for (int ai = 0; ai < 2; ++ai)
#pragma unroll
                for (int n = 0; n < 2; ++n) *(PG8_LAS f32x4*)(xch + ((ai * 2 + wr) * 2 + (fr - 14)) * 128 + chl + 4 * n) = acc[ai][0][3][n];
        }
        f32x4 w0[2], w1[2], w2[2], bb[2];
#pragma unroll
        for (int n = 0; n < 2; ++n) { w0[n] = *(const f32x4*)(wconv + ch0 + 4 * n); w1[n] = *(const f32x4*)(wconv + cfg::DFF + ch0 + 4 * n); w2[n] = *(const f32x4*)(wconv + 2 * cfg::DFF + ch0 + 4 * n); bb[n] = *(const f32x4*)(bconv + ch0 + 4 * n); }
        asm volatile("s_waitcnt lgkmcnt(0)" ::: "memory"); __builtin_amdgcn_s_barrier(); asm volatile("" ::: "memory");
#pragma unroll
        for (int ai = 0; ai < 2; ++ai) {
            f32x4 H1[2], H2[2];
            if (smp) { const int b = (pm - 32) * 4 + ai * 2 + wr;
#pragma unroll
                for (int n = 0; n < 2; ++n) { H2[n] = *(const f32x4*)(stc + (size_t)(b * 2 + 0) * cfg::DFF + ch0 + 4 * n); H1[n] = *(const f32x4*)(stc + (size_t)(b * 2 + 1) * cfg::DFF + ch0 + 4 * n); } }
            else if (ai == 0 && wr == 0) {
#pragma unroll
                for (int n = 0; n < 2; ++n) { H1[n] = (f32x4){0.f, 0.f, 0.f, 0.f}; H2[n] = H1[n]; } }
            else { const int sa = wr ? ai : ai - 1, sw = wr ? 0 : 1;
#pragma unroll
                for (int n = 0; n < 2; ++n) { H2[n] = *(const PG8_LAS f32x4*)(xch + ((sa * 2 + sw) * 2 + 0) * 128 + chl + 4 * n); H1[n] = *(const PG8_LAS f32x4*)(xch + ((sa * 2 + sw) * 2 + 1) * 128 + chl + 4 * n); } }
            if (!smp && ai == 0 && wr == 0 && pm >= 1 && fr < 2) {
#pragma unroll
                for (int n = 0; n < 2; ++n) { *(f32x4*)(topug + (size_t)(pm * 2 + fr) * cfg::DFF + ch0 + 4 * n) = acc[0][0][0][n]; *(f32x4*)(topu + (size_t)(pm * 2 + fr) * cfg::DFF + ch0 + 4 * n) = acc[0][1][0][n]; } }
            if (!smp && ai == 1 && wr == 1 && fr >= 14) {
#pragma unroll
                for (int n = 0; n < 2; ++n) *(f32x4*)(bot + (size_t)(pm * 2 + (fr - 14)) * cfg::DFF + ch0 + 4 * n) = acc[1][0][3][n]; }
#pragma unroll
            for (int m = 0; m < 4; ++m) { const int row = row0 + ai * HALF + m * 16;
                f32x4 a[2];
#pragma unroll
                for (int n = 0; n < 2; ++n)
#pragma unroll
                    for (int e = 0; e < 4; ++e) { const float x = acc[ai][0][m][n][e];
                        const float r1 = dpp_ror1(x), r2 = dpp_ror2(x);
                        float q1, q2;
                        if (m > 0) { q1 = dpp_ror1(acc[ai][0][m > 0 ? m - 1 : 0][n][e]); q2 = dpp_ror2(acc[ai][0][m > 0 ? m - 1 : 0][n][e]); }
                        else { q1 = H1[n][e]; q2 = (fr == 1) ? H1[n][e] : H2[n][e]; }
                        const float p1 = fr >= 1 ? r1 : q1, p2 = fr >= 2 ? r2 : q2;
                        const float c = bb[n][e] + w0[n][e] * p2 + w1[n][e] * p1 + w2[n][e] * x;
                        a[n][e] = c * __builtin_amdgcn_rcpf(1.f + __expf(-c)) * acc[ai][1][m][n][e]; }
                *(u32x4*)(ACT + (size_t)row * cfg::DFF + ch0) = pack8(a[0], a[1]);
                if ((row & 63) >= 62 && row >= cfg::TP - 2) {
                    float* p = (row < cfg::TP) ? out + cfg::O_CONVP + (size_t)(row - (cfg::TP - 2)) * cfg::DFF + ch0
                                               : out + cfg::O_CONVS + (size_t)(((row - cfg::TP) >> 6) * 2 + ((row & 63) - 62)) * cfg::DFF + ch0;
                    *(f32x4*)p = acc[ai][0][m][0]; *(f32x4*)(p + 4) = acc[ai][0][m][1]; } }
        }
        asm volatile("s_waitcnt lgkmcnt(0)" ::: "memory"); __builtin_amdgcn_s_barrier(); asm volatile("" ::: "memory");
    }
};
template <class Epi, class Sched, bool ALIGN_EPI = false, bool SP2 = false>
__device__ __forceinline__ void gemm_phase(PG8_LAS unsigned char* lds, const Gemm g, const Sched& S, const Epi& E) {
    const int tid = threadIdx.x, wid = __builtin_amdgcn_readfirstlane(tid >> 6), lane = tid & 63, wr = wid >> 2, wc = wid & 3, fr = lane & 15, fq = lane >> 4;
    const int K = g.K, nt = K / BK;
    unsigned voffA[2], voffB[2];
#pragma unroll
    for (int i = 0; i < 2; ++i) { int R, C; stage_rc(tid * 16 + i * 8192, R, C); const int Rb = Epi::PERM ? ((R & ~31) + perm32(R & 31)) : R;
        voffA[i] = (unsigned)(R * K + C) * 2u; voffB[i] = (unsigned)(Rb * K + C) * 2u; }
    const size_t kstep = (size_t)(BK * 2);
    const size_t hstep = (size_t)HALF * K * 2;
    const size_t tstep = 2 * hstep;
    const unsigned ldsw = (unsigned)wid * 1024u;
    const int aoff = lds_byte(wr * 64 + fr, fq * 8), boff = lds_byte(wc * 32 + fr, fq * 8);
#define PG8_SA(b, h) (((b) * 2 + (h)) * HTB)
#define PG8_SB(b, h) ((4 + (b) * 2 + (h)) * HTB)
#define PG8_STAGE(bufoff, gbase, voff) do { _Pragma("unroll") for (int _i = 0; _i < 2; ++_i) \
        __builtin_amdgcn_global_load_lds((const unsigned*)((const char*)(gbase) + (voff)[_i]), (PG8_LAS unsigned*)(lds + (bufoff) + ldsw + _i * 8192), 16, 0, 0); } while (0)
#define PG8_LDA(dst, b, h) do { _Pragma("unroll") for (int m = 0; m < 4; ++m) _Pragma("unroll") for (int k = 0; k < 2; ++k) dst[m][k] = *(const PG8_LAS bf16x8*)(lds + PG8_SA(b, h) + aoff + m * 2048 + k * 1024); } while (0)
#define PG8_LDB(dst, b, h) do { _Pragma("unroll") for (int n = 0; n < 2; ++n) _Pragma("unroll") for (int k = 0; k < 2; ++k) dst[n][k] = *(const PG8_LAS bf16x8*)(lds + PG8_SB(b, h) + boff + n * 2048 + k * 1024); } while (0)
#define PG8_MMA(ai, bj, At, Bt) do { __builtin_amdgcn_s_setprio(1); _Pragma("unroll") for (int m = 0; m < 4; ++m) _Pragma("unroll") for (int n = 0; n < 2; ++n) _Pragma("unroll") for (int k = 0; k < 2; ++k) \
        acc[ai][bj][m][n] = __builtin_amdgcn_mfma_f32_16x16x32_bf16(Bt[n][k], At[m][k], acc[ai][bj][m][n], 0, 0, 0); __builtin_amdgcn_s_setprio(0); } while (0)
#define PG8_WAIT_V(n) asm volatile("s_waitcnt vmcnt(" #n ")" ::: "memory")
#define PG8_WAIT_L(n) asm volatile("s_waitcnt lgkmcnt(" #n ")" ::: "memory")
#define PG8_BAR __builtin_amdgcn_s_barrier()
#define PG8_SCHED __builtin_amdgcn_sched_barrier(0)
    Unit cur, nxt; int ui = 0;
    if (!S.next(0, cur)) return;
    f32x4 acc[2][2][4][2];
#pragma unroll
    for (int a = 0; a < 2; ++a)
#pragma unroll
        for (int b = 0; b < 2; ++b)
#pragma unroll
            for (int m = 0; m < 4; ++m)
#pragma unroll
                for (int n = 0; n < 2; ++n) acc[a][b][m][n] = (f32x4){0.f, 0.f, 0.f, 0.f};
    bf16x8 At[4][2], B0[2][2], B1[2][2];
    const char* cA = (const char*)g.A + (size_t)cur.pm * tstep + (size_t)cur.kt0 * kstep; const char* cB = (const char*)g.Bt + (size_t)cur.pn * tstep + (size_t)cur.kt0 * kstep;
    S.a_ready(cur);
    if constexpr (SP2) {
        PG8_STAGE(PG8_SB(0, 0), cB, voffB); PG8_STAGE(PG8_SB(0, 1), cB + hstep, voffB); PG8_STAGE(PG8_SA(0, 0), cA, voffA); PG8_STAGE(PG8_SA(0, 1), cA + hstep, voffA);
        if (wr == 1) PG8_BAR;
        PG8_WAIT_V(2); PG8_BAR;
        PG8_STAGE(PG8_SB(1, 0), cB + kstep, voffB); PG8_STAGE(PG8_SA(1, 0), cA + kstep, voffA); PG8_STAGE(PG8_SB(1, 1), cB + hstep + kstep, voffB);
        PG8_WAIT_V(6); PG8_BAR;
    } else {
        PG8_STAGE(PG8_SB(0, 0), cB, voffB); PG8_STAGE(PG8_SA(0, 0), cA, voffA); PG8_STAGE(PG8_SB(0, 1), cB + hstep, voffB); PG8_STAGE(PG8_SA(0, 1), cA + hstep, voffA);
        if (wr == 1) PG8_BAR;
        PG8_WAIT_V(4); PG8_BAR;
        PG8_STAGE(PG8_SB(1, 0), cB + kstep, voffB); PG8_STAGE(PG8_SA(1, 0), cA + kstep, voffA); PG8_STAGE(PG8_SB(1, 1), cB + hstep + kstep, voffB);
        PG8_WAIT_V(6); PG8_BAR;
    }
    for (;;) {
        const bool has_next = S.next(ui + 1, nxt);
        const char* nA = has_next ? (const char*)g.A + (size_t)nxt.pm * tstep + (size_t)nxt.kt0 * kstep : cA; const char* nB = has_next ? (const char*)g.Bt + (size_t)nxt.pn * tstep + (size_t)nxt.kt0 * kstep : cB;
        const int ntu = cur.ntk ? cur.ntk : nt;
        for (int t = 0; t < ntu; t += 2) {
            const bool last = (t == ntu - 2);
            const char* a1 = cA + (size_t)(t + 1) * kstep;
            const char* a2 = last ? nA : cA + (size_t)(t + 2) * kstep; const char* b2 = last ? nB : cB + (size_t)(t + 2) * kstep;
            const char* a3 = a2 + kstep; const char* b3 = b2 + kstep;
            if (last && has_next) S.a_ready(nxt);
            if constexpr (SP2) {
            PG8_LDB(B0, 0, 0); PG8_LDB(B1, 0, 1); PG8_SCHED; PG8_LDA(At, 0, 0); PG8_STAGE(PG8_SA(1, 1), a1 + hstep, voffA);
            PG8_WAIT_V(8); PG8_WAIT_L(0); PG8_BAR; PG8_MMA(0, 0, At, B0); PG8_MMA(0, 1, At, B1); PG8_BAR; PG8_SCHED;
            PG8_LDA(At, 0, 1); PG8_STAGE(PG8_SB(0, 0), b2, voffB); PG8_STAGE(PG8_SB(0, 1), b2 + hstep, voffB); PG8_STAGE(PG8_SA(0, 0), a2, voffA);
            PG8_WAIT_V(8); PG8_WAIT_L(0); PG8_BAR; PG8_MMA(1, 0, At, B0); PG8_MMA(1, 1, At, B1); PG8_BAR; PG8_SCHED;
            PG8_LDB(B0, 1, 0); PG8_LDB(B1, 1, 1); PG8_SCHED; PG8_LDA(At, 1, 0); PG8_STAGE(PG8_SA(0, 1), a2 + hstep, voffA);
            PG8_WAIT_V(8); PG8_WAIT_L(0); PG8_BAR; PG8_MMA(0, 0, At, B0); PG8_MMA(0, 1, At, B1); PG8_BAR; PG8_SCHED;
            PG8_LDA(At, 1, 1); PG8_STAGE(PG8_SB(1, 0), b3, voffB); PG8_STAGE(PG8_SB(1, 1), b3 + hstep, voffB); PG8_STAGE(PG8_SA(1, 0), a3, voffA);
            PG8_WAIT_V(8); PG8_WAIT_L(0); PG8_BAR; PG8_MMA(1, 0, At, B0); PG8_MMA(1, 1, At, B1); PG8_BAR; PG8_SCHED;
            } else {
            PG8_LDB(B0, 0, 0); PG8_SCHED; PG8_LDA(At, 0, 0); PG8_STAGE(PG8_SA(1, 1), a1 + hstep, voffA);
            PG8_WAIT_L(8); PG8_BAR; PG8_WAIT_L(0); PG8_MMA(0, 0, At, B0); PG8_BAR; PG8_SCHED;
            PG8_LDB(B1, 0, 1); PG8_STAGE(PG8_SB(0, 0), b2, voffB);
            PG8_BAR; PG8_WAIT_L(0); PG8_MMA(0, 1, At, B1); PG8_BAR;
            PG8_LDA(At, 0, 1); PG8_STAGE(PG8_SA(0, 0), a2, voffA);
            PG8_BAR; PG8_WAIT_L(0); PG8_MMA(1, 0, At, B0); PG8_BAR; PG8_SCHED;
            PG8_STAGE(PG8_SB(0, 1), b2 + hstep, voffB);
            PG8_WAIT_V(6); PG8_BAR; PG8_MMA(1, 1, At, B1); PG8_BAR;
            PG8_LDB(B0, 1, 0); PG8_SCHED; PG8_LDA(At, 1, 0); PG8_STAGE(PG8_SA(0, 1), a2 + hstep, voffA);
            PG8_WAIT_L(8); PG8_BAR; PG8_WAIT_L(0); PG8_MMA(0, 0, At, B0); PG8_BAR; PG8_SCHED;
            PG8_LDB(B1, 1, 1); PG8_STAGE(PG8_SB(1, 0), b3, voffB);
            PG8_BAR; PG8_WAIT_L(0); PG8_MMA(0, 1, At, B1); PG8_BAR;
            PG8_LDA(At, 1, 1); PG8_STAGE(PG8_SA(1, 0), a3, voffA);
            PG8_BAR; PG8_WAIT_L(0); PG8_MMA(1, 0, At, B0); PG8_BAR; PG8_SCHED;
            PG8_STAGE(PG8_SB(1, 1), b3 + hstep, voffB);
            PG8_WAIT_V(6); PG8_BAR; PG8_MMA(1, 1, At, B1); PG8_BAR;
            }
        }
        if constexpr (ALIGN_EPI) { if (wr == 0) PG8_BAR; }
        if constexpr (!Epi::AFTER_DRAIN) { E(acc, cur, wr, wc, fr, fq); S.done(cur); }
        if (!has_next) break;
        if (cur.part != 1)
#pragma unroll
        for (int a = 0; a < 2; ++a)
#pragma unroll
            for (int b = 0; b < 2; ++b)
#pragma unroll
                for (int m = 0; m < 4; ++m)
#pragma unroll
                    for (int n = 0; n < 2; ++n) acc[a][b][m][n] = (f32x4){0.f, 0.f, 0.f, 0.f};
        cur = nxt; cA = nA; cB = nB; ++ui;
        if constexpr (ALIGN_EPI) { if (wr == 1) PG8_BAR; }
    }
    PG8_WAIT_V(0);
    if constexpr (!ALIGN_EPI) { if (wr == 0) PG8_BAR; }
    PG8_BAR;
    if constexpr (Epi::AFTER_DRAIN) { E.fused(acc, cur, wr, wc, fr, fq, lds, wid, lane); S.done(cur); }
#undef PG8_SA
#undef PG8_SB
#undef PG8_STAGE
#undef PG8_LDA
#undef PG8_LDB
#undef PG8_MMA
#undef PG8_WAIT_V
#undef PG8_WAIT_L
#undef PG8_BAR
#undef PG8_SCHED
}
}
#define GAS __attribute__((address_space(1)))
#define LAS __attribute__((address_space(3)))
typedef unsigned short bf16;
typedef unsigned v4u __attribute__((ext_vector_type(4)));
typedef float f32x4 __attribute__((ext_vector_type(4)));
typedef short bf16x8 __attribute__((ext_vector_type(8)));
typedef GAS unsigned gu32;
typedef GAS unsigned long long gu64;
#define RLX_AGENT __ATOMIC_RELAXED, __HIP_MEMORY_SCOPE_AGENT
#define LDS_WAIT() asm volatile("s_waitcnt lgkmcnt(0)" ::: "memory")
#define VM_WAIT() asm volatile("s_waitcnt vmcnt(0)" ::: "memory")
__device__ __forceinline__ unsigned long long rt() { return __builtin_amdgcn_s_memrealtime(); }
__device__ __forceinline__ unsigned f2bf(float f) { unsigned u = __builtin_bit_cast(unsigned, f); return (u + 0x7fffu + ((u >> 16) & 1u)) >> 16; }
__device__ __forceinline__ unsigned pk2(float lo, float hi) { return f2bf(lo) | (f2bf(hi) << 16); }

#define XB_TMO      128
#define XB_XCNT(j)  (256  + 64 * (j))
#define XB_XSUB(j)  (1280 + 64 * (j))
#define XB_XGEN(j)  (2304 + 64 * (j))
#define XB_TOP      3328
#define XB_TOPGEN   3392
#define XCD_BAR_WORDS 3456
#define XB_SPIN_CAP (1u << 18)

__device__ __forceinline__ unsigned xb_ld(unsigned* p)              { return __hip_atomic_load(p, __ATOMIC_RELAXED, __HIP_MEMORY_SCOPE_AGENT); }
__device__ __forceinline__ unsigned xb_add(unsigned* p, unsigned v) { return __hip_atomic_fetch_add(p, v, __ATOMIC_RELAXED, __HIP_MEMORY_SCOPE_AGENT); }
__device__ __forceinline__ unsigned xb_xcc_id() { return (unsigned)__builtin_amdgcn_s_getreg((3 << 11) | 20) & 0xFu; }
#define XB_SPIN(cond, bar) do { unsigned _sp = 0; while (cond) { __builtin_amdgcn_s_sleep(1); \
    if ((++_sp & 255u) == 0u) { if (xb_ld(&(bar)[XB_TMO])) break; if (_sp > XB_SPIN_CAP) { atomicAdd(&(bar)[XB_TMO], 1u); break; } } } } while (0)

struct XcdBarrier {
    unsigned* bar; unsigned x;
    volatile LAS unsigned* st;
};

__device__ __forceinline__ XcdBarrier xcd_barrier_post(unsigned* bar, volatile LAS unsigned* st) {
    XcdBarrier b; b.bar = bar; b.x = xb_xcc_id(); b.st = st;
    if (threadIdx.x == 0) (void)xb_add(&bar[XB_XCNT(b.x)], 1u);
    return b;
}
__device__ __forceinline__ void xcd_barrier_complete(unsigned* bar, unsigned x, unsigned& nloc, unsigned& nx) {
    const unsigned G = gridDim.x * gridDim.y * gridDim.z;
    unsigned sum, cnt, mine, sp = 0u;
    for (;;) {
        sum = 0u; cnt = 0u; mine = 0u;
#pragma unroll
        for (unsigned j = 0; j < 16; ++j) { const unsigned c = xb_ld(&bar[XB_XCNT(j)]); sum += c; cnt += (c > 0u) ? 1u : 0u; mine = (j == x) ? c : mine; }
        if (sum == G) break;
        __builtin_amdgcn_s_sleep(1);
        if ((++sp & 255u) == 0u) { if (xb_ld(&bar[XB_TMO])) break; if (sp > XB_SPIN_CAP) { atomicAdd(&bar[XB_TMO], 1u); break; } }
    }
    nloc = mine > 0u ? mine : 1u; nx = cnt > 0u ? cnt : 1u;
}

__device__ __forceinline__ void xcd_barrier(const XcdBarrier& b) {
    asm volatile("s_waitcnt vmcnt(0)" ::: "memory");
    __syncthreads();
    if (threadIdx.x == 0) {
        unsigned* bar = b.bar;
        __builtin_amdgcn_s_waitcnt(0);
        unsigned nloc = b.st[0], nx = b.st[1];
        if (nloc == 0u) { xcd_barrier_complete(bar, b.x, nloc, nx); b.st[0] = nloc; b.st[1] = nx; }
        const unsigned old = xb_add(&bar[XB_XSUB(b.x)], 1u);
        const unsigned gen = old / nloc;
        if (old + 1u == (gen + 1u) * nloc) {
            __builtin_amdgcn_fence(__ATOMIC_RELEASE, "agent");
            asm volatile("s_waitcnt vmcnt(0)" ::: "memory");
            const unsigned og = xb_add(&bar[XB_TOP], 1u);
            const unsigned tg = og / nx;
            if (og + 1u == (tg + 1u) * nx) xb_add(&bar[XB_TOPGEN], 1u);
            else XB_SPIN(xb_ld(&bar[XB_TOPGEN]) == tg, bar);
            __builtin_amdgcn_fence(__ATOMIC_ACQUIRE, "agent");
            xb_add(&bar[XB_XGEN(b.x)], 1u);
            asm volatile("s_waitcnt vmcnt(0)" ::: "memory");
        } else {
            XB_SPIN(xb_ld(&bar[XB_XGEN(b.x)]) == gen, bar);
            __builtin_amdgcn_fence(__ATOMIC_ACQUIRE, "agent");
            asm volatile("s_waitcnt vmcnt(0)" ::: "memory");
        }
    }
    __syncthreads();
}
namespace att {
typedef unsigned short bf16_t;
using bf16x8 = __attribute__((ext_vector_type(8))) short;
using s16x4  = __attribute__((ext_vector_type(4))) short;
using f32x16 = __attribute__((ext_vector_type(16))) float;
using f32x8  = __attribute__((ext_vector_type(8))) float;
using u32x4  = __attribute__((ext_vector_type(4))) unsigned;
constexpr int NW = 8, QBLK = 32, KVBLK = 64;
constexpr int SHM_V = KVBLK * 128 * 2;
constexpr int SHM_KMAX = KVBLK * 192 * 2;
constexpr int LDS_V = 0, LDS_K = 2 * SHM_V, LDS_WS = LDS_K + 2 * SHM_KMAX, LDS_BYTES = LDS_WS + NW * 64 * 4;
#define ASBAR() __builtin_amdgcn_sched_barrier(0)
__device__ __forceinline__ int crow(int r, int hi) { return (r & 3) + 8 * (r >> 2) + 4 * hi; }
typedef float f32x2c_t __attribute__((ext_vector_type(2))); typedef __bf16 bf16x2c_t __attribute__((ext_vector_type(2)));
__device__ __forceinline__ unsigned cvtpk(float lo, float hi) { f32x2c_t v = {lo, hi}; bf16x2c_t b = __builtin_convertvector(v, bf16x2c_t); return __builtin_bit_cast(unsigned, b); }
template <typename TIn> struct Stage;
template <> struct Stage<bf16_t> { using T = bf16x8; static constexpr int NLD = 1;
  __device__ static __forceinline__ T ld8(const bf16_t* p) { return *reinterpret_cast<const bf16x8*>(p); }
  __device__ static __forceinline__ bf16x8 tobf(T x) { return x; } };
template <> struct Stage<float> { using T = f32x8; static constexpr int NLD = 2;
  __device__ static __forceinline__ T ld8(const float* p) { return *reinterpret_cast<const f32x8*>(p); }
  __device__ static __forceinline__ bf16x8 tobf(T x) { u32x4 w = {cvtpk(x[0], x[1]), cvtpk(x[2], x[3]), cvtpk(x[4], x[5]), cvtpk(x[6], x[7])}; return *reinterpret_cast<bf16x8*>(&w); } };

template <int NDQ> __device__ __forceinline__ int kswz(int row, int ch) { return row * (32 * NDQ) + ((ch ^ ((row >> 1) & 7)) << 4); }

__device__ __forceinline__ void partialSM(f32x16& p0, f32x16& p1, float& m_reg, float& mn, float& alpha, const float C, const float THRS) {
  float pmax = p0[0];
#pragma unroll
  for (int r = 1; r < 16; ++r) pmax = fmaxf(pmax, p0[r]);
#pragma unroll
  for (int r = 0; r < 16; ++r) pmax = fmaxf(pmax, p1[r]);
  { auto rr = __builtin_amdgcn_permlane32_swap(__float_as_uint(pmax), __float_as_uint(pmax), false, false);
    pmax = fmaxf(__uint_as_float(rr[0]), __uint_as_float(rr[1])); }
  if (__builtin_expect(__all(pmax - m_reg <= THRS), 1)) { mn = m_reg; alpha = 1.f; }
  else { mn = fmaxf(m_reg, pmax); alpha = __builtin_amdgcn_exp2f((m_reg - mn) * C); m_reg = mn; }
  const float mnC = -mn * C;
#pragma unroll
  for (int r = 0; r < 16; ++r) p0[r] = fmaf(p0[r], C, mnC);
#pragma unroll
  for (int r = 0; r < 16; ++r) p1[r] = fmaf(p1[r], C, mnC);
#pragma unroll
  for (int r = 0; r < 16; ++r) p0[r] = __builtin_amdgcn_exp2f(p0[r]);
}
__device__ __forceinline__ void finishSM(f32x16& p0, f32x16& p1, float alpha, float& l_reg, bf16x8& pa0, bf16x8& pa1, bf16x8& pa2, bf16x8& pa3) {
#pragma unroll
  for (int r = 0; r < 16; ++r) p1[r] = __builtin_amdgcn_exp2f(p1[r]);
  float ps = 0;
#pragma unroll
  for (int r = 0; r < 16; ++r) ps += p0[r];
#pragma unroll
  for (int r = 0; r < 16; ++r) ps += p1[r];
  { auto rr = __builtin_amdgcn_permlane32_swap(__float_as_uint(ps), __float_as_uint(ps), false, false);
    ps = __uint_as_float(rr[0]) + __uint_as_float(rr[1]); }
  l_reg = l_reg * alpha + ps;
#define ATT_PK4(P, BASE, OUT) do { unsigned a0 = cvtpk(P[BASE + 0], P[BASE + 1]), a1 = cvtpk(P[BASE + 2], P[BASE + 3]);   \
    unsigned b0 = cvtpk(P[BASE + 4], P[BASE + 5]), b1 = cvtpk(P[BASE + 6], P[BASE + 7]);                              \
    auto r0 = __builtin_amdgcn_permlane32_swap(a0, b0, false, false); auto r1 = __builtin_amdgcn_permlane32_swap(a1, b1, false, false); \
    u32x4 w = {r0[0], r1[0], r0[1], r1[1]}; OUT = *reinterpret_cast<bf16x8*>(&w); } while (0)
  ATT_PK4(p0, 0, pa0); ATT_PK4(p0, 8, pa1); ATT_PK4(p1, 0, pa2); ATT_PK4(p1, 8, pa3);
#undef ATT_PK4
}
__device__ __forceinline__ void partialSM_neg(f32x16& p0, f32x16& p1, float& mhat, f32x16& negm, float& alpha, const bool first, const float THR2) {
  float pmax = p0[0];
#pragma unroll
  for (int r = 1; r < 16; ++r) pmax = fmaxf(pmax, p0[r]);
#pragma unroll
  for (int r = 0; r < 16; ++r) pmax = fmaxf(pmax, p1[r]);
  { auto rr = __builtin_amdgcn_permlane32_swap(__float_as_uint(pmax), __float_as_uint(pmax), false, false);
    pmax = fmaxf(__uint_as_float(rr[0]), __uint_as_float(rr[1])); }
  if (__builtin_expect(!first && __all(pmax <= THR2), 1)) { alpha = 1.f; }
  else { const float d = first ? pmax : fmaxf(pmax, 0.f); mhat += d; alpha = first ? 1.f : __builtin_amdgcn_exp2f(-d);
#pragma unroll
    for (int r = 0; r < 16; ++r) { p0[r] -= d; p1[r] -= d; }
#pragma unroll
    for (int r = 0; r < 16; ++r) negm[r] = -mhat; }
#pragma unroll
  for (int r = 0; r < 16; ++r) p0[r] = __builtin_amdgcn_exp2f(p0[r]);
}
template <int NDQ> __device__ __forceinline__ void qkt(f32x16& p0, f32x16& p1, const char* Ks, const bf16x8 (&qr)[NDQ], int r32, int hi, const f32x16 cin = f32x16{}) {
  p0 = cin; p1 = cin;
  const int f = (r32 >> 1) & 7; int kb[4];
#pragma unroll
  for (int q = 0; q < 4; ++q) kb[q] = r32 * (32 * NDQ) + (((2 * q + hi) ^ f) << 4);
#pragma unroll
  for (int d0 = 0; d0 < NDQ; ++d0) { const char* kp = Ks + kb[d0 & 3] + 128 * (d0 >> 2);
    const bf16x8 b0 = *reinterpret_cast<const bf16x8*>(kp);
    const bf16x8 b1 = *reinterpret_cast<const bf16x8*>(kp + 32 * 32 * NDQ);
    p0 = __builtin_amdgcn_mfma_f32_32x32x16_bf16(b0, qr[d0], p0, 0, 0, 0);
    p1 = __builtin_amdgcn_mfma_f32_32x32x16_bf16(b1, qr[d0], p1, 0, 0, 0); }
}
__device__ __forceinline__ int v_st(int k, int c) { const int kk = (k & ~0xC) | ((k & 4) << 1) | ((k & 8) >> 1); return ((kk >> 3) * 4 + (c >> 5)) * 512 + ((kk & 7) * 32 + (c & 31)) * 2; }
__device__ __forceinline__ int v_rd_base(int lane) { return ((lane & 3) << 3) | (((lane >> 2) & 3) << 6) | (((lane >> 4) & 1) << 5) | (((lane >> 5) & 1) << 8); }
constexpr int v_rd_off(int d0, int ks, int half) { return d0 * 512 + ks * 4096 + half * 2048; }
template <int OFF> __device__ __forceinline__ s16x4 tr_read(int vb) { s16x4 r; asm volatile("ds_read_b64_tr_b16 %0, %1 offset:%2" : "=&v"(r) : "v"(vb), "i"(OFF) : "memory"); return r; }
template <int D0> __device__ __forceinline__ void pv_one(f32x16& od, int vb, bf16x8 pa0, bf16x8 pa1, bf16x8 pa2, bf16x8 pa3) {
  const s16x4 l0 = tr_read<v_rd_off(D0, 0, 0)>(vb), h0 = tr_read<v_rd_off(D0, 0, 1)>(vb), l1 = tr_read<v_rd_off(D0, 1, 0)>(vb), h1 = tr_read<v_rd_off(D0, 1, 1)>(vb);
  const s16x4 l2 = tr_read<v_rd_off(D0, 2, 0)>(vb), h2 = tr_read<v_rd_off(D0, 2, 1)>(vb), l3 = tr_read<v_rd_off(D0, 3, 0)>(vb), h3 = tr_read<v_rd_off(D0, 3, 1)>(vb);
  asm volatile("s_waitcnt lgkmcnt(0)" ::: "memory"); ASBAR();
#define ATT_PK(L, H) (bf16x8){L[0], L[1], L[2], L[3], H[0], H[1], H[2], H[3]}
  od = __builtin_amdgcn_mfma_f32_32x32x16_bf16(pa0, ATT_PK(l0, h0), od, 0, 0, 0);
  od = __builtin_amdgcn_mfma_f32_32x32x16_bf16(pa1, ATT_PK(l1, h1), od, 0, 0, 0);
  od = __builtin_amdgcn_mfma_f32_32x32x16_bf16(pa2, ATT_PK(l2, h2), od, 0, 0, 0);
  od = __builtin_amdgcn_mfma_f32_32x32x16_bf16(pa3, ATT_PK(l3, h3), od, 0, 0, 0);
#undef ATT_PK
}
__device__ __forceinline__ void pv_d0(f32x16 (&o)[4], int vb, bf16x8 pa0, bf16x8 pa1, bf16x8 pa2, bf16x8 pa3) {
  pv_one<0>(o[0], vb, pa0, pa1, pa2, pa3); pv_one<1>(o[1], vb, pa0, pa1, pa2, pa3); pv_one<2>(o[2], vb, pa0, pa1, pa2, pa3); pv_one<3>(o[3], vb, pa0, pa1, pa2, pa3);
}

__device__ __forceinline__ void glds16(const void* gsrc, unsigned lds_dst) { unsigned keep;
  asm volatile("s_mov_b32 %0, m0\n\ts_mov_b32 m0, %2\n\ts_nop 0\n\tglobal_load_lds_dwordx4 %1, off\n\ts_mov_b32 m0, %0" : "=&s"(keep) : "v"(gsrc), "s"(lds_dst) : "memory"); }
template <typename TKV> struct Src { const TKV* kp; const TKV* kn; const TKV* k2p; const TKV* k2n; const TKV* vp; const TKV* vn; int npast, nvalid; };

template <int NDQ, typename TKV, int LDK, int LDK2, int LDV>
__device__ __forceinline__ void attn_core(const bf16x8 (&qr)[NDQ], const Src<TKV>& S, const int NT, const int limit, const bool active, const float C, const float THRS,
                                          char* lds, f32x16 (&o)[4], float& l_reg) {
  using St = Stage<TKV>;
  constexpr int SHM_K = KVBLK * 32 * NDQ;
  int tid_ = threadIdx.x; asm volatile("" : "+v"(tid_));
  const int tid = tid_, wid = tid >> 6, lane = tid & 63, r32 = lane & 31, hi = lane >> 5;
  char* V_lds = lds + LDS_V; char* K_lds = lds + LDS_K;
  float* al_l = (float*)(lds + LDS_WS) + wid * 64 + 32;
  float m_reg = -1e30f; l_reg = 0.f;
#pragma unroll
  for (int d = 0; d < 4; ++d) o[d] = f32x16{};
  const int sr = tid >> 4, sc = (tid & 15) * 8;
  const int vr = (sr & ~3) + (tid & 3), vc = ((sr & 3) * 4 + ((tid & 15) >> 2)) * 8, vst0 = v_st(vr, vc), vst1 = v_st(32 + vr, vc);
  const int kr8 = tid >> 3, kc8 = tid & 7;
  const int vb0 = (int)(uintptr_t)V_lds + v_rd_base(lane);
  struct Slot { typename St::T vs0, vs1, ks0, ks1, ks2; } sl[1];
#define ATT_SLOAD(i, j) do { const int jj_ = (j) < S.nvalid ? (j) : S.nvalid - 1; const bool ps_ = jj_ < S.npast; const long r0_ = ps_ ? (long)jj_ * 64 : (long)(jj_ - S.npast) * 64; \
    const TKV* vb_ = ps_ ? S.vp : S.vn; const TKV* kb_ = ps_ ? S.kp : S.kn; \
    sl[i].vs0 = St::ld8(vb_ + (r0_ + vr) * LDV + vc); sl[i].vs1 = St::ld8(vb_ + (r0_ + 32 + vr) * LDV + vc); \
    if constexpr (NDQ == 4) { sl[i].ks0 = St::ld8(kb_ + (r0_ + kr8) * LDK + kc8 * 8); } \
    else { const TKV* k2_ = ps_ ? S.k2p : S.k2n; sl[i].ks0 = St::ld8(kb_ + (r0_ + sr) * LDK + sc); sl[i].ks1 = St::ld8(kb_ + (r0_ + 32 + sr) * LDK + sc); sl[i].ks2 = St::ld8(k2_ + (r0_ + kr8) * LDK2 + kc8 * 8); } } while (0)
#define ATT_SWRITE(b, i) do { *(bf16x8*)(V_lds + (b) * SHM_V + vst0) = St::tobf(sl[i].vs0); *(bf16x8*)(V_lds + (b) * SHM_V + vst1) = St::tobf(sl[i].vs1); \
    if constexpr (NDQ == 4) { *(bf16x8*)(K_lds + (b) * SHM_K + kswz<NDQ>(kr8, kc8)) = St::tobf(sl[i].ks0); } \
    else { *(bf16x8*)(K_lds + (b) * SHM_K + kswz<NDQ>(sr, tid & 15)) = St::tobf(sl[i].ks0); *(bf16x8*)(K_lds + (b) * SHM_K + kswz<NDQ>(32 + sr, tid & 15)) = St::tobf(sl[i].ks1); \
           *(bf16x8*)(K_lds + (b) * SHM_K + kswz<NDQ>(kr8, 16 + kc8)) = St::tobf(sl[i].ks2); } } while (0)
#define ATT_RESC(a) do { if (__any((a) < 1.f)) { if (hi == 0) al_l[r32] = (a); asm volatile("s_waitcnt lgkmcnt(0)" ::: "memory"); \
    _Pragma("unroll") for (int d = 0; d < 4; ++d) _Pragma("unroll") for (int r = 0; r < 16; ++r) o[d][r] *= al_l[crow(r, hi)]; } } while (0)
#define ATT_MASK(P0, P1, j) do { if ((j) > limit) { _Pragma("unroll") for (int r = 0; r < 16; ++r) { P0[r] = -1e30f; P1[r] = -1e30f; } } } while (0)
  constexpr bool DMA = sizeof(TKV) == 2;
  const int wu = __builtin_amdgcn_readfirstlane(wid);
  const unsigned lds0 = (unsigned)(uintptr_t)lds;
  unsigned dK[3] = {0u, 0u, 0u}, dV[2] = {0u, 0u};
  if constexpr (DMA) {
    if constexpr (NDQ == 4) { const int row = 8 * wu + (lane >> 3), c = (lane & 7) ^ ((row >> 1) & 7); dK[0] = (unsigned)(row * LDK + c * 8); }
    else {
#pragma unroll
      for (int i = 0; i < 3; ++i) { const int b = (3 * wu + i) * 1024 + lane * 16, row = b / 384, cs = (b - row * 384) >> 4, c = (cs & ~7) | ((cs & 7) ^ ((row >> 1) & 7));
        dK[i] = c < 16 ? (unsigned)(row * LDK + c * 8) : (0x80000000u | (unsigned)(row * LDK2 + (c - 16) * 8)); } }
#pragma unroll
    for (int i = 0; i < 2; ++i) { const int sub = 2 * (2 * wu + i) + (lane >> 5), kk = (sub >> 2) * 8 + ((lane & 31) >> 2), k = (kk & ~0xC) | ((kk & 4) << 1) | ((kk & 8) >> 1), c = (sub & 3) * 32 + (lane & 3) * 8;
      dV[i] = (unsigned)(k * LDV + c); }
  }
#define ATT_DMA(b, j) do { const int jj_ = (j) < S.nvalid ? (j) : S.nvalid - 1; const bool ps_ = jj_ < S.npast; const long r0_ = ps_ ? (long)jj_ * 64 : (long)(jj_ - S.npast) * 64; \
    const TKV* kb_ = (ps_ ? S.kp : S.kn) + r0_ * LDK; const TKV* vb_ = (ps_ ? S.vp : S.vn) + r0_ * LDV; \
    if constexpr (NDQ == 4) glds16(kb_ + dK[0], lds0 + LDS_K + (b) * SHM_K + wu * 1024); \
    else { const TKV* k2_ = (ps_ ? S.k2p : S.k2n) + r0_ * LDK2; _Pragma("unroll") for (int i_ = 0; i_ < 3; ++i_) glds16((dK[i_] >> 31) ? k2_ + (dK[i_] & 0x7fffffffu) : kb_ + dK[i_], lds0 + LDS_K + (b) * SHM_K + (3 * wu + i_) * 1024); } \
    glds16(vb_ + dV[0], lds0 + LDS_V + (b) * SHM_V + (2 * wu) * 1024); glds16(vb_ + dV[1], lds0 + LDS_V + (b) * SHM_V + (2 * wu + 1) * 1024); } while (0)
  f32x16 pA0, pA1; float alA = 1.f; bf16x8 pa0, pa1, pa2, pa3;
  f32x16 negm = f32x16{}; m_reg = 0.f;
  if constexpr (DMA) { ATT_DMA(0, 0); asm volatile("s_waitcnt vmcnt(0)" ::: "memory"); } else { ATT_SLOAD(0, 0); asm volatile("s_waitcnt vmcnt(0)" ::: "memory"); ATT_SWRITE(0, 0); }
  __syncthreads();
#pragma unroll 1
  for (int j = 0; j < NT; ++j) {
    const int cur = j & 1;
    if (j + 1 < NT) { if constexpr (DMA) ATT_DMA(cur ^ 1, j + 1); else ATT_SLOAD(0, j + 1); }
    ASBAR();
    if (active && j <= limit) {
      qkt<NDQ>(pA0, pA1, K_lds + cur * SHM_K, qr, r32, hi, negm); partialSM_neg(pA0, pA1, m_reg, negm, alA, j == 0, THRS * C);
      ATT_RESC(alA);
      finishSM(pA0, pA1, alA, l_reg, pa0, pa1, pa2, pa3);
      ASBAR();
      pv_d0(o, vb0 + cur * SHM_V, pa0, pa1, pa2, pa3);
    }
    ASBAR();
    if constexpr (DMA) asm volatile("s_waitcnt vmcnt(0)" ::: "memory"); else { if (j + 1 < NT) ATT_SWRITE(cur ^ 1, 0); }
    __syncthreads();
  }
#undef ATT_DMA
#undef ATT_SLOAD
#undef ATT_SWRITE
#undef ATT_RESC
#undef ATT_MASK
}
__device__ __forceinline__ void normalize(f32x16 (&o)[4], float l_reg, char* lds, int wid, int r32, int hi) {
  float* li_l = (float*)(lds + LDS_WS) + wid * 64;
  if (hi == 0) li_l[r32] = l_reg;
  asm volatile("s_waitcnt lgkmcnt(0)" ::: "memory");
#pragma unroll
  for (int r = 0; r < 16; ++r) { const float rl = __builtin_amdgcn_rcpf(li_l[crow(r, hi)]);
#pragma unroll
    for (int d = 0; d < 4; ++d) o[d][r] *= rl; }
}
__device__ __forceinline__ unsigned short f2bf1(float f) { unsigned u = __builtin_bit_cast(unsigned, f); return (unsigned short)((u + 0x7fffu + ((u >> 16) & 1u)) >> 16); }

constexpr float LOG2E = 1.4426950408889634f;
constexpr float SCALE_A = 0.125f, SCALE_B = 0.07216878364870322f;
constexpr float THR = 8.f;

template <typename TKV>
__device__ __forceinline__ void diff_unit(const bf16_t* QA, long qrow0, int h, const Src<TKV>& S1, const Src<TKV>& S2, int NT, int limit, bool active, float lam,
                                          const float* g_subln, float* stash, bf16_t* OA, char* lds) {
  asm volatile("" : "+s"(h), "+s"(qrow0));
  const int tid = threadIdx.x, wid = tid >> 6, lane = tid & 63, r32 = lane & 31, hi = lane >> 5;
  const long qrow = qrow0 + (active ? wid * QBLK : 0) + r32;
  f32x16 o[4]; float l_reg; float* st = stash + wid * 4096;
  {
    bf16x8 qr[4];
#pragma unroll
    for (int d0 = 0; d0 < 4; ++d0) qr[d0] = *reinterpret_cast<const bf16x8*>(QA + qrow * 2048 + h * 64 + d0 * 16 + hi * 8);
    attn_core<4, TKV, 2048, 64, 2048>(qr, S1, NT, limit, active, SCALE_A * LOG2E, THR / SCALE_A, lds, o, l_reg);
  }
  if (active) { normalize(o, l_reg, lds, wid, r32, hi);
    __attribute__((address_space(1))) float* st1 = (__attribute__((address_space(1))) float*)(st + lane); asm volatile("" : "+v"(st1));
#pragma unroll
    for (int d = 0; d < 4; ++d)
#pragma unroll
      for (int r = 0; r < 16; ++r) st1[(d * 16 + r) * 64] = o[d][r]; }
  {
    bf16x8 qr[4];
#pragma unroll
    for (int d0 = 0; d0 < 4; ++d0) qr[d0] = *reinterpret_cast<const bf16x8*>(QA + qrow * 2048 + (16 + h) * 64 + d0 * 16 + hi * 8);
    attn_core<4, TKV, 2048, 64, 2048>(qr, S2, NT, limit, active, SCALE_A * LOG2E, THR / SCALE_A, lds, o, l_reg);
  }
  if (active) { normalize(o, l_reg, lds, wid, r32, hi);
    float ss[16];
    const __attribute__((address_space(1))) float* st2 = (const __attribute__((address_space(1))) float*)(st + lane); asm volatile("" : "+v"(st2));
#pragma unroll
    for (int r = 0; r < 16; ++r) ss[r] = 0.f;
#pragma unroll
    for (int d = 0; d < 4; ++d)
#pragma unroll
      for (int r = 0; r < 16; ++r) { const float a = st2[(d * 16 + r) * 64] - lam * o[d][r]; o[d][r] = a; ss[r] += a * a; }
#pragma unroll
    for (int r = 0; r < 16; ++r) { float s = ss[r]; s += __shfl_xor(s, 1); s += __shfl_xor(s, 2); s += __shfl_xor(s, 4); s += __shfl_xor(s, 8); s += __shfl_xor(s, 16);
      ss[r] = 0.8f * rsqrtf(s * (1.f / 128.f) + cfg::EPS); }
    __attribute__((address_space(1))) bf16_t* op = (__attribute__((address_space(1))) bf16_t*)(OA + (qrow0 + wid * QBLK + 4 * hi) * 4096 + h * 128 + r32); asm volatile("" : "+v"(op));
#pragma unroll
    for (int d = 0; d < 4; ++d) { const float g = g_subln[d * 32 + r32];
#pragma unroll
      for (int r = 0; r < 16; ++r) op[((r & 3) + 8 * (r >> 2)) * 4096 + d * 32] = f2bf1(o[d][r] * ss[r] * g); }
  }
}
__device__ __forceinline__ void mla_unit(const bf16_t* QB, long qrow0, int h, const Src<bf16_t>& S, int NT, int limit, bool active, bf16_t* OB, char* lds) {
  asm volatile("" : "+s"(h), "+s"(qrow0));
  const int tid = threadIdx.x, wid = tid >> 6, lane = tid & 63, r32 = lane & 31, hi = lane >> 5;
  const long qrow = qrow0 + (active ? wid * QBLK : 0) + r32;
  f32x16 o[4]; float l_reg;
  bf16x8 qr[12];
#pragma unroll
  for (int d0 = 0; d0 < 12; ++d0) qr[d0] = *reinterpret_cast<const bf16x8*>(QB + qrow * 3072 + h * 192 + d0 * 16 + hi * 8);
  attn_core<12, bf16_t, 4096, 64, 4096>(qr, S, NT, limit, active, SCALE_B * LOG2E, THR / SCALE_B, lds, o, l_reg);
  if (active) { normalize(o, l_reg, lds, wid, r32, hi);
    __attribute__((address_space(1))) bf16_t* op = (__attribute__((address_space(1))) bf16_t*)(OB + (qrow0 + wid * QBLK + 4 * hi) * 4096 + h * 128 + r32); asm volatile("" : "+v"(op));
#pragma unroll
    for (int d = 0; d < 4; ++d)
#pragma unroll
      for (int r = 0; r < 16; ++r) op[((r & 3) + 8 * (r >> 2)) * 4096 + d * 32] = f2bf1(o[d][r]); }
}
#undef ASBAR
}
#ifndef PG8_SP2
#define PG8_SP2 true
#endif
constexpr int NWAVES = 8;
constexpr int NPH = 12;
constexpr int N_LAUNCHES = MK_N_LAUNCHES;
static_assert(N_LAUNCHES == 1 || N_LAUNCHES == NPH, "MK_N_LAUNCHES is 1 or 12");

constexpr size_t MiB = 1u << 20;
constexpr size_t WS_CTL = 0, CTL_ZERO_BYTES = 1 * MiB;
constexpr size_t WS_WIN = 1 * MiB;
constexpr size_t WS_WQB = WS_WIN + (size_t)cfg::NINP * 4096 * 2;
constexpr size_t WS_WKVB = WS_WQB + (size_t)3072 * 896 * 2;
constexpr size_t WS_WBA = WS_WKVB + (size_t)4096 * 512 * 2;
constexpr size_t WS_WBB = WS_WBA + (size_t)4096 * 2048 * 2;
constexpr size_t WS_WOUT = WS_WBB + (size_t)4096 * 2048 * 2;
constexpr size_t WS_WGU = WS_WOUT + (size_t)4096 * 4096 * 2;
constexpr size_t WS_WFD = WS_WGU + (size_t)22016 * 4096 * 2;
constexpr size_t WS_TABA = WS_WFD + (size_t)4096 * 11008 * 2;
constexpr size_t WS_TABB = WS_TABA + (size_t)8192 * 8 * 8;
constexpr size_t WS_XN = WS_TABB + (size_t)8192 * 32 * 8;
constexpr size_t WS_R0 = WS_XN + (size_t)cfg::M * 4096 * 2;
constexpr size_t WS_QA = WS_R0;
constexpr size_t WS_KA = WS_QA + (size_t)cfg::M * 2048 * 2;
constexpr size_t WS_VA = WS_KA + (size_t)cfg::M * 2048 * 2;
constexpr size_t WS_RAW = WS_VA + (size_t)cfg::M * 2048 * 2;
constexpr size_t WS_CQN = WS_RAW + (size_t)cfg::M * cfg::NRAW * 4;
constexpr size_t WS_CKV = WS_CQN + (size_t)cfg::M * 896 * 2;
constexpr size_t WS_KPE = WS_CKV + (size_t)cfg::MKV * 512 * 2;
constexpr size_t WS_QB = WS_KPE + (size_t)cfg::MKV * 64 * 2;
constexpr size_t WS_KVB = WS_QB + (size_t)cfg::M * 3072 * 2;
constexpr size_t WS_G = WS_KVB + (size_t)cfg::MKV * 4096 * 2;
constexpr size_t WS_OA = WS_G + (size_t)cfg::M * 8192 * 2;
constexpr size_t WS_OB = WS_OA + (size_t)cfg::M * 2048 * 2;
constexpr size_t WS_STASH = WS_OB + (size_t)cfg::M * 2048 * 2;
constexpr size_t WS_TOPUG = WS_STASH + (size_t)256 * 8 * 4096 * 4;
constexpr size_t WS_TOPU = WS_TOPUG + (size_t)64 * cfg::DFF * 4;
constexpr size_t WS_BOT = WS_TOPU + (size_t)64 * cfg::DFF * 4;
constexpr size_t WS_END = WS_BOT + (size_t)64 * cfg::DFF * 4;
constexpr size_t WS_MB = WS_QA;
constexpr size_t WS_UG = WS_R0;
constexpr size_t WS_U = WS_UG + (size_t)cfg::M * cfg::DFF * 2;
static_assert(WS_U + (size_t)cfg::M * cfg::DFF * 2 <= WS_END, "FFN overlay fits");
static_assert(WS_END < (size_t)1390 * 1000 * 1000, "workspace budget");
constexpr size_t SLAB_BYTES = (size_t)8 * 512 * 4096 * 4;
constexpr size_t WS_SLAB_A = WS_KVB, WS_SLAB_B = WS_KVB + SLAB_BYTES;
constexpr size_t WS_SLAB_D = WS_UG;
static_assert(2 * SLAB_BYTES <= (size_t)cfg::MKV * 4096 * 2 && SLAB_BYTES <= (size_t)cfg::M * cfg::DFF * 2, "slab overlays fit");
constexpr int CW_TMO = 0, CW_CODE = 1, CW_BAR = 4096;

constexpr int RING_OFF = 0, RING_BYTES = 131072;
constexpr int LDSCTL_OFF = RING_BYTES, MISC_OFF = LDSCTL_OFF + 320;
constexpr int XCH_OFF = RING_BYTES + 1024;
constexpr int LDS_BYTES = 147456;
static_assert(att::LDS_BYTES <= RING_BYTES && pg8::STAGE_BYTES <= RING_BYTES, "phase scratch fits the ring region");

struct Args { const float* in[29]; float* out; unsigned char* ws; int ph_lo, ph_hi; };
struct Frame {
    LAS unsigned char* lds; volatile LAS unsigned* MISC; gu32* ctl;
    int tid, wave, vcu, G;
    float* out; unsigned char* ws;
};
__device__ __forceinline__ int lane_id() { int t = threadIdx.x; asm volatile("" : "+v"(t)); return t & 63; }
__device__ __forceinline__ float wave_sum(float v) {
#pragma unroll
    for (int o = 1; o < 64; o <<= 1) v += __shfl_xor(v, o);
    return v;
}
template <int MAP> __device__ __forceinline__ int src_col(int n) {
    if (MAP == 1) { if (n < 6144) return n; if (n < 14336) return 7616 + (n - 6144); if (n < 15808) return 6144 + (n - 14336); return -1; }
    if (MAP == 2) { const int h = n / 192, d = n - h * 192; if (d < 128) return n; const int e = d - 128; return h * 192 + 128 + (e >> 1) + 32 * (e & 1); }
    return n;
}
template <int MAP> __device__ __forceinline__ void p0_transpose_item(const float* W, int K, int Nsrc, int Ndst, bf16* WT, int row_off, LAS float* scr, int item, int lane) {
    const int nblk = Ndst / 32, kb = item / nblk, nb = item - kb * nblk, k0 = 64 * kb, n0 = 32 * nb;
    if constexpr (MAP == 2) {
        const int sn = src_col<MAP>(n0 + (lane & 31));
#pragma unroll 8
        for (int i = 0; i < 32; ++i) { const int kk = 2 * i + (lane >> 5); scr[kk * 33 + (lane & 31)] = W[(size_t)(k0 + kk) * Nsrc + sn]; }
    } else {
        const int n4 = 4 * (lane & 7), kq = lane >> 3;
        const int sn = src_col<MAP>(n0 + n4);
        f32x4 v[8];
#pragma unroll
        for (int i = 0; i < 8; ++i) v[i] = sn >= 0 ? __builtin_nontemporal_load((const GAS f32x4*)(W + (size_t)(k0 + 8 * i + kq) * Nsrc + sn)) : (f32x4){0.f, 0.f, 0.f, 0.f};
#pragma unroll
        for (int i = 0; i < 8; ++i) { LAS float* d = scr + (8 * i + kq) * 33 + n4; d[0] = v[i].x; d[1] = v[i].y; d[2] = v[i].z; d[3] = v[i].w; }
    }
    LDS_WAIT(); asm volatile("" ::: "memory");
    const int c = lane & 7;
#pragma unroll
    for (int j = 0; j < 4; ++j) { const int n = (lane >> 3) + 8 * j; const LAS float* s = scr + (8 * c) * 33 + n;
        v4u o; o.x = pk2(s[0 * 33], s[1 * 33]); o.y = pk2(s[2 * 33], s[3 * 33]); o.z = pk2(s[4 * 33], s[5 * 33]); o.w = pk2(s[6 * 33], s[7 * 33]);
        *(GAS v4u*)(WT + (size_t)(row_off + n0 + n) * K + k0 + 8 * c) = o; }
    LDS_WAIT(); asm volatile("" ::: "memory");
}
struct XItem { const float* W; bf16* WT; int K, Nsrc, Ndst, row_off, item, ilv, Kp, koff; };
__device__ __forceinline__ void xitem_load(const XItem& x, int lane, f32x4 (&v)[8]) {
    const int nblk = x.Ndst / 32, kb = x.item / nblk, nb = x.item - kb * nblk, k0 = 64 * kb, n0 = 32 * nb;
    const int n4 = 4 * (lane & 7), kq = lane >> 3;
#pragma unroll
    for (int i = 0; i < 8; ++i) v[i] = __builtin_nontemporal_load((const GAS f32x4*)(x.W + (size_t)(k0 + 8 * i + kq) * x.Nsrc + n0 + n4));
}
__device__ __forceinline__ void xitem_finish(const XItem& x, int lane, const f32x4 (&v)[8], LAS float* scr) {
    const int nblk = x.Ndst / 32, kb = x.item / nblk, nb = x.item - kb * nblk, k0 = 64 * kb, n0 = 32 * nb;
    const int n4 = 4 * (lane & 7), kq = lane >> 3;
#pragma unroll
    for (int i = 0; i < 8; ++i) { LAS float* d = scr + (8 * i + kq) * 33 + n4; d[0] = v[i].x; d[1] = v[i].y; d[2] = v[i].z; d[3] = v[i].w; }
    LDS_WAIT(); asm volatile("" ::: "memory");
    const int c = lane & 7;
#pragma unroll
    for (int j = 0; j < 4; ++j) { const int n = (lane >> 3) + 8 * j; const LAS float* s = scr + (8 * c) * 33 + n;
        v4u o; o.x = pk2(s[0 * 33], s[1 * 33]); o.y = pk2(s[2 * 33], s[3 * 33]); o.z = pk2(s[4 * 33], s[5 * 33]); o.w = pk2(s[6 * 33], s[7 * 33]);
        const int nn = n0 + n, drow = x.ilv ? ((nn >> 7) << 8) + (nn & 127) + x.row_off : x.row_off + nn;
        *(GAS v4u*)(x.WT + (size_t)drow * x.Kp + x.koff + k0 + 8 * c) = o; }
    LDS_WAIT(); asm volatile("" ::: "memory");
}
template <typename TO> __device__ __forceinline__ void rms_row4096(const float* xrow, const float* gain, TO* orow, int lane) {
    const GAS f32x4* xr = (const GAS f32x4*)xrow + lane; const GAS f32x4* gr = (const GAS f32x4*)gain + lane;
    f32x4 v[16]; float s = 0.f;
#pragma unroll
    for (int j = 0; j < 16; ++j) { v[j] = xr[64 * j]; s += (v[j].x * v[j].x + v[j].y * v[j].y) + (v[j].z * v[j].z + v[j].w * v[j].w); }
    const float rstd = rsqrtf(wave_sum(s) * (1.f / 4096.f) + cfg::EPS);
#pragma unroll
    for (int j = 0; j < 16; ++j) { const f32x4 g = gr[64 * j]; const f32x4 y = v[j] * rstd * g;
        if constexpr (sizeof(TO) == 2) { ((GAS unsigned long long*)orow)[64 * j + lane] = (unsigned long long)pk2(y.x, y.y) | ((unsigned long long)pk2(y.z, y.w) << 32); }
        else { ((GAS f32x4*)orow)[64 * j + lane] = y; } }
}
template <int S0, int S1> __device__ __forceinline__ void slab_sum4(const float* slab, int srow, int q, int lane, f32x4 (&v)[4]) {
#pragma unroll
    for (int s = S0; s < S1; ++s) { const GAS f32x4* p = (const GAS f32x4*)(slab + ((size_t)s * 512 + srow) * 4096 + 1024 * q) + lane;
#pragma unroll
        for (int j = 0; j < 4; ++j) v[j] += p[64 * j]; }
}
__device__ __forceinline__ void p5c_merge_sample(Frame& F) {
    const int srow = 2 * F.vcu + (F.wave >> 2), q = F.wave & 3, lane = lane_id(); if (F.vcu >= 256) return;
    f32x4 a[4], b[4];
#pragma unroll
    for (int j = 0; j < 4; ++j) { a[j] = (f32x4){0.f, 0.f, 0.f, 0.f}; b[j] = a[j]; }
    slab_sum4<0, 4>((const float*)(F.ws + WS_SLAB_A), srow, q, lane, a); slab_sum4<4, 8>((const float*)(F.ws + WS_SLAB_A), srow, q, lane, b);
    const bf16* G = (const bf16*)(F.ws + WS_G) + (size_t)(cfg::TP + srow) * 8192 + 1024 * q; bf16* MB = (bf16*)(F.ws + WS_MB) + (size_t)(cfg::TP + srow) * 4096 + 1024 * q;
#pragma unroll
    for (int j = 0; j < 4; ++j) { const int c = 4 * lane + 256 * j; const unsigned long long g0 = *(const GAS unsigned long long*)(G + c), g1 = *(const GAS unsigned long long*)(G + 4096 + c);
        const float g00 = __uint_as_float((unsigned)g0 << 16), g01 = __uint_as_float((unsigned)g0 & 0xffff0000u), g02 = __uint_as_float((unsigned)(g0 >> 32) << 16), g03 = __uint_as_float((unsigned)(g0 >> 32) & 0xffff0000u);
        const float g10 = __uint_as_float((unsigned)g1 << 16), g11 = __uint_as_float((unsigned)g1 & 0xffff0000u), g12 = __uint_as_float((unsigned)(g1 >> 32) << 16), g13 = __uint_as_float((unsigned)(g1 >> 32) & 0xffff0000u);
        const float m0 = g00 * a[j].x + g10 * b[j].x, m1 = g01 * a[j].y + g11 * b[j].y, m2 = g02 * a[j].z + g12 * b[j].z, m3 = g03 * a[j].w + g13 * b[j].w;
        *(GAS unsigned long long*)(MB + c) = (unsigned long long)pk2(m0, m1) | ((unsigned long long)pk2(m2, m3) << 32); }
}
template <typename TO> __device__ __forceinline__ void sample_rows_norm(Frame& F, const float* base_rows  , const float* slab, float* hout_rows  , const float* gain, TO* yout_rows  , LAS float* xch) {
    const int srow = 2 * (F.vcu & 255) + (F.wave >> 2), q = F.wave & 3, lane = lane_id();
    f32x4 v[4];
    { const GAS f32x4* p = (const GAS f32x4*)(base_rows + (size_t)srow * 4096 + 1024 * q) + lane;
#pragma unroll
      for (int j = 0; j < 4; ++j) v[j] = p[64 * j]; }
    slab_sum4<0, 8>(slab, srow, q, lane, v);
    float s = 0.f;
#pragma unroll
    for (int j = 0; j < 4; ++j) s += (v[j].x * v[j].x + v[j].y * v[j].y) + (v[j].z * v[j].z + v[j].w * v[j].w);
    s = wave_sum(s);
    if (lane == 0) xch[F.wave] = s;
    LDS_WAIT(); __syncthreads();
    const int w0 = F.wave & 4; const float tot = (xch[w0] + xch[w0 + 1]) + (xch[w0 + 2] + xch[w0 + 3]);
    const float rstd = rsqrtf(tot * (1.f / 4096.f) + cfg::EPS);
    const GAS f32x4* gr = (const GAS f32x4*)(gain + 1024 * q) + lane;
    if constexpr (sizeof(TO) == 2) { GAS f32x4* ho = (GAS f32x4*)(hout_rows + (size_t)srow * 4096 + 1024 * q) + lane;
#pragma unroll
        for (int j = 0; j < 4; ++j) ho[64 * j] = v[j]; }
#pragma unroll
    for (int j = 0; j < 4; ++j) { const f32x4 y = v[j] * rstd * gr[64 * j];
        if constexpr (sizeof(TO) == 2) ((GAS unsigned long long*)(yout_rows + (size_t)srow * 4096 + 1024 * q))[64 * j + lane] = (unsigned long long)pk2(y.x, y.y) | ((unsigned long long)pk2(y.z, y.w) << 32);
        else ((GAS f32x4*)(yout_rows + (size_t)srow * 4096 + 1024 * q))[64 * j + lane] = y; }
    __syncthreads();
}
constexpr int I_IN = 64 * (cfg::NINP / 32), I_QB = 14 * 96, I_KVB = 8 * 128, I_BR = 32 * 128, I_OUT = 64 * 128, I_FF = 64 * 344, I_FD = 172 * 128;
constexpr int NITEMS1 = I_QB + I_KVB + 2 * I_BR + I_OUT + 2 * I_FF, NITEMS2 = I_FD;
constexpr int CW_Q1 = 1024, CW_Q2 = 1088;
#ifndef P8_GEMM_WGS
#define P8_GEMM_WGS 248
#endif
#ifndef P1_GEMM_WGS
#define P1_GEMM_WGS 240
#endif
template <int LIST> __device__ __forceinline__ XItem list_item(const Args& A, unsigned char* ws, int r) {
    if (LIST == 2) return XItem{A.in[27], (bf16*)(ws + WS_WFD), cfg::DFF, 4096, 4096, 0, r, 0, cfg::DFF, 0};
    r -= I_QB;
    if (r < I_KVB) return XItem{A.in[18], (bf16*)(ws + WS_WKVB), 512, 4096, 4096, 0, r, 0, 512, 0}; r -= I_KVB;
    if (r < I_BR) return XItem{A.in[14], (bf16*)(ws + WS_WBA), 2048, 4096, 4096, 0, r, 0, 4096, 0}; r -= I_BR;
    if (r < I_BR) return XItem{A.in[19], (bf16*)(ws + WS_WBA), 2048, 4096, 4096, 0, r, 0, 4096, 2048}; r -= I_BR;
    if (r < I_OUT) return XItem{A.in[21], (bf16*)(ws + WS_WOUT), 4096, 4096, 4096, 0, r, 0, 4096, 0}; r -= I_OUT;
    if (r < I_FF) return XItem{A.in[23], (bf16*)(ws + WS_WGU), 4096, cfg::DFF, cfg::DFF, 0, r, 1, 4096, 0}; r -= I_FF;
    return XItem{A.in[24], (bf16*)(ws + WS_WGU), 4096, cfg::DFF, cfg::DFF, 128, r, 1, 4096, 0};
}
template <int LIST> __device__ __forceinline__ void convert_queue(Frame& F, const Args& A) {
    constexpr int QCH = 8, NIT = LIST == 1 ? NITEMS1 : NITEMS2, NSC = LIST == 1 ? I_QB : 0;
    LAS float* scr = (LAS float*)(F.lds + RING_OFF + F.wave * 16384);
    gu32* head = F.ctl + (LIST == 1 ? CW_Q1 : CW_Q2);
    for (;;) {
        unsigned base = 0u; if (lane_id() == 0) base = __hip_atomic_fetch_add(head, (unsigned)QCH, RLX_AGENT);
        base = (unsigned)__builtin_amdgcn_readfirstlane((int)base);
        if (base >= (unsigned)NIT) break;
        const int lo = (int)base, hi = lo + QCH;
        static_assert(NITEMS1 % 8 == 0 && NITEMS2 % 8 == 0 && I_QB % 8 == 0, "chunks never straddle a list end or the scalar-path boundary");
        if (lo < NSC) {
#pragma unroll 1
            for (int it = lo; it < hi; ++it) p0_transpose_item<2>(A.in[16], 896, 3072, 3072, (bf16*)(F.ws + WS_WQB), 0, scr, it, lane_id());
        } else {
            f32x4 va[8], vb[8];
            { const XItem x = list_item<LIST>(A, F.ws, lo); xitem_load(x, lane_id(), va); }
#pragma unroll 1
            for (int it = lo; it < hi; it += 2) {
                { const XItem x = list_item<LIST>(A, F.ws, it + 1); xitem_load(x, lane_id(), vb); }
                { const XItem x = list_item<LIST>(A, F.ws, it); xitem_finish(x, lane_id(), va, scr); }
                if (it + 2 < hi) { const XItem x = list_item<LIST>(A, F.ws, it + 2); xitem_load(x, lane_id(), va); }
                { const XItem x = list_item<LIST>(A, F.ws, it + 1); xitem_finish(x, lane_id(), vb, scr); }
            }
        }
    }
}
__device__ __forceinline__ void p0_prologue(Frame& F, const Args& A) {
    LAS float* scr = (LAS float*)(F.lds + RING_OFF + F.wave * 16384);
    const int gw = F.vcu * NWAVES + F.wave, NGW = F.G * NWAVES;
    unsigned char* ws = F.ws;
    for (int it = gw; it < I_IN; it += NGW) p0_transpose_item<1>(A.in[8], 4096, 15808, cfg::NINP, (bf16*)(ws + WS_WIN), 0, scr, it, lane_id());
    for (int m = gw; m < cfg::M; m += NGW) { const float* xr = m < cfg::TP ? A.in[0] + (size_t)m * 4096 : A.in[1] + (size_t)(m - cfg::TP) * 4096;
        rms_row4096<bf16>(xr, A.in[7], (bf16*)(ws + WS_XN) + (size_t)m * 4096, lane_id()); }
    const int gt = gw * 64 + lane_id(), NGT = NGW * 64;
    float* tabA = (float*)(ws + WS_TABA); float* tabB = (float*)(ws + WS_TABB);
    for (int i = gt; i < 8192 * 40; i += NGT) {
        int pos, fi; float ex; float* dst;
        if (i < 8192 * 8) { pos = i >> 3; fi = i & 7; ex = (float)fi * (1.f / 8.f); dst = tabA + (size_t)i * 2; }
        else { const int k = i - 8192 * 8; pos = k >> 5; fi = k & 31; ex = (float)fi * (1.f / 32.f); dst = tabB + (size_t)k * 2; }
        const float inv = exp2f(-ex * 18.931568569324174f);
        const float ang = (float)pos * inv;
        double rev = (double)ang * 0.15915494309189535; rev -= __builtin_floor(rev);
        const float fr = (float)rev;
        dst[0] = __builtin_amdgcn_cosf(fr); dst[1] = __builtin_amdgcn_sinf(fr);
    }
    { const float* src = A.in[4]; bf16* dst = (bf16*)(ws + WS_CKV) + (size_t)cfg::TP * 512;
      for (int i = gt; i < 16384 * 512 / 8; i += NGT) { const f32x4 a = *(const GAS f32x4*)(src + (size_t)i * 8), b = *(const GAS f32x4*)(src + (size_t)i * 8 + 4);
          v4u o; o.x = pk2(a.x, a.y); o.y = pk2(a.z, a.w); o.z = pk2(b.x, b.y); o.w = pk2(b.z, b.w); *(GAS v4u*)(dst + (size_t)i * 8) = o; } }
    { const float* src = A.in[5]; bf16* dst = (bf16*)(ws + WS_KPE) + (size_t)cfg::TP * 64;
      for (int i = gt; i < 16384 * 8; i += NGT) { const int row = i >> 3, c = i & 7; const f32x4 a = *(const GAS f32x4*)(src + (size_t)row * 64 + 4 * c), b = *(const GAS f32x4*)(src + (size_t)row * 64 + 32 + 4 * c);
          v4u o; o.x = pk2(a.x, b.x); o.y = pk2(a.y, b.y); o.z = pk2(a.z, b.z); o.w = pk2(a.w, b.w); *(GAS v4u*)(dst + (size_t)row * 64 + 8 * c) = o; } }
}
__device__ __forceinline__ void p2_latents(Frame& F, const Args& A) {
    const int gw = F.vcu * NWAVES + F.wave, NGW = F.G * NWAVES, lane = lane_id();
    unsigned char* ws = F.ws; const float* g_qa = A.in[15]; const float* g_kva = A.in[17]; const float* tabB = (const float*)(ws + WS_TABB);
    for (int m = gw; m < cfg::M; m += NGW) {
        const float* raw = (const float*)(ws + WS_RAW) + (size_t)m * cfg::NRAW;
        const bool smp = m >= cfg::TP; const int pos = smp ? 2048 + (m & 63) : m; const size_t mk = smp ? (size_t)m + 16384 : (size_t)m;
        float v[14]; float s = 0.f;
#pragma unroll
        for (int j = 0; j < 14; ++j) { v[j] = raw[64 * j + lane]; s += v[j] * v[j]; }
        float rstd = rsqrtf(wave_sum(s) * (1.f / 896.f) + cfg::EPS);
        bf16* cq = (bf16*)(ws + WS_CQN) + (size_t)m * 896;
#pragma unroll
        for (int j = 0; j < 14; ++j) cq[64 * j + lane] = (bf16)f2bf(v[j] * rstd * g_qa[64 * j + lane]);
        float w[8]; s = 0.f;
#pragma unroll
        for (int j = 0; j < 8; ++j) { w[j] = raw[896 + 64 * j + lane]; s += w[j] * w[j]; }
        rstd = rsqrtf(wave_sum(s) * (1.f / 512.f) + cfg::EPS);
        float* co = smp ? F.out + cfg::O_CKVS + (size_t)(m - cfg::TP) * 512 : F.out + cfg::O_CKVP + (size_t)m * 512;
        bf16* ck = (bf16*)(ws + WS_CKV) + mk * 512;
#pragma unroll
        for (int j = 0; j < 8; ++j) { const float y = w[j] * rstd * g_kva[64 * j + lane]; co[64 * j + lane] = y; ck[64 * j + lane] = (bf16)f2bf(y); }
        if (lane < 32) { const float x1 = raw[1408 + lane], x2 = raw[1440 + lane]; const float c = tabB[((size_t)pos * 32 + lane) * 2], sn = tabB[((size_t)pos * 32 + lane) * 2 + 1];
            const float o1 = x1 * c - x2 * sn, o2 = x2 * c + x1 * sn;
            float* ko = smp ? F.out + cfg::O_KPES + (size_t)(m - cfg::TP) * 64 : F.out + cfg::O_KPEP + (size_t)m * 64;
            ko[lane] = o1; ko[32 + lane] = o2;
            ((GAS unsigned*)((bf16*)(ws + WS_KPE) + mk * 64))[lane] = pk2(o1, o2); }
    }
}
__device__ __forceinline__ void p9_fix(Frame& F, const Args& A) {
    const int gt = (F.vcu * NWAVES + F.wave) * 64 + lane_id(), NGT = F.G * NWAVES * 64;
    const float* topug = (const float*)(F.ws + WS_TOPUG); const float* topu = (const float*)(F.ws + WS_TOPU); const float* bot = (const float*)(F.ws + WS_BOT);
    bf16* ACT = (bf16*)(F.ws + WS_U); const float* wc = A.in[25]; const float* bc = A.in[26];
    constexpr int NCC = cfg::DFF / 8;
    for (int it = gt; it < 31 * 2 * NCC; it += NGT) {
        const int pj = it / NCC, cc = it - pj * NCC, pm = 1 + (pj >> 1), j = pj & 1, col = cc * 8;
        const float* x0 = topug + (size_t)(pm * 2 + j) * cfg::DFF + col;
        const float* x1 = j ? topug + (size_t)(pm * 2) * cfg::DFF + col : bot + (size_t)((pm - 1) * 2 + 1) * cfg::DFF + col;
        const float* x2 = j ? bot + (size_t)((pm - 1) * 2 + 1) * cfg::DFF + col : bot + (size_t)((pm - 1) * 2) * cfg::DFF + col;
        const float* uu = topu + (size_t)(pm * 2 + j) * cfg::DFF + col;
        float a[8];
#pragma unroll
        for (int e = 0; e < 8; ++e) { const float c = bc[col + e] + wc[col + e] * x2[e] + wc[cfg::DFF + col + e] * x1[e] + wc[2 * cfg::DFF + col + e] * x0[e]; a[e] = c * __builtin_amdgcn_rcpf(1.f + __expf(-c)) * uu[e]; }
        v4u o; o.x = pk2(a[0], a[1]); o.y = pk2(a[2], a[3]); o.z = pk2(a[4], a[5]); o.w = pk2(a[6], a[7]);
        *(GAS v4u*)(ACT + (size_t)(pm * 256 + j) * cfg::DFF + col) = o;
    }
}
__device__ __forceinline__ void p4_attention(Frame& F, const Args& A, char* lds) {
    using att::bf16_t; using att::Src;
    unsigned char* ws = F.ws; const int wid = F.wave;
    const bf16_t* QA = (const bf16_t*)(ws + WS_QA); const bf16_t* KA = (const bf16_t*)(ws + WS_KA); const bf16_t* VA = (const bf16_t*)(ws + WS_VA);
    const bf16_t* QB = (const bf16_t*)(ws + WS_QB); const bf16_t* KVB = (const bf16_t*)(ws + WS_KVB); const bf16_t* KPE = (const bf16_t*)(ws + WS_KPE);
    bf16_t* OA = (bf16_t*)(ws + WS_OA); bf16_t* OB = OA + 2048;
    float lam;
    { const float a = A.in[9][lane_id()] * A.in[10][lane_id()], b = A.in[11][lane_id()] * A.in[12][lane_id()]; lam = __expf(wave_sum(a)) - __expf(wave_sum(b)) + 0.2f; }
    const float* g_subln = A.in[13];
    { const int v = F.vcu & 255;
        float* stash = (float*)(ws + WS_STASH) + (size_t)v * 8 * 4096;
        const int h = v >> 4, s = v & 15;
#ifndef ATT_SEL
#define ATT_SEL 7
#endif
#pragma unroll 1
        for (int k = 0; k < ((ATT_SEL & 1) ? 2 : 0); ++k) {
            const int qb = k ? 31 - s : s, NT = 4 * qb + 4, limit = 4 * qb + (wid >> 1);
            Src<bf16_t> S1{KA + h * 64, KA + h * 64, nullptr, nullptr, VA + h * 128, VA + h * 128, NT, NT};
            Src<bf16_t> S2{KA + (16 + h) * 64, KA + (16 + h) * 64, nullptr, nullptr, VA + h * 128, VA + h * 128, NT, NT};
            att::diff_unit<bf16_t>(QA, (long)qb * 256, h, S1, S2, NT, limit, true, lam, g_subln, stash, OA, lds);
        }
#pragma unroll 1
        for (int k = 0; k < ((ATT_SEL & 2) ? 3 : 0); ++k) {
            if (k < 2) { const int qb = k ? 31 - s : s, NT = 4 * qb + 4, limit = 4 * qb + (wid >> 1);
                Src<bf16_t> S{KVB + h * 256, KVB + h * 256, KPE, KPE, KVB + h * 256 + 128, KVB + h * 256 + 128, NT, NT};
                att::mla_unit(QB, (long)qb * 256, h, S, NT, limit, true, OB, lds);
            } else if (v >= 128) { const int b = (v - 128) >> 4, hh = v & 15;
                const bf16_t* kp = KVB + (size_t)(cfg::TP + b * 2048) * 4096 + hh * 256; const bf16_t* kn = KVB + (size_t)(cfg::TP + 16384 + b * 64) * 4096 + hh * 256;
                Src<bf16_t> S{kp, kn, KPE + (size_t)(cfg::TP + b * 2048) * 64, KPE + (size_t)(cfg::TP + 16384 + b * 64) * 64, kp + 128, kn + 128, 32, 33};
                att::mla_unit(QB, (long)cfg::TP + b * 64, hh, S, 34, 32, wid < 2, OB, lds);
            }
        }
        if ((ATT_SEL & 4) && v < 128) { const int b = v >> 4, hh = v & 15;
            const float* kp = A.in[2] + (size_t)b * 2048 * 2048 + hh * 64; const float* kn = F.out + cfg::O_DKS + (size_t)b * 64 * 2048 + hh * 64;
            const float* vp = A.in[3] + (size_t)b * 2048 * 2048 + hh * 128; const float* vn = F.out + cfg::O_DVS + (size_t)b * 64 * 2048 + hh * 128;
            Src<float> S1{kp, kn, nullptr, nullptr, vp, vn, 32, 33};
            Src<float> S2{kp + 16 * 64, kn + 16 * 64, nullptr, nullptr, vp, vn, 32, 33};
            att::diff_unit<float>(QA, (long)cfg::TP + b * 64, hh, S1, S2, 34, 32, wid < 2, lam, g_subln, stash, OA, lds);
        }
    }
}

__global__ void __launch_bounds__(NWAVES * 64, 2) fwd(Args args) {
    extern __shared__ __attribute__((aligned(16))) unsigned char lds[];
    Frame F;
    F.lds = (LAS unsigned char*)lds; F.MISC = (volatile LAS unsigned*)(F.lds + MISC_OFF);
    F.tid = threadIdx.x; F.wave = __builtin_amdgcn_readfirstlane(F.tid >> 6);
    F.G = gridDim.x; { const int bx = blockIdx.x; F.vcu = (F.G % 8 == 0) ? (bx % 8) * (F.G / 8) + bx / 8 : bx; }
    F.out = args.out; F.ws = args.ws; unsigned char* ws = args.ws;
    F.ctl = (gu32*)(ws + WS_CTL);
    for (int u = F.tid; u < (LDS_BYTES - LDSCTL_OFF) / 4; u += NWAVES * 64) ((LAS unsigned*)(F.lds + LDSCTL_OFF))[u] = 0u;
    __syncthreads();
    XcdBarrier bar; bar.bar = (unsigned*)(F.ctl + CW_BAR); bar.x = 0; bar.st = nullptr;
    if (N_LAUNCHES == 1) bar = xcd_barrier_post((unsigned*)(F.ctl + CW_BAR), F.MISC + 8);
#define GRID_BAR() do { if (N_LAUNCHES == 1) xcd_barrier(bar); } while (0)
    const int lo = args.ph_lo, hi = args.ph_hi;
#ifndef PH_MASK
#define PH_MASK 0xFFF
#endif
#define IN(k) (((PH_MASK >> (k)) & 1) && lo <= (k) && (k) < hi)
    typedef pg8::bf16_t pb;
    float* Y = args.out + cfg::O_Y;

    if (IN(0)) { p0_prologue(F, args); GRID_BAR(); }
#ifdef DUP_P0
    if (IN(0)) { p0_prologue(F, args); GRID_BAR(); }
#endif
#ifndef DUP_PH
#define DUP_PH -1
#endif
    if (IN(1)) {
        if (blockIdx.x < P1_GEMM_WGS) {
        pg8::Gemm g{(const pb*)(ws + WS_XN), (const pb*)(ws + WS_WIN), cfg::M, cfg::NINP, 4096}; pg8::StaticOrder S; S.init(cfg::M, cfg::NINP, P1_GEMM_WGS, (int)blockIdx.x);
        pg8::EpiIn E{(pb*)(ws + WS_QA), (pb*)(ws + WS_KA), (pb*)(ws + WS_VA), (pb*)(ws + WS_G), (float*)(ws + WS_RAW), args.out, args.in[20], (const float*)(ws + WS_TABA)};
        pg8::gemm_phase<pg8::EpiIn, pg8::StaticOrder, true, PG8_SP2>(F.lds + RING_OFF, g, S, E);
        }
        __syncthreads(); convert_queue<1>(F, args);
        GRID_BAR();
    }
#if DUP_PH == 1
    if (IN(1)) {
        if (blockIdx.x < P1_GEMM_WGS) {
        pg8::Gemm g{(const pb*)(ws + WS_XN), (const pb*)(ws + WS_WIN), cfg::M, cfg::NINP, 4096}; pg8::StaticOrder S; S.init(cfg::M, cfg::NINP, P1_GEMM_WGS, (int)blockIdx.x);
        pg8::EpiIn E{(pb*)(ws + WS_QA), (pb*)(ws + WS_KA), (pb*)(ws + WS_VA), (pb*)(ws + WS_G), (float*)(ws + WS_RAW), args.out, args.in[20], (const float*)(ws + WS_TABA)};
        pg8::gemm_phase<pg8::EpiIn, pg8::StaticOrder, true, PG8_SP2>(F.lds + RING_OFF, g, S, E);
        }
        __syncthreads(); convert_queue<1>(F, args);
        GRID_BAR();
    }
#endif
    if (IN(2)) { p2_latents(F, args); GRID_BAR(); }
    if (IN(3)) {
        { pg8::Gemm g{(const pb*)(ws + WS_CQN), (const pb*)(ws + WS_WQB), cfg::M, cfg::NQB, 896}; pg8::StaticOrder S; S.init(cfg::M, cfg::NQB, F.G, (int)blockIdx.x);
          pg8::EpiQB E{(pb*)(ws + WS_QB), (const float*)(ws + WS_TABB)};
          pg8::gemm_phase<pg8::EpiQB, pg8::StaticOrder, true, PG8_SP2>(F.lds + RING_OFF, g, S, E); }
        __syncthreads();
        { pg8::Gemm g{(const pb*)(ws + WS_CKV), (const pb*)(ws + WS_WKVB), cfg::MKV, cfg::NKVBO, 512}; pg8::StaticOrder S; S.init(cfg::MKV, cfg::NKVBO, F.G, (int)((blockIdx.x + F.G / 2) % F.G));
          pg8::EpiPlain E{(pb*)(ws + WS_KVB), cfg::NKVBO};
          pg8::gemm_phase<pg8::EpiPlain, pg8::StaticOrder, true, PG8_SP2>(F.lds + RING_OFF, g, S, E); }
        GRID_BAR();
    }
    if (IN(4)) { p4_attention(F, args, (char*)lds + RING_OFF); GRID_BAR(); }
#ifdef DUP_P4
    if (IN(4)) { p4_attention(F, args, (char*)lds + RING_OFF); GRID_BAR(); }
#endif
    if (IN(5)) {
        { pg8::Gemm g{(const pb*)(ws + WS_OA), (const pb*)(ws + WS_WBA), cfg::M, 4096, 4096}; pg8::SplitTailOrder2 S; S.init(4096, (int)blockIdx.x);
          pg8::EpiY E{(const pb*)(ws + WS_G), (pb*)(ws + WS_MB), (float*)(ws + WS_SLAB_A)};
          pg8::gemm_phase<pg8::EpiY, pg8::SplitTailOrder2, true, PG8_SP2>(F.lds + RING_OFF, g, S, E); }
        GRID_BAR();
        p5c_merge_sample(F);
        GRID_BAR();
    }
    if (IN(6)) {
        pg8::Gemm g{(const pb*)(ws + WS_MB), (const pb*)(ws + WS_WOUT), cfg::M, 4096, 4096}; pg8::SplitTailOrder S; S.init(4096, (int)blockIdx.x);
        pg8::EpiRes E{args.in[0], args.in[1], Y, (float*)(ws + WS_SLAB_A)};
        pg8::gemm_phase<pg8::EpiRes, pg8::SplitTailOrder, true, PG8_SP2>(F.lds + RING_OFF, g, S, E);
        GRID_BAR();
    }
#if DUP_PH == 6
    if (IN(6)) {
        pg8::Gemm g{(const pb*)(ws + WS_MB), (const pb*)(ws + WS_WOUT), cfg::M, 4096, 4096}; pg8::SplitTailOrder S; S.init(4096, (int)blockIdx.x);
        pg8::EpiRes E{args.in[0], args.in[1], Y, (float*)(ws + WS_SLAB_A)};
        pg8::gemm_phase<pg8::EpiRes, pg8::SplitTailOrder, true, PG8_SP2>(F.lds + RING_OFF, g, S, E);
        GRID_BAR();
    }
#endif
    if (IN(7)) {
        const int gw = F.vcu * NWAVES + F.wave, NGW = F.G * NWAVES;
        sample_rows_norm<bf16>(F, args.in[1], (const float*)(ws + WS_SLAB_A), Y + (size_t)cfg::TP * 4096, args.in[22], (bf16*)(ws + WS_XN) + (size_t)cfg::TP * 4096, (LAS float*)(F.lds + RING_OFF));
        for (int m = gw; m < cfg::TP; m += NGW) rms_row4096<bf16>(Y + (size_t)m * 4096, args.in[22], (bf16*)(ws + WS_XN) + (size_t)m * 4096, lane_id());
        GRID_BAR();
    }
    if (IN(8)) {
        if (blockIdx.x < P8_GEMM_WGS) {
        pg8::Gemm g{(const pb*)(ws + WS_XN), (const pb*)(ws + WS_WGU), cfg::M, 2 * cfg::DFF, 4096}; pg8::StaticOrder S; S.init(cfg::M, 2 * cfg::DFF, P8_GEMM_WGS, (int)blockIdx.x);
        pg8::EpiGU2 E{(pb*)(ws + WS_U), args.out, args.in[25], args.in[26], args.in[6], (float*)(ws + WS_TOPUG), (float*)(ws + WS_TOPU), (float*)(ws + WS_BOT), (LAS float*)(F.lds + XCH_OFF)};
        pg8::gemm_phase<pg8::EpiGU2, pg8::StaticOrder, true, PG8_SP2>(F.lds + RING_OFF, g, S, E);
        }
        __syncthreads(); convert_queue<2>(F, args);
        GRID_BAR();
    }
#if DUP_PH == 8
    if (IN(8)) {
        if (blockIdx.x < P8_GEMM_WGS) {
        pg8::Gemm g{(const pb*)(ws + WS_XN), (const pb*)(ws + WS_WGU), cfg::M, 2 * cfg::DFF, 4096}; pg8::StaticOrder S; S.init(cfg::M, 2 * cfg::DFF, P8_GEMM_WGS, (int)blockIdx.x);
        pg8::EpiGU2 E{(pb*)(ws + WS_U), args.out, args.in[25], args.in[26], args.in[6], (float*)(ws + WS_TOPUG), (float*)(ws + WS_TOPU), (float*)(ws + WS_BOT), (LAS float*)(F.lds + XCH_OFF)};
        pg8::gemm_phase<pg8::EpiGU2, pg8::StaticOrder, true, PG8_SP2>(F.lds + RING_OFF, g, S, E);
        }
        __syncthreads(); convert_queue<2>(F, args);
        GRID_BAR();
    }
#endif
    if (IN(9)) { p9_fix(F, args); GRID_BAR(); }
    if (IN(10)) {
        pg8::Gemm g{(const pb*)(ws + WS_U), (const pb*)(ws + WS_WFD), cfg::M, 4096, cfg::DFF}; pg8::SplitTailOrder S; S.init(cfg::DFF, (int)blockIdx.x);
        pg8::EpiRes E{Y, Y + (size_t)cfg::TP * 4096, Y, (float*)(ws + WS_SLAB_D)};
        pg8::gemm_phase<pg8::EpiRes, pg8::SplitTailOrder, true, PG8_SP2>(F.lds + RING_OFF, g, S, E);
        GRID_BAR();
    }
#if DUP_PH == 10
    if (IN(10)) {
        pg8::Gemm g{(const pb*)(ws + WS_U), (const pb*)(ws + WS_WFD), cfg::M, 4096, cfg::DFF}; pg8::SplitTailOrder S; S.init(cfg::DFF, (int)blockIdx.x);
        pg8::EpiRes E{Y, Y + (size_t)cfg::TP * 4096, Y, (float*)(ws + WS_SLAB_D)};
        pg8::gemm_phase<pg8::EpiRes, pg8::SplitTailOrder, true, PG8_SP2>(F.lds + RING_OFF, g, S, E);
        GRID_BAR();
    }
#endif
    if (IN(11)) {
        const int gw = F.vcu * NWAVES + F.wave, NGW = F.G * NWAVES;
        sample_rows_norm<float>(F, Y + (size_t)cfg::TP * 4096, (const float*)(ws + WS_SLAB_D), Y + (size_t)cfg::TP * 4096, args.in[28], Y + (size_t)cfg::TP * 4096, (LAS float*)(F.lds + RING_OFF));
        for (int m = gw; m < cfg::TP; m += NGW) rms_row4096<float>(Y + (size_t)m * 4096, args.in[28], Y + (size_t)m * 4096, lane_id());
    }
#ifdef DBG_COPY
    if (lo <= DBG_COPY && DBG_COPY < hi) {
        const size_t gt = (size_t)(F.vcu * NWAVES + F.wave) * 64 + lane_id(), NGT = (size_t)F.G * NWAVES * 64;
        const v4u* s0 = (const v4u*)(ws + WS_WQB); v4u* d0 = (v4u*)Y; const size_t n0 = (size_t)(WS_WGU - WS_WQB) / 16;
        for (size_t i = gt; i < n0; i += NGT) d0[i] = s0[i];
        const v4u* s1 = (const v4u*)(ws + WS_WFD); v4u* d1 = d0 + n0; const size_t n1 = (size_t)60000000 / 16;
        for (size_t i = gt; i < n1; i += NGT) d1[i] = s1[i];
    }
#endif
#undef IN
#undef GRID_BAR
}

extern "C" void kernel_launch(void* const* d_in, const int* in_sizes, int n_in, void* d_out, int out_size, void* d_ws, size_t ws_size, hipStream_t stream) {
    static int grid = 0;
    if (grid == 0) {
        if (n_in != 29 || in_sizes[0] != cfg::TP * 4096 || (size_t)out_size != cfg::O_END || ws_size < WS_END) {
            fprintf(stderr, "kernel_launch: shape mismatch: n_in %d in0 %d out %d ws %zu (need %zu); nothing launched\n", n_in, n_in > 0 ? in_sizes[0] : -1, out_size, ws_size, (size_t)WS_END); grid = -1; return; }
        int dev = 0, cus = 0, per_cu = 0;
        if (hipGetDevice(&dev) != hipSuccess || hipDeviceGetAttribute(&cus, hipDeviceAttributeMultiprocessorCount, dev) != hipSuccess) { grid = -1; return; }
        if (hipFuncSetAttribute((const void*)fwd, hipFuncAttributeMaxDynamicSharedMemorySize, LDS_BYTES) != hipSuccess) { fprintf(stderr, "kernel_launch: hipFuncSetAttribute failed\n"); grid = -1; return; }
        if (hipOccupancyMaxActiveBlocksPerMultiprocessor(&per_cu, (const void*)fwd, NWAVES * 64, LDS_BYTES) != hipSuccess || per_cu < 1)
            fprintf(stderr, "kernel_launch: note: occupancy query reports %d workgroups per CU\n", per_cu);
        (void)hipGetLastError();
        if (cus < 256) { fprintf(stderr, "kernel_launch: built for a 256-CU device (got %d); nothing launched\n", cus); grid = -1; return; }
        grid = 256;
    }
    if (grid < 0) return;
    if (hipMemsetAsync((char*)d_ws + WS_CTL, 0, CTL_ZERO_BYTES, stream) != hipSuccess) { fprintf(stderr, "kernel_launch: memset failed\n"); return; }
    Args a{};
    for (int i = 0; i < 29; ++i) a.in[i] = (const float*)d_in[i];
    a.out = (float*)d_out; a.ws = (unsigned char*)d_ws;
    for (int li = 0; li < N_LAUNCHES; ++li) {
        a.ph_lo = (N_LAUNCHES == 1) ? 0 : li; a.ph_hi = (N_LAUNCHES == 1) ? NPH : li + 1;
        hipLaunchKernelGGL(fwd, dim3(grid), dim3(NWAVES * 64), LDS_BYTES, stream, a);
        const hipError_t le = hipPeekAtLastError();
        if (le != hipSuccess) { fprintf(stderr, "kernel_launch: launch %d failed: %s\n", li, hipGetErrorName(le)); break; }
    }
}
```

```cpp
#include <hip/hip_runtime.h>
#include <hip/hip_bf16.h>
#include <cstdio>
#include <cstdint>

#define DUP_PH -1
#ifndef MK_N_LAUNCHES
#define MK_N_LAUNCHES 1
#endif

namespace cfg {
constexpr int DM = 4096, TP = 8192, NB = 8, TS = 64, PAST = 2048;
constexpr int MS = NB * TS;
constexpr int M = TP + MS;
constexpr int NQK = 2048, NVA = 2048, QL = 896, KVL = 512, DR = 64, NG = 8192;
constexpr int NINP = 15872;
constexpr int NRAW = 1536;
constexpr int NQB = 3072, NKVBO = 4096;
constexpr int MKV = TP + NB * (PAST + TS);
constexpr int DFF = 11008;
constexpr float EPS = 1e-6f;
constexpr size_t O_Y = 0, O_DKP = 35651584, O_DVP = 52428800, O_CKVP = 69206016, O_KPEP = 73400320, O_CONVP = 73924608,
                 O_DKS = 73946624, O_DVS = 74995200, O_CKVS = 76043776, O_KPES = 76305920, O_CONVS = 76338688, O_END = 76514816;
}
namespace pg8 {
#define PG8_LAS __attribute__((address_space(3)))
typedef unsigned short bf16_t;
typedef short bf16x8 __attribute__((ext_vector_type(8)));
typedef float f32x4 __attribute__((ext_vector_type(4)));
typedef unsigned u32x4 __attribute__((ext_vector_type(4)));
constexpr int BM = 256, BK = 64, HALF = 128, HTB = HALF * BK * 2  , STAGE_BYTES = 8 * HTB, NXCD = 8, WGM = 8;

__host__ __device__ __forceinline__ int lds_byte(int r, int c) { const int st = (r >> 4) * 2 + (c >> 5), rr = r & 15, cc = c & 31, ob = rr * 64 + cc * 2; return st * 1024 + (ob ^ (((ob >> 9) & 1) << 5)); }
__host__ __device__ __forceinline__ void stage_rc(int b, int& R, int& C) { const int st = b / 1024, sb = b % 1024, swz = sb ^ (((sb >> 9) & 1) << 5); R = (st >> 1) * 16 + swz / 64; C = (st & 1) * 32 + (swz % 64) / 2; }
__host__ __device__ __forceinline__ int perm32(int rho) { const int n = rho >> 4, i = rho & 15; return 8 * (i >> 2) + 4 * n + (i & 3); }

struct Unit { int pm, pn, kt0, ntk, split, part; };
struct Gemm { const bf16_t* A; const bf16_t* Bt; int M, N, K; };

struct StaticOrder {
    int nM, nN, nwg, G, c;
    __host__ __device__ void init(int M, int N, int G_, int c_) { nM = M / BM; nN = N / BM; nwg = nM * nN; G = G_; c = c_; }
    __host__ __device__ bool next(int i, Unit& u) const {
        const long L = (long)i * G + c; if (L >= nwg) return false;
        int wgid = (int)L; { const int q = nwg / NXCD, r = nwg % NXCD, xcd = wgid % NXCD, off = wgid / NXCD; wgid = (xcd < r ? xcd * (q + 1) : r * (q + 1) + (xcd - r) * q) + off; }
        const int nig = WGM * nN, gid = wgid / nig, fm = gid * WGM, gsz = (nM - fm) < WGM ? (nM - fm) : WGM;
        u.pm = fm + ((wgid % nig) % gsz); u.pn = (wgid % nig) / gsz; u.kt0 = 0; u.ntk = 0; u.split = 0; u.part = 0; return true;
    }
    __device__ __forceinline__ void a_ready(const Unit&) const {}
    __device__ __forceinline__ void done(const Unit&) const {}
};

struct SplitTailOrder {
    StaticOrder so; int nt, c;
    __host__ __device__ void init(int K, int c_) { so.init(8192, 4096, 256, c_); nt = K / BK; c = c_; }
    __host__ __device__ bool next(int i, Unit& u) const {
        if (i < 2) return so.next(i, u);
        if (i > 2) return false;
        const int tt = c >> 3, s = c & 7, q = nt >> 1, qb = q >> 3, qr = q & 7;
        u.pm = 32 + (tt & 1); u.pn = tt >> 1; u.kt0 = 2 * (s * qb + (s < qr ? s : qr)); u.ntk = 2 * (qb + (s < qr ? 1 : 0)); u.split = s + 1; u.part = 0; return true;
    }
    __device__ __forceinline__ void a_ready(const Unit&) const {}
    __device__ __forceinline__ void done(const Unit&) const {}
};
struct SplitTailOrder2 {
    StaticOrder so; int nt, c;
    __host__ __device__ void init(int K, int c_) { so.init(8192, 4096, 256, c_); nt = K / BK; c = c_; }
    __host__ __device__ bool next(int i, Unit& u) const {
        if (i < 4) { if (!so.next(i >> 1, u)) return false; u.ntk = nt >> 1; u.kt0 = (i & 1) * (nt >> 1); u.part = 1 + (i & 1); return true; }
        if (i > 4) return false;
        const int tt = c >> 3, s = c & 7, q = nt >> 1, qb = q >> 3, qr = q & 7;
        u.pm = 32 + (tt & 1); u.pn = tt >> 1; u.kt0 = 2 * (s * qb + (s < qr ? s : qr)); u.ntk = 2 * (qb + (s < qr ? 1 : 0)); u.split = s + 1; u.part = 0; return true;
    }
    __device__ __forceinline__ void a_ready(const Unit&) const {}
    __device__ __forceinline__ void done(const Unit&) const {}
};
typedef float f32x2c_t __attribute__((ext_vector_type(2))); typedef __bf16 bf16x2c_t __attribute__((ext_vector_type(2)));
__device__ __forceinline__ unsigned cvt_pk_bf16(float lo, float hi) { f32x2c_t v = {lo, hi}; bf16x2c_t b = __builtin_convertvector(v, bf16x2c_t); return __builtin_bit_cast(unsigned, b); }
typedef float f32x2 __attribute__((ext_vector_type(2)));
__device__ __forceinline__ u32x4 pack8(const f32x4 v0, const f32x4 v1) { u32x4 w; w.x = cvt_pk_bf16(v0[0], v0[1]); w.y = cvt_pk_bf16(v0[2], v0[3]); w.z = cvt_pk_bf16(v1[0], v1[1]); w.w = cvt_pk_bf16(v1[2], v1[3]); return w; }
__device__ __forceinline__ void unpack8(const u32x4 w, f32x4& a, f32x4& b) {
    a[0] = __uint_as_float(w.x << 16); a[1] = __uint_as_float(w.x & 0xffff0000u); a[2] = __uint_as_float(w.y << 16); a[3] = __uint_as_float(w.y & 0xffff0000u);
    b[0] = __uint_as_float(w.z << 16); b[1] = __uint_as_float(w.z & 0xffff0000u); b[2] = __uint_as_float(w.w << 16); b[3] = __uint_as_float(w.w & 0xffff0000u); }
__device__ __forceinline__ float sigmoidf_(float x) { return __builtin_amdgcn_rcpf(1.0f + __expf(-x)); }

struct EpiPlain {
    static constexpr bool PERM = true, AFTER_DRAIN = false;
    bf16_t* O; int ldc;
    __device__ __forceinline__ void operator()(const f32x4 (&acc)[2][2][4][2], const Unit& u, int wr, int wc, int fr, int fq) const {
        const int row0 = u.pm * BM + wr * 64 + fr, col0 = u.pn * BM + wc * 32 + 8 * fq;
#pragma unroll
        for (int ai = 0; ai < 2; ++ai)
#pragma unroll
            for (int m = 0; m < 4; ++m) { bf16_t* rowp = O + (size_t)(row0 + ai * HALF + m * 16) * ldc + col0;
#pragma unroll
                for (int bj = 0; bj < 2; ++bj) *(u32x4*)(rowp + bj * HALF) = pack8(acc[ai][bj][m][0], acc[ai][bj][m][1]); }
    }
};

constexpr float QSCALE_A = 0.125f * 1.4426950408889634f, QSCALE_B = 0.07216878364870322f * 1.4426950408889634f;
struct EpiIn {
    static constexpr bool PERM = true, AFTER_DRAIN = false;
    bf16_t* QA; bf16_t* KA; bf16_t* VA; bf16_t* G; float* RAW; float* out; const float* b_gate; const float* tabA;
    __device__ __forceinline__ void operator()(const f32x4 (&acc)[2][2][4][2], const Unit& u, int wr, int wc, int fr, int fq) const {
        const int pn = u.pn; const bool smp = u.pm >= 32;
        const int row0 = u.pm * BM + wr * 64 + fr, cw = wc * 32 + 8 * fq;
        if (pn < 16) {
            const bool isk = pn >= 8; bf16_t* dst = isk ? KA : QA; const int cb = (pn & 7) * BM + cw;
            float* fo = out + (smp ? (cfg::O_DKS - (size_t)cfg::TP * 2048) : cfg::O_DKP);
            const bool ropew = (wc & 1) == 0;
#pragma unroll
            for (int ah = 0; ah < 4; ++ah) {
                const int ai = ah >> 1, mh = ah & 1;
                f32x4 tq[2][4];
                if (ropew) {
#pragma unroll
                    for (int mm = 0; mm < 2; ++mm) { const int row = row0 + ai * HALF + (mh * 2 + mm) * 16; const int pos = smp ? 2048 + (row & 63) : row; const f32x4* tp = (const f32x4*)(tabA + (size_t)pos * 16);
                        tq[mm][0] = tp[0]; tq[mm][1] = tp[1]; tq[mm][2] = tp[2]; tq[mm][3] = tp[3]; } }
#pragma unroll
                for (int mm = 0; mm < 2; ++mm) {
                    const int m = mh * 2 + mm; const int row = row0 + ai * HALF + m * 16;
                    f32x4 t0 = {1.f, 0.f, 1.f, 0.f}, t1 = t0, t2 = t0, t3 = t0;
                    if (ropew) { t0 = tq[mm][0]; t1 = tq[mm][1]; t2 = tq[mm][2]; t3 = tq[mm][3]; }
#pragma unroll
                    for (int bj = 0; bj < 2; ++bj) {
                        f32x4 v0 = acc[ai][bj][m][0], v1 = acc[ai][bj][m][1];
                        if (ropew) {
                            f32x4 p0, p1;
#pragma unroll
                            for (int e = 0; e < 4; ++e) { p0[e] = __shfl_xor(v0[e], 16); p1[e] = __shfl_xor(v1[e], 16); }
                            const float sg = (fq == 0) ? -1.f : 1.f;
                            if (fq < 2) {
                                v0[0] = v0[0] * t0[0] + sg * p0[0] * t0[1]; v0[1] = v0[1] * t0[2] + sg * p0[1] * t0[3];
                                v0[2] = v0[2] * t1[0] + sg * p0[2] * t1[1]; v0[3] = v0[3] * t1[2] + sg * p0[3] * t1[3];
                                v1[0] = v1[0] * t2[0] + sg * p1[0] * t2[1]; v1[1] = v1[1] * t2[2] + sg * p1[1] * t2[3];
                                v1[2] = v1[2] * t3[0] + sg * p1[2] * t3[1]; v1[3] = v1[3] * t3[2] + sg * p1[3] * t3[3];
                            }
                        }
                        const size_t off = (size_t)row * 2048 + cb + bj * HALF;
                        if (isk) { *(u32x4*)(dst + off) = pack8(v0, v1); *(f32x4*)(fo + off) = v0; *(f32x4*)(fo + off + 4) = v1; }
                        else *(u32x4*)(dst + off) = pack8(v0 * QSCALE_A, v1 * QSCALE_A);
                    }
                }
            }
        } else if (pn < 24) {
            const int cb = (pn - 16) * BM + cw; float* fo = out + (smp ? (cfg::O_DVS - (size_t)cfg::TP * 2048) : cfg::O_DVP);
#pragma unroll
            for (int ai = 0; ai < 2; ++ai)
#pragma unroll
                for (int m = 0; m < 4; ++m) { const int row = row0 + ai * HALF + m * 16;
#pragma unroll
                    for (int bj = 0; bj < 2; ++bj) { const size_t off = (size_t)row * 2048 + cb + bj * HALF; const f32x4 v0 = acc[ai][bj][m][0], v1 = acc[ai][bj][m][1];
                        *(u32x4*)(VA + off) = pack8(v0, v1); *(f32x4*)(fo + off) = v0; *(f32x4*)(fo + off + 4) = v1; } }
        } else if (pn < 56) {
            const int cb = (pn - 24) * BM + cw;
            f32x4 bv[2][2];
#pragma unroll
            for (int bj = 0; bj < 2; ++bj) { bv[bj][0] = *(const f32x4*)(b_gate + cb + bj * HALF); bv[bj][1] = *(const f32x4*)(b_gate + cb + bj * HALF + 4); }
#pragma unroll
            for (int ai = 0; ai < 2; ++ai)
#pragma unroll
                for (int m = 0; m < 4; ++m) { const int row = row0 + ai * HALF + m * 16;
#pragma unroll
                    for (int bj = 0; bj < 2; ++bj) { f32x4 v0 = acc[ai][bj][m][0] + bv[bj][0], v1 = acc[ai][bj][m][1] + bv[bj][1];
#pragma unroll
                        for (int e = 0; e < 4; ++e) { v0[e] = sigmoidf_(v0[e]); v1[e] = sigmoidf_(v1[e]); }
                        *(u32x4*)(G + (size_t)row * 8192 + cb + bj * HALF) = pack8(v0, v1); } }
        } else {
            const int cb = (pn - 56) * BM + cw;
#pragma unroll
            for (int ai = 0; ai < 2; ++ai)
#pragma unroll
                for (int m = 0; m < 4; ++m) { const int row = row0 + ai * HALF + m * 16;
#pragma unroll
                    for (int bj = 0; bj < 2; ++bj) { float* p = RAW + (size_t)row * cfg::NRAW + cb + bj * HALF; *(f32x4*)p = acc[ai][bj][m][0]; *(f32x4*)(p + 4) = acc[ai][bj][m][1]; } }
        }
    }
};

struct EpiQB {
    static constexpr bool PERM = true, AFTER_DRAIN = false;
    bf16_t* QB; const float* tabB;
    __device__ __forceinline__ void operator()(const f32x4 (&acc)[2][2][4][2], const Unit& u, int wr, int wc, int fr, int fq) const {
        const bool smp = u.pm >= 32; const int row0 = u.pm * BM + wr * 64 + fr, col0 = u.pn * BM + wc * 32 + 8 * fq;
#pragma unroll
        for (int bj = 0; bj < 2; ++bj) {
            const int g6 = (u.pn * 8 + bj * 4 + wc) % 6; const bool pe = g6 >= 4; const int i0 = 16 * (g6 - 4) + 4 * fq;
#pragma unroll
            for (int ai = 0; ai < 2; ++ai)
#pragma unroll
                for (int m = 0; m < 4; ++m) { const int row = row0 + ai * HALF + m * 16; const int pos = smp ? 2048 + (row & 63) : row;
                    f32x4 v0 = acc[ai][bj][m][0], v1 = acc[ai][bj][m][1];
                    if (pe) { const f32x4* tp = (const f32x4*)(tabB + ((size_t)pos * 32 + i0) * 2); const f32x4 ta = tp[0], tb = tp[1];
                        f32x4 w0, w1;
                        w0[0] = v0[0] * ta[0] - v0[1] * ta[1]; w0[1] = v0[1] * ta[0] + v0[0] * ta[1];
                        w0[2] = v0[2] * ta[2] - v0[3] * ta[3]; w0[3] = v0[3] * ta[2] + v0[2] * ta[3];
                        w1[0] = v1[0] * tb[0] - v1[1] * tb[1]; w1[1] = v1[1] * tb[0] + v1[0] * tb[1];
                        w1[2] = v1[2] * tb[2] - v1[3] * tb[3]; w1[3] = v1[3] * tb[2] + v1[2] * tb[3];
                        v0 = w0; v1 = w1; }
                    *(u32x4*)(QB + (size_t)row * cfg::NQB + col0 + bj * HALF) = pack8(v0 * QSCALE_B, v1 * QSCALE_B); }
        }
    }
};

__device__ __forceinline__ void slab_store(float* slab, const f32x4 (&acc)[2][2][4][2], const Unit& u, int wr, int wc, int fr, int fq) {
    const int row0 = (u.pm - 32) * BM + wr * 64 + fr, col0 = u.pn * BM + wc * 32 + 8 * fq; float* sb = slab + (size_t)(u.split - 1) * 512 * 4096;
#pragma unroll
    for (int ai = 0; ai < 2; ++ai)
#pragma unroll
        for (int m = 0; m < 4; ++m)
#pragma unroll
            for (int bj = 0; bj < 2; ++bj) { float* p = sb + (size_t)(row0 + ai * HALF + m * 16) * 4096 + col0 + bj * HALF; *(f32x4*)p = acc[ai][bj][m][0]; *(f32x4*)(p + 4) = acc[ai][bj][m][1]; }
}
struct EpiY {
    static constexpr bool PERM = true, AFTER_DRAIN = false;
    const bf16_t* G; bf16_t* MB; float* slab;
    __device__ __forceinline__ void operator()(f32x4 (&acc)[2][2][4][2], const Unit& u, int wr, int wc, int fr, int fq) const {
        if (u.split) { slab_store(slab, acc, u, wr, wc, fr, fq); return; }
        const int row0 = u.pm * BM + wr * 64 + fr, col0 = u.pn * BM + wc * 32 + 8 * fq;
#pragma unroll
        for (int ai = 0; ai < 2; ++ai)
#pragma unroll
            for (int mh = 0; mh < 2; ++mh) {
                u32x4 g0q[2][2], g1q[2][2];
#pragma unroll
                for (int mm = 0; mm < 2; ++mm)
#pragma unroll
                    for (int bj = 0; bj < 2; ++bj) { const bf16_t* gp = G + (size_t)(row0 + ai * HALF + (mh * 2 + mm) * 16) * 8192 + col0 + bj * HALF;
                        g1q[mm][bj] = *(const u32x4*)(gp + 4096); if (u.part == 1) g0q[mm][bj] = *(const u32x4*)gp; }
#pragma unroll
                for (int mm = 0; mm < 2; ++mm)
#pragma unroll
                    for (int bj = 0; bj < 2; ++bj) { const int m = mh * 2 + mm; f32x4 a1, b1; unpack8(g1q[mm][bj], a1, b1);
                        if (u.part == 1) { f32x4 a0, b0; unpack8(g0q[mm][bj], a0, b0);
#pragma unroll
                            for (int e = 0; e < 4; ++e) { acc[ai][bj][m][0][e] *= a0[e] * __builtin_amdgcn_rcpf(fmaxf(a1[e], 1e-30f)); acc[ai][bj][m][1][e] *= b0[e] * __builtin_amdgcn_rcpf(fmaxf(b1[e], 1e-30f)); } }
                        else { const int row = row0 + ai * HALF + m * 16, col = col0 + bj * HALF;
                            *(u32x4*)(MB + (size_t)row * 4096 + col) = pack8(acc[ai][bj][m][0] * a1, acc[ai][bj][m][1] * b1); } }
            }
    }
};
struct EpiRes {
    static constexpr bool PERM = true, AFTER_DRAIN = false;
    const float* base_p; const float* base_s; float* out; float* slab;
    __device__ __forceinline__ void operator()(const f32x4 (&acc)[2][2][4][2], const Unit& u, int wr, int wc, int fr, int fq) const {
        if (u.split) { slab_store(slab, acc, u, wr, wc, fr, fq); return; }
        const int row0 = u.pm * BM + wr * 64 + fr, col0 = u.pn * BM + wc * 32 + 8 * fq; const bool smp = u.pm >= 32;
        const float* bs = smp ? base_s - (size_t)cfg::TP * 4096 : base_p;
#pragma unroll
        for (int ai = 0; ai < 2; ++ai)
#pragma unroll
            for (int mh = 0; mh < 2; ++mh) {
                f32x4 bq[2][2][2];
#pragma unroll
                for (int mm = 0; mm < 2; ++mm)
#pragma unroll
                    for (int bj = 0; bj < 2; ++bj) { const size_t off = (size_t)(row0 + ai * HALF + (mh * 2 + mm) * 16) * 4096 + col0 + bj * HALF;
                        bq[mm][bj][0] = *(const f32x4*)(bs + off); bq[mm][bj][1] = *(const f32x4*)(bs + off + 4); }
#pragma unroll
                for (int mm = 0; mm < 2; ++mm)
#pragma unroll
                    for (int bj = 0; bj < 2; ++bj) { const int m = mh * 2 + mm; const size_t off = (size_t)(row0 + ai * HALF + m * 16) * 4096 + col0 + bj * HALF;
                        *(f32x4*)(out + off) = bq[mm][bj][0] + acc[ai][bj][m][0]; *(f32x4*)(out + off + 4) = bq[mm][bj][1] + acc[ai][bj][m][1]; }
            }
    }
};
__device__ __forceinline__ float dpp_ror1(float x) { return __int_as_float(__builtin_amdgcn_update_dpp(0, __float_as_int(x), 0x121, 0xf, 0xf, false)); }
__device__ __forceinline__ float dpp_ror2(float x) { return __int_as_float(__builtin_amdgcn_update_dpp(0, __float_as_int(x), 0x122, 0xf, 0xf, false)); }
struct EpiGU2 {
    static constexpr bool PERM = true, AFTER_DRAIN = false;
    bf16_t* ACT; float* out; const float* wconv; const float* bconv; const float* stc; float* topug; float* topu; float* bot; PG8_LAS float* xch;
    __device__ __forceinline__ void operator()(const f32x4 (&acc)[2][2][4][2], const Unit& u, int wr, int wc, int fr, int fq) const {
        const int pm = u.pm, chl = wc * 32 + 8 * fq, ch0 = u.pn * HALF + chl; const bool smp = pm >= 32;
        const int row0 = pm * BM + wr * 64 + fr;
        if (fr >= 14) {
#pragma unroll
            for (int ai = 0; ai < 2; ++ai)
#pragma unroll
                for (int n = 0; n < 2; ++n) *(PG8_LAS f32x4*)(xch + ((ai * 2 + wr) * 2 + (fr - 14)) * 128 + chl + 4 * n) = acc[ai][0][3][n];
        }
        f32x4 w0[2], w1[2], w2[2], bb[2];
#pragma unroll
        for (int n = 0; n < 2; ++n) { w0[n] = *(const f32x4*)(wconv + ch0 + 4 * n); w1[n] = *(const f32x4*)(wconv + cfg::DFF + ch0 + 4 * n); w2[n] = *(const f32x4*)(wconv + 2 * cfg::DFF + ch0 + 4 * n); bb[n] = *(const f32x4*)(bconv + ch0 + 4 * n); }
        asm volatile("s_waitcnt lgkmcnt(0)" ::: "memory"); __builtin_amdgcn_s_barrier(); asm volatile("" ::: "memory");
#pragma unroll
        for (int ai = 0; ai < 2; ++ai) {
            f32x4 H1[2], H2[2];
            if (smp) { const int b = (pm - 32) * 4 + ai * 2 + wr;
#pragma unroll
                for (int n = 0; n < 2; ++n) { H2[n] = *(const f32x4*)(stc + (size_t)(b * 2 + 0) * cfg::DFF + ch0 + 4 * n); H1[n] = *(const f32x4*)(stc + (size_t)(b * 2 + 1) * cfg::DFF + ch0 + 4 * n); } }
            else if (ai == 0 && wr == 0) {
#pragma unroll
                for (int n = 0; n < 2; ++n) { H1[n] = (f32x4){0.f, 0.f, 0.f, 0.f}; H2[n] = H1[n]; } }
            else { const int sa = wr ? ai : ai - 1, sw = wr ? 0 : 1;
#pragma unroll
                for (int n = 0; n < 2; ++n) { H2[n] = *(const PG8_LAS f32x4*)(xch + ((sa * 2 + sw) * 2 + 0) * 128 + chl + 4 * n); H1[n] = *(const PG8_LAS f32x4*)(xch + ((sa * 2 + sw) * 2 + 1) * 128 + chl + 4 * n); } }
            if (!smp && ai == 0 && wr == 0 && pm >= 1 && fr < 2) {
#pragma unroll
                for (int n = 0; n < 2; ++n) { *(f32x4*)(topug + (size_t)(pm * 2 + fr) * cfg::DFF + ch0 + 4 * n) = acc[0][0][0][n]; *(f32x4*)(topu + (size_t)(pm * 2 + fr) * cfg::DFF + ch0 + 4 * n) = acc[0][1][0][n]; } }
            if (!smp && ai == 1 && wr == 1 && fr >= 14) {
#pragma unroll
                for (int n = 0; n < 2; ++n) *(f32x4*)(bot + (size_t)(pm * 2 + (fr - 14)) * cfg::DFF + ch0 + 4 * n) = acc[1][0][3][n]; }
#pragma unroll
            for (int m = 0; m < 4; ++m) { const int row = row0 + ai * HALF + m * 16;
                f32x4 a[2];
#pragma unroll
                for (int n = 0; n < 2; ++n)
#pragma unroll
                    for (int e = 0; e < 4; ++e) { const float x = acc[ai][0][m][n][e];
                        const float r1 = dpp_ror1(x), r2 = dpp_ror2(x);
                        float q1, q2;
                        if (m > 0) { q1 = dpp_ror1(acc[ai][0][m > 0 ? m - 1 : 0][n][e]); q2 = dpp_ror2(acc[ai][0][m > 0 ? m - 1 : 0][n][e]); }
                        else { q1 = H1[n][e]; q2 = (fr == 1) ? H1[n][e] : H2[n][e]; }
                        const float p1 = fr >= 1 ? r1 : q1, p2 = fr >= 2 ? r2 : q2;
                        const float c = bb[n][e] + w0[n][e] * p2 + w1[n][e] * p1 + w2[n][e] * x;
                        a[n][e] = c * __builtin_amdgcn_rcpf(1.f + __expf(-c)) * acc[ai][1][m][n][e]; }
                *(u32x4*)(ACT + (size_t)row * cfg::DFF + ch0) = pack8(a[0], a[1]);
                if ((row & 63) >= 62 && row >= cfg::TP - 2) {
                    float* p = (row < cfg::TP) ? out + cfg::O_CONVP + (size_t)(row - (cfg::TP - 2)) * cfg::DFF + ch0
                                               : out + cfg::O_CONVS + (size_t)(((row - cfg::TP) >> 6) * 2 + ((row & 63) - 62)) * cfg::DFF + ch0;
                    *(f32x4*)p = acc[ai][0][m][0]; *(f32x4*)(p + 4) = acc[ai][0][m][1]; } }
        }
        asm volatile("s_waitcnt lgkmcnt(0)" ::: "memory"); __builtin_amdgcn_s_barrier(); asm volatile("" ::: "memory");
    }
};
template <class Epi, class Sched, bool ALIGN_EPI = false, bool SP2 = false>
__device__ __forceinline__ void gemm_phase(PG8_LAS unsigned char* lds, const Gemm g, const Sched& S, const Epi& E) {
    const int tid = threadIdx.x, wid = __builtin_amdgcn_readfirstlane(tid >> 6), lane = tid & 63, wr = wid >> 2, wc = wid & 3, fr = lane & 15, fq = lane >> 4;
    const int K = g.K, nt = K / BK;
    unsigned voffA[2], voffB[2];
#pragma unroll
    for (int i = 0; i < 2; ++i) { int R, C; stage_rc(tid * 16 + i * 8192, R, C); const int Rb = Epi::PERM ? ((R & ~31) + perm32(R & 31)) : R;
        voffA[i] = (unsigned)(R * K + C) * 2u; voffB[i] = (unsigned)(Rb * K + C) * 2u; }
    const size_t kstep = (size_t)(BK * 2);
    const size_t hstep = (size_t)HALF * K * 2;
    const size_t tstep = 2 * hstep;
    const unsigned ldsw = (unsigned)wid * 1024u;
    const int aoff = lds_byte(wr * 64 + fr, fq * 8), boff = lds_byte(wc * 32 + fr, fq * 8);
#define PG8_SA(b, h) (((b) * 2 + (h)) * HTB)
#define PG8_SB(b, h) ((4 + (b) * 2 + (h)) * HTB)
#define PG8_STAGE(bufoff, gbase, voff) do { _Pragma("unroll") for (int _i = 0; _i < 2; ++_i) \
        __builtin_amdgcn_global_load_lds((const unsigned*)((const char*)(gbase) + (voff)[_i]), (PG8_LAS unsigned*)(lds + (bufoff) + ldsw + _i * 8192), 16, 0, 0); } while (0)
#define PG8_LDA(dst, b, h) do { _Pragma("unroll") for (int m = 0; m < 4; ++m) _Pragma("unroll") for (int k = 0; k < 2; ++k) dst[m][k] = *(const PG8_LAS bf16x8*)(lds + PG8_SA(b, h) + aoff + m * 2048 + k * 1024); } while (0)
#define PG8_LDB(dst, b, h) do { _Pragma("unroll") for (int n = 0; n < 2; ++n) _Pragma("unroll") for (int k = 0; k < 2; ++k) dst[n][k] = *(const PG8_LAS bf16x8*)(lds + PG8_SB(b, h) + boff + n * 2048 + k * 1024); } while (0)
#define PG8_MMA(ai, bj, At, Bt) do { __builtin_amdgcn_s_setprio(1); _Pragma("unroll") for (int m = 0; m < 4; ++m) _Pragma("unroll") for (int n = 0; n < 2; ++n) _Pragma("unroll") for (int k = 0; k < 2; ++k) \
        acc[ai][bj][m][n] = __builtin_amdgcn_mfma_f32_16x16x32_bf16(Bt[n][k], At[m][k], acc[ai][bj][m][n], 0, 0, 0); __builtin_amdgcn_s_setprio(0); } while (0)
#define PG8_WAIT_V(n) asm volatile("s_waitcnt vmcnt(" #n ")" ::: "memory")
#define PG8_WAIT_L(n) asm volatile("s_waitcnt lgkmcnt(" #n ")" ::: "memory")
#define PG8_BAR __builtin_amdgcn_s_barrier()
#define PG8_SCHED __builtin_amdgcn_sched_barrier(0)
    Unit cur, nxt; int ui = 0;
    if (!S.next(0, cur)) return;
    f32x4 acc[2][2][4][2];
#pragma unroll
    for (int a = 0; a < 2; ++a)
#pragma unroll
        for (int b = 0; b < 2; ++b)
#pragma unroll
            for (int m = 0; m < 4; ++m)
#pragma unroll
                for (int n = 0; n < 2; ++n) acc[a][b][m][n] = (f32x4){0.f, 0.f, 0.f, 0.f};
    bf16x8 At[4][2], B0[2][2], B1[2][2];
    const char* cA = (const char*)g.A + (size_t)cur.pm * tstep + (size_t)cur.kt0 * kstep; const char* cB = (const char*)g.Bt + (size_t)cur.pn * tstep + (size_t)cur.kt0 * kstep;
    S.a_ready(cur);
    if constexpr (SP2) {
        PG8_STAGE(PG8_SB(0, 0), cB, voffB); PG8_STAGE(PG8_SB(0, 1), cB + hstep, voffB); PG8_STAGE(PG8_SA(0, 0), cA, voffA); PG8_STAGE(PG8_SA(0, 1), cA + hstep, voffA);
        if (wr == 1) PG8_BAR;
        PG8_WAIT_V(2); PG8_BAR;
        PG8_STAGE(PG8_SB(1, 0), cB + kstep, voffB); PG8_STAGE(PG8_SA(1, 0), cA + kstep, voffA); PG8_STAGE(PG8_SB(1, 1), cB + hstep + kstep, voffB);
        PG8_WAIT_V(6); PG8_BAR;
    } else {
        PG8_STAGE(PG8_SB(0, 0), cB, voffB); PG8_STAGE(PG8_SA(0, 0), cA, voffA); PG8_STAGE(PG8_SB(0, 1), cB + hstep, voffB); PG8_STAGE(PG8_SA(0, 1), cA + hstep, voffA);
        if (wr == 1) PG8_BAR;
        PG8_WAIT_V(4); PG8_BAR;
        PG8_STAGE(PG8_SB(1, 0), cB + kstep, voffB); PG8_STAGE(PG8_SA(1, 0), cA + kstep, voffA); PG8_STAGE(PG8_SB(1, 1), cB + hstep + kstep, voffB);
        PG8_WAIT_V(6); PG8_BAR;
    }
    for (;;) {
        const bool has_next = S.next(ui + 1, nxt);
        const char* nA = has_next ? (const char*)g.A + (size_t)nxt.pm * tstep + (size_t)nxt.kt0 * kstep : cA; const char* nB = has_next ? (const char*)g.Bt + (size_t)nxt.pn * tstep + (size_t)nxt.kt0 * kstep : cB;
        const int ntu = cur.ntk ? cur.ntk : nt;
        for (int t = 0; t < ntu; t += 2) {
            const bool last = (t == ntu - 2);
            const char* a1 = cA + (size_t)(t + 1) * kstep;
            const char* a2 = last ? nA : cA + (size_t)(t + 2) * kstep; const char* b2 = last ? nB : cB + (size_t)(t + 2) * kstep;
            const char* a3 = a2 + kstep; const char* b3 = b2 + kstep;
            if (last && has_next) S.a_ready(nxt);
            if constexpr (SP2) {
            PG8_LDB(B0, 0, 0); PG8_LDB(B1, 0, 1); PG8_SCHED; PG8_LDA(At, 0, 0); PG8_STAGE(PG8_SA(1, 1), a1 + hstep, voffA);
            PG8_WAIT_V(8); PG8_WAIT_L(0); PG8_BAR; PG8_MMA(0, 0, At, B0); PG8_MMA(0, 1, At, B1); PG8_BAR; PG8_SCHED;
            PG8_LDA(At, 0, 1); PG8_STAGE(PG8_SB(0, 0), b2, voffB); PG8_STAGE(PG8_SB(0, 1), b2 + hstep, voffB); PG8_STAGE(PG8_SA(0, 0), a2, voffA);
            PG8_WAIT_V(8); PG8_WAIT_L(0); PG8_BAR; PG8_MMA(1, 0, At, B0); PG8_MMA(1, 1, At, B1); PG8_BAR; PG8_SCHED;
            PG8_LDB(B0, 1, 0); PG8_LDB(B1, 1, 1); PG8_SCHED; PG8_LDA(At, 1, 0); PG8_STAGE(PG8_SA(0, 1), a2 + hstep, voffA);
            PG8_WAIT_V(8); PG8_WAIT_L(0); PG8_BAR; PG8_MMA(0, 0, At, B0); PG8_MMA(0, 1, At, B1); PG8_BAR; PG8_SCHED;
            PG8_LDA(At, 1, 1); PG8_STAGE(PG8_SB(1, 0), b3, voffB); PG8_STAGE(PG8_SB(1, 1), b3 + hstep, voffB); PG8_STAGE(PG8_SA(1, 0), a3, voffA);
            PG8_WAIT_V(8); PG8_WAIT_L(0); PG8_BAR; PG8_MMA(1, 0, At, B0); PG8_MMA(1, 1, At, B1); PG8_BAR; PG8_SCHED;
            } else {
            PG8_LDB(B0, 0, 0); PG8_SCHED; PG8_LDA(At, 0, 0); PG8_STAGE(PG8_SA(1, 1), a1 + hstep, voffA);
            PG8_WAIT_L(8); PG8_BAR; PG8_WAIT_L(0); PG8_MMA(0, 0, At, B0); PG8_BAR; PG8_SCHED;
            PG8_LDB(B1, 0, 1); PG8_STAGE(PG8_SB(0, 0), b2, voffB);
            PG8_BAR; PG8_WAIT_L(0); PG8_MMA(0, 1, At, B1); PG8_BAR;
            PG8_LDA(At, 0, 1); PG8_STAGE(PG8_SA(0, 0), a2, voffA);
            PG8_BAR; PG8_WAIT_L(0); PG8_MMA(1, 0, At, B0); PG8_BAR; PG8_SCHED;
            PG8_STAGE(PG8_SB(0, 1), b2 + hstep, voffB);
            PG8_WAIT_V(6); PG8_BAR; PG8_MMA(1, 1, At, B1); PG8_BAR;
            PG8_LDB(B0, 1, 0); PG8_SCHED; PG8_LDA(At, 1, 0); PG8_STAGE(PG8_SA(0, 1), a2 + hstep, voffA);
            PG8_WAIT_L(8); PG8_BAR; PG8_WAIT_L(0); PG8_MMA(0, 0, At, B0); PG8_BAR; PG8_SCHED;
            PG8_LDB(B1, 1, 1); PG8_STAGE(PG8_SB(1, 0), b3, voffB);
            PG8_BAR; PG8_WAIT_L(0); PG8_MMA(0, 1, At, B1); PG8_BAR;
            PG8_LDA(At, 1, 1); PG8_STAGE(PG8_SA(1, 0), a3, voffA);
            PG8_BAR; PG8_WAIT_L(0); PG8_MMA(1, 0, At, B0); PG8_BAR; PG8_SCHED;
            PG8_STAGE(PG8_SB(1, 1), b3 + hstep, voffB);
            PG8_WAIT_V(6); PG8_BAR; PG8_MMA(1, 1, At, B1); PG8_BAR;
            }
        }
        if constexpr (ALIGN_EPI) { if (wr == 0) PG8_BAR; }
        if constexpr (!Epi::AFTER_DRAIN) { E(acc, cur, wr, wc, fr, fq); S.done(cur); }
        if (!has_next) break;
        if (cur.part != 1)
#pragma unroll
        for (int a = 0; a < 2; ++a)
#pragma unroll
            for (int b = 0; b < 2; ++b)
#pragma unroll
                for (int m = 0; m < 4; ++m)
#pragma unroll
                    for (int n = 0; n < 2; ++n) acc[a][b][m][n] = (f32x4){0.f, 0.f, 0.f, 0.f};
        cur = nxt; cA = nA; cB = nB; ++ui;
        if constexpr (ALIGN_EPI) { if (wr == 1) PG8_BAR; }
    }
    PG8_WAIT_V(0);
    if constexpr (!ALIGN_EPI) { if (wr == 0) PG8_BAR; }
    PG8_BAR;
    if constexpr (Epi::AFTER_DRAIN) { E.fused(acc, cur, wr, wc, fr, fq, lds, wid, lane); S.done(cur); }
#undef PG8_SA
#undef PG8_SB
#undef PG8_STAGE
#undef PG8_LDA
#undef PG8_LDB
#undef PG8_MMA
#undef PG8_WAIT_V
#undef PG8_WAIT_L
#undef PG8_BAR
#undef PG8_SCHED
}
}
#define GAS __attribute__((address_space(1)))
#define LAS __attribute__((address_space(3)))
typedef unsigned short bf16;
typedef unsigned v4u __attribute__((ext_vector_type(4)));
typedef float f32x4 __attribute__((ext_vector_type(4)));
typedef short bf16x8 __attribute__((ext_vector_type(8)));
typedef GAS unsigned gu32;
typedef GAS unsigned long long gu64;
#define RLX_AGENT __ATOMIC_RELAXED, __HIP_MEMORY_SCOPE_AGENT
#define LDS_WAIT() asm volatile("s_waitcnt lgkmcnt(0)" ::: "memory")
#define VM_WAIT() asm volatile("s_waitcnt vmcnt(0)" ::: "memory")
__device__ __forceinline__ unsigned long long rt() { return __builtin_amdgcn_s_memrealtime(); }
__device__ __forceinline__ unsigned f2bf(float f) { unsigned u = __builtin_bit_cast(unsigned, f); return (u + 0x7fffu + ((u >> 16) & 1u)) >> 16; }
__device__ __forceinline__ unsigned pk2(float lo, float hi) { return f2bf(lo) | (f2bf(hi) << 16); }

#define XB_TMO      128
#define XB_XCNT(j)  (256  + 64 * (j))
#define XB_XSUB(j)  (1280 + 64 * (j))
#define XB_XGEN(j)  (2304 + 64 * (j))
#define XB_TOP      3328
#define XB_TOPGEN   3392
#define XCD_BAR_WORDS 3456
#define XB_SPIN_CAP (1u << 18)

__device__ __forceinline__ unsigned xb_ld(unsigned* p)              { return __hip_atomic_load(p, __ATOMIC_RELAXED, __HIP_MEMORY_SCOPE_AGENT); }
__device__ __forceinline__ unsigned xb_add(unsigned* p, unsigned v) { return __hip_atomic_fetch_add(p, v, __ATOMIC_RELAXED, __HIP_MEMORY_SCOPE_AGENT); }
__device__ __forceinline__ unsigned xb_xcc_id() { return (unsigned)__builtin_amdgcn_s_getreg((3 << 11) | 20) & 0xFu; }
#define XB_SPIN(cond, bar) do { unsigned _sp = 0; while (cond) { __builtin_amdgcn_s_sleep(1); \
    if ((++_sp & 255u) == 0u) { if (xb_ld(&(bar)[XB_TMO])) break; if (_sp > XB_SPIN_CAP) { atomicAdd(&(bar)[XB_TMO], 1u); break; } } } } while (0)

struct XcdBarrier {
    unsigned* bar; unsigned x;
    volatile LAS unsigned* st;
};

__device__ __forceinline__ XcdBarrier xcd_barrier_post(unsigned* bar, volatile LAS unsigned* st) {
    XcdBarrier b; b.bar = bar; b.x = xb_xcc_id(); b.st = st;
    if (threadIdx.x == 0) (void)xb_add(&bar[XB_XCNT(b.x)], 1u);
    return b;
}
__device__ __forceinline__ void xcd_barrier_complete(unsigned* bar, unsigned x, unsigned& nloc, unsigned& nx) {
    const unsigned G = gridDim.x * gridDim.y * gridDim.z;
    unsigned sum, cnt, mine, sp = 0u;
    for (;;) {
        sum = 0u; cnt = 0u; mine = 0u;
#pragma unroll
        for (unsigned j = 0; j < 16; ++j) { const unsigned c = xb_ld(&bar[XB_XCNT(j)]); sum += c; cnt += (c > 0u) ? 1u : 0u; mine = (j == x) ? c : mine; }
        if (sum == G) break;
        __builtin_amdgcn_s_sleep(1);
        if ((++sp & 255u) == 0u) { if (xb_ld(&bar[XB_TMO])) break; if (sp > XB_SPIN_CAP) { atomicAdd(&bar[XB_TMO], 1u); break; } }
    }
    nloc = mine > 0u ? mine : 1u; nx = cnt > 0u ? cnt : 1u;
}

__device__ __forceinline__ void xcd_barrier(const XcdBarrier& b) {
    asm volatile("s_waitcnt vmcnt(0)" ::: "memory");
    __syncthreads();
    if (threadIdx.x == 0) {
        unsigned* bar = b.bar;
        __builtin_amdgcn_s_waitcnt(0);
        unsigned nloc = b.st[0], nx = b.st[1];
        if (nloc == 0u) { xcd_barrier_complete(bar, b.x, nloc, nx); b.st[0] = nloc; b.st[1] = nx; }
        const unsigned old = xb_add(&bar[XB_XSUB(b.x)], 1u);
        const unsigned gen = old / nloc;
        if (old + 1u == (gen + 1u) * nloc) {
            __builtin_amdgcn_fence(__ATOMIC_RELEASE, "agent");
            asm volatile("s_waitcnt vmcnt(0)" ::: "memory");
            const unsigned og = xb_add(&bar[XB_TOP], 1u);
            const unsigned tg = og / nx;
            if (og + 1u == (tg + 1u) * nx) xb_add(&bar[XB_TOPGEN], 1u);
            else XB_SPIN(xb_ld(&bar[XB_TOPGEN]) == tg, bar);
            __builtin_amdgcn_fence(__ATOMIC_ACQUIRE, "agent");
            xb_add(&bar[XB_XGEN(b.x)], 1u);
            asm volatile("s_waitcnt vmcnt(0)" ::: "memory");
        } else {
            XB_SPIN(xb_ld(&bar[XB_XGEN(b.x)]) == gen, bar);
            __builtin_amdgcn_fence(__ATOMIC_ACQUIRE, "agent");
            asm volatile("s_waitcnt vmcnt(0)" ::: "memory");
        }
    }
    __syncthreads();
}
namespace att {
typedef unsigned short bf16_t;
using bf16x8 = __attribute__((ext_vector_type(8))) short;
using s16x4  = __attribute__((ext_vector_type(4))) short;
using f32x16 = __attribute__((ext_vector_type(16))) float;
using f32x8  = __attribute__((ext_vector_type(8))) float;
using u32x4  = __attribute__((ext_vector_type(4))) unsigned;
constexpr int NW = 8, QBLK = 32, KVBLK = 64;
constexpr int SHM_V = KVBLK * 128 * 2;
constexpr int SHM_KMAX = KVBLK * 192 * 2;
constexpr int LDS_V = 0, LDS_K = 2 * SHM_V, LDS_WS = LDS_K + 2 * SHM_KMAX, LDS_BYTES = LDS_WS + NW * 64 * 4;
#define ASBAR() __builtin_amdgcn_sched_barrier(0)
__device__ __forceinline__ int crow(int r, int hi) { return (r & 3) + 8 * (r >> 2) + 4 * hi; }
typedef float f32x2c_t __attribute__((ext_vector_type(2))); typedef __bf16 bf16x2c_t __attribute__((ext_vector_type(2)));
__device__ __forceinline__ unsigned cvtpk(float lo, float hi) { f32x2c_t v = {lo, hi}; bf16x2c_t b = __builtin_convertvector(v, bf16x2c_t); return __builtin_bit_cast(unsigned, b); }
template <typename TIn> struct Stage;
template <> struct Stage<bf16_t> { using T = bf16x8; static constexpr int NLD = 1;
  __device__ static __forceinline__ T ld8(const bf16_t* p) { return *reinterpret_cast<const bf16x8*>(p); }
  __device__ static __forceinline__ bf16x8 tobf(T x) { return x; } };
template <> struct Stage<float> { using T = f32x8; static constexpr int NLD = 2;
  __device__ static __forceinline__ T ld8(const float* p) { return *reinterpret_cast<const f32x8*>(p); }
  __device__ static __forceinline__ bf16x8 tobf(T x) { u32x4 w = {cvtpk(x[0], x[1]), cvtpk(x[2], x[3]), cvtpk(x[4], x[5]), cvtpk(x[6], x[7])}; return *reinterpret_cast<bf16x8*>(&w); } };

template <int NDQ> __device__ __forceinline__ int kswz(int row, int ch) { return row * (32 * NDQ) + ((ch ^ ((row >> 1) & 7)) << 4); }

__device__ __forceinline__ void partialSM(f32x16& p0, f32x16& p1, float& m_reg, float& mn, float& alpha, const float C, const float THRS) {
  float pmax = p0[0];
#pragma unroll
  for (int r = 1; r < 16; ++r) pmax = fmaxf(pmax, p0[r]);
#pragma unroll
  for (int r = 0; r < 16; ++r) pmax = fmaxf(pmax, p1[r]);
  { auto rr = __builtin_amdgcn_permlane32_swap(__float_as_uint(pmax), __float_as_uint(pmax), false, false);
    pmax = fmaxf(__uint_as_float(rr[0]), __uint_as_float(rr[1])); }
  if (__builtin_expect(__all(pmax - m_reg <= THRS), 1)) { mn = m_reg; alpha = 1.f; }
  else { mn = fmaxf(m_reg, pmax); alpha = __builtin_amdgcn_exp2f((m_reg - mn) * C); m_reg = mn; }
  const float mnC = -mn * C;
#pragma unroll
  for (int r = 0; r < 16; ++r) p0[r] = fmaf(p0[r], C, mnC);
#pragma unroll
  for (int r = 0; r < 16; ++r) p1[r] = fmaf(p1[r], C, mnC);
#pragma unroll
  for (int r = 0; r < 16; ++r) p0[r] = __builtin_amdgcn_exp2f(p0[r]);
}
__device__ __forceinline__ void finishSM(f32x16& p0, f32x16& p1, float alpha, float& l_reg, bf16x8& pa0, bf16x8& pa1, bf16x8& pa2, bf16x8& pa3) {
#pragma unroll
  for (int r = 0; r < 16; ++r) p1[r] = __builtin_amdgcn_exp2f(p1[r]);
  float ps = 0;
#pragma unroll
  for (int r = 0; r < 16; ++r) ps += p0[r];
#pragma unroll
  for (int r = 0; r < 16; ++r) ps += p1[r];
  { auto rr = __builtin_amdgcn_permlane32_swap(__float_as_uint(ps), __float_as_uint(ps), false, false);
    ps = __uint_as_float(rr[0]) + __uint_as_float(rr[1]); }
  l_reg = l_reg * alpha + ps;
#define ATT_PK4(P, BASE, OUT) do { unsigned a0 = cvtpk(P[BASE + 0], P[BASE + 1]), a1 = cvtpk(P[BASE + 2], P[BASE + 3]);   \
    unsigned b0 = cvtpk(P[BASE + 4], P[BASE + 5]), b1 = cvtpk(P[BASE + 6], P[BASE + 7]);                              \
    auto r0 = __builtin_amdgcn_permlane32_swap(a0, b0, false, false); auto r1 = __builtin_amdgcn_permlane32_swap(a1, b1, false, false); \
    u32x4 w = {r0[0], r1[0], r0[1], r1[1]}; OUT = *reinterpret_cast<bf16x8*>(&w); } while (0)
  ATT_PK4(p0, 0, pa0); ATT_PK4(p0, 8, pa1); ATT_PK4(p1, 0, pa2); ATT_PK4(p1, 8, pa3);
#undef ATT_PK4
}
__device__ __forceinline__ void partialSM_neg(f32x16& p0, f32x16& p1, float& mhat, f32x16& negm, float& alpha, const bool first, const float THR2) {
  float pmax = p0[0];
#pragma unroll
  for (int r = 1; r < 16; ++r) pmax = fmaxf(pmax, p0[r]);
#pragma unroll
  for (int r = 0; r < 16; ++r) pmax = fmaxf(pmax, p1[r]);
  { auto rr = __builtin_amdgcn_permlane32_swap(__float_as_uint(pmax), __float_as_uint(pmax), false, false);
    pmax = fmaxf(__uint_as_float(rr[0]), __uint_as_float(rr[1])); }
  if (__builtin_expect(!first && __all(pmax <= THR2), 1)) { alpha = 1.f; }
  else { const float d = first ? pmax : fmaxf(pmax, 0.f); mhat += d; alpha = first ? 1.f : __builtin_amdgcn_exp2f(-d);
#pragma unroll
    for (int r = 0; r < 16; ++r) { p0[r] -= d; p1[r] -= d; }
#pragma unroll
    for (int r = 0; r < 16; ++r) negm[r] = -mhat; }
#pragma unroll
  for (int r = 0; r < 16; ++r) p0[r] = __builtin_amdgcn_exp2f(p0[r]);
}
template <int NDQ> __device__ __forceinline__ void qkt(f32x16& p0, f32x16& p1, const char* Ks, const bf16x8 (&qr)[NDQ], int r32, int hi, const f32x16 cin = f32x16{}) {
  p0 = cin; p1 = cin;
  const int f = (r32 >> 1) & 7; int kb[4];
#pragma unroll
  for (int q = 0; q < 4; ++q) kb[q] = r32 * (32 * NDQ) + (((2 * q + hi) ^ f) << 4);
#pragma unroll
  for (int d0 = 0; d0 < NDQ; ++d0) { const char* kp = Ks + kb[d0 & 3] + 128 * (d0 >> 2);
    const bf16x8 b0 = *reinterpret_cast<const bf16x8*>(kp);
    const bf16x8 b1 = *reinterpret_cast<const bf16x8*>(kp + 32 * 32 * NDQ);
    p0 = __builtin_amdgcn_mfma_f32_32x32x16_bf16(b0, qr[d0], p0, 0, 0, 0);
    p1 = __builtin_amdgcn_mfma_f32_32x32x16_bf16(b1, qr[d0], p1, 0, 0, 0); }
}
__device__ __forceinline__ int v_st(int k, int c) { const int kk = (k & ~0xC) | ((k & 4) << 1) | ((k & 8) >> 1); return ((kk >> 3) * 4 + (c >> 5)) * 512 + ((kk & 7) * 32 + (c & 31)) * 2; }
__device__ __forceinline__ int v_rd_base(int lane) { return ((lane & 3) << 3) | (((lane >> 2) & 3) << 6) | (((lane >> 4) & 1) << 5) | (((lane >> 5) & 1) << 8); }
constexpr int v_rd_off(int d0, int ks, int half) { return d0 * 512 + ks * 4096 + half * 2048; }
template <int OFF> __device__ __forceinline__ s16x4 tr_read(int vb) { s16x4 r; asm volatile("ds_read_b64_tr_b16 %0, %1 offset:%2" : "=&v"(r) : "v"(vb), "i"(OFF) : "memory"); return r; }
template <int D0> __device__ __forceinline__ void pv_one(f32x16& od, int vb, bf16x8 pa0, bf16x8 pa1, bf16x8 pa2, bf16x8 pa3) {
  const s16x4 l0 = tr_read<v_rd_off(D0, 0, 0)>(vb), h0 = tr_read<v_rd_off(D0, 0, 1)>(vb), l1 = tr_read<v_rd_off(D0, 1, 0)>(vb), h1 = tr_read<v_rd_off(D0, 1, 1)>(vb);
  const s16x4 l2 = tr_read<v_rd_off(D0, 2, 0)>(vb), h2 = tr_read<v_rd_off(D0, 2, 1)>(vb), l3 = tr_read<v_rd_off(D0, 3, 0)>(vb), h3 = tr_read<v_rd_off(D0, 3, 1)>(vb);
  asm volatile("s_waitcnt lgkmcnt(0)" ::: "memory"); ASBAR();
#define ATT_PK(L, H) (bf16x8){L[0], L[1], L[2], L[3], H[0], H[1], H[2], H[3]}
  od = __builtin_amdgcn_mfma_f32_32x32x16_bf16(pa0, ATT_PK(l0, h0), od, 0, 0, 0);
  od = __builtin_amdgcn_mfma_f32_32x32x16_bf16(pa1, ATT_PK(l1, h1), od, 0, 0, 0);
  od = __builtin_amdgcn_mfma_f32_32x32x16_bf16(pa2, ATT_PK(l2, h2), od, 0, 0, 0);
  od = __builtin_amdgcn_mfma_f32_32x32x16_bf16(pa3, ATT_PK(l3, h3), od, 0, 0, 0);
#undef ATT_PK
}
__device__ __forceinline__ void pv_d0(f32x16 (&o)[4], int vb, bf16x8 pa0, bf16x8 pa1, bf16x8 pa2, bf16x8 pa3) {
  pv_one<0>(o[0], vb, pa0, pa1, pa2, pa3); pv_one<1>(o[1], vb, pa0, pa1, pa2, pa3); pv_one<2>(o[2], vb, pa0, pa1, pa2, pa3); pv_one<3>(o[3], vb, pa0, pa1, pa2, pa3);
}

__device__ __forceinline__ void glds16(const void* gsrc, unsigned lds_dst) { unsigned keep;
  asm volatile("s_mov_b32 %0, m0\n\ts_mov_b32 m0, %2\n\ts_nop 0\n\tglobal_load_lds_dwordx4 %1, off\n\ts_mov_b32 m0, %0" : "=&s"(keep) : "v"(gsrc), "s"(lds_dst) : "memory"); }
template <typename TKV> struct Src { const TKV* kp; const TKV* kn; const TKV* k2p; const TKV* k2n; const TKV* vp; const TKV* vn; int npast, nvalid; };

template <int NDQ, typename TKV, int LDK, int LDK2, int LDV>
__device__ __forceinline__ void attn_core(const bf16x8 (&qr)[NDQ], const Src<TKV>& S, const int NT, const int limit, const bool active, const float C, const float THRS,
                                          char* lds, f32x16 (&o)[4], float& l_reg) {
  using St = Stage<TKV>;
  constexpr int SHM_K = KVBLK * 32 * NDQ;
  int tid_ = threadIdx.x; asm volatile("" : "+v"(tid_));
  const int tid = tid_, wid = tid >> 6, lane = tid & 63, r32 = lane & 31, hi = lane >> 5;
  char* V_lds = lds + LDS_V; char* K_lds = lds + LDS_K;
  float* al_l = (float*)(lds + LDS_WS) + wid * 64 + 32;
  float m_reg = -1e30f; l_reg = 0.f;
#pragma unroll
  for (int d = 0; d < 4; ++d) o[d] = f32x16{};
  const int sr = tid >> 4, sc = (tid & 15) * 8;
  const int vr = (sr & ~3) + (tid & 3), vc = ((sr & 3) * 4 + ((tid & 15) >> 2)) * 8, vst0 = v_st(vr, vc), vst1 = v_st(32 + vr, vc);
  const int kr8 = tid >> 3, kc8 = tid & 7;
  const int vb0 = (int)(uintptr_t)V_lds + v_rd_base(lane);
  struct Slot { typename St::T vs0, vs1, ks0, ks1, ks2; } sl[1];
#define ATT_SLOAD(i, j) do { const int jj_ = (j) < S.nvalid ? (j) : S.nvalid - 1; const bool ps_ = jj_ < S.npast; const long r0_ = ps_ ? (long)jj_ * 64 : (long)(jj_ - S.npast) * 64; \
    const TKV* vb_ = ps_ ? S.vp : S.vn; const TKV* kb_ = ps_ ? S.kp : S.kn; \
    sl[i].vs0 = St::ld8(vb_ + (r0_ + vr) * LDV + vc); sl[i].vs1 = St::ld8(vb_ + (r0_ + 32 + vr) * LDV + vc); \
    if constexpr (NDQ == 4) { sl[i].ks0 = St::ld8(kb_ + (r0_ + kr8) * LDK + kc8 * 8); } \
    else { const TKV* k2_ = ps_ ? S.k2p : S.k2n; sl[i].ks0 = St::ld8(kb_ + (r0_ + sr) * LDK + sc); sl[i].ks1 = St::ld8(kb_ + (r0_ + 32 + sr) * LDK + sc); sl[i].ks2 = St::ld8(k2_ + (r0_ + kr8) * LDK2 + kc8 * 8); } } while (0)
#define ATT_SWRITE(b, i) do { *(bf16x8*)(V_lds + (b) * SHM_V + vst0) = St::tobf(sl[i].vs0); *(bf16x8*)(V_lds + (b) * SHM_V + vst1) = St::tobf(sl[i].vs1); \
    if constexpr (NDQ == 4) { *(bf16x8*)(K_lds + (b) * SHM_K + kswz<NDQ>(kr8, kc8)) = St::tobf(sl[i].ks0); } \
    else { *(bf16x8*)(K_lds + (b) * SHM_K + kswz<NDQ>(sr, tid & 15)) = St::tobf(sl[i].ks0); *(bf16x8*)(K_lds + (b) * SHM_K + kswz<NDQ>(32 + sr, tid & 15)) = St::tobf(sl[i].ks1); \
           *(bf16x8*)(K_lds + (b) * SHM_K + kswz<NDQ>(kr8, 16 + kc8)) = St::tobf(sl[i].ks2); } } while (0)
#define ATT_RESC(a) do { if (__any((a) < 1.f)) { if (hi == 0) al_l[r32] = (a); asm volatile("s_waitcnt lgkmcnt(0)" ::: "memory"); \
    _Pragma("unroll") for (int d = 0; d < 4; ++d) _Pragma("unroll") for (int r = 0; r < 16; ++r) o[d][r] *= al_l[crow(r, hi)]; } } while (0)
#define ATT_MASK(P0, P1, j) do { if ((j) > limit) { _Pragma("unroll") for (int r = 0; r < 16; ++r) { P0[r] = -1e30f; P1[r] = -1e30f; } } } while (0)
  constexpr bool DMA = sizeof(TKV) == 2;
  const int wu = __builtin_amdgcn_readfirstlane(wid);
  const unsigned lds0 = (unsigned)(uintptr_t)lds;
  unsigned dK[3] = {0u, 0u, 0u}, dV[2] = {0u, 0u};
  if constexpr (DMA) {
    if constexpr (NDQ == 4) { const int row = 8 * wu + (lane >> 3), c = (lane & 7) ^ ((row >> 1) & 7); dK[0] = (unsigned)(row * LDK + c * 8); }
    else {
#pragma unroll
      for (int i = 0; i < 3; ++i) { const int b = (3 * wu + i) * 1024 + lane * 16, row = b / 384, cs = (b - row * 384) >> 4, c = (cs & ~7) | ((cs & 7) ^ ((row >> 1) & 7));
        dK[i] = c < 16 ? (unsigned)(row * LDK + c * 8) : (0x80000000u | (unsigned)(row * LDK2 + (c - 16) * 8)); } }
#pragma unroll
    for (int i = 0; i < 2; ++i) { const int sub = 2 * (2 * wu + i) + (lane >> 5), kk = (sub >> 2) * 8 + ((lane & 31) >> 2), k = (kk & ~0xC) | ((kk & 4) << 1) | ((kk & 8) >> 1), c = (sub & 3) * 32 + (lane & 3) * 8;
      dV[i] = (unsigned)(k * LDV + c); }
  }
#define ATT_DMA(b, j) do { const int jj_ = (j) < S.nvalid ? (j) : S.nvalid - 1; const bool ps_ = jj_ < S.npast; const long r0_ = ps_ ? (long)jj_ * 64 : (long)(jj_ - S.npast) * 64; \
    const TKV* kb_ = (ps_ ? S.kp : S.kn) + r0_ * LDK; const TKV* vb_ = (ps_ ? S.vp : S.vn) + r0_ * LDV; \
    if constexpr (NDQ == 4) glds16(kb_ + dK[0], lds0 + LDS_K + (b) * SHM_K + wu * 1024); \
    else { const TKV* k2_ = (ps_ ? S.k2p : S.k2n) + r0_ * LDK2; _Pragma("unroll") for (int i_ = 0; i_ < 3; ++i_) glds16((dK[i_] >> 31) ? k2_ + (dK[i_] & 0x7fffffffu) : kb_ + dK[i_], lds0 + LDS_K + (b) * SHM_K + (3 * wu + i_) * 1024); } \
    glds16(vb_ + dV[0], lds0 + LDS_V + (b) * SHM_V + (2 * wu) * 1024); glds16(vb_ + dV[1], lds0 + LDS_V + (b) * SHM_V + (2 * wu + 1) * 1024); } while (0)
  f32x16 pA0, pA1; float alA = 1.f; bf16x8 pa0, pa1, pa2, pa3;
  f32x16 negm = f32x16{}; m_reg = 0.f;
  if constexpr (DMA) { ATT_DMA(0, 0); asm volatile("s_waitcnt vmcnt(0)" ::: "memory"); } else { ATT_SLOAD(0, 0); asm volatile("s_waitcnt vmcnt(0)" ::: "memory"); ATT_SWRITE(0, 0); }
  __syncthreads();
#pragma unroll 1
  for (int j = 0; j < NT; ++j) {
    const int cur = j & 1;
    if (j + 1 < NT) { if constexpr (DMA) ATT_DMA(cur ^ 1, j + 1); else ATT_SLOAD(0, j + 1); }
    ASBAR();
    if (active && j <= limit) {
      qkt<NDQ>(pA0, pA1, K_lds + cur * SHM_K, qr, r32, hi, negm); partialSM_neg(pA0, pA1, m_reg, negm, alA, j == 0, THRS * C);
      ATT_RESC(alA);
      finishSM(pA0, pA1, alA, l_reg, pa0, pa1, pa2, pa3);
      ASBAR();
      pv_d0(o, vb0 + cur * SHM_V, pa0, pa1, pa2, pa3);
    }
    ASBAR();
    if constexpr (DMA) asm volatile("s_waitcnt vmcnt(0)" ::: "memory"); else { if (j + 1 < NT) ATT_SWRITE(cur ^ 1, 0); }
    __syncthreads();
  }
#undef ATT_DMA
#undef ATT_SLOAD
#undef ATT_SWRITE
#undef ATT_RESC
#undef ATT_MASK
}
__device__ __forceinline__ void normalize(f32x16 (&o)[4], float l_reg, char* lds, int wid, int r32, int hi) {
  float* li_l = (float*)(lds + LDS_WS) + wid * 64;
  if (hi == 0) li_l[r32] = l_reg;
  asm volatile("s_waitcnt lgkmcnt(0)" ::: "memory");
#pragma unroll
  for (int r = 0; r < 16; ++r) { const float rl = __builtin_amdgcn_rcpf(li_l[crow(r, hi)]);
#pragma unroll
    for (int d = 0; d < 4; ++d) o[d][r] *= rl; }
}
__device__ __forceinline__ unsigned short f2bf1(float f) { unsigned u = __builtin_bit_cast(unsigned, f); return (unsigned short)((u + 0x7fffu + ((u >> 16) & 1u)) >> 16); }

constexpr float LOG2E = 1.4426950408889634f;
constexpr float SCALE_A = 0.125f, SCALE_B = 0.07216878364870322f;
constexpr float THR = 8.f;

template <typename TKV>
__device__ __forceinline__ void diff_unit(const bf16_t* QA, long qrow0, int h, const Src<TKV>& S1, const Src<TKV>& S2, int NT, int limit, bool active, float lam,
                                          const float* g_subln, float* stash, bf16_t* OA, char* lds) {
  asm volatile("" : "+s"(h), "+s"(qrow0));
  const int tid = threadIdx.x, wid = tid >> 6, lane = tid & 63, r32 = lane & 31, hi = lane >> 5;
  const long qrow = qrow0 + (active ? wid * QBLK : 0) + r32;
  f32x16 o[4]; float l_reg; float* st = stash + wid * 4096;
  {
    bf16x8 qr[4];
#pragma unroll
    for (int d0 = 0; d0 < 4; ++d0) qr[d0] = *reinterpret_cast<const bf16x8*>(QA + qrow * 2048 + h * 64 + d0 * 16 + hi * 8);
    attn_core<4, TKV, 2048, 64, 2048>(qr, S1, NT, limit, active, SCALE_A * LOG2E, THR / SCALE_A, lds, o, l_reg);
  }
  if (active) { normalize(o, l_reg, lds, wid, r32, hi);
    __attribute__((address_space(1))) float* st1 = (__attribute__((address_space(1))) float*)(st + lane); asm volatile("" : "+v"(st1));
#pragma unroll
    for (int d = 0; d < 4; ++d)
#pragma unroll
      for (int r = 0; r < 16; ++r) st1[(d * 16 + r) * 64] = o[d][r]; }
  {
    bf16x8 qr[4];
#pragma unroll
    for (int d0 = 0; d0 < 4; ++d0) qr[d0] = *reinterpret_cast<const bf16x8*>(QA + qrow * 2048 + (16 + h) * 64 + d0 * 16 + hi * 8);
    attn_core<4, TKV, 2048, 64, 2048>(qr, S2, NT, limit, active, SCALE_A * LOG2E, THR / SCALE_A, lds, o, l_reg);
  }
  if (active) { normalize(o, l_reg, lds, wid, r32, hi);
    float ss[16];
    const __attribute__((address_space(1))) float* st2 = (const __attribute__((address_space(1))) float*)(st + lane); asm volatile("" : "+v"(st2));
#pragma unroll
    for (int r = 0; r < 16; ++r) ss[r] = 0.f;
#pragma unroll
    for (int d = 0; d < 4; ++d)
#pragma unroll
      for (int r = 0; r < 16; ++r) { const float a = st2[(d * 16 + r) * 64] - lam * o[d][r]; o[d][r] = a; ss[r] += a * a; }
#pragma unroll
    for (int r = 0; r < 16; ++r) { float s = ss[r]; s += __shfl_xor(s, 1); s += __shfl_xor(s, 2); s += __shfl_xor(s, 4); s += __shfl_xor(s, 8); s += __shfl_xor(s, 16);
      ss[r] = 0.8f * rsqrtf(s * (1.f / 128.f) + cfg::EPS); }
    __attribute__((address_space(1))) bf16_t* op = (__attribute__((address_space(1))) bf16_t*)(OA + (qrow0 + wid * QBLK + 4 * hi) * 4096 + h * 128 + r32); asm volatile("" : "+v"(op));
#pragma unroll
    for (int d = 0; d < 4; ++d) { const float g = g_subln[d * 32 + r32];
#pragma unroll
      for (int r = 0; r < 16; ++r) op[((r & 3) + 8 * (r >> 2)) * 4096 + d * 32] = f2bf1(o[d][r] * ss[r] * g); }
  }
}
__device__ __forceinline__ void mla_unit(const bf16_t* QB, long qrow0, int h, const Src<bf16_t>& S, int NT, int limit, bool active, bf16_t* OB, char* lds) {
  asm volatile("" : "+s"(h), "+s"(qrow0));
  const int tid = threadIdx.x, wid = tid >> 6, lane = tid & 63, r32 = lane & 31, hi = lane >> 5;
  const long qrow = qrow0 + (active ? wid * QBLK : 0) + r32;
  f32x16 o[4]; float l_reg;
  bf16x8 qr[12];
#pragma unroll
  for (int d0 = 0; d0 < 12; ++d0) qr[d0] = *reinterpret_cast<const bf16x8*>(QB + qrow * 3072 + h * 192 + d0 * 16 + hi * 8);
  attn_core<12, bf16_t, 4096, 64, 4096>(qr, S, NT, limit, active, SCALE_B * LOG2E, THR / SCALE_B, lds, o, l_reg);
  if (active) { normalize(o, l_reg, lds, wid, r32, hi);
    __attribute__((address_space(1))) bf16_t* op = (__attribute__((address_space(1))) bf16_t*)(OB + (qrow0 + wid * QBLK + 4 * hi) * 4096 + h * 128 + r32); asm volatile("" : "+v"(op));
#pragma unroll
    for (int d = 0; d < 4; ++d)
#pragma unroll
      for (int r = 0; r < 16; ++r) op[((r & 3) + 8 * (r >> 2)) * 4096 + d * 32] = f2bf1(o[d][r]); }
}
#undef ASBAR
}
#ifndef PG8_SP2
#define PG8_SP2 true
#endif
constexpr int NWAVES = 8;
constexpr int NPH = 12;
constexpr int N_LAUNCHES = MK_N_LAUNCHES;
static_assert(N_LAUNCHES == 1 || N_LAUNCHES == NPH, "MK_N_LAUNCHES is 1 or 12");

constexpr size_t MiB = 1u << 20;
constexpr size_t WS_CTL = 0, CTL_ZERO_BYTES = 1 * MiB;
constexpr size_t WS_WIN = 1 * MiB;
constexpr size_t WS_WQB = WS_WIN + (size_t)cfg::NINP * 4096 * 2;
constexpr size_t WS_WKVB = WS_WQB + (size_t)3072 * 896 * 2;
constexpr size_t WS_WBA = WS_WKVB + (size_t)4096 * 512 * 2;
constexpr size_t WS_WBB = WS_WBA + (size_t)4096 * 2048 * 2;
constexpr size_t WS_WOUT = WS_WBB + (size_t)4096 * 2048 * 2;
constexpr size_t WS_WGU = WS_WOUT + (size_t)4096 * 4096 * 2;
constexpr size_t WS_WFD = WS_WGU + (size_t)22016 * 4096 * 2;
constexpr size_t WS_TABA = WS_WFD + (size_t)4096 * 11008 * 2;
constexpr size_t WS_TABB = WS_TABA + (size_t)8192 * 8 * 8;
constexpr size_t WS_XN = WS_TABB + (size_t)8192 * 32 * 8;
constexpr size_t WS_R0 = WS_XN + (size_t)cfg::M * 4096 * 2;
constexpr size_t WS_QA = WS_R0;
constexpr size_t WS_KA = WS_QA + (size_t)cfg::M * 2048 * 2;
constexpr size_t WS_VA = WS_KA + (size_t)cfg::M * 2048 * 2;
constexpr size_t WS_RAW = WS_VA + (size_t)cfg::M * 2048 * 2;
constexpr size_t WS_CQN = WS_RAW + (size_t)cfg::M * cfg::NRAW * 4;
constexpr size_t WS_CKV = WS_CQN + (size_t)cfg::M * 896 * 2;
constexpr size_t WS_KPE = WS_CKV + (size_t)cfg::MKV * 512 * 2;
constexpr size_t WS_QB = WS_KPE + (size_t)cfg::MKV * 64 * 2;
constexpr size_t WS_KVB = WS_QB + (size_t)cfg::M * 3072 * 2;
constexpr size_t WS_G = WS_KVB + (size_t)cfg::MKV * 4096 * 2;
constexpr size_t WS_OA = WS_G + (size_t)cfg::M * 8192 * 2;
constexpr size_t WS_OB = WS_OA + (size_t)cfg::M * 2048 * 2;
constexpr size_t WS_STASH = WS_OB + (size_t)cfg::M * 2048 * 2;
constexpr size_t WS_TOPUG = WS_STASH + (size_t)256 * 8 * 4096 * 4;
constexpr size_t WS_TOPU = WS_TOPUG + (size_t)64 * cfg::DFF * 4;
constexpr size_t WS_BOT = WS_TOPU + (size_t)64 * cfg::DFF * 4;
constexpr size_t WS_END = WS_BOT + (size_t)64 * cfg::DFF * 4;
constexpr size_t WS_MB = WS_QA;
constexpr size_t WS_UG = WS_R0;
constexpr size_t WS_U = WS_UG + (size_t)cfg::M * cfg::DFF * 2;
static_assert(WS_U + (size_t)cfg::M * cfg::DFF * 2 <= WS_END, "FFN overlay fits");
static_assert(WS_END < (size_t)1390 * 1000 * 1000, "workspace budget");
constexpr size_t SLAB_BYTES = (size_t)8 * 512 * 4096 * 4;
constexpr size_t WS_SLAB_A = WS_KVB, WS_SLAB_B = WS_KVB + SLAB_BYTES;
constexpr size_t WS_SLAB_D = WS_UG;
static_assert(2 * SLAB_BYTES <= (size_t)cfg::MKV * 4096 * 2 && SLAB_BYTES <= (size_t)cfg::M * cfg::DFF * 2, "slab overlays fit");
constexpr int CW_TMO = 0, CW_CODE = 1, CW_BAR = 4096;

constexpr int RING_OFF = 0, RING_BYTES = 131072;
constexpr int LDSCTL_OFF = RING_BYTES, MISC_OFF = LDSCTL_OFF + 320;
constexpr int XCH_OFF = RING_BYTES + 1024;
constexpr int LDS_BYTES = 147456;
static_assert(att::LDS_BYTES <= RING_BYTES && pg8::STAGE_BYTES <= RING_BYTES, "phase scratch fits the ring region");

struct Args { const float* in[29]; float* out; unsigned char* ws; int ph_lo, ph_hi; };
struct Frame {
    LAS unsigned char* lds; volatile LAS unsigned* MISC; gu32* ctl;
    int tid, wave, vcu, G;
    float* out; unsigned char* ws;
};
__device__ __forceinline__ int lane_id() { int t = threadIdx.x; asm volatile("" : "+v"(t)); return t & 63; }
__device__ __forceinline__ float wave_sum(float v) {
#pragma unroll
    for (int o = 1; o < 64; o <<= 1) v += __shfl_xor(v, o);
    return v;
}
template <int MAP> __device__ __forceinline__ int src_col(int n) {
    if (MAP == 1) { if (n < 6144) return n; if (n < 14336) return 7616 + (n - 6144); if (n < 15808) return 6144 + (n - 14336); return -1; }
    if (MAP == 2) { const int h = n / 192, d = n - h * 192; if (d < 128) return n; const int e = d - 128; return h * 192 + 128 + (e >> 1) + 32 * (e & 1); }
    return n;
}
template <int MAP> __device__ __forceinline__ void p0_transpose_item(const float* W, int K, int Nsrc, int Ndst, bf16* WT, int row_off, LAS float* scr, int item, int lane) {
    const int nblk = Ndst / 32, kb = item / nblk, nb = item - kb * nblk, k0 = 64 * kb, n0 = 32 * nb;
    if constexpr (MAP == 2) {
        const int sn = src_col<MAP>(n0 + (lane & 31));
#pragma unroll 8
        for (int i = 0; i < 32; ++i) { const int kk = 2 * i + (lane >> 5); scr[kk * 33 + (lane & 31)] = W[(size_t)(k0 + kk) * Nsrc + sn]; }
    } else {
        const int n4 = 4 * (lane & 7), kq = lane >> 3;
        const int sn = src_col<MAP>(n0 + n4);
        f32x4 v[8];
#pragma unroll
        for (int i = 0; i < 8; ++i) v[i] = sn >= 0 ? __builtin_nontemporal_load((const GAS f32x4*)(W + (size_t)(k0 + 8 * i + kq) * Nsrc + sn)) : (f32x4){0.f, 0.f, 0.f, 0.f};
#pragma unroll
        for (int i = 0; i < 8; ++i) { LAS float* d = scr + (8 * i + kq) * 33 + n4; d[0] = v[i].x; d[1] = v[i].y; d[2] = v[i].z; d[3] = v[i].w; }
    }
    LDS_WAIT(); asm volatile("" ::: "memory");
    const int c = lane & 7;
#pragma unroll
    for (int j = 0; j < 4; ++j) { const int n = (lane >> 3) + 8 * j; const LAS float* s = scr + (8 * c) * 33 + n;
        v4u o; o.x = pk2(s[0 * 33], s[1 * 33]); o.y = pk2(s[2 * 33], s[3 * 33]); o.z = pk2(s[4 * 33], s[5 * 33]); o.w = pk2(s[6 * 33], s[7 * 33]);
        *(GAS v4u*)(WT + (size_t)(row_off + n0 + n) * K + k0 + 8 * c) = o; }
    LDS_WAIT(); asm volatile("" ::: "memory");
}
struct XItem { const float* W; bf16* WT; int K, Nsrc, Ndst, row_off, item, ilv, Kp, koff; };
__device__ __forceinline__ void xitem_load(const XItem& x, int lane, f32x4 (&v)[8]) {
    const int nblk = x.Ndst / 32, kb = x.item / nblk, nb = x.item - kb * nblk, k0 = 64 * kb, n0 = 32 * nb;
    const int n4 = 4 * (lane & 7), kq = lane >> 3;
#pragma unroll
    for (int i = 0; i < 8; ++i) v[i] = __builtin_nontemporal_load((const GAS f32x4*)(x.W + (size_t)(k0 + 8 * i + kq) * x.Nsrc + n0 + n4));
}
__device__ __forceinline__ void xitem_finish(const XItem& x, int lane, const f32x4 (&v)[8], LAS float* scr) {
    const int nblk = x.Ndst / 32, kb = x.item / nblk, nb = x.item - kb * nblk, k0 = 64 * kb, n0 = 32 * nb;
    const int n4 = 4 * (lane & 7), kq = lane >> 3;
#pragma unroll
    for (int i = 0; i < 8; ++i) { LAS float* d = scr + (8 * i + kq) * 33 + n4; d[0] = v[i].x; d[1] = v[i].y; d[2] = v[i].z; d[3] = v[i].w; }
    LDS_WAIT(); asm volatile("" ::: "memory");
    const int c = lane & 7;
#pragma unroll
    for (int j = 0; j < 4; ++j) { const int n = (lane >> 3) + 8 * j; const LAS float* s = scr + (8 * c) * 33 + n;
        v4u o; o.x = pk2(s[0 * 33], s[1 * 33]); o.y = pk2(s[2 * 33], s[3 * 33]); o.z = pk2(s[4 * 33], s[5 * 33]); o.w = pk2(s[6 * 33], s[7 * 33]);
        const int nn = n0 + n, drow = x.ilv ? ((nn >> 7) << 8) + (nn & 127) + x.row_off : x.row_off + nn;
        *(GAS v4u*)(x.WT + (size_t)drow * x.Kp + x.koff + k0 + 8 * c) = o; }
    LDS_WAIT(); asm volatile("" ::: "memory");
}
template <typename TO> __device__ __forceinline__ void rms_row4096(const float* xrow, const float* gain, TO* orow, int lane) {
    const GAS f32x4* xr = (const GAS f32x4*)xrow + lane; const GAS f32x4* gr = (const GAS f32x4*)gain + lane;
    f32x4 v[16]; float s = 0.f;
#pragma unroll
    for (int j = 0; j < 16; ++j) { v[j] = xr[64 * j]; s += (v[j].x * v[j].x + v[j].y * v[j].y) + (v[j].z * v[j].z + v[j].w * v[j].w); }
    const float rstd = rsqrtf(wave_sum(s) * (1.f / 4096.f) + cfg::EPS);
#pragma unroll
    for (int j = 0; j < 16; ++j) { const f32x4 g = gr[64 * j]; const f32x4 y = v[j] * rstd * g;
        if constexpr (sizeof(TO) == 2) { ((GAS unsigned long long*)orow)[64 * j + lane] = (unsigned long long)pk2(y.x, y.y) | ((unsigned long long)pk2(y.z, y.w) << 32); }
        else { ((GAS f32x4*)orow)[64 * j + lane] = y; } }
}
template <int S0, int S1> __device__ __forceinline__ void slab_sum4(const float* slab, int srow, int q, int lane, f32x4 (&v)[4]) {
#pragma unroll
    for (int s = S0; s < S1; ++s) { const GAS f32x4* p = (const GAS f32x4*)(slab + ((size_t)s * 512 + srow) * 4096 + 1024 * q) + lane;
#pragma unroll
        for (int j = 0; j < 4; ++j) v[j] += p[64 * j]; }
}
__device__ __forceinline__ void p5c_merge_sample(Frame& F) {
    const int srow = 2 * F.vcu + (F.wave >> 2), q = F.wave & 3, lane = lane_id(); if (F.vcu >= 256) return;
    f32x4 a[4], b[4];
#pragma unroll
    for (int j = 0; j < 4; ++j) { a[j] = (f32x4){0.f, 0.f, 0.f, 0.f}; b[j] = a[j]; }
    slab_sum4<0, 4>((const float*)(F.ws + WS_SLAB_A), srow, q, lane, a); slab_sum4<4, 8>((const float*)(F.ws + WS_SLAB_A), srow, q, lane, b);
    const bf16* G = (const bf16*)(F.ws + WS_G) + (size_t)(cfg::TP + srow) * 8192 + 1024 * q; bf16* MB = (bf16*)(F.ws + WS_MB) + (size_t)(cfg::TP + srow) * 4096 + 1024 * q;
#pragma unroll
    for (int j = 0; j < 4; ++j) { const int c = 4 * lane + 256 * j; const unsigned long long g0 = *(const GAS unsigned long long*)(G + c), g1 = *(const GAS unsigned long long*)(G + 4096 + c);
        const float g00 = __uint_as_float((unsigned)g0 << 16), g01 = __uint_as_float((unsigned)g0 & 0xffff0000u), g02 = __uint_as_float((unsigned)(g0 >> 32) << 16), g03 = __uint_as_float((unsigned)(g0 >> 32) & 0xffff0000u);
        const float g10 = __uint_as_float((unsigned)g1 << 16), g11 = __uint_as_float((unsigned)g1 & 0xffff0000u), g12 = __uint_as_float((unsigned)(g1 >> 32) << 16), g13 = __uint_as_float((unsigned)(g1 >> 32) & 0xffff0000u);
        const float m0 = g00 * a[j].x + g10 * b[j].x, m1 = g01 * a[j].y + g11 * b[j].y, m2 = g02 * a[j].z + g12 * b[j].z, m3 = g03 * a[j].w + g13 * b[j].w;
        *(GAS unsigned long long*)(MB + c) = (unsigned long long)pk2(m0, m1) | ((unsigned long long)pk2(m2, m3) << 32); }
}
template <typename TO> __device__ __forceinline__ void sample_rows_norm(Frame& F, const float* base_rows  , const float* slab, float* hout_rows  , const float* gain, TO* yout_rows  , LAS float* xch) {
    const int srow = 2 * (F.vcu & 255) + (F.wave >> 2), q = F.wave & 3, lane = lane_id();
    f32x4 v[4];
    { const GAS f32x4* p = (const GAS f32x4*)(base_rows + (size_t)srow * 4096 + 1024 * q) + lane;
#pragma unroll
      for (int j = 0; j < 4; ++j) v[j] = p[64 * j]; }
    slab_sum4<0, 8>(slab, srow, q, lane, v);
    float s = 0.f;
#pragma unroll
    for (int j = 0; j < 4; ++j) s += (v[j].x * v[j].x + v[j].y * v[j].y) + (v[j].z * v[j].z + v[j].w * v[j].w);
    s = wave_sum(s);
    if (lane == 0) xch[F.wave] = s;
    LDS_WAIT(); __syncthreads();
    const int w0 = F.wave & 4; const float tot = (xch[w0] + xch[w0 + 1]) + (xch[w0 + 2] + xch[w0 + 3]);
    const float rstd = rsqrtf(tot * (1.f / 4096.f) + cfg::EPS);
    const GAS f32x4* gr = (const GAS f32x4*)(gain + 1024 * q) + lane;
    if constexpr (sizeof(TO) == 2) { GAS f32x4* ho = (GAS f32x4*)(hout_rows + (size_t)srow * 4096 + 1024 * q) + lane;
#pragma unroll
        for (int j = 0; j < 4; ++j) ho[64 * j] = v[j]; }
#pragma unroll
    for (int j = 0; j < 4; ++j) { const f32x4 y = v[j] * rstd * gr[64 * j];
        if constexpr (sizeof(TO) == 2) ((GAS unsigned long long*)(yout_rows + (size_t)srow * 4096 + 1024 * q))[64 * j + lane] = (unsigned long long)pk2(y.x, y.y) | ((unsigned long long)pk2(y.z, y.w) << 32);
        else ((GAS f32x4*)(yout_rows + (size_t)srow * 4096 + 1024 * q))[64 * j + lane] = y; }
    __syncthreads();
}
constexpr int I_IN = 64 * (cfg::NINP / 32), I_QB = 14 * 96, I_KVB = 8 * 128, I_BR = 32 * 128, I_OUT = 64 * 128, I_FF = 64 * 344, I_FD = 172 * 128;
constexpr int NITEMS1 = I_QB + I_KVB + 2 * I_BR + I_OUT + 2 * I_FF, NITEMS2 = I_FD;
constexpr int CW_Q1 = 1024, CW_Q2 = 1088;
#ifndef P8_GEMM_WGS
#define P8_GEMM_WGS 248
#endif
#ifndef P1_GEMM_WGS
#define P1_GEMM_WGS 240
#endif
template <int LIST> __device__ __forceinline__ XItem list_item(const Args& A, unsigned char* ws, int r) {
    if (LIST == 2) return XItem{A.in[27], (bf16*)(ws + WS_WFD), cfg::DFF, 4096, 4096, 0, r, 0, cfg::DFF, 0};
    r -= I_QB;
    if (r < I_KVB) return XItem{A.in[18], (bf16*)(ws + WS_WKVB), 512, 4096, 4096, 0, r, 0, 512, 0}; r -= I_KVB;
    if (r < I_BR) return XItem{A.in[14], (bf16*)(ws + WS_WBA), 2048, 4096, 4096, 0, r, 0, 4096, 0}; r -= I_BR;
    if (r < I_BR) return XItem{A.in[19], (bf16*)(ws + WS_WBA), 2048, 4096, 4096, 0, r, 0, 4096, 2048}; r -= I_BR;
    if (r < I_OUT) return XItem{A.in[21], (bf16*)(ws + WS_WOUT), 4096, 4096, 4096, 0, r, 0, 4096, 0}; r -= I_OUT;
    if (r < I_FF) return XItem{A.in[23], (bf16*)(ws + WS_WGU), 4096, cfg::DFF, cfg::DFF, 0, r, 1, 4096, 0}; r -= I_FF;
    return XItem{A.in[24], (bf16*)(ws + WS_WGU), 4096, cfg::DFF, cfg::DFF, 128, r, 1, 4096, 0};
}
template <int LIST> __device__ __forceinline__ void convert_queue(Frame& F, const Args& A) {
    constexpr int QCH = 8, NIT = LIST == 1 ? NITEMS1 : NITEMS2, NSC = LIST == 1 ? I_QB : 0;
    LAS float* scr = (LAS float*)(F.lds + RING_OFF + F.wave * 16384);
    gu32* head = F.ctl + (LIST == 1 ? CW_Q1 : CW_Q2);
    for (;;) {
        unsigned base = 0u; if (lane_id() == 0) base = __hip_atomic_fetch_add(head, (unsigned)QCH, RLX_AGENT);
        base = (unsigned)__builtin_amdgcn_readfirstlane((int)base);
        if (base >= (unsigned)NIT) break;
        const int lo = (int)base, hi = lo + QCH;
        static_assert(NITEMS1 % 8 == 0 && NITEMS2 % 8 == 0 && I_QB % 8 == 0, "chunks never straddle a list end or the scalar-path boundary");
        if (lo < NSC) {
#pragma unroll 1
            for (int it = lo; it < hi; ++it) p0_transpose_item<2>(A.in[16], 896, 3072, 3072, (bf16*)(F.ws + WS_WQB), 0, scr, it, lane_id());
        } else {
            f32x4 va[8], vb[8];
            { const XItem x = list_item<LIST>(A, F.ws, lo); xitem_load(x, lane_id(), va); }
#pragma unroll 1
            for (int it = lo; it < hi; it += 2) {
                { const XItem x = list_item<LIST>(A, F.ws, it + 1); xitem_load(x, lane_id(), vb); }
                { const XItem x = list_item<LIST>(A, F.ws, it); xitem_finish(x, lane_id(), va, scr); }
                if (it + 2 < hi) { const XItem x = list_item<LIST>(A, F.ws, it + 2); xitem_load(x, lane_id(), va); }
                { const XItem x = list_item<LIST>(A, F.ws, it + 1); xitem_finish(x, lane_id(), vb, scr); }
            }
        }
    }
}
__device__ __forceinline__ void p0_prologue(Frame& F, const Args& A) {
    LAS float* scr = (LAS float*)(F.lds + RING_OFF + F.wave * 16384);
    const int gw = F.vcu * NWAVES + F.wave, NGW = F.G * NWAVES;
    unsigned char* ws = F.ws;
    for (int it = gw; it < I_IN; it += NGW) p0_transpose_item<1>(A.in[8], 4096, 15808, cfg::NINP, (bf16*)(ws + WS_WIN), 0, scr, it, lane_id());
    for (int m = gw; m < cfg::M; m += NGW) { const float* xr = m < cfg::TP ? A.in[0] + (size_t)m * 4096 : A.in[1] + (size_t)(m - cfg::TP) * 4096;
        rms_row4096<bf16>(xr, A.in[7], (bf16*)(ws + WS_XN) + (size_t)m * 4096, lane_id()); }
    const int gt = gw * 64 + lane_id(), NGT = NGW * 64;
    float* tabA = (float*)(ws + WS_TABA); float* tabB = (float*)(ws + WS_TABB);
    for (int i = gt; i < 8192 * 40; i += NGT) {
        int pos, fi; float ex; float* dst;
        if (i < 8192 * 8) { pos = i >> 3; fi = i & 7; ex = (float)fi * (1.f / 8.f); dst = tabA + (size_t)i * 2; }
        else { const int k = i - 8192 * 8; pos = k >> 5; fi = k & 31; ex = (float)fi * (1.f / 32.f); dst = tabB + (size_t)k * 2; }
        const float inv = exp2f(-ex * 18.931568569324174f);
        const float ang = (float)pos * inv;
        double rev = (double)ang * 0.15915494309189535; rev -= __builtin_floor(rev);
        const float fr = (float)rev;
        dst[0] = __builtin_amdgcn_cosf(fr); dst[1] = __builtin_amdgcn_sinf(fr);
    }
    { const float* src = A.in[4]; bf16* dst = (bf16*)(ws + WS_CKV) + (size_t)cfg::TP * 512;
      for (int i = gt; i < 16384 * 512 / 8; i += NGT) { const f32x4 a = *(const GAS f32x4*)(src + (size_t)i * 8), b = *(const GAS f32x4*)(src + (size_t)i * 8 + 4);
          v4u o; o.x = pk2(a.x, a.y); o.y = pk2(a.z, a.w); o.z = pk2(b.x, b.y); o.w = pk2(b.z, b.w); *(GAS v4u*)(dst + (size_t)i * 8) = o; } }
    { const float* src = A.in[5]; bf16* dst = (bf16*)(ws + WS_KPE) + (size_t)cfg::TP * 64;
      for (int i = gt; i < 16384 * 8; i += NGT) { const int row = i >> 3, c = i & 7; const f32x4 a = *(const GAS f32x4*)(src + (size_t)row * 64 + 4 * c), b = *(const GAS f32x4*)(src + (size_t)row * 64 + 32 + 4 * c);
          v4u o; o.x = pk2(a.x, b.x); o.y = pk2(a.y, b.y); o.z = pk2(a.z, b.z); o.w = pk2(a.w, b.w); *(GAS v4u*)(dst + (size_t)row * 64 + 8 * c) = o; } }
}
__device__ __forceinline__ void p2_latents(Frame& F, const Args& A) {
    const int gw = F.vcu * NWAVES + F.wave, NGW = F.G * NWAVES, lane = lane_id();
    unsigned char* ws = F.ws; const float* g_qa = A.in[15]; const float* g_kva = A.in[17]; const float* tabB = (const float*)(ws + WS_TABB);
    for (int m = gw; m < cfg::M; m += NGW) {
        const float* raw = (const float*)(ws + WS_RAW) + (size_t)m * cfg::NRAW;
        const bool smp = m >= cfg::TP; const int pos = smp ? 2048 + (m & 63) : m; const size_t mk = smp ? (size_t)m + 16384 : (size_t)m;
        const GAS f32x4* raw4 = (const GAS f32x4*)raw; f32x4 q[4], kx[2]; float s = 0.f, s2 = 0.f;
#pragma unroll
        for (int j = 0; j < 4; ++j) { const int idx = 64 * j + lane; q[j] = idx < 224 ? raw4[idx] : (f32x4){0.f, 0.f, 0.f, 0.f}; }
#pragma unroll
        for (int j = 0; j < 2; ++j) kx[j] = raw4[224 + 64 * j + lane];
#pragma unroll
        for (int j = 0; j < 4; ++j) s += (q[j].x * q[j].x + q[j].y * q[j].y) + (q[j].z * q[j].z + q[j].w * q[j].w);
#pragma unroll
        for (int j = 0; j < 2; ++j) s2 += (kx[j].x * kx[j].x + kx[j].y * kx[j].y) + (kx[j].z * kx[j].z + kx[j].w * kx[j].w);
        float rstd = rsqrtf(wave_sum(s) * (1.f / 896.f) + cfg::EPS);
        bf16* cq = (bf16*)(ws + WS_CQN) + (size_t)m * 896;
#pragma unroll
        for (int j = 0; j < 4; ++j) { const int idx = 64 * j + lane; if (idx < 224) { const f32x4 g = ((const GAS f32x4*)g_qa)[idx]; const f32x4 y = q[j] * rstd * g;
            ((GAS unsigned long long*)cq)[idx] = (unsigned long long)pk2(y.x, y.y) | ((unsigned long long)pk2(y.z, y.w) << 32); } }
        rstd = rsqrtf(wave_sum(s2) * (1.f / 512.f) + cfg::EPS);
        float* co = smp ? F.out + cfg::O_CKVS + (size_t)(m - cfg::TP) * 512 : F.out + cfg::O_CKVP + (size_t)m * 512;
        bf16* ck = (bf16*)(ws + WS_CKV) + mk * 512;
#pragma unroll
        for (int j = 0; j < 2; ++j) { const int idx = 64 * j + lane; const f32x4 g = ((const GAS f32x4*)g_kva)[idx]; const f32x4 y = kx[j] * rstd * g;
            ((GAS f32x4*)co)[idx] = y; ((GAS unsigned long long*)ck)[idx] = (unsigned long long)pk2(y.x, y.y) | ((unsigned long long)pk2(y.z, y.w) << 32); }
        if (lane < 32) { const float x1 = raw[1408 + lane], x2 = raw[1440 + lane]; const float c = tabB[((size_t)pos * 32 + lane) * 2], sn = tabB[((size_t)pos * 32 + lane) * 2 + 1];
            const float o1 = x1 * c - x2 * sn, o2 = x2 * c + x1 * sn;
            float* ko = smp ? F.out + cfg::O_KPES + (size_t)(m - cfg::TP) * 64 : F.out + cfg::O_KPEP + (size_t)m * 64;
            ko[lane] = o1; ko[32 + lane] = o2;
            ((GAS unsigned*)((bf16*)(ws + WS_KPE) + mk * 64))[lane] = pk2(o1, o2); }
    }
}
__device__ __forceinline__ void p9_fix(Frame& F, const Args& A) {
    const int gt = (F.vcu * NWAVES + F.wave) * 64 + lane_id(), NGT = F.G * NWAVES * 64;
    const float* topug = (const float*)(F.ws + WS_TOPUG); const float* topu = (const float*)(F.ws + WS_TOPU); const float* bot = (const float*)(F.ws + WS_BOT);
    bf16* ACT = (bf16*)(F.ws + WS_U); const float* wc = A.in[25]; const float* bc = A.in[26];
    constexpr int NCC = cfg::DFF / 8;
    for (int it = gt; it < 31 * 2 * NCC; it += NGT) {
        const int pj = it / NCC, cc = it - pj * NCC, pm = 1 + (pj >> 1), j = pj & 1, col = cc * 8;
        const float* x0 = topug + (size_t)(pm * 2 + j) * cfg::DFF + col;
        const float* x1 = j ? topug + (size_t)(pm * 2) * cfg::DFF + col : bot + (size_t)((pm - 1) * 2 + 1) * cfg::DFF + col;
        const float* x2 = j ? bot + (size_t)((pm - 1) * 2 + 1) * cfg::DFF + col : bot + (size_t)((pm - 1) * 2) * cfg::DFF + col;
        const float* uu = topu + (size_t)(pm * 2 + j) * cfg::DFF + col;
        float a[8];
#pragma unroll
        for (int e = 0; e < 8; ++e) { const float c = bc[col + e] + wc[col + e] * x2[e] + wc[cfg::DFF + col + e] * x1[e] + wc[2 * cfg::DFF + col + e] * x0[e]; a[e] = c * __builtin_amdgcn_rcpf(1.f + __expf(-c)) * uu[e]; }
        v4u o; o.x = pk2(a[0], a[1]); o.y = pk2(a[2], a[3]); o.z = pk2(a[4], a[5]); o.w = pk2(a[6], a[7]);
        *(GAS v4u*)(ACT + (size_t)(pm * 256 + j) * cfg::DFF + col) = o;
    }
}
__device__ __forceinline__ void p4_attention(Frame& F, const Args& A, char* lds) {
    using att::bf16_t; using att::Src;
    unsigned char* ws = F.ws; const int wid = F.wave;
    const bf16_t* QA = (const bf16_t*)(ws + WS_QA); const bf16_t* KA = (const bf16_t*)(ws + WS_KA); const bf16_t* VA = (const bf16_t*)(ws + WS_VA);
    const bf16_t* QB = (const bf16_t*)(ws + WS_QB); const bf16_t* KVB = (const bf16_t*)(ws + WS_KVB); const bf16_t* KPE = (const bf16_t*)(ws + WS_KPE);
    bf16_t* OA = (bf16_t*)(ws + WS_OA); bf16_t* OB = OA + 2048;
    float lam;
    { const float a = A.in[9][lane_id()] * A.in[10][lane_id()], b = A.in[11][lane_id()] * A.in[12][lane_id()]; lam = __expf(wave_sum(a)) - __expf(wave_sum(b)) + 0.2f; }
    const float* g_subln = A.in[13];
    { const int v = F.vcu & 255;
        float* stash = (float*)(ws + WS_STASH) + (size_t)v * 8 * 4096;
        const int h = v >> 4, s = v & 15;
#ifndef ATT_SEL
#define ATT_SEL 7
#endif
#pragma unroll 1
        for (int k = 0; k < ((ATT_SEL & 1) ? 2 : 0); ++k) {
            const int qb = k ? 31 - s : s, NT = 4 * qb + 4, limit = 4 * qb + (wid >> 1);
            Src<bf16_t> S1{KA + h * 64, KA + h * 64, nullptr, nullptr, VA + h * 128, VA + h * 128, NT, NT};
            Src<bf16_t> S2{KA + (16 + h) * 64, KA + (16 + h) * 64, nullptr, nullptr, VA + h * 128, VA + h * 128, NT, NT};
            att::diff_unit<bf16_t>(QA, (long)qb * 256, h, S1, S2, NT, limit, true, lam, g_subln, stash, OA, lds);
        }
#pragma unroll 1
        for (int k = 0; k < ((ATT_SEL & 2) ? 3 : 0); ++k) {
            if (k < 2) { const int qb = k ? 31 - s : s, NT = 4 * qb + 4, limit = 4 * qb + (wid >> 1);
                Src<bf16_t> S{KVB + h * 256, KVB + h * 256, KPE, KPE, KVB + h * 256 + 128, KVB + h * 256 + 128, NT, NT};
                att::mla_unit(QB, (long)qb * 256, h, S, NT, limit, true, OB, lds);
            } else if (v >= 128) { const int b = (v - 128) >> 4, hh = v & 15;
                const bf16_t* kp = KVB + (size_t)(cfg::TP + b * 2048) * 4096 + hh * 256; const bf16_t* kn = KVB + (size_t)(cfg::TP + 16384 + b * 64) * 4096 + hh * 256;
                Src<bf16_t> S{kp, kn, KPE + (size_t)(cfg::TP + b * 2048) * 64, KPE + (size_t)(cfg::TP + 16384 + b * 64) * 64, kp + 128, kn + 128, 32, 33};
                att::mla_unit(QB, (long)cfg::TP + b * 64, hh, S, 34, 32, wid < 2, OB, lds);
            }
        }
        if ((ATT_SEL & 4) && v < 128) { const int b = v >> 4, hh = v & 15;
            const float* kp = A.in[2] + (size_t)b * 2048 * 2048 + hh * 64; const float* kn = F.out + cfg::O_DKS + (size_t)b * 64 * 2048 + hh * 64;
            const float* vp = A.in[3] + (size_t)b * 2048 * 2048 + hh * 128; const float* vn = F.out + cfg::O_DVS + (size_t)b * 64 * 2048 + hh * 128;
            Src<float> S1{kp, kn, nullptr, nullptr, vp, vn, 32, 33};
            Src<float> S2{kp + 16 * 64, kn + 16 * 64, nullptr, nullptr, vp, vn, 32, 33};
            att::diff_unit<float>(QA, (long)cfg::TP + b * 64, hh, S1, S2, 34, 32, wid < 2, lam, g_subln, stash, OA, lds);
        }
    }
}

__global__ void __launch_bounds__(NWAVES * 64, 2) fwd(Args args) {
    extern __shared__ __attribute__((aligned(16))) unsigned char lds[];
    Frame F;
    F.lds = (LAS unsigned char*)lds; F.MISC = (volatile LAS unsigned*)(F.lds + MISC_OFF);
    F.tid = threadIdx.x; F.wave = __builtin_amdgcn_readfirstlane(F.tid >> 6);
    F.G = gridDim.x; { const int bx = blockIdx.x; F.vcu = (F.G % 8 == 0) ? (bx % 8) * (F.G / 8) + bx / 8 : bx; }
    F.out = args.out; F.ws = args.ws; unsigned char* ws = args.ws;
    F.ctl = (gu32*)(ws + WS_CTL);
    for (int u = F.tid; u < (LDS_BYTES - LDSCTL_OFF) / 4; u += NWAVES * 64) ((LAS unsigned*)(F.lds + LDSCTL_OFF))[u] = 0u;
    __syncthreads();
    XcdBarrier bar; bar.bar = (unsigned*)(F.ctl + CW_BAR); bar.x = 0; bar.st = nullptr;
    if (N_LAUNCHES == 1) bar = xcd_barrier_post((unsigned*)(F.ctl + CW_BAR), F.MISC + 8);
#define GRID_BAR() do { if (N_LAUNCHES == 1) xcd_barrier(bar); } while (0)
    const int lo = args.ph_lo, hi = args.ph_hi;
#ifndef PH_MASK
#define PH_MASK 0xFFF
#endif
#define IN(k) (((PH_MASK >> (k)) & 1) && lo <= (k) && (k) < hi)
    typedef pg8::bf16_t pb;
    float* Y = args.out + cfg::O_Y;

    if (IN(0)) { p0_prologue(F, args); GRID_BAR(); }
#ifdef DUP_P0
    if (IN(0)) { p0_prologue(F, args); GRID_BAR(); }
#endif
#ifndef DUP_PH
#define DUP_PH -1
#endif
    if (IN(1)) {
        if (blockIdx.x < P1_GEMM_WGS) {
        pg8::Gemm g{(const pb*)(ws + WS_XN), (const pb*)(ws + WS_WIN), cfg::M, cfg::NINP, 4096}; pg8::StaticOrder S; S.init(cfg::M, cfg::NINP, P1_GEMM_WGS, (int)blockIdx.x);
        pg8::EpiIn E{(pb*)(ws + WS_QA), (pb*)(ws + WS_KA), (pb*)(ws + WS_VA), (pb*)(ws + WS_G), (float*)(ws + WS_RAW), args.out, args.in[20], (const float*)(ws + WS_TABA)};
        pg8::gemm_phase<pg8::EpiIn, pg8::StaticOrder, true, PG8_SP2>(F.lds + RING_OFF, g, S, E);
        }
        __syncthreads(); convert_queue<1>(F, args);
        GRID_BAR();
    }
#if DUP_PH == 1
    if (IN(1)) {
        if (blockIdx.x < P1_GEMM_WGS) {
        pg8::Gemm g{(const pb*)(ws + WS_XN), (const pb*)(ws + WS_WIN), cfg::M, cfg::NINP, 4096}; pg8::StaticOrder S; S.init(cfg::M, cfg::NINP, P1_GEMM_WGS, (int)blockIdx.x);
        pg8::EpiIn E{(pb*)(ws + WS_QA), (pb*)(ws + WS_KA), (pb*)(ws + WS_VA), (pb*)(ws + WS_G), (float*)(ws + WS_RAW), args.out, args.in[20], (const float*)(ws + WS_TABA)};
        pg8::gemm_phase<pg8::EpiIn, pg8::StaticOrder, true, PG8_SP2>(F.lds + RING_OFF, g, S, E);
        }
        __syncthreads(); convert_queue<1>(F, args);
        GRID_BAR();
    }
#endif
    if (IN(2)) { p2_latents(F, args); GRID_BAR(); }
    if (IN(3)) {
        { pg8::Gemm g{(const pb*)(ws + WS_CQN), (const pb*)(ws + WS_WQB), cfg::M, cfg::NQB, 896}; pg8::StaticOrder S; S.init(cfg::M, cfg::NQB, F.G, (int)blockIdx.x);
          pg8::EpiQB E{(pb*)(ws + WS_QB), (const float*)(ws + WS_TABB)};
          pg8::gemm_phase<pg8::EpiQB, pg8::StaticOrder, true, PG8_SP2>(F.lds + RING_OFF, g, S, E); }
        __syncthreads();
        { pg8::Gemm g{(const pb*)(ws + WS_CKV), (const pb*)(ws + WS_WKVB), cfg::MKV, cfg::NKVBO, 512}; pg8::StaticOrder S; S.init(cfg::MKV, cfg::NKVBO, F.G, (int)((blockIdx.x + F.G / 2) % F.G));
          pg8::EpiPlain E{(pb*)(ws + WS_KVB), cfg::NKVBO};
          pg8::gemm_phase<pg8::EpiPlain, pg8::StaticOrder, true, PG8_SP2>(F.lds + RING_OFF, g, S, E); }
        GRID_BAR();
    }
    if (IN(4)) { p4_attention(F, args, (char*)lds + RING_OFF); GRID_BAR(); }
#ifdef DUP_P4
    if (IN(4)) { p4_attention(F, args, (char*)lds + RING_OFF); GRID_BAR(); }
#endif
    if (IN(5)) {
        { pg8::Gemm g{(const pb*)(ws + WS_OA), (const pb*)(ws + WS_WBA), cfg::M, 4096, 4096}; pg8::SplitTailOrder2 S; S.init(4096, (int)blockIdx.x);
          pg8::EpiY E{(const pb*)(ws + WS_G), (pb*)(ws + WS_MB), (float*)(ws + WS_SLAB_A)};
          pg8::gemm_phase<pg8::EpiY, pg8::SplitTailOrder2, true, PG8_SP2>(F.lds + RING_OFF, g, S, E); }
        GRID_BAR();
        p5c_merge_sample(F);
        GRID_BAR();
    }
    if (IN(6)) {
        pg8::Gemm g{(const pb*)(ws + WS_MB), (const pb*)(ws + WS_WOUT), cfg::M, 4096, 4096}; pg8::SplitTailOrder S; S.init(4096, (int)blockIdx.x);
        pg8::EpiRes E{args.in[0], args.in[1], Y, (float*)(ws + WS_SLAB_A)};
        pg8::gemm_phase<pg8::EpiRes, pg8::SplitTailOrder, true, PG8_SP2>(F.lds + RING_OFF, g, S, E);
        GRID_BAR();
    }
#if DUP_PH == 6
    if (IN(6)) {
        pg8::Gemm g{(const pb*)(ws + WS_MB), (const pb*)(ws + WS_WOUT), cfg::M, 4096, 4096}; pg8::SplitTailOrder S; S.init(4096, (int)blockIdx.x);
        pg8::EpiRes E{args.in[0], args.in[1], Y, (float*)(ws + WS_SLAB_A)};
        pg8::gemm_phase<pg8::EpiRes, pg8::SplitTailOrder, true, PG8_SP2>(F.lds + RING_OFF, g, S, E);
        GRID_BAR();
    }
#endif
    if (IN(7)) {
        const int gw = F.vcu * NWAVES + F.wave, NGW = F.G * NWAVES;
        sample_rows_norm<bf16>(F, args.in[1], (const float*)(ws + WS_SLAB_A), Y + (size_t)cfg::TP * 4096, args.in[22], (bf16*)(ws + WS_XN) + (size_t)cfg::TP * 4096, (LAS float*)(F.lds + RING_OFF));
        for (int m = gw; m < cfg::TP; m += NGW) rms_row4096<bf16>(Y + (size_t)m * 4096, args.in[22], (bf16*)(ws + WS_XN) + (size_t)m * 4096, lane_id());
        GRID_BAR();
    }
    if (IN(8)) {
        if (blockIdx.x < P8_GEMM_WGS) {
        pg8::Gemm g{(const pb*)(ws + WS_XN), (const pb*)(ws + WS_WGU), cfg::M, 2 * cfg::DFF, 4096}; pg8::StaticOrder S; S.init(cfg::M, 2 * cfg::DFF, P8_GEMM_WGS, (int)blockIdx.x);
        pg8::EpiGU2 E{(pb*)(ws + WS_U), args.out, args.in[25], args.in[26], args.in[6], (float*)(ws + WS_TOPUG), (float*)(ws + WS_TOPU), (float*)(ws + WS_BOT), (LAS float*)(F.lds + XCH_OFF)};
        pg8::gemm_phase<pg8::EpiGU2, pg8::StaticOrder, true, PG8_SP2>(F.lds + RING_OFF, g, S, E);
        }
        __syncthreads(); convert_queue<2>(F, args);
        GRID_BAR();
    }
#if DUP_PH == 8
    if (IN(8)) {
        if (blockIdx.x < P8_GEMM_WGS) {
        pg8::Gemm g{(const pb*)(ws + WS_XN), (const pb*)(ws + WS_WGU), cfg::M, 2 * cfg::DFF, 4096}; pg8::StaticOrder S; S.init(cfg::M, 2 * cfg::DFF, P8_GEMM_WGS, (int)blockIdx.x);
        pg8::EpiGU2 E{(pb*)(ws + WS_U), args.out, args.in[25], args.in[26], args.in[6], (float*)(ws + WS_TOPUG), (float*)(ws + WS_TOPU), (float*)(ws + WS_BOT), (LAS float*)(F.lds + XCH_OFF)};
        pg8::gemm_phase<pg8::EpiGU2, pg8::StaticOrder, true, PG8_SP2>(F.lds + RING_OFF, g, S, E);
        }
        __syncthreads(); convert_queue<2>(F, args);
        GRID_BAR();
    }
#endif
    if (IN(9)) { p9_fix(F, args); GRID_BAR(); }
    if (IN(10)) {
        pg8::Gemm g{(const pb*)(ws + WS_U), (const pb*)(ws + WS_WFD), cfg::M, 4096, cfg::DFF}; pg8::SplitTailOrder S; S.init(cfg::DFF, (int)blockIdx.x);
        pg8::EpiRes E{Y, Y + (size_t)cfg::TP * 4096, Y, (float*)(ws + WS_SLAB_D)};
        pg8::gemm_phase<pg8::EpiRes, pg8::SplitTailOrder, true, PG8_SP2>(F.lds + RING_OFF, g, S, E);
        GRID_BAR();
    }
#if DUP_PH == 10
    if (IN(10)) {
        pg8::Gemm g{(const pb*)(ws + WS_U), (const pb*)(ws + WS_WFD), cfg::M, 4096, cfg::DFF}; pg8::SplitTailOrder S; S.init(cfg::DFF, (int)blockIdx.x);
        pg8::EpiRes E{Y, Y + (size_t)cfg::TP * 4096, Y, (float*)(ws + WS_SLAB_D)};
        pg8::gemm_phase<pg8::EpiRes, pg8::SplitTailOrder, true, PG8_SP2>(F.lds + RING_OFF, g, S, E);
        GRID_BAR();
    }
#endif
    if (IN(11)) {
        const int gw = F.vcu * NWAVES + F.wave, NGW = F.G * NWAVES;
        sample_rows_norm<float>(F, Y + (size_t)cfg::TP * 4096, (const float*)(ws + WS_SLAB_D), Y + (size_t)cfg::TP * 4096, args.in[28], Y + (size_t)cfg::TP * 4096, (LAS float*)(F.lds + RING_OFF));
        for (int m = gw; m < cfg::TP; m += NGW) rms_row4096<float>(Y + (size_t)m * 4096, args.in[28], Y + (size_t)m * 4096, lane_id());
    }
#ifdef DBG_COPY
    if (lo <= DBG_COPY && DBG_COPY < hi) {
        const size_t gt = (size_t)(F.vcu * NWAVES + F.wave) * 64 + lane_id(), NGT = (size_t)F.G * NWAVES * 64;
        const v4u* s0 = (const v4u*)(ws + WS_WQB); v4u* d0 = (v4u*)Y; const size_t n0 = (size_t)(WS_WGU - WS_WQB) / 16;
        for (size_t i = gt; i < n0; i += NGT) d0[i] = s0[i];
        const v4u* s1 = (const v4u*)(ws + WS_WFD); v4u* d1 = d0 + n0; const size_t n1 = (size_t)60000000 / 16;
        for (size_t i = gt; i < n1; i += NGT) d1[i] = s1[i];
    }
#endif
#undef IN
#undef GRID_BAR
}

extern "C" void kernel_launch(void* const* d_in, const int* in_sizes, int n_in, void* d_out, int out_size, void* d_ws, size_t ws_size, hipStream_t stream) {
    static int grid = 0;
    if (grid == 0) {
        if (n_in != 29 || in_sizes[0] != cfg::TP * 4096 || (size_t)out_size != cfg::O_END || ws_size < WS_END) {
            fprintf(stderr, "kernel_launch: shape mismatch: n_in %d in0 %d out %d ws %zu (need %zu); nothing launched\n", n_in, n_in > 0 ? in_sizes[0] : -1, out_size, ws_size, (size_t)WS_END); grid = -1; return; }
        int dev = 0, cus = 0, per_cu = 0;
        if (hipGetDevice(&dev) != hipSuccess || hipDeviceGetAttribute(&cus, hipDeviceAttributeMultiprocessorCount, dev) != hipSuccess) { grid = -1; return; }
        if (hipFuncSetAttribute((const void*)fwd, hipFuncAttributeMaxDynamicSharedMemorySize, LDS_BYTES) != hipSuccess) { fprintf(stderr, "kernel_launch: hipFuncSetAttribute failed\n"); grid = -1; return; }
        if (hipOccupancyMaxActiveBlocksPerMultiprocessor(&per_cu, (const void*)fwd, NWAVES * 64, LDS_BYTES) != hipSuccess || per_cu < 1)
            fprintf(stderr, "kernel_launch: note: occupancy query reports %d workgroups per CU\n", per_cu);
        (void)hipGetLastError();
        if (cus < 256) { fprintf(stderr, "kernel_launch: built for a 256-CU device (got %d); nothing launched\n", cus); grid = -1; return; }
        grid = 256;
    }
    if (grid < 0) return;
    if (hipMemsetAsync((char*)d_ws + WS_CTL, 0, CTL_ZERO_BYTES, stream) != hipSuccess) { fprintf(stderr, "kernel_launch: memset failed\n"); return; }
    Args a{};
    for (int i = 0; i < 29; ++i) a.in[i] = (const float*)d_in[i];
    a.out = (float*)d_out; a.ws = (unsigned char*)d_ws;
    for (int li = 0; li < N_LAUNCHES; ++li) {
        a.ph_lo = (N_LAUNCHES == 1) ? 0 : li; a.ph_hi = (N_LAUNCHES == 1) ? NPH : li + 1;
        hipLaunchKernelGGL(fwd, dim3(grid), dim3(NWAVES * 64), LDS_BYTES, stream, a);
        const hipError_t le = hipPeekAtLastError();
        if (le != hipSuccess) { fprintf(stderr, "kernel_launch: launch %d failed: %s\n", li, hipGetErrorName(le)); break; }
    }
}
```

```cpp
#include <hip/hip_runtime.h>
#include <hip/hip_bf16.h>
#include <cstdio>
#include <cstdint>

#define DUP_PH -1
#ifndef MK_N_LAUNCHES
#define MK_N_LAUNCHES 1
#endif

namespace cfg {
constexpr int DM = 4096, TP = 8192, NB = 8, TS = 64, PAST = 2048;
constexpr int MS = NB * TS;
constexpr int M = TP + MS;
constexpr int NQK = 2048, NVA = 2048, QL = 896, KVL = 512, DR = 64, NG = 8192;
constexpr int NINP = 15872;
constexpr int NRAW = 1536;
constexpr int NQB = 3072, NKVBO = 4096;
constexpr int MKV = TP + NB * (PAST + TS);
constexpr int DFF = 11008;
constexpr float EPS = 1e-6f;
constexpr size_t O_Y = 0, O_DKP = 35651584, O_DVP = 52428800, O_CKVP = 69206016, O_KPEP = 73400320, O_CONVP = 73924608,
                 O_DKS = 73946624, O_DVS = 74995200, O_CKVS = 76043776, O_KPES = 76305920, O_CONVS = 76338688, O_END = 76514816;
}
namespace pg8 {
#define PG8_LAS __attribute__((address_space(3)))
typedef unsigned short bf16_t;
typedef short bf16x8 __attribute__((ext_vector_type(8)));
typedef float f32x4 __attribute__((ext_vector_type(4)));
typedef unsigned u32x4 __attribute__((ext_vector_type(4)));
constexpr int BM = 256, BK = 64, HALF = 128, HTB = HALF * BK * 2  , STAGE_BYTES = 8 * HTB, NXCD = 8, WGM = 8;

__host__ __device__ __forceinline__ int lds_byte(int r, int c) { const int st = (r >> 4) * 2 + (c >> 5), rr = r & 15, cc = c & 31, ob = rr * 64 + cc * 2; return st * 1024 + (ob ^ (((ob >> 9) & 1) << 5)); }
__host__ __device__ __forceinline__ void stage_rc(int b, int& R, int& C) { const int st = b / 1024, sb = b % 1024, swz = sb ^ (((sb >> 9) & 1) << 5); R = (st >> 1) * 16 + swz / 64; C = (st & 1) * 32 + (swz % 64) / 2; }
__host__ __device__ __forceinline__ int perm32(int rho) { const int n = rho >> 4, i = rho & 15; return 8 * (i >> 2) + 4 * n + (i & 3); }

struct Unit { int pm, pn, kt0, ntk, split, part; };
struct Gemm { const bf16_t* A; const bf16_t* Bt; int M, N, K; };

struct StaticOrder {
    int nM, nN, nwg, G, c;
    __host__ __device__ void init(int M, int N, int G_, int c_) { nM = M / BM; nN = N / BM; nwg = nM * nN; G = G_; c = c_; }
    __host__ __device__ bool next(int i, Unit& u) const {
        const long L = (long)i * G + c; if (L >= nwg) return false;
        int wgid = (int)L; { const int q = nwg / NXCD, r = nwg % NXCD, xcd = wgid % NXCD, off = wgid / NXCD; wgid = (xcd < r ? xcd * (q + 1) : r * (q + 1) + (xcd - r) * q) + off; }
        const int nig = WGM * nN, gid = wgid / nig, fm = gid * WGM, gsz = (nM - fm) < WGM ? (nM - fm) : WGM;
        u.pm = fm + ((wgid % nig) % gsz); u.pn = (wgid % nig) / gsz; u.kt0 = 0; u.ntk = 0; u.split = 0; u.part = 0; return true;
    }
    __device__ __forceinline__ void a_ready(const Unit&) const {}
    __device__ __forceinline__ void done(const Unit&) const {}
};

struct SplitTailOrder {
    StaticOrder so; int nt, c;
    __host__ __device__ void init(int K, int c_) { so.init(8192, 4096, 256, c_); nt = K / BK; c = c_; }
    __host__ __device__ bool next(int i, Unit& u) const {
        if (i < 2) return so.next(i, u);
        if (i > 2) return false;
        const int tt = c >> 3, s = c & 7, q = nt >> 1, qb = q >> 3, qr = q & 7;
        u.pm = 32 + (tt & 1); u.pn = tt >> 1; u.kt0 = 2 * (s * qb + (s < qr ? s : qr)); u.ntk = 2 * (qb + (s < qr ? 1 : 0)); u.split = s + 1; u.part = 0; return true;
    }
    __device__ __forceinline__ void a_ready(const Unit&) const {}
    __device__ __forceinline__ void done(const Unit&) const {}
};
struct SplitTailOrder2 {
    StaticOrder so; int nt, c;
    __host__ __device__ void init(int K, int c_) { so.init(8192, 4096, 256, c_); nt = K / BK; c = c_; }
    __host__ __device__ bool next(int i, Unit& u) const {
        if (i < 4) { if (!so.next(i >> 1, u)) return false; u.ntk = nt >> 1; u.kt0 = (i & 1) * (nt >> 1); u.part = 1 + (i & 1); return true; }
        if (i > 4) return false;
        const int tt = c >> 3, s = c & 7, q = nt >> 1, qb = q >> 3, qr = q & 7;
        u.pm = 32 + (tt & 1); u.pn = tt >> 1; u.kt0 = 2 * (s * qb + (s < qr ? s : qr)); u.ntk = 2 * (qb + (s < qr ? 1 : 0)); u.split = s + 1; u.part = 0; return true;
    }
    __device__ __forceinline__ void a_ready(const Unit&) const {}
    __device__ __forceinline__ void done(const Unit&) const {}
};
typedef float f32x2c_t __attribute__((ext_vector_type(2))); typedef __bf16 bf16x2c_t __attribute__((ext_vector_type(2)));
__device__ __forceinline__ unsigned cvt_pk_bf16(float lo, float hi) { f32x2c_t v = {lo, hi}; bf16x2c_t b = __builtin_convertvector(v, bf16x2c_t); return __builtin_bit_cast(unsigned, b); }
typedef float f32x2 __attribute__((ext_vector_type(2)));
__device__ __forceinline__ u32x4 pack8(const f32x4 v0, const f32x4 v1) { u32x4 w; w.x = cvt_pk_bf16(v0[0], v0[1]); w.y = cvt_pk_bf16(v0[2], v0[3]); w.z = cvt_pk_bf16(v1[0], v1[1]); w.w = cvt_pk_bf16(v1[2], v1[3]); return w; }
__device__ __forceinline__ void unpack8(const u32x4 w, f32x4& a, f32x4& b) {
    a[0] = __uint_as_float(w.x << 16); a[1] = __uint_as_float(w.x & 0xffff0000u); a[2] = __uint_as_float(w.y << 16); a[3] = __uint_as_float(w.y & 0xffff0000u);
    b[0] = __uint_as_float(w.z << 16); b[1] = __uint_as_float(w.z & 0xffff0000u); b[2] = __uint_as_float(w.w << 16); b[3] = __uint_as_float(w.w & 0xffff0000u); }
#define NT_ST(ptr, val) __builtin_nontemporal_store((val), (ptr))
__device__ __forceinline__ float sigmoidf_(float x) { return __builtin_amdgcn_rcpf(1.0f + __expf(-x)); }

struct EpiPlain {
    static constexpr bool PERM = true, AFTER_DRAIN = false;
    bf16_t* O; int ldc;
    __device__ __forceinline__ void operator()(const f32x4 (&acc)[2][2][4][2], const Unit& u, int wr, int wc, int fr, int fq) const {
        const int row0 = u.pm * BM + wr * 64 + fr, col0 = u.pn * BM + wc * 32 + 8 * fq;
#pragma unroll
        for (int ai = 0; ai < 2; ++ai)
#pragma unroll
            for (int m = 0; m < 4; ++m) { bf16_t* rowp = O + (size_t)(row0 + ai * HALF + m * 16) * ldc + col0;
#pragma unroll
                for (int bj = 0; bj < 2; ++bj) NT_ST((u32x4*)(rowp + bj * HALF), pack8(acc[ai][bj][m][0], acc[ai][bj][m][1])); }
    }
};

constexpr float QSCALE_A = 0.125f * 1.4426950408889634f, QSCALE_B = 0.07216878364870322f * 1.4426950408889634f;
struct EpiIn {
    static constexpr bool PERM = true, AFTER_DRAIN = false;
    bf16_t* QA; bf16_t* KA; bf16_t* VA; bf16_t* G; float* RAW; float* out; const float* b_gate; const float* tabA;
    __device__ __forceinline__ void operator()(const f32x4 (&acc)[2][2][4][2], const Unit& u, int wr, int wc, int fr, int fq) const {
        const int pn = u.pn; const bool smp = u.pm >= 32;
        const int row0 = u.pm * BM + wr * 64 + fr, cw = wc * 32 + 8 * fq;
        if (pn < 16) {
            const bool isk = pn >= 8; bf16_t* dst = isk ? KA : QA; const int cb = (pn & 7) * BM + cw;
            float* fo = out + (smp ? (cfg::O_DKS - (size_t)cfg::TP * 2048) : cfg::O_DKP);
            const bool ropew = (wc & 1) == 0;
#pragma unroll
            for (int ah = 0; ah < 4; ++ah) {
                const int ai = ah >> 1, mh = ah & 1;
                f32x4 tq[2][4];
                if (ropew) {
#pragma unroll
                    for (int mm = 0; mm < 2; ++mm) { const int row = row0 + ai * HALF + (mh * 2 + mm) * 16; const int pos = smp ? 2048 + (row & 63) : row; const f32x4* tp = (const f32x4*)(tabA + (size_t)pos * 16);
                        tq[mm][0] = tp[0]; tq[mm][1] = tp[1]; tq[mm][2] = tp[2]; tq[mm][3] = tp[3]; } }
#pragma unroll
                for (int mm = 0; mm < 2; ++mm) {
                    const int m = mh * 2 + mm; const int row = row0 + ai * HALF + m * 16;
                    f32x4 t0 = {1.f, 0.f, 1.f, 0.f}, t1 = t0, t2 = t0, t3 = t0;
                    if (ropew) { t0 = tq[mm][0]; t1 = tq[mm][1]; t2 = tq[mm][2]; t3 = tq[mm][3]; }
#pragma unroll
                    for (int bj = 0; bj < 2; ++bj) {
                        f32x4 v0 = acc[ai][bj][m][0], v1 = acc[ai][bj][m][1];
                        if (ropew) {
                            f32x4 p0, p1;
#pragma unroll
                            for (int e = 0; e < 4; ++e) { p0[e] = __shfl_xor(v0[e], 16); p1[e] = __shfl_xor(v1[e], 16); }
                            const float sg = (fq == 0) ? -1.f : 1.f;
                            if (fq < 2) {
                                v0[0] = v0[0] * t0[0] + sg * p0[0] * t0[1]; v0[1] = v0[1] * t0[2] + sg * p0[1] * t0[3];
                                v0[2] = v0[2] * t1[0] + sg * p0[2] * t1[1]; v0[3] = v0[3] * t1[2] + sg * p0[3] * t1[3];
                                v1[0] = v1[0] * t2[0] + sg * p1[0] * t2[1]; v1[1] = v1[1] * t2[2] + sg * p1[1] * t2[3];
                                v1[2] = v1[2] * t3[0] + sg * p1[2] * t3[1]; v1[3] = v1[3] * t3[2] + sg * p1[3] * t3[3];
                            }
                        }
                        const size_t off = (size_t)row * 2048 + cb + bj * HALF;
                        if (isk) { NT_ST((u32x4*)(dst + off), pack8(v0, v1)); NT_ST((f32x4*)(fo + off), v0); NT_ST((f32x4*)(fo + off + 4), v1); }
                        else NT_ST((u32x4*)(dst + off), pack8(v0 * QSCALE_A, v1 * QSCALE_A));
                    }
                }
            }
        } else if (pn < 24) {
            const int cb = (pn - 16) * BM + cw; float* fo = out + (smp ? (cfg::O_DVS - (size_t)cfg::TP * 2048) : cfg::O_DVP);
#pragma unroll
            for (int ai = 0; ai < 2; ++ai)
#pragma unroll
                for (int m = 0; m < 4; ++m) { const int row = row0 + ai * HALF + m * 16;
#pragma unroll
                    for (int bj = 0; bj < 2; ++bj) { const size_t off = (size_t)row * 2048 + cb + bj * HALF; const f32x4 v0 = acc[ai][bj][m][0], v1 = acc[ai][bj][m][1];
                        NT_ST((u32x4*)(VA + off), pack8(v0, v1)); NT_ST((f32x4*)(fo + off), v0); NT_ST((f32x4*)(fo + off + 4), v1); } }
        } else if (pn < 56) {
            const int cb = (pn - 24) * BM + cw;
            f32x4 bv[2][2];
#pragma unroll
            for (int bj = 0; bj < 2; ++bj) { bv[bj][0] = *(const f32x4*)(b_gate + cb + bj * HALF); bv[bj][1] = *(const f32x4*)(b_gate + cb + bj * HALF + 4); }
#pragma unroll
            for (int ai = 0; ai < 2; ++ai)
#pragma unroll
                for (int m = 0; m < 4; ++m) { const int row = row0 + ai * HALF + m * 16;
#pragma unroll
                    for (int bj = 0; bj < 2; ++bj) { f32x4 v0 = acc[ai][bj][m][0] + bv[bj][0], v1 = acc[ai][bj][m][1] + bv[bj][1];
#pragma unroll
                        for (int e = 0; e < 4; ++e) { v0[e] = sigmoidf_(v0[e]); v1[e] = sigmoidf_(v1[e]); }
                        NT_ST((u32x4*)(G + (size_t)row * 8192 + cb + bj * HALF), pack8(v0, v1)); } }
        } else {
            const int cb = (pn - 56) * BM + cw;
#pragma unroll
            for (int ai = 0; ai < 2; ++ai)
#pragma unroll
                for (int m = 0; m < 4; ++m) { const int row = row0 + ai * HALF + m * 16;
#pragma unroll
                    for (int bj = 0; bj < 2; ++bj) { float* p = RAW + (size_t)row * cfg::NRAW + cb + bj * HALF; *(f32x4*)p = acc[ai][bj][m][0]; *(f32x4*)(p + 4) = acc[ai][bj][m][1]; } }
        }
    }
};

struct EpiQB {
    static constexpr bool PERM = true, AFTER_DRAIN = false;
    bf16_t* QB; const float* tabB;
    __device__ __forceinline__ void operator()(const f32x4 (&acc)[2][2][4][2], const Unit& u, int wr, int wc, int fr, int fq) const {
        const bool smp = u.pm >= 32; const int row0 = u.pm * BM + wr * 64 + fr, col0 = u.pn * BM + wc * 32 + 8 * fq;
#pragma unroll
        for (int bj = 0; bj < 2; ++bj) {
            const int g6 = (u.pn * 8 + bj * 4 + wc) % 6; const bool pe = g6 >= 4; const int i0 = 16 * (g6 - 4) + 4 * fq;
#pragma unroll
            for (int ai = 0; ai < 2; ++ai)
#pragma unroll
                for (int m = 0; m < 4; ++m) { const int row = row0 + ai * HALF + m * 16; const int pos = smp ? 2048 + (row & 63) : row;
                    f32x4 v0 = acc[ai][bj][m][0], v1 = acc[ai][bj][m][1];
                    if (pe) { const f32x4* tp = (const f32x4*)(tabB + ((size_t)pos * 32 + i0) * 2); const f32x4 ta = tp[0], tb = tp[1];
                        f32x4 w0, w1;
                        w0[0] = v0[0] * ta[0] - v0[1] * ta[1]; w0[1] = v0[1] * ta[0] + v0[0] * ta[1];
                        w0[2] = v0[2] * ta[2] - v0[3] * ta[3]; w0[3] = v0[3] * ta[2] + v0[2] * ta[3];
                        w1[0] = v1[0] * tb[0] - v1[1] * tb[1]; w1[1] = v1[1] * tb[0] + v1[0] * tb[1];
                        w1[2] = v1[2] * tb[2] - v1[3] * tb[3]; w1[3] = v1[3] * tb[2] + v1[2] * tb[3];
                        v0 = w0; v1 = w1; }
                    NT_ST((u32x4*)(QB + (size_t)row * cfg::NQB + col0 + bj * HALF), pack8(v0 * QSCALE_B, v1 * QSCALE_B)); }
        }
    }
};

__device__ __forceinline__ void slab_store(float* slab, const f32x4 (&acc)[2][2][4][2], const Unit& u, int wr, int wc, int fr, int fq) {
    const int row0 = (u.pm - 32) * BM + wr * 64 + fr, col0 = u.pn * BM + wc * 32 + 8 * fq; float* sb = slab + (size_t)(u.split - 1) * 512 * 4096;
#pragma unroll
    for (int ai = 0; ai < 2; ++ai)
#pragma unroll
        for (int m = 0; m < 4; ++m)
#pragma unroll
            for (int bj = 0; bj < 2; ++bj) { float* p = sb + (size_t)(row0 + ai * HALF + m * 16) * 4096 + col0 + bj * HALF; *(f32x4*)p = acc[ai][bj][m][0]; *(f32x4*)(p + 4) = acc[ai][bj][m][1]; }
}
struct EpiY {
    static constexpr bool PERM = true, AFTER_DRAIN = false;
    const bf16_t* G; bf16_t* MB; float* slab;
    __device__ __forceinline__ void operator()(f32x4 (&acc)[2][2][4][2], const Unit& u, int wr, int wc, int fr, int fq) const {
        if (u.split) { slab_store(slab, acc, u, wr, wc, fr, fq); return; }
        const int row0 = u.pm * BM + wr * 64 + fr, col0 = u.pn * BM + wc * 32 + 8 * fq;
#pragma unroll
        for (int ai = 0; ai < 2; ++ai)
#pragma unroll
            for (int mh = 0; mh < 2; ++mh) {
                u32x4 g0q[2][2], g1q[2][2];
#pragma unroll
                for (int mm = 0; mm < 2; ++mm)
#pragma unroll
                    for (int bj = 0; bj < 2; ++bj) { const bf16_t* gp = G + (size_t)(row0 + ai * HALF + (mh * 2 + mm) * 16) * 8192 + col0 + bj * HALF;
                        g1q[mm][bj] = *(const u32x4*)(gp + 4096); if (u.part == 1) g0q[mm][bj] = *(const u32x4*)gp; }
#pragma unroll
                for (int mm = 0; mm < 2; ++mm)
#pragma unroll
                    for (int bj = 0; bj < 2; ++bj) { const int m = mh * 2 + mm; f32x4 a1, b1; unpack8(g1q[mm][bj], a1, b1);
                        if (u.part == 1) { f32x4 a0, b0; unpack8(g0q[mm][bj], a0, b0);
#pragma unroll
                            for (int e = 0; e < 4; ++e) { acc[ai][bj][m][0][e] *= a0[e] * __builtin_amdgcn_rcpf(fmaxf(a1[e], 1e-30f)); acc[ai][bj][m][1][e] *= b0[e] * __builtin_amdgcn_rcpf(fmaxf(b1[e], 1e-30f)); } }
                        else { const int row = row0 + ai * HALF + m * 16, col = col0 + bj * HALF;
                            *(u32x4*)(MB + (size_t)row * 4096 + col) = pack8(acc[ai][bj][m][0] * a1, acc[ai][bj][m][1] * b1); } }
            }
    }
};
struct EpiRes {
    static constexpr bool PERM = true, AFTER_DRAIN = false;
    const float* base_p; const float* base_s; float* out; float* slab;
    __device__ __forceinline__ void operator()(const f32x4 (&acc)[2][2][4][2], const Unit& u, int wr, int wc, int fr, int fq) const {
        if (u.split) { slab_store(slab, acc, u, wr, wc, fr, fq); return; }
        const int row0 = u.pm * BM + wr * 64 + fr, col0 = u.pn * BM + wc * 32 + 8 * fq; const bool smp = u.pm >= 32;
        const float* bs = smp ? base_s - (size_t)cfg::TP * 4096 : base_p;
#pragma unroll
        for (int ai = 0; ai < 2; ++ai)
#pragma unroll
            for (int mh = 0; mh < 2; ++mh) {
                f32x4 bq[2][2][2];
#pragma unroll
                for (int mm = 0; mm < 2; ++mm)
#pragma unroll
                    for (int bj = 0; bj < 2; ++bj) { const size_t off = (size_t)(row0 + ai * HALF + (mh * 2 + mm) * 16) * 4096 + col0 + bj * HALF;
                        bq[mm][bj][0] = *(const f32x4*)(bs + off); bq[mm][bj][1] = *(const f32x4*)(bs + off + 4); }
#pragma unroll
                for (int mm = 0; mm < 2; ++mm)
#pragma unroll
                    for (int bj = 0; bj < 2; ++bj) { const int m = mh * 2 + mm; const size_t off = (size_t)(row0 + ai * HALF + m * 16) * 4096 + col0 + bj * HALF;
                        *(f32x4*)(out + off) = bq[mm][bj][0] + acc[ai][bj][m][0]; *(f32x4*)(out + off + 4) = bq[mm][bj][1] + acc[ai][bj][m][1]; }
            }
    }
};
__device__ __forceinline__ float dpp_ror1(float x) { return __int_as_float(__builtin_amdgcn_update_dpp(0, __float_as_int(x), 0x121, 0xf, 0xf, false)); }
__device__ __forceinline__ float dpp_ror2(float x) { return __int_as_float(__builtin_amdgcn_update_dpp(0, __float_as_int(x), 0x122, 0xf, 0xf, false)); }
struct EpiGU2 {
    static constexpr bool PERM = true, AFTER_DRAIN = false;
    bf16_t* ACT; float* out; const float* wconv; const float* bconv; const float* stc; float* topug; float* topu; float* bot; PG8_LAS float* xch;
    __device__ __forceinline__ void operator()(const f32x4 (&acc)[2][2][4][2], const Unit& u, int wr, int wc, int fr, int fq) const {
        const int pm = u.pm, chl = wc * 32 + 8 * fq, ch0 = u.pn * HALF + chl; const bool smp = pm >= 32;
        const int row0 = pm * BM + wr * 64 + fr;
        if (fr >= 14) {
#pragma unroll
            for (int ai = 0; ai < 2; ++ai)
#pragma unroll
                for (int n = 0; n < 2; ++n) *(PG8_LAS f32x4*)(xch + ((ai * 2 + wr) * 2 + (fr - 14)) * 128 + chl + 4 * n) = acc[ai][0][3][n];
        }
        f32x4 w0[2], w1[2], w2[2], bb[2];
#pragma unroll
        for (int n = 0; n < 2; ++n) { w0[n] = *(const f32x4*)(wconv + ch0 + 4 * n); w1[n] = *(const f32x4*)(wconv + cfg::DFF + ch0 + 4 * n); w2[n] = *(const f32x4*)(wconv + 2 * cfg::DFF + ch0 + 4 * n); bb[n] = *(const f32x4*)(bconv + ch0 + 4 * n); }
        asm volatile("s_waitcnt lgkmcnt(0)" ::: "memory"); __builtin_amdgcn_s_barrier(); asm volatile("" ::: "memory");
#pragma unroll
        for (int ai = 0; ai < 2; ++ai) {
            f32x4 H1[2], H2[2];
            if (smp) { const int b = (pm - 32) * 4 + ai * 2 + wr;
#pragma unroll
                for (int n = 0; n < 2; ++n) { H2[n] = *(const f32x4*)(stc + (size_t)(b * 2 + 0) * cfg::DFF + ch0 + 4 * n); H1[n] = *(const f32x4*)(stc + (size_t)(b * 2 + 1) * cfg::DFF + ch0 + 4 * n); } }
            else if (ai == 0 && wr == 0) {
#pragma unroll
                for (int n = 0; n < 2; ++n) { H1[n] = (f32x4){0.f, 0.f, 0.f, 0.f}; H2[n] = H1[n]; } }
            else { const int sa = wr ? ai : ai - 1, sw = wr ? 0 : 1;
#pragma unroll
                for (int n = 0; n < 2; ++n) { H2[n] = *(const PG8_LAS f32x4*)(xch + ((sa * 2 + sw) * 2 + 0) * 128 + chl + 4 * n); H1[n] = *(const PG8_LAS f32x4*)(xch + ((sa * 2 + sw) * 2 + 1) * 128 + chl + 4 * n); } }
            if (!smp && ai == 0 && wr == 0 && pm >= 1 && fr < 2) {
#pragma unroll
                for (int n = 0; n < 2; ++n) { *(f32x4*)(topug + (size_t)(pm * 2 + fr) * cfg::DFF + ch0 + 4 * n) = acc[0][0][0][n]; *(f32x4*)(topu + (size_t)(pm * 2 + fr) * cfg::DFF + ch0 + 4 * n) = acc[0][1][0][n]; } }
            if (!smp && ai == 1 && wr == 1 && fr >= 14) {
#pragma unroll
                for (int n = 0; n < 2; ++n) *(f32x4*)(bot + (size_t)(pm * 2 + (fr - 14)) * cfg::DFF + ch0 + 4 * n) = acc[1][0][3][n]; }
#pragma unroll
            for (int m = 0; m < 4; ++m) { const int row = row0 + ai * HALF + m * 16;
                f32x4 a[2];
#pragma unroll
                for (int n = 0; n < 2; ++n)
#pragma unroll
                    for (int e = 0; e < 4; ++e) { const float x = acc[ai][0][m][n][e];
                        const float r1 = dpp_ror1(x), r2 = dpp_ror2(x);
                        float q1, q2;
                        if (m > 0) { q1 = dpp_ror1(acc[ai][0][m > 0 ? m - 1 : 0][n][e]); q2 = dpp_ror2(acc[ai][0][m > 0 ? m - 1 : 0][n][e]); }
                        else { q1 = H1[n][e]; q2 = (fr == 1) ? H1[n][e] : H2[n][e]; }
                        const float p1 = fr >= 1 ? r1 : q1, p2 = fr >= 2 ? r2 : q2;
                        const float c = bb[n][e] + w0[n][e] * p2 + w1[n][e] * p1 + w2[n][e] * x;
                        a[n][e] = c * __builtin_amdgcn_rcpf(1.f + __expf(-c)) * acc[ai][1][m][n][e]; }
                __builtin_nontemporal_store(pack8(a[0], a[1]), (u32x4*)(ACT + (size_t)row * cfg::DFF + ch0));
                if ((row & 63) >= 62 && row >= cfg::TP - 2) {
                    float* p = (row < cfg::TP) ? out + cfg::O_CONVP + (size_t)(row - (cfg::TP - 2)) * cfg::DFF + ch0
                                               : out + cfg::O_CONVS + (size_t)(((row - cfg::TP) >> 6) * 2 + ((row & 63) - 62)) * cfg::DFF + ch0;
                    *(f32x4*)p = acc[ai][0][m][0]; *(f32x4*)(p + 4) = acc[ai][0][m][1]; } }
        }
        asm volatile("s_waitcnt lgkmcnt(0)" ::: "memory"); __builtin_amdgcn_s_barrier(); asm volatile("" ::: "memory");
    }
};
template <class Epi, class Sched, bool ALIGN_EPI = false, bool SP2 = false>
__device__ __forceinline__ void gemm_phase(PG8_LAS unsigned char* lds, const Gemm g, const Sched& S, const Epi& E) {
    const int tid = threadIdx.x, wid = __builtin_amdgcn_readfirstlane(tid >> 6), lane = tid & 63, wr = wid >> 2, wc = wid & 3, fr = lane & 15, fq = lane >> 4;
    const int K = g.K, nt = K / BK;
    unsigned voffA[2], voffB[2];
#pragma unroll
    for (int i = 0; i < 2; ++i) { int R, C; stage_rc(tid * 16 + i * 8192, R, C); const int Rb = Epi::PERM ? ((R & ~31) + perm32(R & 31)) : R;
        voffA[i] = (unsigned)(R * K + C) * 2u; voffB[i] = (unsigned)(Rb * K + C) * 2u; }
    const size_t kstep = (size_t)(BK * 2);
    const size_t hstep = (size_t)HALF * K * 2;
    const size_t tstep = 2 * hstep;
    const unsigned ldsw = (unsigned)wid * 1024u;
    const int aoff = lds_byte(wr * 64 + fr, fq * 8), boff = lds_byte(wc * 32 + fr, fq * 8);
#define PG8_SA(b, h) (((b) * 2 + (h)) * HTB)
#define PG8_SB(b, h) ((4 + (b) * 2 + (h)) * HTB)
#define PG8_STAGE(bufoff, gbase, voff) do { _Pragma("unroll") for (int _i = 0; _i < 2; ++_i) \
        __builtin_amdgcn_global_load_lds((const unsigned*)((const char*)(gbase) + (voff)[_i]), (PG8_LAS unsigned*)(lds + (bufoff) + ldsw + _i * 8192), 16, 0, 0); } while (0)
#define PG8_LDA(dst, b, h) do { _Pragma("unroll") for (int m = 0; m < 4; ++m) _Pragma("unroll") for (int k = 0; k < 2; ++k) dst[m][k] = *(const PG8_LAS bf16x8*)(lds + PG8_SA(b, h) + aoff + m * 2048 + k * 1024); } while (0)
#define PG8_LDB(dst, b, h) do { _Pragma("unroll") for (int n = 0; n < 2; ++n) _Pragma("unroll") for (int k = 0; k < 2; ++k) dst[n][k] = *(const PG8_LAS bf16x8*)(lds + PG8_SB(b, h) + boff + n * 2048 + k * 1024); } while (0)
#define PG8_MMA(ai, bj, At, Bt) do { __builtin_amdgcn_s_setprio(1); _Pragma("unroll") for (int m = 0; m < 4; ++m) _Pragma("unroll") for (int n = 0; n < 2; ++n) _Pragma("unroll") for (int k = 0; k < 2; ++k) \
        acc[ai][bj][m][n] = __builtin_amdgcn_mfma_f32_16x16x32_bf16(Bt[n][k], At[m][k], acc[ai][bj][m][n], 0, 0, 0); __builtin_amdgcn_s_setprio(0); } while (0)
#define PG8_WAIT_V(n) asm volatile("s_waitcnt vmcnt(" #n ")" ::: "memory")
#define PG8_WAIT_L(n) asm volatile("s_waitcnt lgkmcnt(" #n ")" ::: "memory")
#define PG8_BAR __builtin_amdgcn_s_barrier()
#define PG8_SCHED __builtin_amdgcn_sched_barrier(0)
    Unit cur, nxt; int ui = 0;
    if (!S.next(0, cur)) return;
    f32x4 acc[2][2][4][2];
#pragma unroll
    for (int a = 0; a < 2; ++a)
#pragma unroll
        for (int b = 0; b < 2; ++b)
#pragma unroll
            for (int m = 0; m < 4; ++m)
#pragma unroll
                for (int n = 0; n < 2; ++n) acc[a][b][m][n] = (f32x4){0.f, 0.f, 0.f, 0.f};
    bf16x8 At[4][2], B0[2][2], B1[2][2];
    const char* cA = (const char*)g.A + (size_t)cur.pm * tstep + (size_t)cur.kt0 * kstep; const char* cB = (const char*)g.Bt + (size_t)cur.pn * tstep + (size_t)cur.kt0 * kstep;
    S.a_ready(cur);
    if constexpr (SP2) {
        PG8_STAGE(PG8_SB(0, 0), cB, voffB); PG8_STAGE(PG8_SB(0, 1), cB + hstep, voffB); PG8_STAGE(PG8_SA(0, 0), cA, voffA); PG8_STAGE(PG8_SA(0, 1), cA + hstep, voffA);
        if (wr == 1) PG8_BAR;
        PG8_WAIT_V(2); PG8_BAR;
        PG8_STAGE(PG8_SB(1, 0), cB + kstep, voffB); PG8_STAGE(PG8_SA(1, 0), cA + kstep, voffA); PG8_STAGE(PG8_SB(1, 1), cB + hstep + kstep, voffB);
        PG8_WAIT_V(6); PG8_BAR;
    } else {
        PG8_STAGE(PG8_SB(0, 0), cB, voffB); PG8_STAGE(PG8_SA(0, 0), cA, voffA); PG8_STAGE(PG8_SB(0, 1), cB + hstep, voffB); PG8_STAGE(PG8_SA(0, 1), cA + hstep, voffA);
        if (wr == 1) PG8_BAR;
        PG8_WAIT_V(4); PG8_BAR;
        PG8_STAGE(PG8_SB(1, 0), cB + kstep, voffB); PG8_STAGE(PG8_SA(1, 0), cA + kstep, voffA); PG8_STAGE(PG8_SB(1, 1), cB + hstep + kstep, voffB);
        PG8_WAIT_V(6); PG8_BAR;
    }
    for (;;) {
        const bool has_next = S.next(ui + 1, nxt);
        const char* nA = has_next ? (const char*)g.A + (size_t)nxt.pm * tstep + (size_t)nxt.kt0 * kstep : cA; const char* nB = has_next ? (const char*)g.Bt + (size_t)nxt.pn * tstep + (size_t)nxt.kt0 * kstep : cB;
        const int ntu = cur.ntk ? cur.ntk : nt;
        for (int t = 0; t < ntu; t += 2) {
            const bool last = (t == ntu - 2);
            const char* a1 = cA + (size_t)(t + 1) * kstep;
            const char* a2 = last ? nA : cA + (size_t)(t + 2) * kstep; const char* b2 = last ? nB : cB + (size_t)(t + 2) * kstep;
            const char* a3 = a2 + kstep; const char* b3 = b2 + kstep;
            if (last && has_next) S.a_ready(nxt);
            if constexpr (SP2) {
            PG8_LDB(B0, 0, 0); PG8_LDB(B1, 0, 1); PG8_SCHED; PG8_LDA(At, 0, 0); PG8_STAGE(PG8_SA(1, 1), a1 + hstep, voffA);
            PG8_WAIT_V(8); PG8_WAIT_L(0); PG8_BAR; PG8_MMA(0, 0, At, B0); PG8_MMA(0, 1, At, B1); PG8_BAR; PG8_SCHED;
            PG8_LDA(At, 0, 1); PG8_STAGE(PG8_SB(0, 0), b2, voffB); PG8_STAGE(PG8_SB(0, 1), b2 + hstep, voffB); PG8_STAGE(PG8_SA(0, 0), a2, voffA);
            PG8_WAIT_V(8); PG8_WAIT_L(0); PG8_BAR; PG8_MMA(1, 0, At, B0); PG8_MMA(1, 1, At, B1); PG8_BAR; PG8_SCHED;
            PG8_LDB(B0, 1, 0); PG8_LDB(B1, 1, 1); PG8_SCHED; PG8_LDA(At, 1, 0); PG8_STAGE(PG8_SA(0, 1), a2 + hstep, voffA);
            PG8_WAIT_V(8); PG8_WAIT_L(0); PG8_BAR; PG8_MMA(0, 0, At, B0); PG8_MMA(0, 1, At, B1); PG8_BAR; PG8_SCHED;
            PG8_LDA(At, 1, 1); PG8_STAGE(PG8_SB(1, 0), b3, voffB); PG8_STAGE(PG8_SB(1, 1), b3 + hstep, voffB); PG8_STAGE(PG8_SA(1, 0), a3, voffA);
            PG8_WAIT_V(8); PG8_WAIT_L(0); PG8_BAR; PG8_MMA(1, 0, At, B0); PG8_MMA(1, 1, At, B1); PG8_BAR; PG8_SCHED;
            } else {
            PG8_LDB(B0, 0, 0); PG8_SCHED; PG8_LDA(At, 0, 0); PG8_STAGE(PG8_SA(1, 1), a1 + hstep, voffA);
            PG8_WAIT_L(8); PG8_BAR; PG8_WAIT_L(0); PG8_MMA(0, 0, At, B0); PG8_BAR; PG8_SCHED;
            PG8_LDB(B1, 0, 1); PG8_STAGE(PG8_SB(0, 0), b2, voffB);
            PG8_BAR; PG8_WAIT_L(0); PG8_MMA(0, 1, At, B1); PG8_BAR;
            PG8_LDA(At, 0, 1); PG8_STAGE(PG8_SA(0, 0), a2, voffA);
            PG8_BAR; PG8_WAIT_L(0); PG8_MMA(1, 0, At, B0); PG8_BAR; PG8_SCHED;
            PG8_STAGE(PG8_SB(0, 1), b2 + hstep, voffB);
            PG8_WAIT_V(6); PG8_BAR; PG8_MMA(1, 1, At, B1); PG8_BAR;
            PG8_LDB(B0, 1, 0); PG8_SCHED; PG8_LDA(At, 1, 0); PG8_STAGE(PG8_SA(0, 1), a2 + hstep, voffA);
            PG8_WAIT_L(8); PG8_BAR; PG8_WAIT_L(0); PG8_MMA(0, 0, At, B0); PG8_BAR; PG8_SCHED;
            PG8_LDB(B1, 1, 1); PG8_STAGE(PG8_SB(1, 0), b3, voffB);
            PG8_BAR; PG8_WAIT_L(0); PG8_MMA(0, 1, At, B1); PG8_BAR;
            PG8_LDA(At, 1, 1); PG8_STAGE(PG8_SA(1, 0), a3, voffA);
            PG8_BAR; PG8_WAIT_L(0); PG8_MMA(1, 0, At, B0); PG8_BAR; PG8_SCHED;
            PG8_STAGE(PG8_SB(1, 1), b3 + hstep, voffB);
            PG8_WAIT_V(6); PG8_BAR; PG8_MMA(1, 1, At, B1); PG8_BAR;
            }
        }
        if constexpr (ALIGN_EPI) { if (wr == 0) PG8_BAR; }
        if constexpr (!Epi::AFTER_DRAIN) { E(acc, cur, wr, wc, fr, fq); S.done(cur); }
        if (!has_next) break;
        if (cur.part != 1)
#pragma unroll
        for (int a = 0; a < 2; ++a)
#pragma unroll
            for (int b = 0; b < 2; ++b)
#pragma unroll
                for (int m = 0; m < 4; ++m)
#pragma unroll
                    for (int n = 0; n < 2; ++n) acc[a][b][m][n] = (f32x4){0.f, 0.f, 0.f, 0.f};
        cur = nxt; cA = nA; cB = nB; ++ui;
        if constexpr (ALIGN_EPI) { if (wr == 1) PG8_BAR; }
    }
    PG8_WAIT_V(0);
    if constexpr (!ALIGN_EPI) { if (wr == 0) PG8_BAR; }
    PG8_BAR;
    if constexpr (Epi::AFTER_DRAIN) { E.fused(acc, cur, wr, wc, fr, fq, lds, wid, lane); S.done(cur); }
#undef PG8_SA
#undef PG8_SB
#undef PG8_STAGE
#undef PG8_LDA
#undef PG8_LDB
#undef PG8_MMA
#undef PG8_WAIT_V
#undef PG8_WAIT_L
#undef PG8_BAR
#undef PG8_SCHED
}
}
#define GAS __attribute__((address_space(1)))
#define LAS __attribute__((address_space(3)))
typedef unsigned short bf16;
typedef unsigned v4u __attribute__((ext_vector_type(4)));
typedef float f32x4 __attribute__((ext_vector_type(4)));
typedef short bf16x8 __attribute__((ext_vector_type(8)));
typedef GAS unsigned gu32;
typedef GAS unsigned long long gu64;
#define RLX_AGENT __ATOMIC_RELAXED, __HIP_MEMORY_SCOPE_AGENT
#define LDS_WAIT() asm volatile("s_waitcnt lgkmcnt(0)" ::: "memory")
#define VM_WAIT() asm volatile("s_waitcnt vmcnt(0)" ::: "memory")
__device__ __forceinline__ unsigned long long rt() { return __builtin_amdgcn_s_memrealtime(); }
__device__ __forceinline__ unsigned f2bf(float f) { unsigned u = __builtin_bit_cast(unsigned, f); return (u + 0x7fffu + ((u >> 16) & 1u)) >> 16; }
__device__ __forceinline__ unsigned pk2(float lo, float hi) { return f2bf(lo) | (f2bf(hi) << 16); }

#define XB_TMO      128
#define XB_XCNT(j)  (256  + 64 * (j))
#define XB_XSUB(j)  (1280 + 64 * (j))
#define XB_XGEN(j)  (2304 + 64 * (j))
#define XB_TOP      3328
#define XB_TOPGEN   3392
#define XCD_BAR_WORDS 3456
#define XB_SPIN_CAP (1u << 18)

__device__ __forceinline__ unsigned xb_ld(unsigned* p)              { return __hip_atomic_load(p, __ATOMIC_RELAXED, __HIP_MEMORY_SCOPE_AGENT); }
__device__ __forceinline__ unsigned xb_add(unsigned* p, unsigned v) { return __hip_atomic_fetch_add(p, v, __ATOMIC_RELAXED, __HIP_MEMORY_SCOPE_AGENT); }
__device__ __forceinline__ unsigned xb_xcc_id() { return (unsigned)__builtin_amdgcn_s_getreg((3 << 11) | 20) & 0xFu; }
#define XB_SPIN(cond, bar) do { unsigned _sp = 0; while (cond) { __builtin_amdgcn_s_sleep(1); \
    if ((++_sp & 255u) == 0u) { if (xb_ld(&(bar)[XB_TMO])) break; if (_sp > XB_SPIN_CAP) { atomicAdd(&(bar)[XB_TMO], 1u); break; } } } } while (0)

struct XcdBarrier {
    unsigned* bar; unsigned x;
    volatile LAS unsigned* st;
};

__device__ __forceinline__ XcdBarrier xcd_barrier_post(unsigned* bar, volatile LAS unsigned* st) {
    XcdBarrier b; b.bar = bar; b.x = xb_xcc_id(); b.st = st;
    if (threadIdx.x == 0) (void)xb_add(&bar[XB_XCNT(b.x)], 1u);
    return b;
}
__device__ __forceinline__ void xcd_barrier_complete(unsigned* bar, unsigned x, unsigned& nloc, unsigned& nx) {
    const unsigned G = gridDim.x * gridDim.y * gridDim.z;
    unsigned sum, cnt, mine, sp = 0u;
    for (;;) {
        sum = 0u; cnt = 0u; mine = 0u;
#pragma unroll
        for (unsigned j = 0; j < 16; ++j) { const unsigned c = xb_ld(&bar[XB_XCNT(j)]); sum += c; cnt += (c > 0u) ? 1u : 0u; mine = (j == x) ? c : mine; }
        if (sum == G) break;
        __builtin_amdgcn_s_sleep(1);
        if ((++sp & 255u) == 0u) { if (xb_ld(&bar[XB_TMO])) break; if (sp > XB_SPIN_CAP) { atomicAdd(&bar[XB_TMO], 1u); break; } }
    }
    nloc = mine > 0u ? mine : 1u; nx = cnt > 0u ? cnt : 1u;
}

__device__ __forceinline__ void xcd_barrier(const XcdBarrier& b) {
    asm volatile("s_waitcnt vmcnt(0)" ::: "memory");
    __syncthreads();
    if (threadIdx.x == 0) {
        unsigned* bar = b.bar;
        __builtin_amdgcn_s_waitcnt(0);
        unsigned nloc = b.st[0], nx = b.st[1];
        if (nloc == 0u) { xcd_barrier_complete(bar, b.x, nloc, nx); b.st[0] = nloc; b.st[1] = nx; }
        const unsigned old = xb_add(&bar[XB_XSUB(b.x)], 1u);
        const unsigned gen = old / nloc;
        if (old + 1u == (gen + 1u) * nloc) {
            __builtin_amdgcn_fence(__ATOMIC_RELEASE, "agent");
            asm volatile("s_waitcnt vmcnt(0)" ::: "memory");
            const unsigned og = xb_add(&bar[XB_TOP], 1u);
            const unsigned tg = og / nx;
            if (og + 1u == (tg + 1u) * nx) xb_add(&bar[XB_TOPGEN], 1u);
            else XB_SPIN(xb_ld(&bar[XB_TOPGEN]) == tg, bar);
            __builtin_amdgcn_fence(__ATOMIC_ACQUIRE, "agent");
            xb_add(&bar[XB_XGEN(b.x)], 1u);
            asm volatile("s_waitcnt vmcnt(0)" ::: "memory");
        } else {
            XB_SPIN(xb_ld(&bar[XB_XGEN(b.x)]) == gen, bar);
            __builtin_amdgcn_fence(__ATOMIC_ACQUIRE, "agent");
            asm volatile("s_waitcnt vmcnt(0)" ::: "memory");
        }
    }
    __syncthreads();
}
namespace att {
typedef unsigned short bf16_t;
using bf16x8 = __attribute__((ext_vector_type(8))) short;
using s16x4  = __attribute__((ext_vector_type(4))) short;
using f32x16 = __attribute__((ext_vector_type(16))) float;
using f32x8  = __attribute__((ext_vector_type(8))) float;
using u32x4  = __attribute__((ext_vector_type(4))) unsigned;
constexpr int NW = 8, QBLK = 32, KVBLK = 64;
constexpr int SHM_V = KVBLK * 128 * 2;
constexpr int SHM_KMAX = KVBLK * 192 * 2;
constexpr int LDS_V = 0, LDS_K = 2 * SHM_V, LDS_WS = LDS_K + 2 * SHM_KMAX, LDS_BYTES = LDS_WS + NW * 64 * 4;
#define ASBAR() __builtin_amdgcn_sched_barrier(0)
__device__ __forceinline__ int crow(int r, int hi) { return (r & 3) + 8 * (r >> 2) + 4 * hi; }
typedef float f32x2c_t __attribute__((ext_vector_type(2))); typedef __bf16 bf16x2c_t __attribute__((ext_vector_type(2)));
__device__ __forceinline__ unsigned cvtpk(float lo, float hi) { f32x2c_t v = {lo, hi}; bf16x2c_t b = __builtin_convertvector(v, bf16x2c_t); return __builtin_bit_cast(unsigned, b); }
template <typename TIn> struct Stage;
template <> struct Stage<bf16_t> { using T = bf16x8; static constexpr int NLD = 1;
  __device__ static __forceinline__ T ld8(const bf16_t* p) { return *reinterpret_cast<const bf16x8*>(p); }
  __device__ static __forceinline__ bf16x8 tobf(T x) { return x; } };
template <> struct Stage<float> { using T = f32x8; static constexpr int NLD = 2;
  __device__ static __forceinline__ T ld8(const float* p) { return *reinterpret_cast<const f32x8*>(p); }
  __device__ static __forceinline__ bf16x8 tobf(T x) { u32x4 w = {cvtpk(x[0], x[1]), cvtpk(x[2], x[3]), cvtpk(x[4], x[5]), cvtpk(x[6], x[7])}; return *reinterpret_cast<bf16x8*>(&w); } };

template <int NDQ> __device__ __forceinline__ int kswz(int row, int ch) { return row * (32 * NDQ) + ((ch ^ ((row >> 1) & 7)) << 4); }

__device__ __forceinline__ void partialSM(f32x16& p0, f32x16& p1, float& m_reg, float& mn, float& alpha, const float C, const float THRS) {
  float pmax = p0[0];
#pragma unroll
  for (int r = 1; r < 16; ++r) pmax = fmaxf(pmax, p0[r]);
#pragma unroll
  for (int r = 0; r < 16; ++r) pmax = fmaxf(pmax, p1[r]);
  { auto rr = __builtin_amdgcn_permlane32_swap(__float_as_uint(pmax), __float_as_uint(pmax), false, false);
    pmax = fmaxf(__uint_as_float(rr[0]), __uint_as_float(rr[1])); }
  if (__builtin_expect(__all(pmax - m_reg <= THRS), 1)) { mn = m_reg; alpha = 1.f; }
  else { mn = fmaxf(m_reg, pmax); alpha = __builtin_amdgcn_exp2f((m_reg - mn) * C); m_reg = mn; }
  const float mnC = -mn * C;
#pragma unroll
  for (int r = 0; r < 16; ++r) p0[r] = fmaf(p0[r], C, mnC);
#pragma unroll
  for (int r = 0; r < 16; ++r) p1[r] = fmaf(p1[r], C, mnC);
#pragma unroll
  for (int r = 0; r < 16; ++r) p0[r] = __builtin_amdgcn_exp2f(p0[r]);
}
__device__ __forceinline__ void finishSM(f32x16& p0, f32x16& p1, float alpha, float& l_reg, bf16x8& pa0, bf16x8& pa1, bf16x8& pa2, bf16x8& pa3) {
#pragma unroll
  for (int r = 0; r < 16; ++r) p1[r] = __builtin_amdgcn_exp2f(p1[r]);
  float ps = 0;
#pragma unroll
  for (int r = 0; r < 16; ++r) ps += p0[r];
#pragma unroll
  for (int r = 0; r < 16; ++r) ps += p1[r];
  { auto rr = __builtin_amdgcn_permlane32_swap(__float_as_uint(ps), __float_as_uint(ps), false, false);
    ps = __uint_as_float(rr[0]) + __uint_as_float(rr[1]); }
  l_reg = l_reg * alpha + ps;
#define ATT_PK4(P, BASE, OUT) do { unsigned a0 = cvtpk(P[BASE + 0], P[BASE + 1]), a1 = cvtpk(P[BASE + 2], P[BASE + 3]);   \
    unsigned b0 = cvtpk(P[BASE + 4], P[BASE + 5]), b1 = cvtpk(P[BASE + 6], P[BASE + 7]);                              \
    auto r0 = __builtin_amdgcn_permlane32_swap(a0, b0, false, false); auto r1 = __builtin_amdgcn_permlane32_swap(a1, b1, false, false); \
    u32x4 w = {r0[0], r1[0], r0[1], r1[1]}; OUT = *reinterpret_cast<bf16x8*>(&w); } while (0)
  ATT_PK4(p0, 0, pa0); ATT_PK4(p0, 8, pa1); ATT_PK4(p1, 0, pa2); ATT_PK4(p1, 8, pa3);
#undef ATT_PK4
}
__device__ __forceinline__ void partialSM_neg(f32x16& p0, f32x16& p1, float& mhat, f32x16& negm, float& alpha, const bool first, const float THR2) {
  float pmax = p0[0];
#pragma unroll
  for (int r = 1; r < 16; ++r) pmax = fmaxf(pmax, p0[r]);
#pragma unroll
  for (int r = 0; r < 16; ++r) pmax = fmaxf(pmax, p1[r]);
  { auto rr = __builtin_amdgcn_permlane32_swap(__float_as_uint(pmax), __float_as_uint(pmax), false, false);
    pmax = fmaxf(__uint_as_float(rr[0]), __uint_as_float(rr[1])); }
  if (__builtin_expect(!first && __all(pmax <= THR2), 1)) { alpha = 1.f; }
  else { const float d = first ? pmax : fmaxf(pmax, 0.f); mhat += d; alpha = first ? 1.f : __builtin_amdgcn_exp2f(-d);
#pragma unroll
    for (int r = 0; r < 16; ++r) { p0[r] -= d; p1[r] -= d; }
#pragma unroll
    for (int r = 0; r < 16; ++r) negm[r] = -mhat; }
#pragma unroll
  for (int r = 0; r < 16; ++r) p0[r] = __builtin_amdgcn_exp2f(p0[r]);
}
template <int NDQ> __device__ __forceinline__ void qkt(f32x16& p0, f32x16& p1, const char* Ks, const bf16x8 (&qr)[NDQ], int r32, int hi, const f32x16 cin = f32x16{}) {
  p0 = cin; p1 = cin;
  const int f = (r32 >> 1) & 7; int kb[4];
#pragma unroll
  for (int q = 0; q < 4; ++q) kb[q] = r32 * (32 * NDQ) + (((2 * q + hi) ^ f) << 4);
#pragma unroll
  for (int d0 = 0; d0 < NDQ; ++d0) { const char* kp = Ks + kb[d0 & 3] + 128 * (d0 >> 2);
    const bf16x8 b0 = *reinterpret_cast<const bf16x8*>(kp);
    const bf16x8 b1 = *reinterpret_cast<const bf16x8*>(kp + 32 * 32 * NDQ);
    p0 = __builtin_amdgcn_mfma_f32_32x32x16_bf16(b0, qr[d0], p0, 0, 0, 0);
    p1 = __builtin_amdgcn_mfma_f32_32x32x16_bf16(b1, qr[d0], p1, 0, 0, 0); }
}
__device__ __forceinline__ int v_st(int k, int c) { const int kk = (k & ~0xC) | ((k & 4) << 1) | ((k & 8) >> 1); return ((kk >> 3) * 4 + (c >> 5)) * 512 + ((kk & 7) * 32 + (c & 31)) * 2; }
__device__ __forceinline__ int v_rd_base(int lane) { return ((lane & 3) << 3) | (((lane >> 2) & 3) << 6) | (((lane >> 4) & 1) << 5) | (((lane >> 5) & 1) << 8); }
constexpr int v_rd_off(int d0, int ks, int half) { return d0 * 512 + ks * 4096 + half * 2048; }
template <int OFF> __device__ __forceinline__ s16x4 tr_read(int vb) { s16x4 r; asm volatile("ds_read_b64_tr_b16 %0, %1 offset:%2" : "=&v"(r) : "v"(vb), "i"(OFF) : "memory"); return r; }
template <int D0> __device__ __forceinline__ void pv_one(f32x16& od, int vb, bf16x8 pa0, bf16x8 pa1, bf16x8 pa2, bf16x8 pa3) {
  const s16x4 l0 = tr_read<v_rd_off(D0, 0, 0)>(vb), h0 = tr_read<v_rd_off(D0, 0, 1)>(vb), l1 = tr_read<v_rd_off(D0, 1, 0)>(vb), h1 = tr_read<v_rd_off(D0, 1, 1)>(vb);
  const s16x4 l2 = tr_read<v_rd_off(D0, 2, 0)>(vb), h2 = tr_read<v_rd_off(D0, 2, 1)>(vb), l3 = tr_read<v_rd_off(D0, 3, 0)>(vb), h3 = tr_read<v_rd_off(D0, 3, 1)>(vb);
  asm volatile("s_waitcnt lgkmcnt(0)" ::: "memory"); ASBAR();
#define ATT_PK(L, H) (bf16x8){L[0], L[1], L[2], L[3], H[0], H[1], H[2], H[3]}
  od = __builtin_amdgcn_mfma_f32_32x32x16_bf16(pa0, ATT_PK(l0, h0), od, 0, 0, 0);
  od = __builtin_amdgcn_mfma_f32_32x32x16_bf16(pa1, ATT_PK(l1, h1), od, 0, 0, 0);
  od = __builtin_amdgcn_mfma_f32_32x32x16_bf16(pa2, ATT_PK(l2, h2), od, 0, 0, 0);
  od = __builtin_amdgcn_mfma_f32_32x32x16_bf16(pa3, ATT_PK(l3, h3), od, 0, 0, 0);
#undef ATT_PK
}
__device__ __forceinline__ void pv_d0(f32x16 (&o)[4], int vb, bf16x8 pa0, bf16x8 pa1, bf16x8 pa2, bf16x8 pa3) {
  pv_one<0>(o[0], vb, pa0, pa1, pa2, pa3); pv_one<1>(o[1], vb, pa0, pa1, pa2, pa3); pv_one<2>(o[2], vb, pa0, pa1, pa2, pa3); pv_one<3>(o[3], vb, pa0, pa1, pa2, pa3);
}

__device__ __forceinline__ void glds16(const void* gsrc, unsigned lds_dst) { unsigned keep;
  asm volatile("s_mov_b32 %0, m0\n\ts_mov_b32 m0, %2\n\ts_nop 0\n\tglobal_load_lds_dwordx4 %1, off\n\ts_mov_b32 m0, %0" : "=&s"(keep) : "v"(gsrc), "s"(lds_dst) : "memory"); }
template <typename TKV> struct Src { const TKV* kp; const TKV* kn; const TKV* k2p; const TKV* k2n; const TKV* vp; const TKV* vn; int npast, nvalid; };

template <int NDQ, typename TKV, int LDK, int LDK2, int LDV>
__device__ __forceinline__ void attn_core(const bf16x8 (&qr)[NDQ], const Src<TKV>& S, const int NT, const int limit, const bool active, const float C, const float THRS,
                                          char* lds, f32x16 (&o)[4], float& l_reg) {
  using St = Stage<TKV>;
  constexpr int SHM_K = KVBLK * 32 * NDQ;
  int tid_ = threadIdx.x; asm volatile("" : "+v"(tid_));
  const int tid = tid_, wid = tid >> 6, lane = tid & 63, r32 = lane & 31, hi = lane >> 5;
  char* V_lds = lds + LDS_V; char* K_lds = lds + LDS_K;
  float* al_l = (float*)(lds + LDS_WS) + wid * 64 + 32;
  float m_reg = -1e30f; l_reg = 0.f;
#pragma unroll
  for (int d = 0; d < 4; ++d) o[d] = f32x16{};
  const int sr = tid >> 4, sc = (tid & 15) * 8;
  const int vr = (sr & ~3) + (tid & 3), vc = ((sr & 3) * 4 + ((tid & 15) >> 2)) * 8, vst0 = v_st(vr, vc), vst1 = v_st(32 + vr, vc);
  const int kr8 = tid >> 3, kc8 = tid & 7;
  const int vb0 = (int)(uintptr_t)V_lds + v_rd_base(lane);
  struct Slot { typename St::T vs0, vs1, ks0, ks1, ks2; } sl[1];
#define ATT_SLOAD(i, j) do { const int jj_ = (j) < S.nvalid ? (j) : S.nvalid - 1; const bool ps_ = jj_ < S.npast; const long r0_ = ps_ ? (long)jj_ * 64 : (long)(jj_ - S.npast) * 64; \
    const TKV* vb_ = ps_ ? S.vp : S.vn; const TKV* kb_ = ps_ ? S.kp : S.kn; \
    sl[i].vs0 = St::ld8(vb_ + (r0_ + vr) * LDV + vc); sl[i].vs1 = St::ld8(vb_ + (r0_ + 32 + vr) * LDV + vc); \
    if constexpr (NDQ == 4) { sl[i].ks0 = St::ld8(kb_ + (r0_ + kr8) * LDK + kc8 * 8); } \
    else { const TKV* k2_ = ps_ ? S.k2p : S.k2n; sl[i].ks0 = St::ld8(kb_ + (r0_ + sr) * LDK + sc); sl[i].ks1 = St::ld8(kb_ + (r0_ + 32 + sr) * LDK + sc); sl[i].ks2 = St::ld8(k2_ + (r0_ + kr8) * LDK2 + kc8 * 8); } } while (0)
#define ATT_SWRITE(b, i) do { *(bf16x8*)(V_lds + (b) * SHM_V + vst0) = St::tobf(sl[i].vs0); *(bf16x8*)(V_lds + (b) * SHM_V + vst1) = St::tobf(sl[i].vs1); \
    if constexpr (NDQ == 4) { *(bf16x8*)(K_lds + (b) * SHM_K + kswz<NDQ>(kr8, kc8)) = St::tobf(sl[i].ks0); } \
    else { *(bf16x8*)(K_lds + (b) * SHM_K + kswz<NDQ>(sr, tid & 15)) = St::tobf(sl[i].ks0); *(bf16x8*)(K_lds + (b) * SHM_K + kswz<NDQ>(32 + sr, tid & 15)) = St::tobf(sl[i].ks1); \
           *(bf16x8*)(K_lds + (b) * SHM_K + kswz<NDQ>(kr8, 16 + kc8)) = St::tobf(sl[i].ks2); } } while (0)
#define ATT_RESC(a) do { if (__any((a) < 1.f)) { if (hi == 0) al_l[r32] = (a); asm volatile("s_waitcnt lgkmcnt(0)" ::: "memory"); \
    _Pragma("unroll") for (int d = 0; d < 4; ++d) _Pragma("unroll") for (int r = 0; r < 16; ++r) o[d][r] *= al_l[crow(r, hi)]; } } while (0)
#define ATT_MASK(P0, P1, j) do { if ((j) > limit) { _Pragma("unroll") for (int r = 0; r < 16; ++r) { P0[r] = -1e30f; P1[r] = -1e30f; } } } while (0)
  constexpr bool DMA = sizeof(TKV) == 2;
  const int wu = __builtin_amdgcn_readfirstlane(wid);
  const unsigned lds0 = (unsigned)(uintptr_t)lds;
  unsigned dK[3] = {0u, 0u, 0u}, dV[2] = {0u, 0u};
  if constexpr (DMA) {
    if constexpr (NDQ == 4) { const int row = 8 * wu + (lane >> 3), c = (lane & 7) ^ ((row >> 1) & 7); dK[0] = (unsigned)(row * LDK + c * 8); }
    else {
#pragma unroll
      for (int i = 0; i < 3; ++i) { const int b = (3 * wu + i) * 1024 + lane * 16, row = b / 384, cs = (b - row * 384) >> 4, c = (cs & ~7) | ((cs & 7) ^ ((row >> 1) & 7));
        dK[i] = c < 16 ? (unsigned)(row * LDK + c * 8) : (0x80000000u | (unsigned)(row * LDK2 + (c - 16) * 8)); } }
#pragma unroll
    for (int i = 0; i < 2; ++i) { const int sub = 2 * (2 * wu + i) + (lane >> 5), kk = (sub >> 2) * 8 + ((lane & 31) >> 2), k = (kk & ~0xC) | ((kk & 4) << 1) | ((kk & 8) >> 1), c = (sub & 3) * 32 + (lane & 3) * 8;
      dV[i] = (unsigned)(k * LDV + c); }
  }
#define ATT_DMA(b, j) do { const int jj_ = (j) < S.nvalid ? (j) : S.nvalid - 1; const bool ps_ = jj_ < S.npast; const long r0_ = ps_ ? (long)jj_ * 64 : (long)(jj_ - S.npast) * 64; \
    const TKV* kb_ = (ps_ ? S.kp : S.kn) + r0_ * LDK; const TKV* vb_ = (ps_ ? S.vp : S.vn) + r0_ * LDV; \
    if constexpr (NDQ == 4) glds16(kb_ + dK[0], lds0 + LDS_K + (b) * SHM_K + wu * 1024); \
    else { const TKV* k2_ = (ps_ ? S.k2p : S.k2n) + r0_ * LDK2; _Pragma("unroll") for (int i_ = 0; i_ < 3; ++i_) glds16((dK[i_] >> 31) ? k2_ + (dK[i_] & 0x7fffffffu) : kb_ + dK[i_], lds0 + LDS_K + (b) * SHM_K + (3 * wu + i_) * 1024); } \
    glds16(vb_ + dV[0], lds0 + LDS_V + (b) * SHM_V + (2 * wu) * 1024); glds16(vb_ + dV[1], lds0 + LDS_V + (b) * SHM_V + (2 * wu + 1) * 1024); } while (0)
  f32x16 pA0, pA1; float alA = 1.f; bf16x8 pa0, pa1, pa2, pa3;
  f32x16 negm = f32x16{}; m_reg = 0.f;
  if constexpr (DMA) { ATT_DMA(0, 0); asm volatile("s_waitcnt vmcnt(0)" ::: "memory"); } else { ATT_SLOAD(0, 0); asm volatile("s_waitcnt vmcnt(0)" ::: "memory"); ATT_SWRITE(0, 0); }
  __syncthreads();
#pragma unroll 1
  for (int j = 0; j < NT; ++j) {
    const int cur = j & 1;
    if (j + 1 < NT) { if constexpr (DMA) ATT_DMA(cur ^ 1, j + 1); else ATT_SLOAD(0, j + 1); }
    ASBAR();
    if (active && j <= limit) {
      qkt<NDQ>(pA0, pA1, K_lds + cur * SHM_K, qr, r32, hi, negm); partialSM_neg(pA0, pA1, m_reg, negm, alA, j == 0, THRS * C);
      ATT_RESC(alA);
      finishSM(pA0, pA1, alA, l_reg, pa0, pa1, pa2, pa3);
      ASBAR();
      pv_d0(o, vb0 + cur * SHM_V, pa0, pa1, pa2, pa3);
    }
    ASBAR();
    if constexpr (DMA) asm volatile("s_waitcnt vmcnt(0)" ::: "memory"); else { if (j + 1 < NT) ATT_SWRITE(cur ^ 1, 0); }
    __syncthreads();
  }
#undef ATT_DMA
#undef ATT_SLOAD
#undef ATT_SWRITE
#undef ATT_RESC
#undef ATT_MASK
}
__device__ __forceinline__ void normalize(f32x16 (&o)[4], float l_reg, char* lds, int wid, int r32, int hi) {
  float* li_l = (float*)(lds + LDS_WS) + wid * 64;
  if (hi == 0) li_l[r32] = l_reg;
  asm volatile("s_waitcnt lgkmcnt(0)" ::: "memory");
#pragma unroll
  for (int r = 0; r < 16; ++r) { const float rl = __builtin_amdgcn_rcpf(li_l[crow(r, hi)]);
#pragma unroll
    for (int d = 0; d < 4; ++d) o[d][r] *= rl; }
}
__device__ __forceinline__ unsigned short f2bf1(float f) { unsigned u = __builtin_bit_cast(unsigned, f); return (unsigned short)((u + 0x7fffu + ((u >> 16) & 1u)) >> 16); }

constexpr float LOG2E = 1.4426950408889634f;
constexpr float SCALE_A = 0.125f, SCALE_B = 0.07216878364870322f;
constexpr float THR = 8.f;

template <typename TKV>
__device__ __forceinline__ void diff_unit(const bf16_t* QA, long qrow0, int h, const Src<TKV>& S1, const Src<TKV>& S2, int NT, int limit, bool active, float lam,
                                          const float* g_subln, float* stash, bf16_t* OA, char* lds) {
  asm volatile("" : "+s"(h), "+s"(qrow0));
  const int tid = threadIdx.x, wid = tid >> 6, lane = tid & 63, r32 = lane & 31, hi = lane >> 5;
  const long qrow = qrow0 + (active ? wid * QBLK : 0) + r32;
  f32x16 o[4]; float l_reg; float* st = stash + wid * 4096;
  {
    bf16x8 qr[4];
#pragma unroll
    for (int d0 = 0; d0 < 4; ++d0) qr[d0] = *reinterpret_cast<const bf16x8*>(QA + qrow * 2048 + h * 64 + d0 * 16 + hi * 8);
    attn_core<4, TKV, 2048, 64, 2048>(qr, S1, NT, limit, active, SCALE_A * LOG2E, THR / SCALE_A, lds, o, l_reg);
  }
  if (active) { normalize(o, l_reg, lds, wid, r32, hi);
    __attribute__((address_space(1))) float* st1 = (__attribute__((address_space(1))) float*)(st + lane); asm volatile("" : "+v"(st1));
#pragma unroll
    for (int d = 0; d < 4; ++d)
#pragma unroll
      for (int r = 0; r < 16; ++r) st1[(d * 16 + r) * 64] = o[d][r]; }
  {
    bf16x8 qr[4];
#pragma unroll
    for (int d0 = 0; d0 < 4; ++d0) qr[d0] = *reinterpret_cast<const bf16x8*>(QA + qrow * 2048 + (16 + h) * 64 + d0 * 16 + hi * 8);
    attn_core<4, TKV, 2048, 64, 2048>(qr, S2, NT, limit, active, SCALE_A * LOG2E, THR / SCALE_A, lds, o, l_reg);
  }
  if (active) { normalize(o, l_reg, lds, wid, r32, hi);
    float ss[16];
    const __attribute__((address_space(1))) float* st2 = (const __attribute__((address_space(1))) float*)(st + lane); asm volatile("" : "+v"(st2));
#pragma unroll
    for (int r = 0; r < 16; ++r) ss[r] = 0.f;
#pragma unroll
    for (int d = 0; d < 4; ++d)
#pragma unroll
      for (int r = 0; r < 16; ++r) { const float a = st2[(d * 16 + r) * 64] - lam * o[d][r]; o[d][r] = a; ss[r] += a * a; }
#pragma unroll
    for (int r = 0; r < 16; ++r) { float s = ss[r]; s += __shfl_xor(s, 1); s += __shfl_xor(s, 2); s += __shfl_xor(s, 4); s += __shfl_xor(s, 8); s += __shfl_xor(s, 16);
      ss[r] = 0.8f * rsqrtf(s * (1.f / 128.f) + cfg::EPS); }
    __attribute__((address_space(1))) bf16_t* op = (__attribute__((address_space(1))) bf16_t*)(OA + (qrow0 + wid * QBLK + 4 * hi) * 4096 + h * 128 + r32); asm volatile("" : "+v"(op));
#pragma unroll
    for (int d = 0; d < 4; ++d) { const float g = g_subln[d * 32 + r32];
#pragma unroll
      for (int r = 0; r < 16; ++r) op[((r & 3) + 8 * (r >> 2)) * 4096 + d * 32] = f2bf1(o[d][r] * ss[r] * g); }
  }
}
__device__ __forceinline__ void mla_unit(const bf16_t* QB, long qrow0, int h, const Src<bf16_t>& S, int NT, int limit, bool active, bf16_t* OB, char* lds) {
  asm volatile("" : "+s"(h), "+s"(qrow0));
  const int tid = threadIdx.x, wid = tid >> 6, lane = tid & 63, r32 = lane & 31, hi = lane >> 5;
  const long qrow = qrow0 + (active ? wid * QBLK : 0) + r32;
  f32x16 o[4]; float l_reg;
  bf16x8 qr[12];
#pragma unroll
  for (int d0 = 0; d0 < 12; ++d0) qr[d0] = *reinterpret_cast<const bf16x8*>(QB + qrow * 3072 + h * 192 + d0 * 16 + hi * 8);
  attn_core<12, bf16_t, 4096, 64, 4096>(qr, S, NT, limit, active, SCALE_B * LOG2E, THR / SCALE_B, lds, o, l_reg);
  if (active) { normalize(o, l_reg, lds, wid, r32, hi);
    __attribute__((address_space(1))) bf16_t* op = (__attribute__((address_space(1))) bf16_t*)(OB + (qrow0 + wid * QBLK + 4 * hi) * 4096 + h * 128 + r32); asm volatile("" : "+v"(op));
#pragma unroll
    for (int d = 0; d < 4; ++d)
#pragma unroll
      for (int r = 0; r < 16; ++r) op[((r & 3) + 8 * (r >> 2)) * 4096 + d * 32] = f2bf1(o[d][r]); }
}
#undef ASBAR
}
#ifndef PG8_SP2
#define PG8_SP2 true
#endif
constexpr int NWAVES = 8;
constexpr int NPH = 12;
constexpr int N_LAUNCHES = MK_N_LAUNCHES;
static_assert(N_LAUNCHES == 1 || N_LAUNCHES == NPH, "MK_N_LAUNCHES is 1 or 12");

constexpr size_t MiB = 1u << 20;
constexpr size_t WS_CTL = 0, CTL_ZERO_BYTES = 1 * MiB;
constexpr size_t WS_WIN = 1 * MiB;
constexpr size_t WS_WQB = WS_WIN + (size_t)cfg::NINP * 4096 * 2;
constexpr size_t WS_WKVB = WS_WQB + (size_t)3072 * 896 * 2;
constexpr size_t WS_WBA = WS_WKVB + (size_t)4096 * 512 * 2;
constexpr size_t WS_WBB = WS_WBA + (size_t)4096 * 2048 * 2;
constexpr size_t WS_WOUT = WS_WBB + (size_t)4096 * 2048 * 2;
constexpr size_t WS_WGU = WS_WOUT + (size_t)4096 * 4096 * 2;
constexpr size_t WS_WFD = WS_WGU + (size_t)22016 * 4096 * 2;
constexpr size_t WS_TABA = WS_WFD + (size_t)4096 * 11008 * 2;
constexpr size_t WS_TABB = WS_TABA + (size_t)8192 * 8 * 8;
constexpr size_t WS_XN = WS_TABB + (size_t)8192 * 32 * 8;
constexpr size_t WS_R0 = WS_XN + (size_t)cfg::M * 4096 * 2;
constexpr size_t WS_QA = WS_R0;
constexpr size_t WS_KA = WS_QA + (size_t)cfg::M * 2048 * 2;
constexpr size_t WS_VA = WS_KA + (size_t)cfg::M * 2048 * 2;
constexpr size_t WS_RAW = WS_VA + (size_t)cfg::M * 2048 * 2;
constexpr size_t WS_CQN = WS_RAW + (size_t)cfg::M * cfg::NRAW * 4;
constexpr size_t WS_CKV = WS_CQN + (size_t)cfg::M * 896 * 2;
constexpr size_t WS_KPE = WS_CKV + (size_t)cfg::MKV * 512 * 2;
constexpr size_t WS_QB = WS_KPE + (size_t)cfg::MKV * 64 * 2;
constexpr size_t WS_KVB = WS_QB + (size_t)cfg::M * 3072 * 2;
constexpr size_t WS_G = WS_KVB + (size_t)cfg::MKV * 4096 * 2;
constexpr size_t WS_OA = WS_G + (size_t)cfg::M * 8192 * 2;
constexpr size_t WS_OB = WS_OA + (size_t)cfg::M * 2048 * 2;
constexpr size_t WS_STASH = WS_OB + (size_t)cfg::M * 2048 * 2;
constexpr size_t WS_TOPUG = WS_STASH + (size_t)256 * 8 * 4096 * 4;
constexpr size_t WS_TOPU = WS_TOPUG + (size_t)64 * cfg::DFF * 4;
constexpr size_t WS_BOT = WS_TOPU + (size_t)64 * cfg::DFF * 4;
constexpr size_t WS_END = WS_BOT + (size_t)64 * cfg::DFF * 4;
constexpr size_t WS_MB = WS_QA;
constexpr size_t WS_UG = WS_R0;
constexpr size_t WS_U = WS_UG + (size_t)cfg::M * cfg::DFF * 2;
static_assert(WS_U + (size_t)cfg::M * cfg::DFF * 2 <= WS_END, "FFN overlay fits");
static_assert(WS_END < (size_t)1390 * 1000 * 1000, "workspace budget");
constexpr size_t SLAB_BYTES = (size_t)8 * 512 * 4096 * 4;
constexpr size_t WS_SLAB_A = WS_KVB, WS_SLAB_B = WS_KVB + SLAB_BYTES;
constexpr size_t WS_SLAB_D = WS_UG;
static_assert(2 * SLAB_BYTES <= (size_t)cfg::MKV * 4096 * 2 && SLAB_BYTES <= (size_t)cfg::M * cfg::DFF * 2, "slab overlays fit");
constexpr int CW_TMO = 0, CW_CODE = 1, CW_BAR = 4096;

constexpr int RING_OFF = 0, RING_BYTES = 131072;
constexpr int LDSCTL_OFF = RING_BYTES, MISC_OFF = LDSCTL_OFF + 320;
constexpr int XCH_OFF = RING_BYTES + 1024;
constexpr int LDS_BYTES = 147456;
static_assert(att::LDS_BYTES <= RING_BYTES && pg8::STAGE_BYTES <= RING_BYTES, "phase scratch fits the ring region");

struct Args { const float* in[29]; float* out; unsigned char* ws; int ph_lo, ph_hi; };
struct Frame {
    LAS unsigned char* lds; volatile LAS unsigned* MISC; gu32* ctl;
    int tid, wave, vcu, G;
    float* out; unsigned char* ws;
};
__device__ __forceinline__ int lane_id() { int t = threadIdx.x; asm volatile("" : "+v"(t)); return t & 63; }
__device__ __forceinline__ float wave_sum(float v) {
#pragma unroll
    for (int o = 1; o < 64; o <<= 1) v += __shfl_xor(v, o);
    return v;
}
template <int MAP> __device__ __forceinline__ int src_col(int n) {
    if (MAP == 1) { if (n < 6144) return n; if (n < 14336) return 7616 + (n - 6144); if (n < 15808) return 6144 + (n - 14336); return -1; }
    if (MAP == 2) { const int h = n / 192, d = n - h * 192; if (d < 128) return n; const int e = d - 128; return h * 192 + 128 + (e >> 1) + 32 * (e & 1); }
    return n;
}
template <int MAP> __device__ __forceinline__ void p0_transpose_item(const float* W, int K, int Nsrc, int Ndst, bf16* WT, int row_off, LAS float* scr, int item, int lane) {
    const int nblk = Ndst / 32, kb = item / nblk, nb = item - kb * nblk, k0 = 64 * kb, n0 = 32 * nb;
    if constexpr (MAP == 2) {
        const int sn = src_col<MAP>(n0 + (lane & 31));
#pragma unroll 8
        for (int i = 0; i < 32; ++i) { const int kk = 2 * i + (lane >> 5); scr[kk * 33 + (lane & 31)] = W[(size_t)(k0 + kk) * Nsrc + sn]; }
    } else {
        const int n4 = 4 * (lane & 7), kq = lane >> 3;
        const int sn = src_col<MAP>(n0 + n4);
        f32x4 v[8];
#pragma unroll
        for (int i = 0; i < 8; ++i) v[i] = sn >= 0 ? __builtin_nontemporal_load((const GAS f32x4*)(W + (size_t)(k0 + 8 * i + kq) * Nsrc + sn)) : (f32x4){0.f, 0.f, 0.f, 0.f};
#pragma unroll
        for (int i = 0; i < 8; ++i) { LAS float* d = scr + (8 * i + kq) * 33 + n4; d[0] = v[i].x; d[1] = v[i].y; d[2] = v[i].z; d[3] = v[i].w; }
    }
    LDS_WAIT(); asm volatile("" ::: "memory");
    const int c = lane & 7;
#pragma unroll
    for (int j = 0; j < 4; ++j) { const int n = (lane >> 3) + 8 * j; const LAS float* s = scr + (8 * c) * 33 + n;
        v4u o; o.x = pk2(s[0 * 33], s[1 * 33]); o.y = pk2(s[2 * 33], s[3 * 33]); o.z = pk2(s[4 * 33], s[5 * 33]); o.w = pk2(s[6 * 33], s[7 * 33]);
        *(GAS v4u*)(WT + (size_t)(row_off + n0 + n) * K + k0 + 8 * c) = o; }
    LDS_WAIT(); asm volatile("" ::: "memory");
}
struct XItem { const float* W; bf16* WT; int K, Nsrc, Ndst, row_off, item, ilv, Kp, koff; };
__device__ __forceinline__ void xitem_load(const XItem& x, int lane, f32x4 (&v)[8]) {
    const int nblk = x.Ndst / 32, kb = x.item / nblk, nb = x.item - kb * nblk, k0 = 64 * kb, n0 = 32 * nb;
    const int n4 = 4 * (lane & 7), kq = lane >> 3;
#pragma unroll
    for (int i = 0; i < 8; ++i) v[i] = __builtin_nontemporal_load((const GAS f32x4*)(x.W + (size_t)(k0 + 8 * i + kq) * x.Nsrc + n0 + n4));
}
__device__ __forceinline__ void xitem_finish(const XItem& x, int lane, const f32x4 (&v)[8], LAS float* scr) {
    const int nblk = x.Ndst / 32, kb = x.item / nblk, nb = x.item - kb * nblk, k0 = 64 * kb, n0 = 32 * nb;
    const int n4 = 4 * (lane & 7), kq = lane >> 3;
#pragma unroll
    for (int i = 0; i < 8; ++i) { LAS float* d = scr + (8 * i + kq) * 33 + n4; d[0] = v[i].x; d[1] = v[i].y; d[2] = v[i].z; d[3] = v[i].w; }
    LDS_WAIT(); asm volatile("" ::: "memory");
    const int c = lane & 7;
#pragma unroll
    for (int j = 0; j < 4; ++j) { const int n = (lane >> 3) + 8 * j; const LAS float* s = scr + (8 * c) * 33 + n;
        v4u o; o.x = pk2(s[0 * 33], s[1 * 33]); o.y = pk2(s[2 * 33], s[3 * 33]); o.z = pk2(s[4 * 33], s[5 * 33]); o.w = pk2(s[6 * 33], s[7 * 33]);
        const int nn = n0 + n, drow = x.ilv ? ((nn >> 7) << 8) + (nn & 127) + x.row_off : x.row_off + nn;
        *(GAS v4u*)(x.WT + (size_t)drow * x.Kp + x.koff + k0 + 8 * c) = o; }
    LDS_WAIT(); asm volatile("" ::: "memory");
}
template <typename TO> __device__ __forceinline__ void rms_row4096(const float* xrow, const float* gain, TO* orow, int lane) {
    const GAS f32x4* xr = (const GAS f32x4*)xrow + lane; const GAS f32x4* gr = (const GAS f32x4*)gain + lane;
    f32x4 v[16]; float s = 0.f;
#pragma unroll
    for (int j = 0; j < 16; ++j) { v[j] = xr[64 * j]; s += (v[j].x * v[j].x + v[j].y * v[j].y) + (v[j].z * v[j].z + v[j].w * v[j].w); }
    const float rstd = rsqrtf(wave_sum(s) * (1.f / 4096.f) + cfg::EPS);
#pragma unroll
    for (int j = 0; j < 16; ++j) { const f32x4 g = gr[64 * j]; const f32x4 y = v[j] * rstd * g;
        if constexpr (sizeof(TO) == 2) { ((GAS unsigned long long*)orow)[64 * j + lane] = (unsigned long long)pk2(y.x, y.y) | ((unsigned long long)pk2(y.z, y.w) << 32); }
        else { ((GAS f32x4*)orow)[64 * j + lane] = y; } }
}
template <int S0, int S1> __device__ __forceinline__ void slab_sum4(const float* slab, int srow, int q, int lane, f32x4 (&v)[4]) {
#pragma unroll
    for (int s = S0; s < S1; ++s) { const GAS f32x4* p = (const GAS f32x4*)(slab + ((size_t)s * 512 + srow) * 4096 + 1024 * q) + lane;
#pragma unroll
        for (int j = 0; j < 4; ++j) v[j] += p[64 * j]; }
}
__device__ __forceinline__ void p5c_merge_sample(Frame& F) {
    const int srow = 2 * F.vcu + (F.wave >> 2), q = F.wave & 3, lane = lane_id(); if (F.vcu >= 256) return;
    f32x4 a[4], b[4];
#pragma unroll
    for (int j = 0; j < 4; ++j) { a[j] = (f32x4){0.f, 0.f, 0.f, 0.f}; b[j] = a[j]; }
    slab_sum4<0, 4>((const float*)(F.ws + WS_SLAB_A), srow, q, lane, a); slab_sum4<4, 8>((const float*)(F.ws + WS_SLAB_A), srow, q, lane, b);
    const bf16* G = (const bf16*)(F.ws + WS_G) + (size_t)(cfg::TP + srow) * 8192 + 1024 * q; bf16* MB = (bf16*)(F.ws + WS_MB) + (size_t)(cfg::TP + srow) * 4096 + 1024 * q;
#pragma unroll
    for (int j = 0; j < 4; ++j) { const int c = 4 * lane + 256 * j; const unsigned long long g0 = *(const GAS unsigned long long*)(G + c), g1 = *(const GAS unsigned long long*)(G + 4096 + c);
        const float g00 = __uint_as_float((unsigned)g0 << 16), g01 = __uint_as_float((unsigned)g0 & 0xffff0000u), g02 = __uint_as_float((unsigned)(g0 >> 32) << 16), g03 = __uint_as_float((unsigned)(g0 >> 32) & 0xffff0000u);
        const float g10 = __uint_as_float((unsigned)g1 << 16), g11 = __uint_as_float((unsigned)g1 & 0xffff0000u), g12 = __uint_as_float((unsigned)(g1 >> 32) << 16), g13 = __uint_as_float((unsigned)(g1 >> 32) & 0xffff0000u);
        const float m0 = g00 * a[j].x + g10 * b[j].x, m1 = g01 * a[j].y + g11 * b[j].y, m2 = g02 * a[j].z + g12 * b[j].z, m3 = g03 * a[j].w + g13 * b[j].w;
        *(GAS unsigned long long*)(MB + c) = (unsigned long long)pk2(m0, m1) | ((unsigned long long)pk2(m2, m3) << 32); }
}
template <typename TO> __device__ __forceinline__ void sample_rows_norm(Frame& F, const float* base_rows  , const float* slab, float* hout_rows  , const float* gain, TO* yout_rows  , LAS float* xch) {
    const int srow = 2 * (F.vcu & 255) + (F.wave >> 2), q = F.wave & 3, lane = lane_id();
    f32x4 v[4];
    { const GAS f32x4* p = (const GAS f32x4*)(base_rows + (size_t)srow * 4096 + 1024 * q) + lane;
#pragma unroll
      for (int j = 0; j < 4; ++j) v[j] = p[64 * j]; }
    slab_sum4<0, 8>(slab, srow, q, lane, v);
    float s = 0.f;
#pragma unroll
    for (int j = 0; j < 4; ++j) s += (v[j].x * v[j].x + v[j].y * v[j].y) + (v[j].z * v[j].z + v[j].w * v[j].w);
    s = wave_sum(s);
    if (lane == 0) xch[F.wave] = s;
    LDS_WAIT(); __syncthreads();
    const int w0 = F.wave & 4; const float tot = (xch[w0] + xch[w0 + 1]) + (xch[w0 + 2] + xch[w0 + 3]);
    const float rstd = rsqrtf(tot * (1.f / 4096.f) + cfg::EPS);
    const GAS f32x4* gr = (const GAS f32x4*)(gain + 1024 * q) + lane;
    if constexpr (sizeof(TO) == 2) { GAS f32x4* ho = (GAS f32x4*)(hout_rows + (size_t)srow * 4096 + 1024 * q) + lane;
#pragma unroll
        for (int j = 0; j < 4; ++j) ho[64 * j] = v[j]; }
#pragma unroll
    for (int j = 0; j < 4; ++j) { const f32x4 y = v[j] * rstd * gr[64 * j];
        if constexpr (sizeof(TO) == 2) ((GAS unsigned long long*)(yout_rows + (size_t)srow * 4096 + 1024 * q))[64 * j + lane] = (unsigned long long)pk2(y.x, y.y) | ((unsigned long long)pk2(y.z, y.w) << 32);
        else ((GAS f32x4*)(yout_rows + (size_t)srow * 4096 + 1024 * q))[64 * j + lane] = y; }
    __syncthreads();
}
constexpr int I_IN = 64 * (cfg::NINP / 32), I_QB = 14 * 96, I_KVB = 8 * 128, I_BR = 32 * 128, I_OUT = 64 * 128, I_FF = 64 * 344, I_FD = 172 * 128;
constexpr int NITEMS1 = I_QB + I_KVB + 2 * I_BR + I_OUT + 2 * I_FF, NITEMS2 = I_FD;
constexpr int CW_Q1 = 1024, CW_Q2 = 1088;
#ifndef P8_GEMM_WGS
#define P8_GEMM_WGS 248
#endif
#ifndef P1_GEMM_WGS
#define P1_GEMM_WGS 240
#endif
template <int LIST> __device__ __forceinline__ XItem list_item(const Args& A, unsigned char* ws, int r) {
    if (LIST == 2) return XItem{A.in[27], (bf16*)(ws + WS_WFD), cfg::DFF, 4096, 4096, 0, r, 0, cfg::DFF, 0};
    r -= I_QB;
    if (r < I_KVB) return XItem{A.in[18], (bf16*)(ws + WS_WKVB), 512, 4096, 4096, 0, r, 0, 512, 0}; r -= I_KVB;
    if (r < I_BR) return XItem{A.in[14], (bf16*)(ws + WS_WBA), 2048, 4096, 4096, 0, r, 0, 4096, 0}; r -= I_BR;
    if (r < I_BR) return XItem{A.in[19], (bf16*)(ws + WS_WBA), 2048, 4096, 4096, 0, r, 0, 4096, 2048}; r -= I_BR;
    if (r < I_OUT) return XItem{A.in[21], (bf16*)(ws + WS_WOUT), 4096, 4096, 4096, 0, r, 0, 4096, 0}; r -= I_OUT;
    if (r < I_FF) return XItem{A.in[23], (bf16*)(ws + WS_WGU), 4096, cfg::DFF, cfg::DFF, 0, r, 1, 4096, 0}; r -= I_FF;
    return XItem{A.in[24], (bf16*)(ws + WS_WGU), 4096, cfg::DFF, cfg::DFF, 128, r, 1, 4096, 0};
}
template <int LIST> __device__ __forceinline__ void convert_queue(Frame& F, const Args& A) {
    constexpr int QCH = 8, NIT = LIST == 1 ? NITEMS1 : NITEMS2, NSC = LIST == 1 ? I_QB : 0;
    LAS float* scr = (LAS float*)(F.lds + RING_OFF + F.wave * 16384);
    gu32* head = F.ctl + (LIST == 1 ? CW_Q1 : CW_Q2);
    for (;;) {
        unsigned base = 0u; if (lane_id() == 0) base = __hip_atomic_fetch_add(head, (unsigned)QCH, RLX_AGENT);
        base = (unsigned)__builtin_amdgcn_readfirstlane((int)base);
        if (base >= (unsigned)NIT) break;
        const int lo = (int)base, hi = lo + QCH;
        static_assert(NITEMS1 % 8 == 0 && NITEMS2 % 8 == 0 && I_QB % 8 == 0, "chunks never straddle a list end or the scalar-path boundary");
        if (lo < NSC) {
#pragma unroll 1
            for (int it = lo; it < hi; ++it) p0_transpose_item<2>(A.in[16], 896, 3072, 3072, (bf16*)(F.ws + WS_WQB), 0, scr, it, lane_id());
        } else {
            f32x4 va[8], vb[8];
            { const XItem x = list_item<LIST>(A, F.ws, lo); xitem_load(x, lane_id(), va); }
#pragma unroll 1
            for (int it = lo; it < hi; it += 2) {
                { const XItem x = list_item<LIST>(A, F.ws, it + 1); xitem_load(x, lane_id(), vb); }
                { const XItem x = list_item<LIST>(A, F.ws, it); xitem_finish(x, lane_id(), va, scr); }
                if (it + 2 < hi) { const XItem x = list_item<LIST>(A, F.ws, it + 2); xitem_load(x, lane_id(), va); }
                { const XItem x = list_item<LIST>(A, F.ws, it + 1); xitem_finish(x, lane_id(), vb, scr); }
            }
        }
    }
}
__device__ __forceinline__ void p0_prologue(Frame& F, const Args& A) {
    LAS float* scr = (LAS float*)(F.lds + RING_OFF + F.wave * 16384);
    const int gw = F.vcu * NWAVES + F.wave, NGW = F.G * NWAVES;
    unsigned char* ws = F.ws;
    for (int it = gw; it < I_IN; it += NGW) p0_transpose_item<1>(A.in[8], 4096, 15808, cfg::NINP, (bf16*)(ws + WS_WIN), 0, scr, it, lane_id());
    for (int m = gw; m < cfg::M; m += NGW) { const float* xr = m < cfg::TP ? A.in[0] + (size_t)m * 4096 : A.in[1] + (size_t)(m - cfg::TP) * 4096;
        rms_row4096<bf16>(xr, A.in[7], (bf16*)(ws + WS_XN) + (size_t)m * 4096, lane_id()); }
    const int gt = gw * 64 + lane_id(), NGT = NGW * 64;
    float* tabA = (float*)(ws + WS_TABA); float* tabB = (float*)(ws + WS_TABB);
    for (int i = gt; i < 8192 * 40; i += NGT) {
        int pos, fi; float ex; float* dst;
        if (i < 8192 * 8) { pos = i >> 3; fi = i & 7; ex = (float)fi * (1.f / 8.f); dst = tabA + (size_t)i * 2; }
        else { const int k = i - 8192 * 8; pos = k >> 5; fi = k & 31; ex = (float)fi * (1.f / 32.f); dst = tabB + (size_t)k * 2; }
        const float inv = exp2f(-ex * 18.931568569324174f);
        const float ang = (float)pos * inv;
        double rev = (double)ang * 0.15915494309189535; rev -= __builtin_floor(rev);
        const float fr = (float)rev;
        dst[0] = __builtin_amdgcn_cosf(fr); dst[1] = __builtin_amdgcn_sinf(fr);
    }
    { const float* src = A.in[4]; bf16* dst = (bf16*)(ws + WS_CKV) + (size_t)cfg::TP * 512;
      for (int i = gt; i < 16384 * 512 / 8; i += NGT) { const f32x4 a = *(const GAS f32x4*)(src + (size_t)i * 8), b = *(const GAS f32x4*)(src + (size_t)i * 8 + 4);
          v4u o; o.x = pk2(a.x, a.y); o.y = pk2(a.z, a.w); o.z = pk2(b.x, b.y); o.w = pk2(b.z, b.w); *(GAS v4u*)(dst + (size_t)i * 8) = o; } }
    { const float* src = A.in[5]; bf16* dst = (bf16*)(ws + WS_KPE) + (size_t)cfg::TP * 64;
      for (int i = gt; i < 16384 * 8; i += NGT) { const int row = i >> 3, c = i & 7; const f32x4 a = *(const GAS f32x4*)(src + (size_t)row * 64 + 4 * c), b = *(const GAS f32x4*)(src + (size_t)row * 64 + 32 + 4 * c);
          v4u o; o.x = pk2(a.x, b.x); o.y = pk2(a.y, b.y); o.z = pk2(a.z, b.z); o.w = pk2(a.w, b.w); *(GAS v4u*)(dst + (size_t)row * 64 + 8 * c) = o; } }
}
__device__ __forceinline__ void p2_latents(Frame& F, const Args& A) {
    const int gw = F.vcu * NWAVES + F.wave, NGW = F.G * NWAVES, lane = lane_id();
    unsigned char* ws = F.ws; const float* g_qa = A.in[15]; const float* g_kva = A.in[17]; const float* tabB = (const float*)(ws + WS_TABB);
    for (int m = gw; m < cfg::M; m += NGW) {
        const float* raw = (const float*)(ws + WS_RAW) + (size_t)m * cfg::NRAW;
        const bool smp = m >= cfg::TP; const int pos = smp ? 2048 + (m & 63) : m; const size_t mk = smp ? (size_t)m + 16384 : (size_t)m;
        const GAS f32x4* raw4 = (const GAS f32x4*)raw; f32x4 q[4], kx[2]; float s = 0.f, s2 = 0.f;
#pragma unroll
        for (int j = 0; j < 4; ++j) { const int idx = 64 * j + lane; q[j] = idx < 224 ? raw4[idx] : (f32x4){0.f, 0.f, 0.f, 0.f}; }
#pragma unroll
        for (int j = 0; j < 2; ++j) kx[j] = raw4[224 + 64 * j + lane];
#pragma unroll
        for (int j = 0; j < 4; ++j) s += (q[j].x * q[j].x + q[j].y * q[j].y) + (q[j].z * q[j].z + q[j].w * q[j].w);
#pragma unroll
        for (int j = 0; j < 2; ++j) s2 += (kx[j].x * kx[j].x + kx[j].y * kx[j].y) + (kx[j].z * kx[j].z + kx[j].w * kx[j].w);
        float rstd = rsqrtf(wave_sum(s) * (1.f / 896.f) + cfg::EPS);
        bf16* cq = (bf16*)(ws + WS_CQN) + (size_t)m * 896;
#pragma unroll
        for (int j = 0; j < 4; ++j) { const int idx = 64 * j + lane; if (idx < 224) { const f32x4 g = ((const GAS f32x4*)g_qa)[idx]; const f32x4 y = q[j] * rstd * g;
            ((GAS unsigned long long*)cq)[idx] = (unsigned long long)pk2(y.x, y.y) | ((unsigned long long)pk2(y.z, y.w) << 32); } }
        rstd = rsqrtf(wave_sum(s2) * (1.f / 512.f) + cfg::EPS);
        float* co = smp ? F.out + cfg::O_CKVS + (size_t)(m - cfg::TP) * 512 : F.out + cfg::O_CKVP + (size_t)m * 512;
        bf16* ck = (bf16*)(ws + WS_CKV) + mk * 512;
#pragma unroll
        for (int j = 0; j < 2; ++j) { const int idx = 64 * j + lane; const f32x4 g = ((const GAS f32x4*)g_kva)[idx]; const f32x4 y = kx[j] * rstd * g;
            ((GAS f32x4*)co)[idx] = y; ((GAS unsigned long long*)ck)[idx] = (unsigned long long)pk2(y.x, y.y) | ((unsigned long long)pk2(y.z, y.w) << 32); }
        if (lane < 32) { const float x1 = raw[1408 + lane], x2 = raw[1440 + lane]; const float c = tabB[((size_t)pos * 32 + lane) * 2], sn = tabB[((size_t)pos * 32 + lane) * 2 + 1];
            const float o1 = x1 * c - x2 * sn, o2 = x2 * c + x1 * sn;
            float* ko = smp ? F.out + cfg::O_KPES + (size_t)(m - cfg::TP) * 64 : F.out + cfg::O_KPEP + (size_t)m * 64;
            ko[lane] = o1; ko[32 + lane] = o2;
            ((GAS unsigned*)((bf16*)(ws + WS_KPE) + mk * 64))[lane] = pk2(o1, o2); }
    }
}
__device__ __forceinline__ void p9_fix(Frame& F, const Args& A) {
    const int gt = (F.vcu * NWAVES + F.wave) * 64 + lane_id(), NGT = F.G * NWAVES * 64;
    const float* topug = (const float*)(F.ws + WS_TOPUG); const float* topu = (const float*)(F.ws + WS_TOPU); const float* bot = (const float*)(F.ws + WS_BOT);
    bf16* ACT = (bf16*)(F.ws + WS_U); const float* wc = A.in[25]; const float* bc = A.in[26];
    constexpr int NCC = cfg::DFF / 8;
    for (int it = gt; it < 31 * 2 * NCC; it += NGT) {
        const int pj = it / NCC, cc = it - pj * NCC, pm = 1 + (pj >> 1), j = pj & 1, col = cc * 8;
        const float* x0 = topug + (size_t)(pm * 2 + j) * cfg::DFF + col;
        const float* x1 = j ? topug + (size_t)(pm * 2) * cfg::DFF + col : bot + (size_t)((pm - 1) * 2 + 1) * cfg::DFF + col;
        const float* x2 = j ? bot + (size_t)((pm - 1) * 2 + 1) * cfg::DFF + col : bot + (size_t)((pm - 1) * 2) * cfg::DFF + col;
        const float* uu = topu + (size_t)(pm * 2 + j) * cfg::DFF + col;
        float a[8];
#pragma unroll
        for (int e = 0; e < 8; ++e) { const float c = bc[col + e] + wc[col + e] * x2[e] + wc[cfg::DFF + col + e] * x1[e] + wc[2 * cfg::DFF + col + e] * x0[e]; a[e] = c * __builtin_amdgcn_rcpf(1.f + __expf(-c)) * uu[e]; }
        v4u o; o.x = pk2(a[0], a[1]); o.y = pk2(a[2], a[3]); o.z = pk2(a[4], a[5]); o.w = pk2(a[6], a[7]);
        *(GAS v4u*)(ACT + (size_t)(pm * 256 + j) * cfg::DFF + col) = o;
    }
}
__device__ __forceinline__ void p4_attention(Frame& F, const Args& A, char* lds) {
    using att::bf16_t; using att::Src;
    unsigned char* ws = F.ws; const int wid = F.wave;
    const bf16_t* QA = (const bf16_t*)(ws + WS_QA); const bf16_t* KA = (const bf16_t*)(ws + WS_KA); const bf16_t* VA = (const bf16_t*)(ws + WS_VA);
    const bf16_t* QB = (const bf16_t*)(ws + WS_QB); const bf16_t* KVB = (const bf16_t*)(ws + WS_KVB); const bf16_t* KPE = (const bf16_t*)(ws + WS_KPE);
    bf16_t* OA = (bf16_t*)(ws + WS_OA); bf16_t* OB = OA + 2048;
    float lam;
    { const float a = A.in[9][lane_id()] * A.in[10][lane_id()], b = A.in[11][lane_id()] * A.in[12][lane_id()]; lam = __expf(wave_sum(a)) - __expf(wave_sum(b)) + 0.2f; }
    const float* g_subln = A.in[13];
    { const int v = F.vcu & 255;
        float* stash = (float*)(ws + WS_STASH) + (size_t)v * 8 * 4096;
        const int h = v >> 4, s = v & 15;
#ifndef ATT_SEL
#define ATT_SEL 7
#endif
#pragma unroll 1
        for (int k = 0; k < ((ATT_SEL & 1) ? 2 : 0); ++k) {
            const int qb = k ? 31 - s : s, NT = 4 * qb + 4, limit = 4 * qb + (wid >> 1);
            Src<bf16_t> S1{KA + h * 64, KA + h * 64, nullptr, nullptr, VA + h * 128, VA + h * 128, NT, NT};
            Src<bf16_t> S2{KA + (16 + h) * 64, KA + (16 + h) * 64, nullptr, nullptr, VA + h * 128, VA + h * 128, NT, NT};
            att::diff_unit<bf16_t>(QA, (long)qb * 256, h, S1, S2, NT, limit, true, lam, g_subln, stash, OA, lds);
        }
#pragma unroll 1
        for (int k = 0; k < ((ATT_SEL & 2) ? 3 : 0); ++k) {
            if (k < 2) { const int qb = k ? 31 - s : s, NT = 4 * qb + 4, limit = 4 * qb + (wid >> 1);
                Src<bf16_t> S{KVB + h * 256, KVB + h * 256, KPE, KPE, KVB + h * 256 + 128, KVB + h * 256 + 128, NT, NT};
                att::mla_unit(QB, (long)qb * 256, h, S, NT, limit, true, OB, lds);
            } else if (v >= 128) { const int b = (v - 128) >> 4, hh = v & 15;
                const bf16_t* kp = KVB + (size_t)(cfg::TP + b * 2048) * 4096 + hh * 256; const bf16_t* kn = KVB + (size_t)(cfg::TP + 16384 + b * 64) * 4096 + hh * 256;
                Src<bf16_t> S{kp, kn, KPE + (size_t)(cfg::TP + b * 2048) * 64, KPE + (size_t)(cfg::TP + 16384 + b * 64) * 64, kp + 128, kn + 128, 32, 33};
                att::mla_unit(QB, (long)cfg::TP + b * 64, hh, S, 34, 32, wid < 2, OB, lds);
            }
        }
        if ((ATT_SEL & 4) && v < 128) { const int b = v >> 4, hh = v & 15;
            const float* kp = A.in[2] + (size_t)b * 2048 * 2048 + hh * 64; const float* kn = F.out + cfg::O_DKS + (size_t)b * 64 * 2048 + hh * 64;
            const float* vp = A.in[3] + (size_t)b * 2048 * 2048 + hh * 128; const float* vn = F.out + cfg::O_DVS + (size_t)b * 64 * 2048 + hh * 128;
            Src<float> S1{kp, kn, nullptr, nullptr, vp, vn, 32, 33};
            Src<float> S2{kp + 16 * 64, kn + 16 * 64, nullptr, nullptr, vp, vn, 32, 33};
            att::diff_unit<float>(QA, (long)cfg::TP + b * 64, hh, S1, S2, 34, 32, wid < 2, lam, g_subln, stash, OA, lds);
        }
    }
}

__global__ void __launch_bounds__(NWAVES * 64, 2) fwd(Args args) {
    extern __shared__ __attribute__((aligned(16))) unsigned char lds[];
    Frame F;
    F.lds = (LAS unsigned char*)lds; F.MISC = (volatile LAS unsigned*)(F.lds + MISC_OFF);
    F.tid = threadIdx.x; F.wave = __builtin_amdgcn_readfirstlane(F.tid >> 6);
    F.G = gridDim.x; { const int bx = blockIdx.x; F.vcu = (F.G % 8 == 0) ? (bx % 8) * (F.G / 8) + bx / 8 : bx; }
    F.out = args.out; F.ws = args.ws; unsigned char* ws = args.ws;
    F.ctl = (gu32*)(ws + WS_CTL);
    for (int u = F.tid; u < (LDS_BYTES - LDSCTL_OFF) / 4; u += NWAVES * 64) ((LAS unsigned*)(F.lds + LDSCTL_OFF))[u] = 0u;
    __syncthreads();
    XcdBarrier bar; bar.bar = (unsigned*)(F.ctl + CW_BAR); bar.x = 0; bar.st = nullptr;
    if (N_LAUNCHES == 1) bar = xcd_barrier_post((unsigned*)(F.ctl + CW_BAR), F.MISC + 8);
#define GRID_BAR() do { if (N_LAUNCHES == 1) xcd_barrier(bar); } while (0)
    const int lo = args.ph_lo, hi = args.ph_hi;
#ifndef PH_MASK
#define PH_MASK 0xFFF
#endif
#define IN(k) (((PH_MASK >> (k)) & 1) && lo <= (k) && (k) < hi)
    typedef pg8::bf16_t pb;
    float* Y = args.out + cfg::O_Y;

    if (IN(0)) { p0_prologue(F, args); GRID_BAR(); }
#ifdef DUP_P0
    if (IN(0)) { p0_prologue(F, args); GRID_BAR(); }
#endif
#ifndef DUP_PH
#define DUP_PH -1
#endif
    if (IN(1)) {
        if (blockIdx.x < P1_GEMM_WGS) {
        pg8::Gemm g{(const pb*)(ws + WS_XN), (const pb*)(ws + WS_WIN), cfg::M, cfg::NINP, 4096}; pg8::StaticOrder S; S.init(cfg::M, cfg::NINP, P1_GEMM_WGS, (int)blockIdx.x);
        pg8::EpiIn E{(pb*)(ws + WS_QA), (pb*)(ws + WS_KA), (pb*)(ws + WS_VA), (pb*)(ws + WS_G), (float*)(ws + WS_RAW), args.out, args.in[20], (const float*)(ws + WS_TABA)};
        pg8::gemm_phase<pg8::EpiIn, pg8::StaticOrder, true, PG8_SP2>(F.lds + RING_OFF, g, S, E);
        }
        __syncthreads(); convert_queue<1>(F, args);
        GRID_BAR();
    }
#if DUP_PH == 1
    if (IN(1)) {
        if (blockIdx.x < P1_GEMM_WGS) {
        pg8::Gemm g{(const pb*)(ws + WS_XN), (const pb*)(ws + WS_WIN), cfg::M, cfg::NINP, 4096}; pg8::StaticOrder S; S.init(cfg::M, cfg::NINP, P1_GEMM_WGS, (int)blockIdx.x);
        pg8::EpiIn E{(pb*)(ws + WS_QA), (pb*)(ws + WS_KA), (pb*)(ws + WS_VA), (pb*)(ws + WS_G), (float*)(ws + WS_RAW), args.out, args.in[20], (const float*)(ws + WS_TABA)};
        pg8::gemm_phase<pg8::EpiIn, pg8::StaticOrder, true, PG8_SP2>(F.lds + RING_OFF, g, S, E);
        }
        __syncthreads(); convert_queue<1>(F, args);
        GRID_BAR();
    }
#endif
    if (IN(2)) { p2_latents(F, args); GRID_BAR(); }
    if (IN(3)) {
        { pg8::Gemm g{(const pb*)(ws + WS_CQN), (const pb*)(ws + WS_WQB), cfg::M, cfg::NQB, 896}; pg8::StaticOrder S; S.init(cfg::M, cfg::NQB, F.G, (int)blockIdx.x);
          pg8::EpiQB E{(pb*)(ws + WS_QB), (const float*)(ws + WS_TABB)};
          pg8::gemm_phase<pg8::EpiQB, pg8::StaticOrder, true, PG8_SP2>(F.lds + RING_OFF, g, S, E); }
        __syncthreads();
        { pg8::Gemm g{(const pb*)(ws + WS_CKV), (const pb*)(ws + WS_WKVB), cfg::MKV, cfg::NKVBO, 512}; pg8::StaticOrder S; S.init(cfg::MKV, cfg::NKVBO, F.G, (int)((blockIdx.x + F.G / 2) % F.G));
          pg8::EpiPlain E{(pb*)(ws + WS_KVB), cfg::NKVBO};
          pg8::gemm_phase<pg8::EpiPlain, pg8::StaticOrder, true, PG8_SP2>(F.lds + RING_OFF, g, S, E); }
        GRID_BAR();
    }
    if (IN(4)) { p4_attention(F, args, (char*)lds + RING_OFF); GRID_BAR(); }
#ifdef DUP_P4
    if (IN(4)) { p4_attention(F, args, (char*)lds + RING_OFF); GRID_BAR(); }
#endif
    if (IN(5)) {
        { pg8::Gemm g{(const pb*)(ws + WS_OA), (const pb*)(ws + WS_WBA), cfg::M, 4096, 4096}; pg8::SplitTailOrder2 S; S.init(4096, (int)blockIdx.x);
          pg8::EpiY E{(const pb*)(ws + WS_G), (pb*)(ws + WS_MB), (float*)(ws + WS_SLAB_A)};
          pg8::gemm_phase<pg8::EpiY, pg8::SplitTailOrder2, true, PG8_SP2>(F.lds + RING_OFF, g, S, E); }
        GRID_BAR();
        p5c_merge_sample(F);
        GRID_BAR();
    }
    if (IN(6)) {
        pg8::Gemm g{(const pb*)(ws + WS_MB), (const pb*)(ws + WS_WOUT), cfg::M, 4096, 4096}; pg8::SplitTailOrder S; S.init(4096, (int)blockIdx.x);
        pg8::EpiRes E{args.in[0], args.in[1], Y, (float*)(ws + WS_SLAB_A)};
        pg8::gemm_phase<pg8::EpiRes, pg8::SplitTailOrder, true, PG8_SP2>(F.lds + RING_OFF, g, S, E);
        GRID_BAR();
    }
#if DUP_PH == 6
    if (IN(6)) {
        pg8::Gemm g{(const pb*)(ws + WS_MB), (const pb*)(ws + WS_WOUT), cfg::M, 4096, 4096}; pg8::SplitTailOrder S; S.init(4096, (int)blockIdx.x);
        pg8::EpiRes E{args.in[0], args.in[1], Y, (float*)(ws + WS_SLAB_A)};
        pg8::gemm_phase<pg8::EpiRes, pg8::SplitTailOrder, true, PG8_SP2>(F.lds + RING_OFF, g, S, E);
        GRID_BAR();
    }
#endif
    if (IN(7)) {
        const int gw = F.vcu * NWAVES + F.wave, NGW = F.G * NWAVES;
        sample_rows_norm<bf16>(F, args.in[1], (const float*)(ws + WS_SLAB_A), Y + (size_t)cfg::TP * 4096, args.in[22], (bf16*)(ws + WS_XN) + (size_t)cfg::TP * 4096, (LAS float*)(F.lds + RING_OFF));
        for (int m = gw; m < cfg::TP; m += NGW) rms_row4096<bf16>(Y + (size_t)m * 4096, args.in[22], (bf16*)(ws + WS_XN) + (size_t)m * 4096, lane_id());
        GRID_BAR();
    }
    if (IN(8)) {
        if (blockIdx.x < P8_GEMM_WGS) {
        pg8::Gemm g{(const pb*)(ws + WS_XN), (const pb*)(ws + WS_WGU), cfg::M, 2 * cfg::DFF, 4096}; pg8::StaticOrder S; S.init(cfg::M, 2 * cfg::DFF, P8_GEMM_WGS, (int)blockIdx.x);
        pg8::EpiGU2 E{(pb*)(ws + WS_U), args.out, args.in[25], args.in[26], args.in[6], (float*)(ws + WS_TOPUG), (float*)(ws + WS_TOPU), (float*)(ws + WS_BOT), (LAS float*)(F.lds + XCH_OFF)};
        pg8::gemm_phase<pg8::EpiGU2, pg8::StaticOrder, true, PG8_SP2>(F.lds + RING_OFF, g, S, E);
        }
        __syncthreads(); convert_queue<2>(F, args);
        GRID_BAR();
    }
#if DUP_PH == 8
    if (IN(8)) {
        if (blockIdx.x < P8_GEMM_WGS) {
        pg8::Gemm g{(const pb*)(ws + WS_XN), (const pb*)(ws + WS_WGU), cfg::M, 2 * cfg::DFF, 4096}; pg8::StaticOrder S; S.init(cfg::M, 2 * cfg::DFF, P8_GEMM_WGS, (int)blockIdx.x);
        pg8::EpiGU2 E{(pb*)(ws + WS_U), args.out, args.in[25], args.in[26], args.in[6], (float*)(ws + WS_TOPUG), (float*)(ws + WS_TOPU), (float*)(ws + WS_BOT), (LAS float*)(F.lds + XCH_OFF)};
        pg8::gemm_phase<pg8::EpiGU2, pg8::StaticOrder, true, PG8_SP2>(F.lds + RING_OFF, g, S, E);
        }
        __syncthreads(); convert_queue<2>(F, args);
        GRID_BAR();
    }
#endif
    if (IN(9)) { p9_fix(F, args); GRID_BAR(); }
    if (IN(10)) {
        pg8::Gemm g{(const pb*)(ws + WS_U), (const pb*)(ws + WS_WFD), cfg::M, 4096, cfg::DFF}; pg8::SplitTailOrder S; S.init(cfg::DFF, (int)blockIdx.x);
        pg8::EpiRes E{Y, Y + (size_t)cfg::TP * 4096, Y, (float*)(ws + WS_SLAB_D)};
        pg8::gemm_phase<pg8::EpiRes, pg8::SplitTailOrder, true, PG8_SP2>(F.lds + RING_OFF, g, S, E);
        GRID_BAR();
    }
#if DUP_PH == 10
    if (IN(10)) {
        pg8::Gemm g{(const pb*)(ws + WS_U), (const pb*)(ws + WS_WFD), cfg::M, 4096, cfg::DFF}; pg8::SplitTailOrder S; S.init(cfg::DFF, (int)blockIdx.x);
        pg8::EpiRes E{Y, Y + (size_t)cfg::TP * 4096, Y, (float*)(ws + WS_SLAB_D)};
        pg8::gemm_phase<pg8::EpiRes, pg8::SplitTailOrder, true, PG8_SP2>(F.lds + RING_OFF, g, S, E);
        GRID_BAR();
    }
#endif
    if (IN(11)) {
        const int gw = F.vcu * NWAVES + F.wave, NGW = F.G * NWAVES;
        sample_rows_norm<float>(F, Y + (size_t)cfg::TP * 4096, (const float*)(ws + WS_SLAB_D), Y + (size_t)cfg::TP * 4096, args.in[28], Y + (size_t)cfg::TP * 4096, (LAS float*)(F.lds + RING_OFF));
        for (int m = gw; m < cfg::TP; m += NGW) rms_row4096<float>(Y + (size_t)m * 4096, args.in[28], Y + (size_t)m * 4096, lane_id());
    }
#ifdef DBG_COPY
    if (lo <= DBG_COPY && DBG_COPY < hi) {
        const size_t gt = (size_t)(F.vcu * NWAVES + F.wave) * 64 + lane_id(), NGT = (size_t)F.G * NWAVES * 64;
        const v4u* s0 = (const v4u*)(ws + WS_WQB); v4u* d0 = (v4u*)Y; const size_t n0 = (size_t)(WS_WGU - WS_WQB) / 16;
        for (size_t i = gt; i < n0; i += NGT) d0[i] = s0[i];
        const v4u* s1 = (const v4u*)(ws + WS_WFD); v4u* d1 = d0 + n0; const size_t n1 = (size_t)60000000 / 16;
        for (size_t i = gt; i < n1; i += NGT) d1[i] = s1[i];
    }
#endif
#undef IN
#undef GRID_BAR
}

extern "C" void kernel_launch(void* const* d_in, const int* in_sizes, int n_in, void* d_out, int out_size, void* d_ws, size_t ws_size, hipStream_t stream) {
    static int grid = 0;
    if (grid == 0) {
        if (n_in != 29 || in_sizes[0] != cfg::TP * 4096 || (size_t)out_size != cfg::O_END || ws_size < WS_END) {
            fprintf(stderr, "kernel_launch: shape mismatch: n_in %d in0 %d out %d ws %zu (need %zu); nothing launched\n", n_in, n_in > 0 ? in_sizes[0] : -1, out_size, ws_size, (size_t)WS_END); grid = -1; return; }
        int dev = 0, cus = 0, per_cu = 0;
        if (hipGetDevice(&dev) != hipSuccess || hipDeviceGetAttribute(&cus, hipDeviceAttributeMultiprocessorCount, dev) != hipSuccess) { grid = -1; return; }
        if (hipFuncSetAttribute((const void*)fwd, hipFuncAttributeMaxDynamicSharedMemorySize, LDS_BYTES) != hipSuccess) { fprintf(stderr, "kernel_launch: hipFuncSetAttribute failed\n"); grid = -1; return; }
        if (hipOccupancyMaxActiveBlocksPerMultiprocessor(&per_cu, (const void*)fwd, NWAVES * 64, LDS_BYTES) != hipSuccess || per_cu < 1)
            fprintf(stderr, "kernel_launch: note: occupancy query reports %d workgroups per CU\n", per_cu);
        (void)hipGetLastError();
        if (cus < 256) { fprintf(stderr, "kernel_launch: built for a 256-CU device (got %d); nothing launched\n", cus); grid = -1; return; }
        grid = 256;
    }
    if (grid < 0) return;
    if (hipMemsetAsync((char*)d_ws + WS_CTL, 0, CTL_ZERO_BYTES, stream) != hipSuccess) { fprintf(stderr, "kernel_launch: memset failed\n"); return; }
    Args a{};
    for (int i = 0; i < 29; ++i) a.in[i] = (const float*)d_in[i];
    a.out = (float*)d_out; a.ws = (unsigned char*)d_ws;
    for (int li = 0; li < N_LAUNCHES; ++li) {
        a.ph_lo = (N_LAUNCHES == 1) ? 0 : li; a.ph_hi = (N_LAUNCHES == 1) ? NPH : li + 1;
        hipLaunchKernelGGL(fwd, dim3(grid), dim3(NWAVES * 64), LDS_BYTES, stream, a);
        const hipError_t le = hipPeekAtLastError();
        if (le != hipSuccess) { fprintf(stderr, "kernel_launch: launch %d failed: %s\n", li, hipGetErrorName(le)); break; }
    }
}
```
